# Optimizing an MI355X kernel written in HIP

```python
import math
import jax, jax.numpy as jnp
from jax import lax
import numpy as np

D_MODEL = 1024
BATCH = 8
SEQ = 4096
DEPTH = 2

HEAD_DIM = 64
ATTN_SCALE = HEAD_DIM ** -0.5
QBLK = 128
A_HEADS = 8
A_LATENT = 128
IDX_HEADS = 8
IDX_DIM = 64
IDX_SCALE = (IDX_HEADS * IDX_DIM) ** -0.5
TOPK_MAX = 256
B_HEADS = 4
C_GROUPS = ((128, 1), (512, 4), (2048, 16))
C_HEADS_PER_GROUP = 4
C_HEADS = C_HEADS_PER_GROUP * len(C_GROUPS)
N_BUCKETS = 32
MAX_DISTANCE = 2048
N_BIAS_HEADS = A_HEADS + B_HEADS + C_HEADS
D_FF = -(-8 * D_MODEL // (3 * 256)) * 256
N_BRANCH = 3
IN_SPLITS = (A_HEADS * HEAD_DIM, A_LATENT, IDX_HEADS * IDX_DIM, IDX_DIM, IDX_HEADS,
             B_HEADS * 2 * HEAD_DIM, B_HEADS * 2 * HEAD_DIM, B_HEADS * 2 * HEAD_DIM,
             C_HEADS * HEAD_DIM, C_HEADS * HEAD_DIM, C_HEADS * HEAD_DIM,
             D_MODEL, D_MODEL, D_MODEL)
IN_WIDTH = sum(IN_SPLITS)
EPS = 1e-6

kernel_name = 'hybrid_dsa_diff_dilated_gated_block'


def rmsnorm(x, g):
    xf = x.astype(jnp.float32)
    y = xf * lax.rsqrt(jnp.mean(xf * xf, axis=-1, keepdims=True) + EPS)
    return (y * g.astype(jnp.float32)).astype(x.dtype)


def split_cols(t, widths):
    offs, acc = [], 0
    for w in widths[:-1]:
        acc += w
        offs.append(acc)
    return jnp.split(t, offs, axis=-1)


def rel_bucket(dist):
    max_exact = N_BUCKETS // 2
    n = jnp.maximum(dist, 0)
    nf = jnp.maximum(n, 1).astype(jnp.float32)
    large = max_exact + (jnp.log(nf / max_exact) / math.log(MAX_DISTANCE / max_exact)
                         * (N_BUCKETS - max_exact)).astype(jnp.int32)
    large = jnp.minimum(large, N_BUCKETS - 1)
    return jnp.where(n < max_exact, n, large)


def dsa_attention(q_lat, kv_lat, q_idx, k_idx, w_idx, bias_tab):
    B, S = kv_lat.shape[:2]
    topk = min(TOPK_MAX, S // 4)
    key_pos = jnp.arange(S)

    def block(i):
        start = i * QBLK
        qi = lax.dynamic_slice_in_dim(q_idx, start, QBLK, axis=1)
        wi = lax.dynamic_slice_in_dim(w_idx, start, QBLK, axis=1)
        ql = lax.dynamic_slice_in_dim(q_lat, start, QBLK, axis=1)
        q_pos = start + jnp.arange(QBLK)
        score = jnp.einsum('bqh,bqhs->bqs', wi,
                           jax.nn.relu(jnp.einsum('bqhd,bsd->bqhs', qi, k_idx))).astype(jnp.float32)
        score = jnp.where((key_pos[None, :] <= q_pos[:, None])[None], score, -jnp.inf)
        _, sel = lax.top_k(score, topk)
        kv_sel = jax.vmap(lambda kv, ix: kv[ix])(kv_lat, sel)
        dist = q_pos[None, :, None] - sel
        bias = jnp.moveaxis(bias_tab[rel_bucket(dist)], -1, 2)
        logits = jnp.einsum('bqhc,bqkc->bqhk', ql, kv_sel) * ATTN_SCALE + bias
        logits = jnp.where((dist >= 0)[:, :, None, :], logits.astype(jnp.float32), -jnp.inf)
        p = jax.nn.softmax(logits, axis=-1).astype(kv_sel.dtype)
        return jnp.einsum('bqhk,bqkc->bqhc', p, kv_sel)

    out = lax.map(block, jnp.arange(S // QBLK))
    return jnp.moveaxis(out, 0, 1).reshape(B, S, A_HEADS, -1)


def diff_attention(q, k, v, lam, bias_tab):
    B, S = q.shape[:2]
    key_pos = jnp.arange(S)

    def block(i):
        start = i * QBLK
        qb = lax.dynamic_slice_in_dim(q, start, QBLK, axis=1)
        q_pos = start + jnp.arange(QBLK)
        dist = q_pos[:, None] - key_pos[None, :]
        bias = jnp.moveaxis(bias_tab[rel_bucket(dist)], -1, 0)
        logits = jnp.einsum('bqhmd,bshmd->bmhqs', qb, k) * ATTN_SCALE + bias
        logits = jnp.where(dist >= 0, logits.astype(jnp.float32), -jnp.inf)
        p = jax.nn.softmax(logits, axis=-1)
        attn = (p[:, 0] - lam * p[:, 1]).astype(v.dtype)
        return jnp.einsum('bhqs,bshe->bqhe', attn, v)

    out = lax.map(block, jnp.arange(S // QBLK))
    return jnp.moveaxis(out, 0, 1).reshape(B, S, B_HEADS, -1)


def dilated_group(q, k, v, dil, n_back, bias_tab):
    B, S, H, E = q.shape
    M = S // dil
    nb = -(-M // n_back)
    Mp = nb * n_back

    def by_residue(t):
        return t.reshape(B, M, dil, H, E).transpose(0, 2, 1, 3, 4)

    qr = jnp.pad(by_residue(q), ((0, 0), (0, 0), (0, Mp - M), (0, 0), (0, 0))).reshape(B, dil, nb, n_back, H, E)

    def band(t):
        tp = jnp.pad(by_residue(t), ((0, 0), (0, 0), (n_back, Mp - M), (0, 0), (0, 0)))
        tp = tp.reshape(B, dil, nb + 1, n_back, H, E)
        return jnp.concatenate([tp[:, :, :-1], tp[:, :, 1:]], axis=3)

    kb, vb = band(k), band(v)
    i = jnp.arange(n_back)[:, None]
    j = jnp.arange(2 * n_back)[None, :]
    rel = i - j + n_back
    key_ok = (jnp.arange(nb)[:, None] * n_back + j - n_back) >= 0
    mask = ((rel >= 0) & (rel <= n_back))[None] & key_ok[:, None, :]
    bias = jnp.moveaxis(bias_tab[rel_bucket(rel * dil)], -1, 0)
    logits = jnp.einsum('bdcqhe,bdckhe->bdchqk', qr, kb) * ATTN_SCALE + bias
    logits = jnp.where(mask[:, None], logits.astype(jnp.float32), -jnp.inf)
    lse = jax.nn.logsumexp(logits, axis=-1)
    p = jnp.exp(logits - lse[..., None]).astype(v.dtype)
    out = jnp.einsum('bdchqk,bdckhe->bdcqhe', p, vb)
    out = out.reshape(B, dil, Mp, H, E)[:, :, :M].transpose(0, 2, 1, 3, 4).reshape(B, S, H, E)
    lse = lse.transpose(0, 1, 2, 4, 3).reshape(B, dil, Mp, H)[:, :, :M].transpose(0, 2, 1, 3).reshape(B, S, H)
    return out, lse


def dilated_attention(q, k, v, bias_tab):
    outs, lses = [], []
    for g, (window, dil) in enumerate(C_GROUPS):
        hs = slice(g * C_HEADS_PER_GROUP, (g + 1) * C_HEADS_PER_GROUP)
        o, s = dilated_group(q[:, :, hs], k[:, :, hs], v[:, :, hs], dil, window // dil, bias_tab[:, hs])
        outs.append(o)
        lses.append(s)
    alpha = jax.nn.softmax(jnp.stack(lses), axis=0).astype(q.dtype)
    return jnp.einsum('gbsh,gbshe->bshe', alpha, jnp.stack(outs))


def setup_inputs(seed: int = 0) -> dict:
    key = jax.random.key(seed)
    ks = jax.random.split(key, 24)
    f32 = jnp.float32
    nrm = lambda k, shape, s: jax.random.normal(k, shape, f32) * s
    gain = lambda k, shape: 1.0 + 0.02 * jax.random.normal(k, shape, f32)
    L, D = DEPTH, D_MODEL
    return {
        'x': nrm(ks[0], (BATCH, SEQ, D), 1.0),
        'c': nrm(ks[1], (BATCH, D), 1.0),
        'w_ada': nrm(ks[2], (L, D, 6 * D), D ** -0.5),
        'b_ada': nrm(ks[3], (L, 6 * D), 0.02),
        'g_norm1': gain(ks[4], (L, D)),
        'w_in': nrm(ks[5], (L, D, IN_WIDTH), D ** -0.5),
        'w_uk': nrm(ks[6], (L, A_HEADS, HEAD_DIM, A_LATENT), HEAD_DIM ** -0.5),
        'w_uv': nrm(ks[7], (L, A_HEADS, A_LATENT, HEAD_DIM), A_LATENT ** -0.5),
        'g_kv': gain(ks[8], (L, A_LATENT)),
        'lam_q1': nrm(ks[9], (L, HEAD_DIM), 0.1),
        'lam_k1': nrm(ks[10], (L, HEAD_DIM), 0.1),
        'lam_q2': nrm(ks[11], (L, HEAD_DIM), 0.1),
        'lam_k2': nrm(ks[12], (L, HEAD_DIM), 0.1),
        'g_subln': gain(ks[13], (L, 2 * HEAD_DIM)),
        'w_branch_a': nrm(ks[14], (L, A_HEADS * HEAD_DIM, D), (A_HEADS * HEAD_DIM) ** -0.5),
        'w_branch_b': nrm(ks[15], (L, B_HEADS * 2 * HEAD_DIM, D), (B_HEADS * 2 * HEAD_DIM) ** -0.5),
        'w_branch_c': nrm(ks[16], (L, C_HEADS_PER_GROUP * HEAD_DIM, D), (C_HEADS_PER_GROUP * HEAD_DIM) ** -0.5),
        'w_out': nrm(ks[17], (L, D, D), D ** -0.5),
        'g_norm2': gain(ks[18], (L, D)),
        'w_gate_up': nrm(ks[19], (L, D, 2 * D_FF), D ** -0.5),
        'w_down': nrm(ks[20], (L, D_FF, D), D_FF ** -0.5),
        'rel_bias': nrm(ks[21], (N_BUCKETS, N_BIAS_HEADS), 0.5),
        'g_final': gain(ks[22], (D,)),
    }


def reference(x, c, w_ada, b_ada, g_norm1, w_in, w_uk, w_uv, g_kv, lam_q1, lam_k1, lam_q2, lam_k2,
              g_subln, w_branch_a, w_branch_b, w_branch_c, w_out, g_norm2, w_gate_up, w_down,
              rel_bias, g_final):
    B, S, D = x.shape
    bias_a = rel_bias[:, :A_HEADS]
    bias_b = rel_bias[:, A_HEADS:A_HEADS + B_HEADS]
    bias_c = rel_bias[:, A_HEADS + B_HEADS:]
    c_act = jax.nn.silu(c)
    for l in range(DEPTH):
        mod = (c_act @ w_ada[l] + b_ada[l])[:, None, :]
        sh1, sc1, gt1, sh2, sc2, gt2 = jnp.split(mod, 6, axis=-1)
        h = rmsnorm(x, g_norm1[l]) * (1 + sc1) + sh1
        (a_q, a_kv, i_q, i_k, i_w, b_q, b_k, b_v, c_q, c_k, c_v,
         z_a, z_b, z_c) = split_cols(h @ w_in[l], IN_SPLITS)
        q_lat = jnp.einsum('bshd,hdc->bshc', a_q.reshape(B, S, A_HEADS, HEAD_DIM), w_uk[l])
        kv_lat = rmsnorm(a_kv, g_kv[l])
        o_lat = dsa_attention(q_lat, kv_lat, i_q.reshape(B, S, IDX_HEADS, IDX_DIM), i_k,
                              i_w * IDX_SCALE, bias_a)
        o_a = jnp.einsum('bshc,hce->bshe', o_lat, w_uv[l]).reshape(B, S, -1)
        lam_init = 0.8 - 0.6 * math.exp(-0.3 * l)
        lam = (jnp.exp(jnp.sum(lam_q1[l] * lam_k1[l]).astype(jnp.float32))
               - jnp.exp(jnp.sum(lam_q2[l] * lam_k2[l]).astype(jnp.float32)) + lam_init)
        o_b = diff_attention(b_q.reshape(B, S, B_HEADS, 2, HEAD_DIM), b_k.reshape(B, S, B_HEADS, 2, HEAD_DIM),
                             b_v.reshape(B, S, B_HEADS, 2 * HEAD_DIM), lam, bias_b)
        o_b = (rmsnorm(o_b, g_subln[l]) * (1 - lam_init)).reshape(B, S, -1)
        o_c = dilated_attention(c_q.reshape(B, S, C_HEADS, HEAD_DIM), c_k.reshape(B, S, C_HEADS, HEAD_DIM),
                                c_v.reshape(B, S, C_HEADS, HEAD_DIM), bias_c).reshape(B, S, -1)
        merged = (jax.nn.sigmoid(z_a) * (o_a @ w_branch_a[l])
                  + jax.nn.sigmoid(z_b) * (o_b @ w_branch_b[l])
                  + jax.nn.sigmoid(z_c) * (o_c @ w_branch_c[l]))
        x = x + gt1 * (merged @ w_out[l])
        h2 = rmsnorm(x, g_norm2[l]) * (1 + sc2) + sh2
        f_g, f_u = jnp.split(h2 @ w_gate_up[l], 2, axis=-1)
        x = x + gt2 * ((jax.nn.silu(f_g) * f_u) @ w_down[l])
    return rmsnorm(x, g_final)
```

```cpp
#include <hip/hip_runtime.h>
#include <cstdio>
#include <cstdint>
namespace pg8 {
#define PG8_LAS __attribute__((address_space(3)))
typedef unsigned short bf16_t;
typedef short bf16x8 __attribute__((ext_vector_type(8)));
typedef float f32x4 __attribute__((ext_vector_type(4)));
typedef unsigned u32x4 __attribute__((ext_vector_type(4)));
constexpr int BM = 256, BK = 64, HALF = 128, HTB = HALF * BK * 2  , STAGE_BYTES = 8 * HTB, NXCD = 8, WGM = 8;

__host__ __device__ __forceinline__ int lds_byte(int r, int c) { const int st = (r >> 4) * 2 + (c >> 5), rr = r & 15, cc = c & 31, ob = rr * 64 + cc * 2; return st * 1024 + (ob ^ (((ob >> 9) & 1) << 5)); }
__host__ __device__ __forceinline__ void stage_rc(int b, int& R, int& C) { const int st = b / 1024, sb = b % 1024, swz = sb ^ (((sb >> 9) & 1) << 5); R = (st >> 1) * 16 + swz / 64; C = (st & 1) * 32 + (swz % 64) / 2; }
__host__ __device__ __forceinline__ int perm32(int rho) { const int n = rho >> 4, i = rho & 15; return 8 * (i >> 2) + 4 * n + (i & 3); }

struct Unit { int pm, pn; };
struct Gemm { const bf16_t* A; const bf16_t* Bt; int M, N, K; };

struct StaticOrder {
    int nM, nN, nwg, G, c;
    __host__ __device__ void init(int M, int N, int G_, int c_) { nM = M / BM; nN = N / BM; nwg = nM * nN; G = G_; c = c_; }
    __host__ __device__ bool next(int i, Unit& u) const {
        const long L = (long)i * G + c; if (L >= nwg) return false;
        int wgid = (int)L; { const int q = nwg / NXCD, r = nwg % NXCD, xcd = wgid % NXCD, off = wgid / NXCD; wgid = (xcd < r ? xcd * (q + 1) : r * (q + 1) + (xcd - r) * q) + off; }
        const int nig = WGM * nN, gid = wgid / nig, fm = gid * WGM, gsz = (nM - fm) < WGM ? (nM - fm) : WGM;
        u.pm = fm + ((wgid % nig) % gsz); u.pn = (wgid % nig) / gsz; return true;
    }
    __device__ __forceinline__ void a_ready(const Unit&) const {}
    __device__ __forceinline__ void done(const Unit&) const {}
};

template <class Epi, class Sched, bool ALIGN_EPI = false, bool SP2 = false>
__device__ __forceinline__ void gemm_phase(PG8_LAS unsigned char* lds, const Gemm g, const Sched& S, const Epi& E) {
    int tid_l = threadIdx.x; asm volatile("" : "+v"(tid_l));
    const int tid = tid_l, wid = __builtin_amdgcn_readfirstlane(tid >> 6), lane = tid & 63, wr = wid >> 2, wc = wid & 3, fr = lane & 15, fq = lane >> 4;
    int K_l = g.K; asm volatile("" : "+s"(K_l));
    const int K = K_l, nt = K / BK;
    unsigned voffA[2], voffB[2];
#pragma unroll
    for (int i = 0; i < 2; ++i) { int R, C; stage_rc(tid * 16 + i * 8192, R, C); const int Rb = Epi::PERM ? ((R & ~31) + perm32(R & 31)) : R;
        voffA[i] = (unsigned)(R * K + C) * 2u; voffB[i] = (unsigned)(Rb * K + C) * 2u; }
    const size_t kstep = (size_t)(BK * 2);
    const size_t hstep = (size_t)HALF * K * 2;
    const size_t tstep = 2 * hstep;
    const unsigned ldsw = (unsigned)wid * 1024u;
    const int aoff = lds_byte(wr * 64 + fr, fq * 8), boff = lds_byte(wc * 32 + fr, fq * 8);
#define PG8_SA(b, h) (((b) * 2 + (h)) * HTB)
#define PG8_SB(b, h) ((4 + (b) * 2 + (h)) * HTB)
#define PG8_STAGE(bufoff, gbase, voff) do { _Pragma("unroll") for (int _i = 0; _i < 2; ++_i) \
        __builtin_amdgcn_global_load_lds((const unsigned*)((const char*)(gbase) + (voff)[_i]), (PG8_LAS unsigned*)(lds + (bufoff) + ldsw + _i * 8192), 16, 0, 0); } while (0)
#define PG8_LDA(dst, b, h) do { _Pragma("unroll") for (int m = 0; m < 4; ++m) _Pragma("unroll") for (int k = 0; k < 2; ++k) dst[m][k] = *(const PG8_LAS bf16x8*)(lds + PG8_SA(b, h) + aoff + m * 2048 + k * 1024); } while (0)
#define PG8_LDB(dst, b, h) do { _Pragma("unroll") for (int n = 0; n < 2; ++n) _Pragma("unroll") for (int k = 0; k < 2; ++k) dst[n][k] = *(const PG8_LAS bf16x8*)(lds + PG8_SB(b, h) + boff + n * 2048 + k * 1024); } while (0)
#define PG8_MMA(ai, bj, At, Bt) do { __builtin_amdgcn_s_setprio(1); _Pragma("unroll") for (int m = 0; m < 4; ++m) _Pragma("unroll") for (int n = 0; n < 2; ++n) _Pragma("unroll") for (int k = 0; k < 2; ++k) \
        acc[ai][bj][m][n] = __builtin_amdgcn_mfma_f32_16x16x32_bf16(Bt[n][k], At[m][k], acc[ai][bj][m][n], 0, 0, 0); __builtin_amdgcn_s_setprio(0); } while (0)
#define PG8_WAIT_V(n) asm volatile("s_waitcnt vmcnt(" #n ")" ::: "memory")
#define PG8_WAIT_L(n) asm volatile("s_waitcnt lgkmcnt(" #n ")" ::: "memory")
#define PG8_BAR __builtin_amdgcn_s_barrier()
#define PG8_SCHED __builtin_amdgcn_sched_barrier(0)
    Unit cur, nxt; int ui = 0;
    if (!S.next(0, cur)) return;
    f32x4 acc[2][2][4][2];
#pragma unroll
    for (int a = 0; a < 2; ++a)
#pragma unroll
        for (int b = 0; b < 2; ++b)
#pragma unroll
            for (int m = 0; m < 4; ++m)
#pragma unroll
                for (int n = 0; n < 2; ++n) acc[a][b][m][n] = (f32x4){0.f, 0.f, 0.f, 0.f};
    bf16x8 At[4][2], B0[2][2], B1[2][2];
    const char* cA = (const char*)g.A + (size_t)cur.pm * tstep; const char* cB = (const char*)g.Bt + (size_t)cur.pn * tstep;
    S.a_ready(cur);
    if constexpr (SP2) {
        PG8_STAGE(PG8_SB(0, 0), cB, voffB); PG8_STAGE(PG8_SB(0, 1), cB + hstep, voffB); PG8_STAGE(PG8_SA(0, 0), cA, voffA); PG8_STAGE(PG8_SA(0, 1), cA + hstep, voffA);
        if (wr == 1) PG8_BAR;
        PG8_WAIT_V(2); PG8_BAR;
        PG8_STAGE(PG8_SB(1, 0), cB + kstep, voffB); PG8_STAGE(PG8_SA(1, 0), cA + kstep, voffA); PG8_STAGE(PG8_SB(1, 1), cB + hstep + kstep, voffB);
        PG8_WAIT_V(6); PG8_BAR;
    } else {
        PG8_STAGE(PG8_SB(0, 0), cB, voffB); PG8_STAGE(PG8_SA(0, 0), cA, voffA); PG8_STAGE(PG8_SB(0, 1), cB + hstep, voffB); PG8_STAGE(PG8_SA(0, 1), cA + hstep, voffA);
        if (wr == 1) PG8_BAR;
        PG8_WAIT_V(4); PG8_BAR;
        PG8_STAGE(PG8_SB(1, 0), cB + kstep, voffB); PG8_STAGE(PG8_SA(1, 0), cA + kstep, voffA); PG8_STAGE(PG8_SB(1, 1), cB + hstep + kstep, voffB);
        PG8_WAIT_V(6); PG8_BAR;
    }
    for (;;) {
        const bool has_next = S.next(ui + 1, nxt);
        const char* nA = has_next ? (const char*)g.A + (size_t)nxt.pm * tstep : cA; const char* nB = has_next ? (const char*)g.Bt + (size_t)nxt.pn * tstep : cB;
        for (int t = 0; t < nt; t += 2) {
            const bool last = (t == nt - 2);
            const char* a1 = cA + (size_t)(t + 1) * kstep;
            const char* a2 = last ? nA : cA + (size_t)(t + 2) * kstep; const char* b2 = last ? nB : cB + (size_t)(t + 2) * kstep;
            const char* a3 = a2 + kstep; const char* b3 = b2 + kstep;
            if (last && has_next) S.a_ready(nxt);
            if constexpr (SP2) {
            PG8_LDB(B0, 0, 0); PG8_LDB(B1, 0, 1); PG8_SCHED; PG8_LDA(At, 0, 0); PG8_STAGE(PG8_SA(1, 1), a1 + hstep, voffA);
            PG8_WAIT_V(8); PG8_WAIT_L(0); PG8_BAR; PG8_MMA(0, 0, At, B0); PG8_MMA(0, 1, At, B1); PG8_BAR; PG8_SCHED;
            PG8_LDA(At, 0, 1); PG8_STAGE(PG8_SB(0, 0), b2, voffB); PG8_STAGE(PG8_SB(0, 1), b2 + hstep, voffB); PG8_STAGE(PG8_SA(0, 0), a2, voffA);
            PG8_WAIT_V(8); PG8_WAIT_L(0); PG8_BAR; PG8_MMA(1, 0, At, B0); PG8_MMA(1, 1, At, B1); PG8_BAR; PG8_SCHED;
            PG8_LDB(B0, 1, 0); PG8_LDB(B1, 1, 1); PG8_SCHED; PG8_LDA(At, 1, 0); PG8_STAGE(PG8_SA(0, 1), a2 + hstep, voffA);
            PG8_WAIT_V(8); PG8_WAIT_L(0); PG8_BAR; PG8_MMA(0, 0, At, B0); PG8_MMA(0, 1, At, B1); PG8_BAR; PG8_SCHED;
            PG8_LDA(At, 1, 1); PG8_STAGE(PG8_SB(1, 0), b3, voffB); PG8_STAGE(PG8_SB(1, 1), b3 + hstep, voffB); PG8_STAGE(PG8_SA(1, 0), a3, voffA);
            PG8_WAIT_V(8); PG8_WAIT_L(0); PG8_BAR; PG8_MMA(1, 0, At, B0); PG8_MMA(1, 1, At, B1); PG8_BAR; PG8_SCHED;
            } else {
            PG8_LDB(B0, 0, 0); PG8_SCHED; PG8_LDA(At, 0, 0); PG8_STAGE(PG8_SA(1, 1), a1 + hstep, voffA);
            PG8_WAIT_L(8); PG8_BAR; PG8_WAIT_L(0); PG8_MMA(0, 0, At, B0); PG8_BAR; PG8_SCHED;
            PG8_LDB(B1, 0, 1); PG8_STAGE(PG8_SB(0, 0), b2, voffB);
            PG8_BAR; PG8_WAIT_L(0); PG8_MMA(0, 1, At, B1); PG8_BAR;
            PG8_LDA(At, 0, 1); PG8_STAGE(PG8_SA(0, 0), a2, voffA);
            PG8_BAR; PG8_WAIT_L(0); PG8_MMA(1, 0, At, B0); PG8_BAR; PG8_SCHED;
            PG8_STAGE(PG8_SB(0, 1), b2 + hstep, voffB);
            PG8_WAIT_V(6); PG8_BAR; PG8_MMA(1, 1, At, B1); PG8_BAR;
            PG8_LDB(B0, 1, 0); PG8_SCHED; PG8_LDA(At, 1, 0); PG8_STAGE(PG8_SA(0, 1), a2 + hstep, voffA);
            PG8_WAIT_L(8); PG8_BAR; PG8_WAIT_L(0); PG8_MMA(0, 0, At, B0); PG8_BAR; PG8_SCHED;
            PG8_LDB(B1, 1, 1); PG8_STAGE(PG8_SB(1, 0), b3, voffB);
            PG8_BAR; PG8_WAIT_L(0); PG8_MMA(0, 1, At, B1); PG8_BAR;
            PG8_LDA(At, 1, 1); PG8_STAGE(PG8_SA(1, 0), a3, voffA);
            PG8_BAR; PG8_WAIT_L(0); PG8_MMA(1, 0, At, B0); PG8_BAR; PG8_SCHED;
            PG8_STAGE(PG8_SB(1, 1), b3 + hstep, voffB);
            PG8_WAIT_V(6); PG8_BAR; PG8_MMA(1, 1, At, B1); PG8_BAR;
            }
        }
        if constexpr (ALIGN_EPI) { if (wr == 0) PG8_BAR; }
        if constexpr (!Epi::AFTER_DRAIN) { E(acc, cur, wr, wc, fr, fq); S.done(cur); }
        if (!has_next) break;
#pragma unroll
        for (int a = 0; a < 2; ++a)
#pragma unroll
            for (int b = 0; b < 2; ++b)
#pragma unroll
                for (int m = 0; m < 4; ++m)
#pragma unroll
                    for (int n = 0; n < 2; ++n) acc[a][b][m][n] = (f32x4){0.f, 0.f, 0.f, 0.f};
        cur = nxt; cA = nA; cB = nB; ++ui;
        if constexpr (ALIGN_EPI) { if (wr == 1) PG8_BAR; }
    }
    PG8_WAIT_V(0);
    if constexpr (!ALIGN_EPI) { if (wr == 0) PG8_BAR; }
    PG8_BAR;
    if constexpr (Epi::AFTER_DRAIN) { E.fused(acc, cur, wr, wc, fr, fq, lds, wid, lane); S.done(cur); }
#undef PG8_SA
#undef PG8_SB
#undef PG8_STAGE
#undef PG8_LDA
#undef PG8_LDB
#undef PG8_MMA
#undef PG8_WAIT_V
#undef PG8_WAIT_L
#undef PG8_BAR
#undef PG8_SCHED
}
}

constexpr int NB = 8, SEQ = 4096, DM = 1024, MT = NB * SEQ, NL = 2;
constexpr int CHB = 4, CHR = CHB * SEQ, NCH = NB / CHB;
constexpr int NIN = 8704, DFF = 2816, NGU = 2 * DFF, WIN_SRC = 8136;
constexpr int TOPK = 256;
constexpr float EPS = 1e-6f;
constexpr int NWAVES = 8, NTHREADS = 512;

constexpr size_t MiB = 1u << 20;
constexpr size_t WS_CTL = 0, CTL_ZERO_BYTES = 1 * MiB;
constexpr size_t WS_MOD = 1 * MiB;
constexpr size_t WS_TAB = WS_MOD + 393216;
constexpr size_t WS_LAM = WS_TAB + 393216;
constexpr size_t WS_W = 2 * MiB, W_LAYER = 39 * MiB;
constexpr size_t W_IN = 0, W_A = 17 * MiB, W_B = 19 * MiB, W_C = 20 * MiB, W_OUT = 20 * MiB + 512 * 1024, W_GU = 22 * MiB + 512 * 1024, W_D = 33 * MiB + 512 * 1024;
constexpr size_t WS_H = 80 * MiB;
constexpr size_t WS_Y = 144 * MiB;
constexpr size_t Y_QLAT = 0, Y_MISC = 32 * MiB, Y_IQ = 40 * MiB, Y_BQ = 56 * MiB, Y_BK = 72 * MiB, Y_BV = 88 * MiB, Y_CQ = 104 * MiB, Y_CK = 128 * MiB, Y_CV = 152 * MiB, Y_Z = 176 * MiB, Y_OC = 272 * MiB;
constexpr size_t Y_MF32 = Y_CQ, Y_MBF = Y_BK;
constexpr size_t WS_ACT = WS_Y;
constexpr size_t WS_KVN = 424 * MiB;
constexpr size_t WS_END = 428 * MiB;
constexpr int CW_BAR = 4096;

#define GAS __attribute__((address_space(1)))
#define LAS __attribute__((address_space(3)))
typedef unsigned short bf16;
typedef unsigned v4u __attribute__((ext_vector_type(4)));
typedef unsigned v2u __attribute__((ext_vector_type(2)));
typedef float f32x4 __attribute__((ext_vector_type(4)));

__device__ __forceinline__ unsigned f2bf(float f) { unsigned u = __builtin_bit_cast(unsigned, f); return (u + 0x7fffu + ((u >> 16) & 1u)) >> 16; }
__device__ __forceinline__ unsigned pk2(float lo, float hi) { return f2bf(lo) | (f2bf(hi) << 16); }
__device__ __forceinline__ float bflo(unsigned w) { return __uint_as_float(w << 16); }
__device__ __forceinline__ float bfhi(unsigned w) { return __uint_as_float(w & 0xffff0000u); }
__device__ __forceinline__ float bf2f(bf16 h) { return __uint_as_float((unsigned)h << 16); }
__device__ __forceinline__ float wave_sum(float v) {
#pragma unroll
    for (int o = 1; o < 64; o <<= 1) v += __shfl_xor(v, o);
    return v;
}
__device__ __forceinline__ float wave_max(float v) {
#pragma unroll
    for (int o = 1; o < 64; o <<= 1) v = fmaxf(v, __shfl_xor(v, o));
    return v;
}
__device__ __forceinline__ float sigmoidf_(float v) { return 1.f / (1.f + __expf(-v)); }

namespace pg8 {
struct EpiIn {
    static constexpr bool PERM = true, AFTER_DRAIN = false;
    unsigned char* y;
    __device__ __forceinline__ void operator()(const f32x4 (&acc)[2][2][4][2], const Unit& u, int wr, int wc, int fr, int fq) const {
        const int pn = u.pn; size_t off; int ld, c0; bool sig = false;
        if (pn < 4)        { off = Y_QLAT; ld = 1024; c0 = pn * 256; }
        else if (pn == 4)  { off = Y_MISC; ld = 256;  c0 = 0; }
        else if (pn < 7)   { off = Y_IQ;   ld = 512;  c0 = (pn - 5) * 256; }
        else if (pn < 9)   { off = Y_BQ;   ld = 512;  c0 = (pn - 7) * 256; }
        else if (pn < 11)  { off = Y_BK;   ld = 512;  c0 = (pn - 9) * 256; }
        else if (pn < 13)  { off = Y_BV;   ld = 512;  c0 = (pn - 11) * 256; }
        else if (pn < 16)  { off = Y_CQ;   ld = 768;  c0 = (pn - 13) * 256; }
        else if (pn < 19)  { off = Y_CK;   ld = 768;  c0 = (pn - 16) * 256; }
        else if (pn < 22)  { off = Y_CV;   ld = 768;  c0 = (pn - 19) * 256; }
        else               { off = Y_Z;    ld = 3072; c0 = (pn - 22) * 256; sig = true; }
        bf16_t* base = (bf16_t*)(y + off);
        const int row0 = u.pm * BM + wr * 64 + fr, col0 = c0 + wc * 32 + 8 * fq;
#pragma unroll
        for (int ai = 0; ai < 2; ++ai)
#pragma unroll
            for (int m = 0; m < 4; ++m) { bf16_t* rowp = base + (size_t)(row0 + ai * HALF + m * 16) * ld + col0;
#pragma unroll
                for (int bj = 0; bj < 2; ++bj) { f32x4 v0 = acc[ai][bj][m][0], v1 = acc[ai][bj][m][1];
                    if (sig) {
#pragma unroll
                        for (int i = 0; i < 4; ++i) { v0[i] = sigmoidf_(v0[i]); v1[i] = sigmoidf_(v1[i]); } }
                    u32x4 w; w.x = pk2(v0[0], v0[1]); w.y = pk2(v0[2], v0[3]); w.z = pk2(v1[0], v1[1]); w.w = pk2(v1[2], v1[3]);
                    *(u32x4*)(rowp + bj * HALF) = w; } }
    }
};
template <int MODE> struct EpiGate {
    static constexpr bool PERM = true, AFTER_DRAIN = false;
    const bf16_t* z; int zc0; float* mf; bf16_t* mb;
    __device__ __forceinline__ void operator()(const f32x4 (&acc)[2][2][4][2], const Unit& u, int wr, int wc, int fr, int fq) const {
        const int row0 = u.pm * BM + wr * 64 + fr, col0 = u.pn * BM + wc * 32 + 8 * fq;
#pragma unroll
        for (int ai = 0; ai < 2; ++ai)
#pragma unroll
            for (int m = 0; m < 4; ++m) { const size_t row = (size_t)(row0 + ai * HALF + m * 16);
#pragma unroll
                for (int bj = 0; bj < 2; ++bj) { const int col = col0 + bj * HALF;
                    const u32x4 zw = *(const u32x4*)(z + row * 3072 + zc0 + col);
                    f32x4 v0 = acc[ai][bj][m][0], v1 = acc[ai][bj][m][1];
                    v0[0] *= __uint_as_float(zw.x << 16); v0[1] *= __uint_as_float(zw.x & 0xffff0000u); v0[2] *= __uint_as_float(zw.y << 16); v0[3] *= __uint_as_float(zw.y & 0xffff0000u);
                    v1[0] *= __uint_as_float(zw.z << 16); v1[1] *= __uint_as_float(zw.z & 0xffff0000u); v1[2] *= __uint_as_float(zw.w << 16); v1[3] *= __uint_as_float(zw.w & 0xffff0000u);
                    float* mp = mf + row * 1024 + col;
                    if (MODE >= 1) { v0 += *(const f32x4*)mp; v1 += *(const f32x4*)(mp + 4); }
                    if (MODE <= 1) { *(f32x4*)mp = v0; *(f32x4*)(mp + 4) = v1; }
                    else { u32x4 w; w.x = pk2(v0[0], v0[1]); w.y = pk2(v0[2], v0[3]); w.z = pk2(v1[0], v1[1]); w.w = pk2(v1[2], v1[3]); *(u32x4*)(mb + row * 1024 + col) = w; } }
                asm volatile("" ::: "memory"); }
    }
};
struct EpiRes {
    static constexpr bool PERM = true, AFTER_DRAIN = false;
    const float* xin; float* xout; const float* gate; int row_off;
    __device__ __forceinline__ void operator()(const f32x4 (&acc)[2][2][4][2], const Unit& u, int wr, int wc, int fr, int fq) const {
        const int row0 = row_off + u.pm * BM + wr * 64 + fr, col0 = u.pn * BM + wc * 32 + 8 * fq;
        const float* gp = gate + (size_t)((row_off + u.pm * BM) / SEQ) * 6144 + col0;
        f32x4 g[2][2];
#pragma unroll
        for (int bj = 0; bj < 2; ++bj) { g[bj][0] = *(const f32x4*)(gp + bj * HALF); g[bj][1] = *(const f32x4*)(gp + bj * HALF + 4); }
#pragma unroll
        for (int ai = 0; ai < 2; ++ai)
#pragma unroll
            for (int m = 0; m < 4; ++m) { const size_t o = (size_t)(row0 + ai * HALF + m * 16) * 1024 + col0;
#pragma unroll
                for (int bj = 0; bj < 2; ++bj) {
                    const f32x4 a0 = *(const f32x4*)(xin + o + bj * HALF), a1 = *(const f32x4*)(xin + o + bj * HALF + 4);
                    *(f32x4*)(xout + o + bj * HALF) = a0 + g[bj][0] * acc[ai][bj][m][0];
                    *(f32x4*)(xout + o + bj * HALF + 4) = a1 + g[bj][1] * acc[ai][bj][m][1]; }
                asm volatile("" ::: "memory"); }
    }
};
struct EpiSwiGLU {
    static constexpr bool PERM = true, AFTER_DRAIN = false;
    bf16_t* act;
    __device__ __forceinline__ void operator()(const f32x4 (&acc)[2][2][4][2], const Unit& u, int wr, int wc, int fr, int fq) const {
        const int row0 = u.pm * BM + wr * 64 + fr, col0 = u.pn * HALF + wc * 32 + 8 * fq;
#pragma unroll
        for (int ai = 0; ai < 2; ++ai)
#pragma unroll
            for (int m = 0; m < 4; ++m) { bf16_t* rowp = act + (size_t)(row0 + ai * HALF + m * 16) * DFF + col0;
                f32x4 v0, v1;
#pragma unroll
                for (int i = 0; i < 4; ++i) { const float g0 = acc[ai][0][m][0][i], g1 = acc[ai][0][m][1][i];
                    v0[i] = g0 * sigmoidf_(g0) * acc[ai][1][m][0][i]; v1[i] = g1 * sigmoidf_(g1) * acc[ai][1][m][1][i]; }
                u32x4 w; w.x = pk2(v0[0], v0[1]); w.y = pk2(v0[2], v0[3]); w.z = pk2(v1[0], v1[1]); w.w = pk2(v1[2], v1[3]);
                *(u32x4*)rowp = w; }
    }
};
}

#define XB_TMO      128
#define XB_XCNT(j)  (256  + 64 * (j))
#define XB_XSUB(j)  (1280 + 64 * (j))
#define XB_XGEN(j)  (2304 + 64 * (j))
#define XB_TOP      3328
#define XB_TOPGEN   3392
#define XCD_BAR_WORDS 3456
#define XB_SPIN_CAP (1u << 24)

__device__ __forceinline__ unsigned xb_ld(unsigned* p)              { return __hip_atomic_load(p, __ATOMIC_RELAXED, __HIP_MEMORY_SCOPE_AGENT); }
__device__ __forceinline__ unsigned xb_add(unsigned* p, unsigned v) { return __hip_atomic_fetch_add(p, v, __ATOMIC_RELAXED, __HIP_MEMORY_SCOPE_AGENT); }
__device__ __forceinline__ unsigned xb_xcc_id() { return (unsigned)__builtin_amdgcn_s_getreg((3 << 11) | 20) & 0xFu; }
#define XB_SPIN(cond, bar) do { unsigned _sp = 0; while (cond) { __builtin_amdgcn_s_sleep(1); \
    if ((++_sp & 255u) == 0u) { if (xb_ld(&(bar)[XB_TMO])) break; if (_sp > XB_SPIN_CAP) { atomicAdd(&(bar)[XB_TMO], 1u); break; } } } } while (0)

struct XcdBarrier { unsigned* bar; unsigned x; volatile LAS unsigned* st; };

__device__ __forceinline__ XcdBarrier xcd_barrier_post(unsigned* bar, volatile LAS unsigned* st) {
    XcdBarrier b; b.bar = bar; b.x = (unsigned)__builtin_amdgcn_readfirstlane((int)xb_xcc_id()); b.st = st;
    if (threadIdx.x == 0) (void)xb_add(&bar[XB_XCNT(b.x)], 1u);
    return b;
}
__device__ __forceinline__ void xcd_barrier_complete(unsigned* bar, unsigned x, unsigned& nloc, unsigned& nx) {
    const unsigned G = gridDim.x * gridDim.y * gridDim.z;
    unsigned sum, cnt, mine, sp = 0u;
    for (;;) {
        sum = 0u; cnt = 0u; mine = 0u;
#pragma unroll
        for (unsigned j = 0; j < 16; ++j) { const unsigned c = xb_ld(&bar[XB_XCNT(j)]); sum += c; cnt += (c > 0u) ? 1u : 0u; mine = (j == x) ? c : mine; }
        if (sum == G) break;
        __builtin_amdgcn_s_sleep(1);
        if ((++sp & 255u) == 0u) { if (xb_ld(&bar[XB_TMO])) break; if (sp > XB_SPIN_CAP) { atomicAdd(&bar[XB_TMO], 1u); break; } }
    }
    nloc = mine > 0u ? mine : 1u; nx = cnt > 0u ? cnt : 1u;
}
__device__ __forceinline__ void xcd_barrier(const XcdBarrier& b) {
    asm volatile("s_waitcnt vmcnt(0)" ::: "memory");
    __syncthreads();
    if (threadIdx.x == 0) {
        unsigned* bar = b.bar; asm volatile("" : "+s"(bar));
        __builtin_amdgcn_s_waitcnt(0);
        unsigned nloc = b.st[0], nx = b.st[1];
        if (nloc == 0u) { xcd_barrier_complete(bar, b.x, nloc, nx); b.st[0] = nloc; b.st[1] = nx; }
        const unsigned old = xb_add(&bar[XB_XSUB(b.x)], 1u);
        const unsigned gen = old / nloc;
        if (old + 1u == (gen + 1u) * nloc) {
            __builtin_amdgcn_fence(__ATOMIC_RELEASE, "agent");
            asm volatile("s_waitcnt vmcnt(0)" ::: "memory");
            const unsigned og = xb_add(&bar[XB_TOP], 1u);
            const unsigned tg = og / nx;
            if (og + 1u == (tg + 1u) * nx) xb_add(&bar[XB_TOPGEN], 1u);
            else XB_SPIN(xb_ld(&bar[XB_TOPGEN]) == tg, bar);
            __builtin_amdgcn_fence(__ATOMIC_ACQUIRE, "agent");
            xb_add(&bar[XB_XGEN(b.x)], 1u);
            asm volatile("s_waitcnt vmcnt(0)" ::: "memory");
        } else {
            XB_SPIN(xb_ld(&bar[XB_XGEN(b.x)]) == gen, bar);
            __builtin_amdgcn_fence(__ATOMIC_ACQUIRE, "agent");
            asm volatile("s_waitcnt vmcnt(0)" ::: "memory");
        }
    }
    __syncthreads();
}

constexpr int RING_BYTES = 131072;
constexpr int LDSCTL_OFF = 155648;
constexpr int LDS_BYTES = 156672;

struct Args {
    const float* in[23]; float* out; unsigned char* ws; int pad0, pad1;
};

__device__ __forceinline__ int rel_bucket(int d) {
    if (d < 16) return d;
    int b = 16;
    b += (d >= 22); b += (d >= 30); b += (d >= 40); b += (d >= 54); b += (d >= 73); b += (d >= 99); b += (d >= 134); b += (d >= 182);
    b += (d >= 246); b += (d >= 332); b += (d >= 450); b += (d >= 609); b += (d >= 825); b += (d >= 1117); b += (d >= 1513);
    return b;
}
__device__ __forceinline__ int win_src_col(int n) {
    if (n < 1152) return 512 + (n - 1024);
    if (n < 1224) return n;
    if (n < 1280) return -1;
    if (n < 1792) return 640 + (n - 1280);
    return n - 568;
}
__device__ __forceinline__ void transpose_item(const float* W, int ldw, int K, bf16* WT, int kind, int kb, int nb, LAS float* scr, int lane) {
    const int k0 = 64 * kb, n0 = 32 * nb, nl = n0 + (lane & 31);
    int sc;
    if (kind == 0) sc = win_src_col(nl + 1024);
    else if (kind == 2) { const int j = nl >> 8, r = nl & 255; sc = (r < 128) ? (j * 128 + r) : (DFF + j * 128 + r - 128); }
    else sc = nl;
#pragma unroll 8
    for (int i = 0; i < 32; ++i) { const int kk = 2 * i + (lane >> 5); scr[kk * 33 + (lane & 31)] = (sc >= 0) ? W[(size_t)(k0 + kk) * ldw + sc] : 0.f; }
    asm volatile("s_waitcnt lgkmcnt(0)" ::: "memory");
    const int c = lane & 7;
    const int nrow0 = (kind == 0) ? 1024 : 0;
#pragma unroll
    for (int j = 0; j < 4; ++j) { const int n = (lane >> 3) + 8 * j; const LAS float* s = scr + (8 * c) * 33 + n;
        v4u o; o.x = pk2(s[0 * 33], s[1 * 33]); o.y = pk2(s[2 * 33], s[3 * 33]); o.z = pk2(s[4 * 33], s[5 * 33]); o.w = pk2(s[6 * 33], s[7 * 33]);
        *(v4u*)(WT + (size_t)(nrow0 + n0 + n) * K + k0 + 8 * c) = o; }
    asm volatile("s_waitcnt lgkmcnt(0)" ::: "memory");
}

__device__ __forceinline__ void p0a_prologue(const Args& a, unsigned char* ws, LAS unsigned char* lds, int tid, int lane, int wave, int G) {
    asm volatile("" : "+v"(lane), "+v"(tid));
    const float* c = a.in[1]; const float* w_ada = a.in[2]; const float* b_ada = a.in[3];
    float* mod = (float*)(ws + WS_MOD);
    if (blockIdx.x < 192) {
        LAS float* cs = (LAS float*)lds;
        LAS float* red = (LAS float*)(lds + 32768);
        for (int i = tid; i < 8192; i += NTHREADS) { const float v = c[i]; cs[i] = v / (1.f + __expf(-v)); }
        __syncthreads();
        for (int it = blockIdx.x; it < 192; it += G) {
            const int l = it / 96, cg = it % 96, n = cg * 64 + lane;
            float acc[8];
#pragma unroll
            for (int b = 0; b < 8; ++b) acc[b] = 0.f;
            const float* wp = w_ada + ((size_t)l * 1024 + wave * 128) * 6144 + n;
#pragma unroll 8
            for (int k = 0; k < 128; ++k) { const float wv = wp[(size_t)k * 6144];
#pragma unroll
                for (int b = 0; b < 8; ++b) acc[b] += cs[b * 1024 + wave * 128 + k] * wv; }
#pragma unroll
            for (int b = 0; b < 8; ++b) red[(wave * 8 + b) * 64 + lane] = acc[b];
            __syncthreads();
            { const int b = tid >> 6; float s = 0.f;
#pragma unroll
              for (int w = 0; w < 8; ++w) s += red[(w * 8 + b) * 64 + lane];
              mod[((size_t)l * 8 + b) * 6144 + n] = s + b_ada[l * 6144 + n]; }
            __syncthreads();
        }
    }
    { const float* rb = a.in[21]; float* T = (float*)(ws + WS_TAB);
      for (int d = blockIdx.x * NTHREADS + tid; d < 4096; d += G * NTHREADS) { const int bk = rel_bucket(d);
          for (int j = 0; j < 24; ++j) T[d * 24 + j] = rb[bk * 24 + j]; } }
    if (blockIdx.x == G - 1 && wave == 0) {
        float* lam = (float*)(ws + WS_LAM);
        for (int l = 0; l < NL; ++l) {
            const float s1 = wave_sum(a.in[9][l * 64 + lane] * a.in[10][l * 64 + lane]);
            const float s2 = wave_sum(a.in[11][l * 64 + lane] * a.in[12][l * 64 + lane]);
            const float lam_init = (l == 0) ? 0.2f : 0.35550907f;
            if (lane == 0) lam[l] = expf(s1) - expf(s2) + lam_init;
        }
    }
    {
        LAS float* scr = (LAS float*)(lds + 65536 + wave * 8448);
        const int gw = blockIdx.x * NWAVES + wave, NGW = G * NWAVES;
        constexpr int I_WIN = 16 * 240, I_B = 8 * 32, I_C = 4 * 32, I_OUT = 16 * 32, I_GU = 16 * 176, I_D = 44 * 32, I_FQ = 2048, I_FA = 2048;
        constexpr int I_LAYER = I_WIN + I_B + I_C + I_OUT + I_GU + I_D + I_FQ + I_FA;
        for (int it = gw; it < NL * I_LAYER; it += NGW) {
            const int l = it / I_LAYER; int r = it % I_LAYER;
            unsigned char* wl = ws + WS_W + (size_t)l * W_LAYER;
            const float* w_in = a.in[5] + (size_t)l * 1024 * WIN_SRC;
            if (r < I_WIN) { transpose_item(w_in, WIN_SRC, 1024, (bf16*)(wl + W_IN), 0, r / 240, r % 240, scr, lane); continue; } r -= I_WIN;
            if (r < I_B)   { transpose_item(a.in[15] + (size_t)l * 512 * 1024, 1024, 512, (bf16*)(wl + W_B), 1, r / 32, r % 32, scr, lane); continue; } r -= I_B;
            if (r < I_C)   { transpose_item(a.in[16] + (size_t)l * 256 * 1024, 1024, 256, (bf16*)(wl + W_C), 1, r / 32, r % 32, scr, lane); continue; } r -= I_C;
            if (r < I_OUT) { transpose_item(a.in[17] + (size_t)l * 1024 * 1024, 1024, 1024, (bf16*)(wl + W_OUT), 1, r / 32, r % 32, scr, lane); continue; } r -= I_OUT;
            if (r < I_GU)  { transpose_item(a.in[19] + (size_t)l * 1024 * NGU, NGU, 1024, (bf16*)(wl + W_GU), 2, r / 176, r % 176, scr, lane); continue; } r -= I_GU;
            if (r < I_D)   { transpose_item(a.in[20] + (size_t)l * DFF * 1024, 1024, DFF, (bf16*)(wl + W_D), 1, r / 32, r % 32, scr, lane); continue; } r -= I_D;
            if (r < I_FQ) {
                const int h = r >> 8, rem = r & 255, cc = (rem >> 7) * 64 + lane, k0 = (rem & 127) * 8;
                const float* uk = a.in[6] + ((size_t)(l * 8 + h) * 64) * 128 + cc;
                const float* wi = w_in + (size_t)k0 * WIN_SRC + h * 64;
                float acc[8];
#pragma unroll
                for (int j = 0; j < 8; ++j) acc[j] = 0.f;
                for (int d = 0; d < 64; ++d) { const float u = uk[d * 128];
#pragma unroll
                    for (int j = 0; j < 8; ++j) acc[j] += wi[(size_t)j * WIN_SRC + d] * u; }
                v4u o; o.x = pk2(acc[0], acc[1]); o.y = pk2(acc[2], acc[3]); o.z = pk2(acc[4], acc[5]); o.w = pk2(acc[6], acc[7]);
                *(v4u*)((bf16*)(wl + W_IN) + (size_t)(h * 128 + cc) * 1024 + k0) = o;
                continue; }
            r -= I_FQ;
            {
                const int ng = r >> 7, kg = r & 127, h = kg >> 4, c0 = (kg & 15) * 8, n = ng * 64 + lane;
                const float* uv = a.in[7] + ((size_t)(l * 8 + h) * 128 + c0) * 64;
                const float* wa = a.in[14] + ((size_t)l * 512 + h * 64) * 1024 + n;
                float acc[8];
#pragma unroll
                for (int j = 0; j < 8; ++j) acc[j] = 0.f;
                for (int e = 0; e < 64; ++e) { const float wv = wa[(size_t)e * 1024];
#pragma unroll
                    for (int j = 0; j < 8; ++j) acc[j] += uv[j * 64 + e] * wv; }
                v4u o; o.x = pk2(acc[0], acc[1]); o.y = pk2(acc[2], acc[3]); o.z = pk2(acc[4], acc[5]); o.w = pk2(acc[6], acc[7]);
                *(v4u*)((bf16*)(wl + W_A) + (size_t)n * 1024 + kg * 8) = o;
            }
        }
    }
}

__device__ __forceinline__ void norm_rows(const float* x, bf16* out, const float* g, const float* sh, const float* sc, int gw, int NGW, int lane) {
    asm volatile("" : "+v"(lane));
    for (int row = gw; row < MT; row += NGW) {
        const int b = row / SEQ;
        const f32x4* xr = (const f32x4*)(x + (size_t)row * 1024) + lane;
        f32x4 v[4]; float s = 0.f;
#pragma unroll
        for (int j = 0; j < 4; ++j) { v[j] = xr[64 * j]; s += (v[j].x * v[j].x + v[j].y * v[j].y) + (v[j].z * v[j].z + v[j].w * v[j].w); }
        const float rstd = 1.0f / sqrtf(wave_sum(s) * (1.f / 1024.f) + EPS);
        v2u* o8 = (v2u*)(out + (size_t)row * 1024) + lane;
#pragma unroll
        for (int j = 0; j < 4; ++j) { const int col = 256 * j + 4 * lane;
            const f32x4 gg = *(const f32x4*)(g + col), s1 = *(const f32x4*)(sc + (size_t)b * 6144 + col), s0 = *(const f32x4*)(sh + (size_t)b * 6144 + col);
            const f32x4 y = v[j] * rstd * gg * (s1 + 1.0f) + s0;
            v2u w; w.x = pk2(y.x, y.y); w.y = pk2(y.z, y.w); o8[64 * j] = w; }
    }
}
__device__ __forceinline__ void final_rows(float* x, const float* g, int gw, int NGW, int lane) {
    asm volatile("" : "+v"(lane));
    for (int row = gw; row < MT; row += NGW) {
        f32x4* xr = (f32x4*)(x + (size_t)row * 1024) + lane;
        f32x4 v[4]; float s = 0.f;
#pragma unroll
        for (int j = 0; j < 4; ++j) { v[j] = xr[64 * j]; s += (v[j].x * v[j].x + v[j].y * v[j].y) + (v[j].z * v[j].z + v[j].w * v[j].w); }
        const float rstd = 1.0f / sqrtf(wave_sum(s) * (1.f / 1024.f) + EPS);
#pragma unroll
        for (int j = 0; j < 4; ++j) { const f32x4 gg = *(const f32x4*)(g + 256 * j + 4 * lane); xr[64 * j] = v[j] * rstd * gg; }
    }
}

__device__ __forceinline__ float dot8(const LAS float* q, v4u w) {
    return q[0] * bflo(w.x) + q[1] * bfhi(w.x) + q[2] * bflo(w.y) + q[3] * bfhi(w.y) + q[4] * bflo(w.z) + q[5] * bfhi(w.z) + q[6] * bflo(w.w) + q[7] * bfhi(w.w);
}
__device__ __forceinline__ void kvn_rows(unsigned char* y, bf16* kvn, const float* gkv, int gw, int NGW, int lane) {
    asm volatile("" : "+v"(lane));
    const bf16* misc = (const bf16*)(y + Y_MISC);
    for (int r = gw; r < CHR; r += NGW) {
        const unsigned w = *(const unsigned*)(misc + (size_t)r * 256 + 2 * lane);
        const float a0 = bflo(w), a1 = bfhi(w);
        const float rstd = 1.0f / sqrtf(wave_sum(a0 * a0 + a1 * a1) * (1.f / 128.f) + EPS);
        *(unsigned*)(kvn + (size_t)r * 128 + 2 * lane) = pk2(a0 * rstd * gkv[2 * lane], a1 * rstd * gkv[2 * lane + 1]);
    }
}
__device__ __forceinline__ void mixC_v1(unsigned char* y, const float* T, LAS unsigned char* lds, int gw, int NGW, int lane, int wave) {
    asm volatile("" : "+v"(lane));
    const bf16* CQ = (const bf16*)(y + Y_CQ); const bf16* CK = (const bf16*)(y + Y_CK); const bf16* CV = (const bf16*)(y + Y_CV); bf16* OC = (bf16*)(y + Y_OC);
    LAS float* qs = (LAS float*)(lds + wave * 2048);
    LAS float* ps = qs + 64;
    for (int task = gw; task < CHR * 4; task += NGW) {
        const int r = task >> 2, hp = task & 3, t = r & (SEQ - 1), rb = r - t;
        float og[3], lse[3];
#pragma unroll
        for (int g = 0; g < 3; ++g) {
            const int dil = (g == 0) ? 1 : (g == 1) ? 4 : 16, hh = 4 * g + hp;
            qs[lane] = bf2f(CQ[(size_t)r * 768 + hh * 64 + lane]);
            asm volatile("s_waitcnt lgkmcnt(0)" ::: "memory");
            const int tq = t / dil, nv = (tq < 128 ? tq : 128) + 1;
            float lg[3];
#pragma unroll
            for (int rd = 0; rd < 3; ++rd) {
                const int j = lane + 64 * rd; float v = -INFINITY;
                if (j < nv) { const int s = t - j * dil; const bf16* kp = CK + (size_t)(rb + s) * 768 + hh * 64; float dot = 0.f;
#pragma unroll
                    for (int c8 = 0; c8 < 8; ++c8) dot += dot8(qs + 8 * c8, *(const v4u*)(kp + 8 * c8));
                    v = dot * 0.125f + T[(j * dil) * 24 + 12 + hh]; }
                lg[rd] = v;
            }
            const float m = wave_max(fmaxf(fmaxf(lg[0], lg[1]), lg[2]));
            float p[3], ls = 0.f;
#pragma unroll
            for (int rd = 0; rd < 3; ++rd) { p[rd] = (lane + 64 * rd < nv) ? __expf(lg[rd] - m) : 0.f; ls += p[rd]; ps[64 * rd + lane] = p[rd]; }
            const float l = wave_sum(ls);
            asm volatile("s_waitcnt lgkmcnt(0)" ::: "memory");
            float o = 0.f;
            for (int j = 0; j < nv; ++j) { const int s = t - j * dil; o += ps[j] * bf2f(CV[(size_t)(rb + s) * 768 + hh * 64 + lane]); }
            og[g] = o / l; lse[g] = m + __logf(l);
            asm volatile("s_waitcnt lgkmcnt(0)" ::: "memory");
        }
        const float M = fmaxf(fmaxf(lse[0], lse[1]), lse[2]);
        const float a0 = __expf(lse[0] - M), a1 = __expf(lse[1] - M), a2 = __expf(lse[2] - M);
        OC[(size_t)r * 256 + hp * 64 + lane] = (bf16)f2bf((a0 * og[0] + a1 * og[1] + a2 * og[2]) / (a0 + a1 + a2));
    }
}
__device__ __forceinline__ void mixB_v1(unsigned char* y, const float* T, const float* gsub, float lam, float one_m_li, LAS unsigned char* lds, int gw, int NGW, int lane, int wave) {
    asm volatile("" : "+v"(lane));
    bf16* BQ = (bf16*)(y + Y_BQ); const bf16* BK = (const bf16*)(y + Y_BK); const bf16* BV = (const bf16*)(y + Y_BV);
    LAS float* qs = (LAS float*)(lds + wave * 2048);
    LAS float* ps = qs + 128;
    for (int task = gw; task < CHR * 4; task += NGW) {
        const int r = task >> 2, h = task & 3, t = r & (SEQ - 1), rb = r - t;
        qs[lane] = bf2f(BQ[(size_t)r * 512 + h * 128 + lane]); qs[64 + lane] = bf2f(BQ[(size_t)r * 512 + h * 128 + 64 + lane]);
        asm volatile("s_waitcnt lgkmcnt(0)" ::: "memory");
        float m0 = -INFINITY, m1 = -INFINITY, l0 = 0.f, l1 = 0.f, o00 = 0.f, o01 = 0.f, o10 = 0.f, o11 = 0.f;
        for (int s0 = 0; s0 <= t; s0 += 64) {
            const int s = s0 + lane; float lg0 = -INFINITY, lg1 = -INFINITY;
            if (s <= t) { const bf16* kp = BK + (size_t)(rb + s) * 512 + h * 128; float d0 = 0.f, d1 = 0.f;
#pragma unroll
                for (int c8 = 0; c8 < 8; ++c8) { d0 += dot8(qs + 8 * c8, *(const v4u*)(kp + 8 * c8)); d1 += dot8(qs + 64 + 8 * c8, *(const v4u*)(kp + 64 + 8 * c8)); }
                const float bias = T[(t - s) * 24 + 8 + h]; lg0 = d0 * 0.125f + bias; lg1 = d1 * 0.125f + bias; }
            const float nm0 = fmaxf(m0, wave_max(lg0)), nm1 = fmaxf(m1, wave_max(lg1));
            const float f0 = __expf(m0 - nm0), f1 = __expf(m1 - nm1);
            const float p0 = (s <= t) ? __expf(lg0 - nm0) : 0.f, p1 = (s <= t) ? __expf(lg1 - nm1) : 0.f;
            l0 = l0 * f0 + wave_sum(p0); l1 = l1 * f1 + wave_sum(p1); o00 *= f0; o01 *= f0; o10 *= f1; o11 *= f1; m0 = nm0; m1 = nm1;
            ps[lane] = p0; ps[64 + lane] = p1;
            asm volatile("s_waitcnt lgkmcnt(0)" ::: "memory");
            const int nk = (t - s0 + 1 < 64) ? (t - s0 + 1) : 64;
            const bf16* vp = BV + (size_t)(rb + s0) * 512 + h * 128 + lane;
            for (int j = 0; j < nk; ++j) { const float v0 = bf2f(vp[(size_t)j * 512]), v1 = bf2f(vp[(size_t)j * 512 + 64]); const float pa = ps[j], pb = ps[64 + j];
                o00 += pa * v0; o01 += pa * v1; o10 += pb * v0; o11 += pb * v1; }
            asm volatile("s_waitcnt lgkmcnt(0)" ::: "memory");
        }
        const float oa = o00 / l0 - lam * (o10 / l1), ob = o01 / l0 - lam * (o11 / l1);
        const float rstd = 1.0f / sqrtf(wave_sum(oa * oa + ob * ob) * (1.f / 128.f) + EPS);
        BQ[(size_t)r * 512 + h * 128 + lane] = (bf16)f2bf(oa * rstd * gsub[lane] * one_m_li);
        BQ[(size_t)r * 512 + h * 128 + 64 + lane] = (bf16)f2bf(ob * rstd * gsub[64 + lane] * one_m_li);
    }
}
__device__ __forceinline__ unsigned mono_key(float f) { const unsigned u = __float_as_uint(f); return (u & 0x80000000u) ? ~u : (u | 0x80000000u); }
__device__ __forceinline__ void mixA_v1(unsigned char* y, const bf16* KVN, const float* T, LAS unsigned char* lds, int gw, int NGW, int lane, int wave) {
    asm volatile("" : "+v"(lane));
    bf16* QLAT = (bf16*)(y + Y_QLAT); const bf16* MISC = (const bf16*)(y + Y_MISC); const bf16* IQ = (const bf16*)(y + Y_IQ);
    LAS unsigned char* wb = lds + wave * 19456;
    LAS unsigned* scb = (LAS unsigned*)wb;
    LAS float* qi = (LAS float*)(wb + 16384);
    LAS unsigned* sel = (LAS unsigned*)(wb + 18432);
    LAS float* ql = (LAS float*)wb;
    LAS float* pb = (LAS float*)(wb + 4096);
    const unsigned long long lt_mask = (1ull << lane) - 1ull;
    for (int r = gw; r < CHR; r += NGW) {
        const int t = r & (SEQ - 1), rb = r - t, N = t + 1;
#pragma unroll
        for (int i = 0; i < 8; ++i) qi[i * 64 + lane] = bf2f(IQ[(size_t)r * 512 + i * 64 + lane]);
        const float wv = (lane < 8) ? bf2f(MISC[(size_t)r * 256 + 192 + lane]) * 0.044194173824159216f : 0.f;
        float wh[8];
#pragma unroll
        for (int h = 0; h < 8; ++h) wh[h] = __shfl(wv, h);
        asm volatile("s_waitcnt lgkmcnt(0)" ::: "memory");
        for (int s0 = 0; s0 < N; s0 += 64) {
            const int s = s0 + lane;
            if (s < N) { const bf16* kp = MISC + (size_t)(rb + s) * 256 + 128; v4u kw[8];
#pragma unroll
                for (int c8 = 0; c8 < 8; ++c8) kw[c8] = *(const v4u*)(kp + 8 * c8);
                float sc = 0.f;
#pragma unroll
                for (int h = 0; h < 8; ++h) { float d = 0.f;
#pragma unroll
                    for (int c8 = 0; c8 < 8; ++c8) d += dot8(qi + h * 64 + 8 * c8, kw[c8]);
                    sc += wh[h] * fmaxf(d, 0.f); }
                sc += 0.f;
                scb[s] = mono_key(sc); }
        }
        asm volatile("s_waitcnt lgkmcnt(0)" ::: "memory");
        int nsel;
        if (N <= TOPK) { for (int i = lane; i < N; i += 64) sel[i] = (unsigned)i; nsel = N; }
        else {
            unsigned tau = 0u;
            for (int bit = 31; bit >= 0; --bit) { const unsigned cand = tau | (1u << bit); int cnt = 0;
                for (int i = lane; i < N; i += 64) cnt += (scb[i] >= cand) ? 1 : 0;
#pragma unroll
                for (int o = 1; o < 64; o <<= 1) cnt += __shfl_xor(cnt, o);
                if (cnt >= TOPK) tau = cand; }
            int cgt = 0;
            for (int i = lane; i < N; i += 64) cgt += (scb[i] > tau) ? 1 : 0;
#pragma unroll
            for (int o = 1; o < 64; o <<= 1) cgt += __shfl_xor(cgt, o);
            const int need = TOPK - cgt; int pos = 0, eqt = 0;
            for (int s0 = 0; s0 < N; s0 += 64) { const int s = s0 + lane; const unsigned key = (s < N) ? scb[s] : 0u;
                const bool gt = (s < N) && key > tau, eq = (s < N) && key == tau;
                const unsigned long long beq = __ballot(eq);
                const bool take = gt || (eq && (eqt + __popcll(beq & lt_mask)) < need);
                const unsigned long long bt = __ballot(take);
                if (take) sel[pos + __popcll(bt & lt_mask)] = (unsigned)s;
                pos += __popcll(bt); eqt += __popcll(beq); }
            nsel = TOPK;
        }
        asm volatile("s_waitcnt lgkmcnt(0)" ::: "memory");
#pragma unroll
        for (int i = 0; i < 16; ++i) ql[i * 64 + lane] = bf2f(QLAT[(size_t)r * 1024 + i * 64 + lane]);
        asm volatile("s_waitcnt lgkmcnt(0)" ::: "memory");
        for (int rd = 0; rd < 4; ++rd) { const int jj = rd * 64 + lane;
            float acc[8];
#pragma unroll
            for (int h = 0; h < 8; ++h) acc[h] = -INFINITY;
            if (jj < nsel) { const int s = (int)sel[jj]; const bf16* kp = KVN + (size_t)(rb + s) * 128;
#pragma unroll
                for (int h = 0; h < 8; ++h) acc[h] = 0.f;
#pragma unroll 4
                for (int c8 = 0; c8 < 16; ++c8) { const v4u w = *(const v4u*)(kp + 8 * c8);
#pragma unroll
                    for (int h = 0; h < 8; ++h) acc[h] += dot8(ql + h * 128 + 8 * c8, w); }
                const float* tb = T + (t - s) * 24;
#pragma unroll
                for (int h = 0; h < 8; ++h) acc[h] = acc[h] * 0.125f + tb[h]; }
#pragma unroll
            for (int h = 0; h < 8; ++h) pb[h * 256 + jj] = acc[h];
        }
        asm volatile("s_waitcnt lgkmcnt(0)" ::: "memory");
#pragma unroll
        for (int h = 0; h < 8; ++h) { float v[4];
#pragma unroll
            for (int i = 0; i < 4; ++i) v[i] = pb[h * 256 + 64 * i + lane];
            const float m = wave_max(fmaxf(fmaxf(v[0], v[1]), fmaxf(v[2], v[3])));
#pragma unroll
            for (int i = 0; i < 4; ++i) v[i] = __expf(v[i] - m);
            const float inv = 1.0f / wave_sum((v[0] + v[1]) + (v[2] + v[3]));
#pragma unroll
            for (int i = 0; i < 4; ++i) pb[h * 256 + 64 * i + lane] = v[i] * inv; }
        asm volatile("s_waitcnt lgkmcnt(0)" ::: "memory");
        float o0[8], o1[8];
#pragma unroll
        for (int h = 0; h < 8; ++h) { o0[h] = 0.f; o1[h] = 0.f; }
        for (int jj = 0; jj < nsel; ++jj) { const int s = (int)sel[jj]; const bf16* vp = KVN + (size_t)(rb + s) * 128 + lane;
            const float v0 = bf2f(vp[0]), v1 = bf2f(vp[64]);
#pragma unroll
            for (int h = 0; h < 8; ++h) { const float p = pb[h * 256 + jj]; o0[h] += p * v0; o1[h] += p * v1; } }
#pragma unroll
        for (int h = 0; h < 8; ++h) { QLAT[(size_t)r * 1024 + h * 128 + lane] = (bf16)f2bf(o0[h]); QLAT[(size_t)r * 1024 + h * 128 + 64 + lane] = (bf16)f2bf(o1[h]); }
        asm volatile("s_waitcnt lgkmcnt(0)" ::: "memory");
    }
}

__global__ void __launch_bounds__(NTHREADS, 2) fwd(Args a) {
    extern __shared__ __attribute__((aligned(16))) unsigned char lds_raw[];
    LAS unsigned char* lds = (LAS unsigned char*)lds_raw;
    const int tid = threadIdx.x, lane = tid & 63, wave = __builtin_amdgcn_readfirstlane(tid >> 6);
    const int G = gridDim.x, gw = blockIdx.x * NWAVES + wave, NGW = G * NWAVES;
    unsigned char* ws = a.ws;
    for (int u = tid; u < (LDS_BYTES - LDSCTL_OFF) / 4; u += NTHREADS) ((LAS unsigned*)(lds + LDSCTL_OFF))[u] = 0u;
    __syncthreads();
    XcdBarrier bar = xcd_barrier_post((unsigned*)(ws + WS_CTL) + CW_BAR, (volatile LAS unsigned*)(lds + LDSCTL_OFF));

    const float* x_in = a.in[0]; float* xo = a.out;
    float* mod = (float*)(ws + WS_MOD); const float* T = (const float*)(ws + WS_TAB); const float* lamp = (const float*)(ws + WS_LAM);
    bf16* H = (bf16*)(ws + WS_H); unsigned char* y = ws + WS_Y; bf16* KVN = (bf16*)(ws + WS_KVN);

    p0a_prologue(a, ws, lds, tid, lane, wave, G);
    xcd_barrier(bar);
    norm_rows(x_in, H, a.in[4], mod + 0 * 1024, mod + 1 * 1024, gw, NGW, lane);
    xcd_barrier(bar);

#pragma unroll
    for (int l = 0; l < NL; ++l) {
        unsigned char* wl = ws + WS_W + (size_t)l * W_LAYER;
        const float* modl = mod + (size_t)l * 8 * 6144;
#pragma unroll
        for (int ch = 0; ch < NCH; ++ch) {
            { pg8::Gemm g{H + (size_t)ch * CHR * 1024, (const bf16*)(wl + W_IN), CHR, NIN, 1024}; pg8::StaticOrder S; S.init(CHR, NIN, G, (int)blockIdx.x);
              pg8::EpiIn E{y};
              pg8::gemm_phase<pg8::EpiIn, pg8::StaticOrder, true, true>(lds, g, S, E); }
            xcd_barrier(bar);
            kvn_rows(y, KVN, a.in[8] + l * 128, gw, NGW, lane);
            mixC_v1(y, T, lds, gw, NGW, lane, wave);
            mixB_v1(y, T, a.in[13] + l * 128, lamp[l], (l == 0) ? 0.8f : 0.64449093f, lds, gw, NGW, lane, wave);
            xcd_barrier(bar);
            mixA_v1(y, KVN, T, lds, gw, NGW, lane, wave);
            xcd_barrier(bar);
            { pg8::StaticOrder S; S.init(CHR, 1024, G, (int)blockIdx.x);
              const bf16* Z = (const bf16*)(y + Y_Z); float* MF = (float*)(y + Y_MF32); bf16* MB = (bf16*)(y + Y_MBF);
              { pg8::Gemm g{(const bf16*)(y + Y_QLAT), (const bf16*)(wl + W_A), CHR, 1024, 1024}; pg8::EpiGate<0> E{Z, 0, MF, MB};
                pg8::gemm_phase<pg8::EpiGate<0>, pg8::StaticOrder, true, true>(lds, g, S, E); }
              { pg8::Gemm g{(const bf16*)(y + Y_BQ), (const bf16*)(wl + W_B), CHR, 1024, 512}; pg8::EpiGate<1> E{Z, 1024, MF, MB};
                pg8::gemm_phase<pg8::EpiGate<1>, pg8::StaticOrder, true, true>(lds, g, S, E); }
              { pg8::Gemm g{(const bf16*)(y + Y_OC), (const bf16*)(wl + W_C), CHR, 1024, 256}; pg8::EpiGate<2> E{Z, 2048, MF, MB};
                pg8::gemm_phase<pg8::EpiGate<2>, pg8::StaticOrder, true, true>(lds, g, S, E); } }
            xcd_barrier(bar);
            { pg8::Gemm g{(const bf16*)(y + Y_MBF), (const bf16*)(wl + W_OUT), CHR, 1024, 1024}; pg8::StaticOrder S; S.init(CHR, 1024, G, (int)blockIdx.x);
              pg8::EpiRes E{(l == 0) ? x_in : (const float*)xo, xo, modl + 2 * 1024, ch * CHR};
              pg8::gemm_phase<pg8::EpiRes, pg8::StaticOrder, true, true>(lds, g, S, E); }
            xcd_barrier(bar);
        }
        norm_rows(xo, H, a.in[18] + l * 1024, modl + 3 * 1024, modl + 4 * 1024, gw, NGW, lane);
        xcd_barrier(bar);
        { pg8::Gemm g{H, (const bf16*)(wl + W_GU), MT, NGU, 1024}; pg8::StaticOrder S; S.init(MT, NGU, G, (int)blockIdx.x);
          pg8::EpiSwiGLU E{(bf16*)(ws + WS_ACT)};
          pg8::gemm_phase<pg8::EpiSwiGLU, pg8::StaticOrder, true, true>(lds, g, S, E); }
        xcd_barrier(bar);
        { pg8::Gemm g{(const bf16*)(ws + WS_ACT), (const bf16*)(wl + W_D), MT, 1024, DFF}; pg8::StaticOrder S; S.init(MT, 1024, G, (int)blockIdx.x);
          pg8::EpiRes E{xo, xo, modl + 5 * 1024, 0};
          pg8::gemm_phase<pg8::EpiRes, pg8::StaticOrder, true, true>(lds, g, S, E); }
        xcd_barrier(bar);
        if (l + 1 < NL) { norm_rows(xo, H, a.in[4] + (l + 1) * 1024, modl + 8 * 6144 + 0 * 1024, modl + 8 * 6144 + 1 * 1024, gw, NGW, lane); xcd_barrier(bar); }
        else final_rows(xo, a.in[22], gw, NGW, lane);
    }
}

extern "C" void kernel_launch(void* const* d_in, const int* in_sizes, int n_in, void* d_out, int out_size, void* d_ws, size_t ws_size, hipStream_t stream) {
    static int grid = 0;
    if (grid == 0) {
        if (n_in != 23 || out_size != MT * DM || ws_size < WS_END) { fprintf(stderr, "kernel_launch: unexpected shapes (n_in %d out %d ws %zu)\n", n_in, out_size, ws_size); grid = -1; return; }
        int dev = 0, cus = 0, per_cu = 0;
        if (hipGetDevice(&dev) != hipSuccess || hipDeviceGetAttribute(&cus, hipDeviceAttributeMultiprocessorCount, dev) != hipSuccess) { grid = -1; return; }
        if (hipFuncSetAttribute((const void*)fwd, hipFuncAttributeMaxDynamicSharedMemorySize, LDS_BYTES) != hipSuccess) { fprintf(stderr, "kernel_launch: hipFuncSetAttribute failed\n"); grid = -1; return; }
        if (hipOccupancyMaxActiveBlocksPerMultiprocessor(&per_cu, (const void*)fwd, NTHREADS, LDS_BYTES) != hipSuccess || per_cu < 1) { fprintf(stderr, "kernel_launch: occupancy query says %d\n", per_cu); }
        (void)hipGetLastError();
        grid = cus;
    }
    if (grid < 0) return;
    (void)hipMemsetAsync((char*)d_ws + WS_CTL, 0, CTL_ZERO_BYTES, stream);
    Args a{};
    for (int i = 0; i < 23; ++i) a.in[i] = (const float*)d_in[i];
    a.out = (float*)d_out; a.ws = (unsigned char*)d_ws; a.pad0 = 0; a.pad1 = 0;
    hipLaunchKernelGGL(fwd, dim3(grid), dim3(NTHREADS), LDS_BYTES, stream, a);
}
```

```cpp
#include <hip/hip_runtime.h>
#include <cstdio>
#include <cstdint>
namespace pg8 {
#define PG8_LAS __attribute__((address_space(3)))
typedef unsigned short bf16_t;
typedef short bf16x8 __attribute__((ext_vector_type(8)));
typedef float f32x4 __attribute__((ext_vector_type(4)));
typedef unsigned u32x4 __attribute__((ext_vector_type(4)));
constexpr int BM = 256, BK = 64, HALF = 128, HTB = HALF * BK * 2  , STAGE_BYTES = 8 * HTB, NXCD = 8, WGM = 8;

__host__ __device__ __forceinline__ int lds_byte(int r, int c) { const int st = (r >> 4) * 2 + (c >> 5), rr = r & 15, cc = c & 31, ob = rr * 64 + cc * 2; return st * 1024 + (ob ^ (((ob >> 9) & 1) << 5)); }
__host__ __device__ __forceinline__ void stage_rc(int b, int& R, int& C) { const int st = b / 1024, sb = b % 1024, swz = sb ^ (((sb >> 9) & 1) << 5); R = (st >> 1) * 16 + swz / 64; C = (st & 1) * 32 + (swz % 64) / 2; }
__host__ __device__ __forceinline__ int perm32(int rho) { const int n = rho >> 4, i = rho & 15; return 8 * (i >> 2) + 4 * n + (i & 3); }

struct Unit { int pm, pn; };
struct Gemm { const bf16_t* A; const bf16_t* Bt; int M, N, K; };

struct StaticOrder {
    int nM, nN, nwg, G, c;
    __host__ __device__ void init(int M, int N, int G_, int c_) { nM = M / BM; nN = N / BM; nwg = nM * nN; G = G_; c = c_; }
    __host__ __device__ bool next(int i, Unit& u) const {
        const long L = (long)i * G + c; if (L >= nwg) return false;
        int wgid = (int)L; { const int q = nwg / NXCD, r = nwg % NXCD, xcd = wgid % NXCD, off = wgid / NXCD; wgid = (xcd < r ? xcd * (q + 1) : r * (q + 1) + (xcd - r) * q) + off; }
        const int nig = WGM * nN, gid = wgid / nig, fm = gid * WGM, gsz = (nM - fm) < WGM ? (nM - fm) : WGM;
        u.pm = fm + ((wgid % nig) % gsz); u.pn = (wgid % nig) / gsz; return true;
    }
    __device__ __forceinline__ void a_ready(const Unit&) const {}
    __device__ __forceinline__ void done(const Unit&) const {}
};

template <class Epi, class Sched, bool ALIGN_EPI = false, bool SP2 = false>
__device__ __forceinline__ void gemm_phase(PG8_LAS unsigned char* lds, const Gemm g, const Sched& S, const Epi& E) {
    int tid_l = threadIdx.x; asm volatile("" : "+v"(tid_l));
    const int tid = tid_l, wid = __builtin_amdgcn_readfirstlane(tid >> 6), lane = tid & 63, wr = wid >> 2, wc = wid & 3, fr = lane & 15, fq = lane >> 4;
    int K_l = g.K; asm volatile("" : "+s"(K_l));
    const int K = K_l, nt = K / BK;
    unsigned voffA[2], voffB[2];
#pragma unroll
    for (int i = 0; i < 2; ++i) { int R, C; stage_rc(tid * 16 + i * 8192, R, C); const int Rb = Epi::PERM ? ((R & ~31) + perm32(R & 31)) : R;
        voffA[i] = (unsigned)(R * K + C) * 2u; voffB[i] = (unsigned)(Rb * K + C) * 2u; }
    const size_t kstep = (size_t)(BK * 2);
    const size_t hstep = (size_t)HALF * K * 2;
    const size_t tstep = 2 * hstep;
    const unsigned ldsw = (unsigned)wid * 1024u;
    const int aoff = lds_byte(wr * 64 + fr, fq * 8), boff = lds_byte(wc * 32 + fr, fq * 8);
#define PG8_SA(b, h) (((b) * 2 + (h)) * HTB)
#define PG8_SB(b, h) ((4 + (b) * 2 + (h)) * HTB)
#define PG8_STAGE(bufoff, gbase, voff) do { _Pragma("unroll") for (int _i = 0; _i < 2; ++_i) \
        __builtin_amdgcn_global_load_lds((const unsigned*)((const char*)(gbase) + (voff)[_i]), (PG8_LAS unsigned*)(lds + (bufoff) + ldsw + _i * 8192), 16, 0, 0); } while (0)
#define PG8_LDA(dst, b, h) do { _Pragma("unroll") for (int m = 0; m < 4; ++m) _Pragma("unroll") for (int k = 0; k < 2; ++k) dst[m][k] = *(const PG8_LAS bf16x8*)(lds + PG8_SA(b, h) + aoff + m * 2048 + k * 1024); } while (0)
#define PG8_LDB(dst, b, h) do { _Pragma("unroll") for (int n = 0; n < 2; ++n) _Pragma("unroll") for (int k = 0; k < 2; ++k) dst[n][k] = *(const PG8_LAS bf16x8*)(lds + PG8_SB(b, h) + boff + n * 2048 + k * 1024); } while (0)
#define PG8_MMA(ai, bj, At, Bt) do { __builtin_amdgcn_s_setprio(1); _Pragma("unroll") for (int m = 0; m < 4; ++m) _Pragma("unroll") for (int n = 0; n < 2; ++n) _Pragma("unroll") for (int k = 0; k < 2; ++k) \
        acc[ai][bj][m][n] = __builtin_amdgcn_mfma_f32_16x16x32_bf16(Bt[n][k], At[m][k], acc[ai][bj][m][n], 0, 0, 0); __builtin_amdgcn_s_setprio(0); } while (0)
#define PG8_WAIT_V(n) asm volatile("s_waitcnt vmcnt(" #n ")" ::: "memory")
#define PG8_WAIT_L(n) asm volatile("s_waitcnt lgkmcnt(" #n ")" ::: "memory")
#define PG8_BAR __builtin_amdgcn_s_barrier()
#define PG8_SCHED __builtin_amdgcn_sched_barrier(0)
    Unit cur, nxt; int ui = 0;
    if (!S.next(0, cur)) return;
    f32x4 acc[2][2][4][2];
#pragma unroll
    for (int a = 0; a < 2; ++a)
#pragma unroll
        for (int b = 0; b < 2; ++b)
#pragma unroll
            for (int m = 0; m < 4; ++m)
#pragma unroll
                for (int n = 0; n < 2; ++n) acc[a][b][m][n] = (f32x4){0.f, 0.f, 0.f, 0.f};
    bf16x8 At[4][2], B0[2][2], B1[2][2];
    const char* cA = (const char*)g.A + (size_t)cur.pm * tstep; const char* cB = (const char*)g.Bt + (size_t)cur.pn * tstep;
    S.a_ready(cur);
    if constexpr (SP2) {
        PG8_STAGE(PG8_SB(0, 0), cB, voffB); PG8_STAGE(PG8_SB(0, 1), cB + hstep, voffB); PG8_STAGE(PG8_SA(0, 0), cA, voffA); PG8_STAGE(PG8_SA(0, 1), cA + hstep, voffA);
        if (wr == 1) PG8_BAR;
        PG8_WAIT_V(2); PG8_BAR;
        PG8_STAGE(PG8_SB(1, 0), cB + kstep, voffB); PG8_STAGE(PG8_SA(1, 0), cA + kstep, voffA); PG8_STAGE(PG8_SB(1, 1), cB + hstep + kstep, voffB);
        PG8_WAIT_V(6); PG8_BAR;
    } else {
        PG8_STAGE(PG8_SB(0, 0), cB, voffB); PG8_STAGE(PG8_SA(0, 0), cA, voffA); PG8_STAGE(PG8_SB(0, 1), cB + hstep, voffB); PG8_STAGE(PG8_SA(0, 1), cA + hstep, voffA);
        if (wr == 1) PG8_BAR;
        PG8_WAIT_V(4); PG8_BAR;
        PG8_STAGE(PG8_SB(1, 0), cB + kstep, voffB); PG8_STAGE(PG8_SA(1, 0), cA + kstep, voffA); PG8_STAGE(PG8_SB(1, 1), cB + hstep + kstep, voffB);
        PG8_WAIT_V(6); PG8_BAR;
    }
    for (;;) {
        const bool has_next = S.next(ui + 1, nxt);
        const char* nA = has_next ? (const char*)g.A + (size_t)nxt.pm * tstep : cA; const char* nB = has_next ? (const char*)g.Bt + (size_t)nxt.pn * tstep : cB;
        for (int t = 0; t < nt; t += 2) {
            const bool last = (t == nt - 2);
            const char* a1 = cA + (size_t)(t + 1) * kstep;
            const char* a2 = last ? nA : cA + (size_t)(t + 2) * kstep; const char* b2 = last ? nB : cB + (size_t)(t + 2) * kstep;
            const char* a3 = a2 + kstep; const char* b3 = b2 + kstep;
            if (last && has_next) S.a_ready(nxt);
            if constexpr (SP2) {
            PG8_LDB(B0, 0, 0); PG8_LDB(B1, 0, 1); PG8_SCHED; PG8_LDA(At, 0, 0); PG8_STAGE(PG8_SA(1, 1), a1 + hstep, voffA);
            PG8_WAIT_V(8); PG8_WAIT_L(0); PG8_BAR; PG8_MMA(0, 0, At, B0); PG8_MMA(0, 1, At, B1); PG8_BAR; PG8_SCHED;
            PG8_LDA(At, 0, 1); PG8_STAGE(PG8_SB(0, 0), b2, voffB); PG8_STAGE(PG8_SB(0, 1), b2 + hstep, voffB); PG8_STAGE(PG8_SA(0, 0), a2, voffA);
            PG8_WAIT_V(8); PG8_WAIT_L(0); PG8_BAR; PG8_MMA(1, 0, At, B0); PG8_MMA(1, 1, At, B1); PG8_BAR; PG8_SCHED;
            PG8_LDB(B0, 1, 0); PG8_LDB(B1, 1, 1); PG8_SCHED; PG8_LDA(At, 1, 0); PG8_STAGE(PG8_SA(0, 1), a2 + hstep, voffA);
            PG8_WAIT_V(8); PG8_WAIT_L(0); PG8_BAR; PG8_MMA(0, 0, At, B0); PG8_MMA(0, 1, At, B1); PG8_BAR; PG8_SCHED;
            PG8_LDA(At, 1, 1); PG8_STAGE(PG8_SB(1, 0), b3, voffB); PG8_STAGE(PG8_SB(1, 1), b3 + hstep, voffB); PG8_STAGE(PG8_SA(1, 0), a3, voffA);
            PG8_WAIT_V(8); PG8_WAIT_L(0); PG8_BAR; PG8_MMA(1, 0, At, B0); PG8_MMA(1, 1, At, B1); PG8_BAR; PG8_SCHED;
            } else {
            PG8_LDB(B0, 0, 0); PG8_SCHED; PG8_LDA(At, 0, 0); PG8_STAGE(PG8_SA(1, 1), a1 + hstep, voffA);
            PG8_WAIT_L(8); PG8_BAR; PG8_WAIT_L(0); PG8_MMA(0, 0, At, B0); PG8_BAR; PG8_SCHED;
            PG8_LDB(B1, 0, 1); PG8_STAGE(PG8_SB(0, 0), b2, voffB);
            PG8_BAR; PG8_WAIT_L(0); PG8_MMA(0, 1, At, B1); PG8_BAR;
            PG8_LDA(At, 0, 1); PG8_STAGE(PG8_SA(0, 0), a2, voffA);
            PG8_BAR; PG8_WAIT_L(0); PG8_MMA(1, 0, At, B0); PG8_BAR; PG8_SCHED;
            PG8_STAGE(PG8_SB(0, 1), b2 + hstep, voffB);
            PG8_WAIT_V(6); PG8_BAR; PG8_MMA(1, 1, At, B1); PG8_BAR;
            PG8_LDB(B0, 1, 0); PG8_SCHED; PG8_LDA(At, 1, 0); PG8_STAGE(PG8_SA(0, 1), a2 + hstep, voffA);
            PG8_WAIT_L(8); PG8_BAR; PG8_WAIT_L(0); PG8_MMA(0, 0, At, B0); PG8_BAR; PG8_SCHED;
            PG8_LDB(B1, 1, 1); PG8_STAGE(PG8_SB(1, 0), b3, voffB);
            PG8_BAR; PG8_WAIT_L(0); PG8_MMA(0, 1, At, B1); PG8_BAR;
            PG8_LDA(At, 1, 1); PG8_STAGE(PG8_SA(1, 0), a3, voffA);
            PG8_BAR; PG8_WAIT_L(0); PG8_MMA(1, 0, At, B0); PG8_BAR; PG8_SCHED;
            PG8_STAGE(PG8_SB(1, 1), b3 + hstep, voffB);
            PG8_WAIT_V(6); PG8_BAR; PG8_MMA(1, 1, At, B1); PG8_BAR;
            }
        }
        if constexpr (ALIGN_EPI) { if (wr == 0) PG8_BAR; }
        if constexpr (!Epi::AFTER_DRAIN) { E(acc, cur, wr, wc, fr, fq); S.done(cur); }
        if (!has_next) break;
#pragma unroll
        for (int a = 0; a < 2; ++a)
#pragma unroll
            for (int b = 0; b < 2; ++b)
#pragma unroll
                for (int m = 0; m < 4; ++m)
#pragma unroll
                    for (int n = 0; n < 2; ++n) acc[a][b][m][n] = (f32x4){0.f, 0.f, 0.f, 0.f};
        cur = nxt; cA = nA; cB = nB; ++ui;
        if constexpr (ALIGN_EPI) { if (wr == 1) PG8_BAR; }
    }
    PG8_WAIT_V(0);
    if constexpr (!ALIGN_EPI) { if (wr == 0) PG8_BAR; }
    PG8_BAR;
    if constexpr (Epi::AFTER_DRAIN) { E.fused(acc, cur, wr, wc, fr, fq, lds, wid, lane); S.done(cur); }
#undef PG8_SA
#undef PG8_SB
#undef PG8_STAGE
#undef PG8_LDA
#undef PG8_LDB
#undef PG8_MMA
#undef PG8_WAIT_V
#undef PG8_WAIT_L
#undef PG8_BAR
#undef PG8_SCHED
}
}

constexpr int NB = 8, SEQ = 4096, DM = 1024, MT = NB * SEQ, NL = 2;
constexpr int CHB = 4, CHR = CHB * SEQ, NCH = NB / CHB;
constexpr int NIN = 8704, DFF = 2816, NGU = 2 * DFF, WIN_SRC = 8136;
constexpr int TOPK = 256;
constexpr float EPS = 1e-6f;
constexpr int NWAVES = 8, NTHREADS = 512;

constexpr size_t MiB = 1u << 20;
constexpr size_t WS_CTL = 0, CTL_ZERO_BYTES = 1 * MiB;
constexpr size_t WS_MOD = 1 * MiB;
constexpr size_t WS_TAB = WS_MOD + 393216;
constexpr size_t WS_LAM = WS_TAB + 393216;
constexpr size_t WS_W = 2 * MiB, W_LAYER = 39 * MiB;
constexpr size_t W_IN = 0, W_A = 17 * MiB, W_B = 19 * MiB, W_C = 20 * MiB, W_OUT = 20 * MiB + 512 * 1024, W_GU = 22 * MiB + 512 * 1024, W_D = 33 * MiB + 512 * 1024;
constexpr size_t WS_H = 80 * MiB;
constexpr size_t WS_Y = 144 * MiB;
constexpr size_t Y_QLAT = 0, Y_MISC = 32 * MiB, Y_IQ = 40 * MiB, Y_BQ = 56 * MiB, Y_BK = 72 * MiB, Y_BV = 88 * MiB, Y_CQ = 104 * MiB, Y_CK = 128 * MiB, Y_CV = 152 * MiB, Y_Z = 176 * MiB, Y_OC = 272 * MiB;
constexpr size_t Y_MF32 = Y_CQ, Y_MBF = Y_BK;
constexpr size_t WS_ACT = WS_Y;
constexpr size_t WS_KVN = 424 * MiB;
constexpr size_t WS_END = 428 * MiB;
constexpr int CW_BAR = 4096;

#define GAS __attribute__((address_space(1)))
#define LAS __attribute__((address_space(3)))
typedef unsigned short bf16;
typedef unsigned v4u __attribute__((ext_vector_type(4)));
typedef unsigned v2u __attribute__((ext_vector_type(2)));
typedef float f32x4 __attribute__((ext_vector_type(4)));

__device__ __forceinline__ unsigned f2bf(float f) { unsigned u = __builtin_bit_cast(unsigned, f); return (u + 0x7fffu + ((u >> 16) & 1u)) >> 16; }
__device__ __forceinline__ unsigned pk2(float lo, float hi) { return f2bf(lo) | (f2bf(hi) << 16); }
__device__ __forceinline__ float bflo(unsigned w) { return __uint_as_float(w << 16); }
__device__ __forceinline__ float bfhi(unsigned w) { return __uint_as_float(w & 0xffff0000u); }
__device__ __forceinline__ float bf2f(bf16 h) { return __uint_as_float((unsigned)h << 16); }
__device__ __forceinline__ float wave_sum(float v) {
#pragma unroll
    for (int o = 1; o < 64; o <<= 1) v += __shfl_xor(v, o);
    return v;
}
__device__ __forceinline__ float wave_max(float v) {
#pragma unroll
    for (int o = 1; o < 64; o <<= 1) v = fmaxf(v, __shfl_xor(v, o));
    return v;
}
__device__ __forceinline__ float sigmoidf_(float v) { return 1.f / (1.f + __expf(-v)); }

namespace pg8 {
struct EpiIn {
    static constexpr bool PERM = true, AFTER_DRAIN = false;
    unsigned char* y;
    __device__ __forceinline__ void operator()(const f32x4 (&acc)[2][2][4][2], const Unit& u, int wr, int wc, int fr, int fq) const {
        const int pn = u.pn; size_t off; int ld, c0; bool sig = false;
        if (pn < 4)        { off = Y_QLAT; ld = 1024; c0 = pn * 256; }
        else if (pn == 4)  { off = Y_MISC; ld = 256;  c0 = 0; }
        else if (pn < 7)   { off = Y_IQ;   ld = 512;  c0 = (pn - 5) * 256; }
        else if (pn < 9)   { off = Y_BQ;   ld = 512;  c0 = (pn - 7) * 256; }
        else if (pn < 11)  { off = Y_BK;   ld = 512;  c0 = (pn - 9) * 256; }
        else if (pn < 13)  { off = Y_BV;   ld = 512;  c0 = (pn - 11) * 256; }
        else if (pn < 16)  { off = Y_CQ;   ld = 768;  c0 = (pn - 13) * 256; }
        else if (pn < 19)  { off = Y_CK;   ld = 768;  c0 = (pn - 16) * 256; }
        else if (pn < 22)  { off = Y_CV;   ld = 768;  c0 = (pn - 19) * 256; }
        else               { off = Y_Z;    ld = 3072; c0 = (pn - 22) * 256; sig = true; }
        bf16_t* base = (bf16_t*)(y + off);
        const int row0 = u.pm * BM + wr * 64 + fr, col0 = c0 + wc * 32 + 8 * fq;
#pragma unroll
        for (int ai = 0; ai < 2; ++ai)
#pragma unroll
            for (int m = 0; m < 4; ++m) { bf16_t* rowp = base + (size_t)(row0 + ai * HALF + m * 16) * ld + col0;
#pragma unroll
                for (int bj = 0; bj < 2; ++bj) { f32x4 v0 = acc[ai][bj][m][0], v1 = acc[ai][bj][m][1];
                    if (sig) {
#pragma unroll
                        for (int i = 0; i < 4; ++i) { v0[i] = sigmoidf_(v0[i]); v1[i] = sigmoidf_(v1[i]); } }
                    u32x4 w; w.x = pk2(v0[0], v0[1]); w.y = pk2(v0[2], v0[3]); w.z = pk2(v1[0], v1[1]); w.w = pk2(v1[2], v1[3]);
                    *(u32x4*)(rowp + bj * HALF) = w; } }
    }
};
template <int MODE> struct EpiGate {
    static constexpr bool PERM = true, AFTER_DRAIN = false;
    const bf16_t* z; int zc0; float* mf; bf16_t* mb;
    __device__ __forceinline__ void operator()(const f32x4 (&acc)[2][2][4][2], const Unit& u, int wr, int wc, int fr, int fq) const {
        const int row0 = u.pm * BM + wr * 64 + fr, col0 = u.pn * BM + wc * 32 + 8 * fq;
#pragma unroll
        for (int ai = 0; ai < 2; ++ai)
#pragma unroll
            for (int m = 0; m < 4; ++m) { const size_t row = (size_t)(row0 + ai * HALF + m * 16);
#pragma unroll
                for (int bj = 0; bj < 2; ++bj) { const int col = col0 + bj * HALF;
                    const u32x4 zw = *(const u32x4*)(z + row * 3072 + zc0 + col);
                    f32x4 v0 = acc[ai][bj][m][0], v1 = acc[ai][bj][m][1];
                    v0[0] *= __uint_as_float(zw.x << 16); v0[1] *= __uint_as_float(zw.x & 0xffff0000u); v0[2] *= __uint_as_float(zw.y << 16); v0[3] *= __uint_as_float(zw.y & 0xffff0000u);
                    v1[0] *= __uint_as_float(zw.z << 16); v1[1] *= __uint_as_float(zw.z & 0xffff0000u); v1[2] *= __uint_as_float(zw.w << 16); v1[3] *= __uint_as_float(zw.w & 0xffff0000u);
                    float* mp = mf + row * 1024 + col;
                    if (MODE >= 1) { v0 += *(const f32x4*)mp; v1 += *(const f32x4*)(mp + 4); }
                    if (MODE <= 1) { *(f32x4*)mp = v0; *(f32x4*)(mp + 4) = v1; }
                    else { u32x4 w; w.x = pk2(v0[0], v0[1]); w.y = pk2(v0[2], v0[3]); w.z = pk2(v1[0], v1[1]); w.w = pk2(v1[2], v1[3]); *(u32x4*)(mb + row * 1024 + col) = w; } }
                asm volatile("" ::: "memory"); }
    }
};
struct EpiRes {
    static constexpr bool PERM = true, AFTER_DRAIN = false;
    const float* xin; float* xout; const float* gate; int row_off;
    __device__ __forceinline__ void operator()(const f32x4 (&acc)[2][2][4][2], const Unit& u, int wr, int wc, int fr, int fq) const {
        const int row0 = row_off + u.pm * BM + wr * 64 + fr, col0 = u.pn * BM + wc * 32 + 8 * fq;
        const float* gp = gate + (size_t)((row_off + u.pm * BM) / SEQ) * 6144 + col0;
        f32x4 g[2][2];
#pragma unroll
        for (int bj = 0; bj < 2; ++bj) { g[bj][0] = *(const f32x4*)(gp + bj * HALF); g[bj][1] = *(const f32x4*)(gp + bj * HALF + 4); }
#pragma unroll
        for (int ai = 0; ai < 2; ++ai)
#pragma unroll
            for (int m = 0; m < 4; ++m) { const size_t o = (size_t)(row0 + ai * HALF + m * 16) * 1024 + col0;
#pragma unroll
                for (int bj = 0; bj < 2; ++bj) {
                    const f32x4 a0 = *(const f32x4*)(xin + o + bj * HALF), a1 = *(const f32x4*)(xin + o + bj * HALF + 4);
                    *(f32x4*)(xout + o + bj * HALF) = a0 + g[bj][0] * acc[ai][bj][m][0];
                    *(f32x4*)(xout + o + bj * HALF + 4) = a1 + g[bj][1] * acc[ai][bj][m][1]; }
                asm volatile("" ::: "memory"); }
    }
};
struct EpiSwiGLU {
    static constexpr bool PERM = true, AFTER_DRAIN = false;
    bf16_t* act;
    __device__ __forceinline__ void operator()(const f32x4 (&acc)[2][2][4][2], const Unit& u, int wr, int wc, int fr, int fq) const {
        const int row0 = u.pm * BM + wr * 64 + fr, col0 = u.pn * HALF + wc * 32 + 8 * fq;
#pragma unroll
        for (int ai = 0; ai < 2; ++ai)
#pragma unroll
            for (int m = 0; m < 4; ++m) { bf16_t* rowp = act + (size_t)(row0 + ai * HALF + m * 16) * DFF + col0;
                f32x4 v0, v1;
#pragma unroll
                for (int i = 0; i < 4; ++i) { const float g0 = acc[ai][0][m][0][i], g1 = acc[ai][0][m][1][i];
                    v0[i] = g0 * sigmoidf_(g0) * acc[ai][1][m][0][i]; v1[i] = g1 * sigmoidf_(g1) * acc[ai][1][m][1][i]; }
                u32x4 w; w.x = pk2(v0[0], v0[1]); w.y = pk2(v0[2], v0[3]); w.z = pk2(v1[0], v1[1]); w.w = pk2(v1[2], v1[3]);
                *(u32x4*)rowp = w; }
    }
};
}

#define XB_TMO      128
#define XB_XCNT(j)  (256  + 64 * (j))
#define XB_XSUB(j)  (1280 + 64 * (j))
#define XB_XGEN(j)  (2304 + 64 * (j))
#define XB_TOP      3328
#define XB_TOPGEN   3392
#define XCD_BAR_WORDS 3456
#define XB_SPIN_CAP (1u << 24)

__device__ __forceinline__ unsigned xb_ld(unsigned* p)              { return __hip_atomic_load(p, __ATOMIC_RELAXED, __HIP_MEMORY_SCOPE_AGENT); }
__device__ __forceinline__ unsigned xb_add(unsigned* p, unsigned v) { return __hip_atomic_fetch_add(p, v, __ATOMIC_RELAXED, __HIP_MEMORY_SCOPE_AGENT); }
__device__ __forceinline__ unsigned xb_xcc_id() { return (unsigned)__builtin_amdgcn_s_getreg((3 << 11) | 20) & 0xFu; }
#define XB_SPIN(cond, bar) do { unsigned _sp = 0; while (cond) { __builtin_amdgcn_s_sleep(1); \
    if ((++_sp & 255u) == 0u) { if (xb_ld(&(bar)[XB_TMO])) break; if (_sp > XB_SPIN_CAP) { atomicAdd(&(bar)[XB_TMO], 1u); break; } } } } while (0)

struct XcdBarrier { unsigned* bar; unsigned x; volatile LAS unsigned* st; };

__device__ __forceinline__ XcdBarrier xcd_barrier_post(unsigned* bar, volatile LAS unsigned* st) {
    XcdBarrier b; b.bar = bar; b.x = (unsigned)__builtin_amdgcn_readfirstlane((int)xb_xcc_id()); b.st = st;
    if (threadIdx.x == 0) (void)xb_add(&bar[XB_XCNT(b.x)], 1u);
    return b;
}
__device__ __forceinline__ void xcd_barrier_complete(unsigned* bar, unsigned x, unsigned& nloc, unsigned& nx) {
    const unsigned G = gridDim.x * gridDim.y * gridDim.z;
    unsigned sum, cnt, mine, sp = 0u;
    for (;;) {
        sum = 0u; cnt = 0u; mine = 0u;
#pragma unroll
        for (unsigned j = 0; j < 16; ++j) { const unsigned c = xb_ld(&bar[XB_XCNT(j)]); sum += c; cnt += (c > 0u) ? 1u : 0u; mine = (j == x) ? c : mine; }
        if (sum == G) break;
        __builtin_amdgcn_s_sleep(1);
        if ((++sp & 255u) == 0u) { if (xb_ld(&bar[XB_TMO])) break; if (sp > XB_SPIN_CAP) { atomicAdd(&bar[XB_TMO], 1u); break; } }
    }
    nloc = mine > 0u ? mine : 1u; nx = cnt > 0u ? cnt : 1u;
}
__device__ __forceinline__ void xcd_barrier(const XcdBarrier& b) {
    asm volatile("s_waitcnt vmcnt(0)" ::: "memory");
    __syncthreads();
    if (threadIdx.x == 0) {
        unsigned* bar = b.bar; asm volatile("" : "+s"(bar));
        __builtin_amdgcn_s_waitcnt(0);
        unsigned nloc = b.st[0], nx = b.st[1];
        if (nloc == 0u) { xcd_barrier_complete(bar, b.x, nloc, nx); b.st[0] = nloc; b.st[1] = nx; }
        const unsigned old = xb_add(&bar[XB_XSUB(b.x)], 1u);
        const unsigned gen = old / nloc;
        if (old + 1u == (gen + 1u) * nloc) {
            __builtin_amdgcn_fence(__ATOMIC_RELEASE, "agent");
            asm volatile("s_waitcnt vmcnt(0)" ::: "memory");
            const unsigned og = xb_add(&bar[XB_TOP], 1u);
            const unsigned tg = og / nx;
            if (og + 1u == (tg + 1u) * nx) xb_add(&bar[XB_TOPGEN], 1u);
            else XB_SPIN(xb_ld(&bar[XB_TOPGEN]) == tg, bar);
            __builtin_amdgcn_fence(__ATOMIC_ACQUIRE, "agent");
            xb_add(&bar[XB_XGEN(b.x)], 1u);
            asm volatile("s_waitcnt vmcnt(0)" ::: "memory");
        } else {
            XB_SPIN(xb_ld(&bar[XB_XGEN(b.x)]) == gen, bar);
            __builtin_amdgcn_fence(__ATOMIC_ACQUIRE, "agent");
            asm volatile("s_waitcnt vmcnt(0)" ::: "memory");
        }
    }
    __syncthreads();
}

constexpr int RING_BYTES = 131072;
constexpr int LDSCTL_OFF = 155648;
constexpr int LDS_BYTES = 156672;

struct Args {
    const float* in[23]; float* out; unsigned char* ws; int pad0, pad1;
};

__device__ __forceinline__ int rel_bucket(int d) {
    if (d < 16) return d;
    int b = 16;
    b += (d >= 22); b += (d >= 30); b += (d >= 40); b += (d >= 54); b += (d >= 73); b += (d >= 99); b += (d >= 134); b += (d >= 182);
    b += (d >= 246); b += (d >= 332); b += (d >= 450); b += (d >= 609); b += (d >= 825); b += (d >= 1117); b += (d >= 1513);
    return b;
}
__device__ __forceinline__ int win_src_col(int n) {
    if (n < 1152) return 512 + (n - 1024);
    if (n < 1224) return n;
    if (n < 1280) return -1;
    if (n < 1792) return 640 + (n - 1280);
    return n - 568;
}
__device__ __forceinline__ void transpose_item(const float* W, int ldw, int K, bf16* WT, int kind, int kb, int nb, LAS float* scr, int lane) {
    const int k0 = 64 * kb, n0 = 32 * nb, nl = n0 + (lane & 31);
    int sc;
    if (kind == 0) sc = win_src_col(nl + 1024);
    else if (kind == 2) { const int j = nl >> 8, r = nl & 255; sc = (r < 128) ? (j * 128 + r) : (DFF + j * 128 + r - 128); }
    else sc = nl;
#pragma unroll 8
    for (int i = 0; i < 32; ++i) { const int kk = 2 * i + (lane >> 5); scr[kk * 33 + (lane & 31)] = (sc >= 0) ? W[(size_t)(k0 + kk) * ldw + sc] : 0.f; }
    asm volatile("s_waitcnt lgkmcnt(0)" ::: "memory");
    const int c = lane & 7;
    const int nrow0 = (kind == 0) ? 1024 : 0;
#pragma unroll
    for (int j = 0; j < 4; ++j) { const int n = (lane >> 3) + 8 * j; const LAS float* s = scr + (8 * c) * 33 + n;
        v4u o; o.x = pk2(s[0 * 33], s[1 * 33]); o.y = pk2(s[2 * 33], s[3 * 33]); o.z = pk2(s[4 * 33], s[5 * 33]); o.w = pk2(s[6 * 33], s[7 * 33]);
        *(v4u*)(WT + (size_t)(nrow0 + n0 + n) * K + k0 + 8 * c) = o; }
    asm volatile("s_waitcnt lgkmcnt(0)" ::: "memory");
}

__device__ __forceinline__ void p0a_prologue(const Args& a, unsigned char* ws, LAS unsigned char* lds, int tid, int lane, int wave, int G) {
    asm volatile("" : "+v"(lane), "+v"(tid));
    const float* c = a.in[1]; const float* w_ada = a.in[2]; const float* b_ada = a.in[3];
    float* mod = (float*)(ws + WS_MOD);
    if (blockIdx.x < 192) {
        LAS float* cs = (LAS float*)lds;
        LAS float* red = (LAS float*)(lds + 32768);
        for (int i = tid; i < 8192; i += NTHREADS) { const float v = c[i]; cs[i] = v / (1.f + __expf(-v)); }
        __syncthreads();
        for (int it = blockIdx.x; it < 192; it += G) {
            const int l = it / 96, cg = it % 96, n = cg * 64 + lane;
            float acc[8];
#pragma unroll
            for (int b = 0; b < 8; ++b) acc[b] = 0.f;
            const float* wp = w_ada + ((size_t)l * 1024 + wave * 128) * 6144 + n;
#pragma unroll 8
            for (int k = 0; k < 128; ++k) { const float wv = wp[(size_t)k * 6144];
#pragma unroll
                for (int b = 0; b < 8; ++b) acc[b] += cs[b * 1024 + wave * 128 + k] * wv; }
#pragma unroll
            for (int b = 0; b < 8; ++b) red[(wave * 8 + b) * 64 + lane] = acc[b];
            __syncthreads();
            { const int b = tid >> 6; float s = 0.f;
#pragma unroll
              for (int w = 0; w < 8; ++w) s += red[(w * 8 + b) * 64 + lane];
              mod[((size_t)l * 8 + b) * 6144 + n] = s + b_ada[l * 6144 + n]; }
            __syncthreads();
        }
    }
    { const float* rb = a.in[21]; float* T = (float*)(ws + WS_TAB);
      for (int d = blockIdx.x * NTHREADS + tid; d < 4096; d += G * NTHREADS) { const int bk = rel_bucket(d);
          for (int j = 0; j < 24; ++j) T[d * 24 + j] = rb[bk * 24 + j]; } }
    if (blockIdx.x == G - 1 && wave == 0) {
        float* lam = (float*)(ws + WS_LAM);
        for (int l = 0; l < NL; ++l) {
            const float s1 = wave_sum(a.in[9][l * 64 + lane] * a.in[10][l * 64 + lane]);
            const float s2 = wave_sum(a.in[11][l * 64 + lane] * a.in[12][l * 64 + lane]);
            const float lam_init = (l == 0) ? 0.2f : 0.35550907f;
            if (lane == 0) lam[l] = expf(s1) - expf(s2) + lam_init;
        }
    }
    {
        LAS float* scr = (LAS float*)(lds + 65536 + wave * 8448);
        const int gw = blockIdx.x * NWAVES + wave, NGW = G * NWAVES;
        constexpr int I_WIN = 16 * 240, I_B = 8 * 32, I_C = 4 * 32, I_OUT = 16 * 32, I_GU = 16 * 176, I_D = 44 * 32, I_FQ = 2048, I_FA = 2048;
        constexpr int I_LAYER = I_WIN + I_B + I_C + I_OUT + I_GU + I_D + I_FQ + I_FA;
        for (int it = gw; it < NL * I_LAYER; it += NGW) {
            const int l = it / I_LAYER; int r = it % I_LAYER;
            unsigned char* wl = ws + WS_W + (size_t)l * W_LAYER;
            const float* w_in = a.in[5] + (size_t)l * 1024 * WIN_SRC;
            if (r < I_WIN) { transpose_item(w_in, WIN_SRC, 1024, (bf16*)(wl + W_IN), 0, r / 240, r % 240, scr, lane); continue; } r -= I_WIN;
            if (r < I_B)   { transpose_item(a.in[15] + (size_t)l * 512 * 1024, 1024, 512, (bf16*)(wl + W_B), 1, r / 32, r % 32, scr, lane); continue; } r -= I_B;
            if (r < I_C)   { transpose_item(a.in[16] + (size_t)l * 256 * 1024, 1024, 256, (bf16*)(wl + W_C), 1, r / 32, r % 32, scr, lane); continue; } r -= I_C;
            if (r < I_OUT) { transpose_item(a.in[17] + (size_t)l * 1024 * 1024, 1024, 1024, (bf16*)(wl + W_OUT), 1, r / 32, r % 32, scr, lane); continue; } r -= I_OUT;
            if (r < I_GU)  { transpose_item(a.in[19] + (size_t)l * 1024 * NGU, NGU, 1024, (bf16*)(wl + W_GU), 2, r / 176, r % 176, scr, lane); continue; } r -= I_GU;
            if (r < I_D)   { transpose_item(a.in[20] + (size_t)l * DFF * 1024, 1024, DFF, (bf16*)(wl + W_D), 1, r / 32, r % 32, scr, lane); continue; } r -= I_D;
            if (r < I_FQ) {
                const int h = r >> 8, rem = r & 255, cc = (rem >> 7) * 64 + lane, k0 = (rem & 127) * 8;
                const float* uk = a.in[6] + ((size_t)(l * 8 + h) * 64) * 128 + cc;
                const float* wi = w_in + (size_t)k0 * WIN_SRC + h * 64;
                float acc[8];
#pragma unroll
                for (int j = 0; j < 8; ++j) acc[j] = 0.f;
                for (int d = 0; d < 64; ++d) { const float u = uk[d * 128];
#pragma unroll
                    for (int j = 0; j < 8; ++j) acc[j] += wi[(size_t)j * WIN_SRC + d] * u; }
                v4u o; o.x = pk2(acc[0], acc[1]); o.y = pk2(acc[2], acc[3]); o.z = pk2(acc[4], acc[5]); o.w = pk2(acc[6], acc[7]);
                *(v4u*)((bf16*)(wl + W_IN) + (size_t)(h * 128 + cc) * 1024 + k0) = o;
                continue; }
            r -= I_FQ;
            {
                const int ng = r >> 7, kg = r & 127, h = kg >> 4, c0 = (kg & 15) * 8, n = ng * 64 + lane;
                const float* uv = a.in[7] + ((size_t)(l * 8 + h) * 128 + c0) * 64;
                const float* wa = a.in[14] + ((size_t)l * 512 + h * 64) * 1024 + n;
                float acc[8];
#pragma unroll
                for (int j = 0; j < 8; ++j) acc[j] = 0.f;
                for (int e = 0; e < 64; ++e) { const float wv = wa[(size_t)e * 1024];
#pragma unroll
                    for (int j = 0; j < 8; ++j) acc[j] += uv[j * 64 + e] * wv; }
                v4u o; o.x = pk2(acc[0], acc[1]); o.y = pk2(acc[2], acc[3]); o.z = pk2(acc[4], acc[5]); o.w = pk2(acc[6], acc[7]);
                *(v4u*)((bf16*)(wl + W_A) + (size_t)n * 1024 + kg * 8) = o;
            }
        }
    }
}

__device__ __forceinline__ void norm_rows(const float* x, bf16* out, const float* g, const float* sh, const float* sc, int gw, int NGW, int lane) {
    asm volatile("" : "+v"(lane));
    for (int row = gw; row < MT; row += NGW) {
        const int b = row / SEQ;
        const f32x4* xr = (const f32x4*)(x + (size_t)row * 1024) + lane;
        f32x4 v[4]; float s = 0.f;
#pragma unroll
        for (int j = 0; j < 4; ++j) { v[j] = xr[64 * j]; s += (v[j].x * v[j].x + v[j].y * v[j].y) + (v[j].z * v[j].z + v[j].w * v[j].w); }
        const float rstd = 1.0f / sqrtf(wave_sum(s) * (1.f / 1024.f) + EPS);
        v2u* o8 = (v2u*)(out + (size_t)row * 1024) + lane;
#pragma unroll
        for (int j = 0; j < 4; ++j) { const int col = 256 * j + 4 * lane;
            const f32x4 gg = *(const f32x4*)(g + col), s1 = *(const f32x4*)(sc + (size_t)b * 6144 + col), s0 = *(const f32x4*)(sh + (size_t)b * 6144 + col);
            const f32x4 y = v[j] * rstd * gg * (s1 + 1.0f) + s0;
            v2u w; w.x = pk2(y.x, y.y); w.y = pk2(y.z, y.w); o8[64 * j] = w; }
    }
}
__device__ __forceinline__ void final_rows(float* x, const float* g, int gw, int NGW, int lane) {
    asm volatile("" : "+v"(lane));
    for (int row = gw; row < MT; row += NGW) {
        f32x4* xr = (f32x4*)(x + (size_t)row * 1024) + lane;
        f32x4 v[4]; float s = 0.f;
#pragma unroll
        for (int j = 0; j < 4; ++j) { v[j] = xr[64 * j]; s += (v[j].x * v[j].x + v[j].y * v[j].y) + (v[j].z * v[j].z + v[j].w * v[j].w); }
        const float rstd = 1.0f / sqrtf(wave_sum(s) * (1.f / 1024.f) + EPS);
#pragma unroll
        for (int j = 0; j < 4; ++j) { const f32x4 gg = *(const f32x4*)(g + 256 * j + 4 * lane); xr[64 * j] = v[j] * rstd * gg; }
    }
}

__device__ __forceinline__ float dot8(const LAS float* q, v4u w) {
    return q[0] * bflo(w.x) + q[1] * bfhi(w.x) + q[2] * bflo(w.y) + q[3] * bfhi(w.y) + q[4] * bflo(w.z) + q[5] * bfhi(w.z) + q[6] * bflo(w.w) + q[7] * bfhi(w.w);
}
__device__ __forceinline__ void kvn_rows(unsigned char* y, bf16* kvn, const float* gkv, int gw, int NGW, int lane) {
    asm volatile("" : "+v"(lane));
    const bf16* misc = (const bf16*)(y + Y_MISC);
    for (int r = gw; r < CHR; r += NGW) {
        const unsigned w = *(const unsigned*)(misc + (size_t)r * 256 + 2 * lane);
        const float a0 = bflo(w), a1 = bfhi(w);
        const float rstd = 1.0f / sqrtf(wave_sum(a0 * a0 + a1 * a1) * (1.f / 128.f) + EPS);
        *(unsigned*)(kvn + (size_t)r * 128 + 2 * lane) = pk2(a0 * rstd * gkv[2 * lane], a1 * rstd * gkv[2 * lane + 1]);
    }
}
__device__ __forceinline__ void mixC_v1(unsigned char* y, const float* T, LAS unsigned char* lds, int gw, int NGW, int lane, int wave) {
    asm volatile("" : "+v"(lane));
    const bf16* CQ = (const bf16*)(y + Y_CQ); const bf16* CK = (const bf16*)(y + Y_CK); const bf16* CV = (const bf16*)(y + Y_CV); bf16* OC = (bf16*)(y + Y_OC);
    LAS float* qs = (LAS float*)(lds + wave * 2048);
    LAS float* ps = qs + 64;
    for (int task = gw; task < CHR * 4; task += NGW) {
        const int r = task >> 2, hp = task & 3, t = r & (SEQ - 1), rb = r - t;
        float og[3], lse[3];
#pragma unroll
        for (int g = 0; g < 3; ++g) {
            const int dil = (g == 0) ? 1 : (g == 1) ? 4 : 16, hh = 4 * g + hp;
            qs[lane] = bf2f(CQ[(size_t)r * 768 + hh * 64 + lane]);
            asm volatile("s_waitcnt lgkmcnt(0)" ::: "memory");
            const int tq = t / dil, nv = (tq < 128 ? tq : 128) + 1;
            float lg[3];
#pragma unroll
            for (int rd = 0; rd < 3; ++rd) {
                const int j = lane + 64 * rd; float v = -INFINITY;
                if (j < nv) { const int s = t - j * dil; const bf16* kp = CK + (size_t)(rb + s) * 768 + hh * 64; float dot = 0.f;
#pragma unroll
                    for (int c8 = 0; c8 < 8; ++c8) dot += dot8(qs + 8 * c8, *(const v4u*)(kp + 8 * c8));
                    v = dot * 0.125f + T[(j * dil) * 24 + 12 + hh]; }
                lg[rd] = v;
            }
            const float m = wave_max(fmaxf(fmaxf(lg[0], lg[1]), lg[2]));
            float p[3], ls = 0.f;
#pragma unroll
            for (int rd = 0; rd < 3; ++rd) { p[rd] = (lane + 64 * rd < nv) ? __expf(lg[rd] - m) : 0.f; ls += p[rd]; ps[64 * rd + lane] = p[rd]; }
            const float l = wave_sum(ls);
            asm volatile("s_waitcnt lgkmcnt(0)" ::: "memory");
            float o = 0.f;
            for (int j = 0; j < nv; ++j) { const int s = t - j * dil; o += ps[j] * bf2f(CV[(size_t)(rb + s) * 768 + hh * 64 + lane]); }
            og[g] = o / l; lse[g] = m + __logf(l);
            asm volatile("s_waitcnt lgkmcnt(0)" ::: "memory");
        }
        const float M = fmaxf(fmaxf(lse[0], lse[1]), lse[2]);
        const float a0 = __expf(lse[0] - M), a1 = __expf(lse[1] - M), a2 = __expf(lse[2] - M);
        OC[(size_t)r * 256 + hp * 64 + lane] = (bf16)f2bf((a0 * og[0] + a1 * og[1] + a2 * og[2]) / (a0 + a1 + a2));
    }
}
__device__ __forceinline__ void mixB_v1(unsigned char* y, const float* T, const float* gsub, float lam, float one_m_li, LAS unsigned char* lds, int gw, int NGW, int lane, int wave) {
    asm volatile("" : "+v"(lane));
    bf16* BQ = (bf16*)(y + Y_BQ); const bf16* BK = (const bf16*)(y + Y_BK); const bf16* BV = (const bf16*)(y + Y_BV);
    LAS float* qs = (LAS float*)(lds + wave * 2048);
    LAS float* ps = qs + 128;
    for (int task = gw; task < CHR * 4; task += NGW) {
        const int r = task >> 2, h = task & 3, t = r & (SEQ - 1), rb = r - t;
        qs[lane] = bf2f(BQ[(size_t)r * 512 + h * 128 + lane]); qs[64 + lane] = bf2f(BQ[(size_t)r * 512 + h * 128 + 64 + lane]);
        asm volatile("s_waitcnt lgkmcnt(0)" ::: "memory");
        float m0 = -INFINITY, m1 = -INFINITY, l0 = 0.f, l1 = 0.f, o00 = 0.f, o01 = 0.f, o10 = 0.f, o11 = 0.f;
        for (int s0 = 0; s0 <= t; s0 += 64) {
            const int s = s0 + lane; float lg0 = -INFINITY, lg1 = -INFINITY;
            if (s <= t) { const bf16* kp = BK + (size_t)(rb + s) * 512 + h * 128; float d0 = 0.f, d1 = 0.f;
#pragma unroll
                for (int c8 = 0; c8 < 8; ++c8) { d0 += dot8(qs + 8 * c8, *(const v4u*)(kp + 8 * c8)); d1 += dot8(qs + 64 + 8 * c8, *(const v4u*)(kp + 64 + 8 * c8)); }
                const float bias = T[(t - s) * 24 + 8 + h]; lg0 = d0 * 0.125f + bias; lg1 = d1 * 0.125f + bias; }
            const float nm0 = fmaxf(m0, wave_max(lg0)), nm1 = fmaxf(m1, wave_max(lg1));
            const float f0 = __expf(m0 - nm0), f1 = __expf(m1 - nm1);
            const float p0 = (s <= t) ? __expf(lg0 - nm0) : 0.f, p1 = (s <= t) ? __expf(lg1 - nm1) : 0.f;
            l0 = l0 * f0 + wave_sum(p0); l1 = l1 * f1 + wave_sum(p1); o00 *= f0; o01 *= f0; o10 *= f1; o11 *= f1; m0 = nm0; m1 = nm1;
            ps[lane] = p0; ps[64 + lane] = p1;
            asm volatile("s_waitcnt lgkmcnt(0)" ::: "memory");
            const int nk = (t - s0 + 1 < 64) ? (t - s0 + 1) : 64;
            const bf16* vp = BV + (size_t)(rb + s0) * 512 + h * 128 + lane;
            for (int j = 0; j < nk; ++j) { const float v0 = bf2f(vp[(size_t)j * 512]), v1 = bf2f(vp[(size_t)j * 512 + 64]); const float pa = ps[j], pb = ps[64 + j];
                o00 += pa * v0; o01 += pa * v1; o10 += pb * v0; o11 += pb * v1; }
            asm volatile("s_waitcnt lgkmcnt(0)" ::: "memory");
        }
        const float oa = o00 / l0 - lam * (o10 / l1), ob = o01 / l0 - lam * (o11 / l1);
        const float rstd = 1.0f / sqrtf(wave_sum(oa * oa + ob * ob) * (1.f / 128.f) + EPS);
        BQ[(size_t)r * 512 + h * 128 + lane] = (bf16)f2bf(oa * rstd * gsub[lane] * one_m_li);
        BQ[(size_t)r * 512 + h * 128 + 64 + lane] = (bf16)f2bf(ob * rstd * gsub[64 + lane] * one_m_li);
    }
}
__device__ __forceinline__ unsigned mono_key(float f) { const unsigned u = __float_as_uint(f); return (u & 0x80000000u) ? ~u : (u | 0x80000000u); }
__device__ __forceinline__ void mixA_v1(unsigned char* y, const bf16* KVN, const float* T, LAS unsigned char* lds, int gw, int NGW, int lane, int wave) {
    asm volatile("" : "+v"(lane));
    bf16* QLAT = (bf16*)(y + Y_QLAT); const bf16* MISC = (const bf16*)(y + Y_MISC); const bf16* IQ = (const bf16*)(y + Y_IQ);
    LAS unsigned char* wb = lds + wave * 19456;
    LAS unsigned* scb = (LAS unsigned*)wb;
    LAS float* qi = (LAS float*)(wb + 16384);
    LAS unsigned* sel = (LAS unsigned*)(wb + 18432);
    LAS float* ql = (LAS float*)wb;
    LAS float* pb = (LAS float*)(wb + 4096);
    const unsigned long long lt_mask = (1ull << lane) - 1ull;
    for (int r = gw; r < CHR; r += NGW) {
        const int t = r & (SEQ - 1), rb = r - t, N = t + 1;
#pragma unroll
        for (int i = 0; i < 8; ++i) qi[i * 64 + lane] = bf2f(IQ[(size_t)r * 512 + i * 64 + lane]);
        const float wv = (lane < 8) ? bf2f(MISC[(size_t)r * 256 + 192 + lane]) * 0.044194173824159216f : 0.f;
        float wh[8];
#pragma unroll
        for (int h = 0; h < 8; ++h) wh[h] = __shfl(wv, h);
        asm volatile("s_waitcnt lgkmcnt(0)" ::: "memory");
        for (int s0 = 0; s0 < N; s0 += 64) {
            const int s = s0 + lane;
            if (s < N) { const bf16* kp = MISC + (size_t)(rb + s) * 256 + 128; v4u kw[8];
#pragma unroll
                for (int c8 = 0; c8 < 8; ++c8) kw[c8] = *(const v4u*)(kp + 8 * c8);
                float sc = 0.f;
#pragma unroll
                for (int h = 0; h < 8; ++h) { float d = 0.f;
#pragma unroll
                    for (int c8 = 0; c8 < 8; ++c8) d += dot8(qi + h * 64 + 8 * c8, kw[c8]);
                    sc += wh[h] * fmaxf(d, 0.f); }
                sc += 0.f;
                scb[s] = mono_key(sc); }
        }
        asm volatile("s_waitcnt lgkmcnt(0)" ::: "memory");
        int nsel;
        if (N <= TOPK) { for (int i = lane; i < N; i += 64) sel[i] = (unsigned)i; nsel = N; }
        else {
            unsigned tau = 0u;
            for (int bit = 31; bit >= 0; --bit) { const unsigned cand = tau | (1u << bit); int cnt = 0;
                for (int i = lane; i < N; i += 64) cnt += (scb[i] >= cand) ? 1 : 0;
#pragma unroll
                for (int o = 1; o < 64; o <<= 1) cnt += __shfl_xor(cnt, o);
                if (cnt >= TOPK) tau = cand; }
            int cgt = 0;
            for (int i = lane; i < N; i += 64) cgt += (scb[i] > tau) ? 1 : 0;
#pragma unroll
            for (int o = 1; o < 64; o <<= 1) cgt += __shfl_xor(cgt, o);
            const int need = TOPK - cgt; int pos = 0, eqt = 0;
            for (int s0 = 0; s0 < N; s0 += 64) { const int s = s0 + lane; const unsigned key = (s < N) ? scb[s] : 0u;
                const bool gt = (s < N) && key > tau, eq = (s < N) && key == tau;
                const unsigned long long beq = __ballot(eq);
                const bool take = gt || (eq && (eqt + __popcll(beq & lt_mask)) < need);
                const unsigned long long bt = __ballot(take);
                if (take) sel[pos + __popcll(bt & lt_mask)] = (unsigned)s;
                pos += __popcll(bt); eqt += __popcll(beq); }
            nsel = TOPK;
        }
        asm volatile("s_waitcnt lgkmcnt(0)" ::: "memory");
#pragma unroll
        for (int i = 0; i < 16; ++i) ql[i * 64 + lane] = bf2f(QLAT[(size_t)r * 1024 + i * 64 + lane]);
        asm volatile("s_waitcnt lgkmcnt(0)" ::: "memory");
        for (int rd = 0; rd < 4; ++rd) { const int jj = rd * 64 + lane;
            float acc[8];
#pragma unroll
            for (int h = 0; h < 8; ++h) acc[h] = -INFINITY;
            if (jj < nsel) { const int s = (int)sel[jj]; const bf16* kp = KVN + (size_t)(rb + s) * 128;
#pragma unroll
                for (int h = 0; h < 8; ++h) acc[h] = 0.f;
#pragma unroll 4
                for (int c8 = 0; c8 < 16; ++c8) { const v4u w = *(const v4u*)(kp + 8 * c8);
#pragma unroll
                    for (int h = 0; h < 8; ++h) acc[h] += dot8(ql + h * 128 + 8 * c8, w); }
                const float* tb = T + (t - s) * 24;
#pragma unroll
                for (int h = 0; h < 8; ++h) acc[h] = acc[h] * 0.125f + tb[h]; }
#pragma unroll
            for (int h = 0; h < 8; ++h) pb[h * 256 + jj] = acc[h];
        }
        asm volatile("s_waitcnt lgkmcnt(0)" ::: "memory");
#pragma unroll
        for (int h = 0; h < 8; ++h) { float v[4];
#pragma unroll
            for (int i = 0; i < 4; ++i) v[i] = pb[h * 256 + 64 * i + lane];
            const float m = wave_max(fmaxf(fmaxf(v[0], v[1]), fmaxf(v[2], v[3])));
#pragma unroll
            for (int i = 0; i < 4; ++i) v[i] = __expf(v[i] - m);
            const float inv = 1.0f / wave_sum((v[0] + v[1]) + (v[2] + v[3]));
#pragma unroll
            for (int i = 0; i < 4; ++i) pb[h * 256 + 64 * i + lane] = v[i] * inv; }
        asm volatile("s_waitcnt lgkmcnt(0)" ::: "memory");
        float o0[8], o1[8];
#pragma unroll
        for (int h = 0; h < 8; ++h) { o0[h] = 0.f; o1[h] = 0.f; }
        for (int jj = 0; jj < nsel; ++jj) { const int s = (int)sel[jj]; const bf16* vp = KVN + (size_t)(rb + s) * 128 + lane;
            const float v0 = bf2f(vp[0]), v1 = bf2f(vp[64]);
#pragma unroll
            for (int h = 0; h < 8; ++h) { const float p = pb[h * 256 + jj]; o0[h] += p * v0; o1[h] += p * v1; } }
#pragma unroll
        for (int h = 0; h < 8; ++h) { QLAT[(size_t)r * 1024 + h * 128 + lane] = (bf16)f2bf(o0[h]); QLAT[(size_t)r * 1024 + h * 128 + 64 + lane] = (bf16)f2bf(o1[h]); }
        asm volatile("s_waitcnt lgkmcnt(0)" ::: "memory");
    }
}

typedef short bf16x8 __attribute__((ext_vector_type(8)));
typedef short s16x4 __attribute__((ext_vector_type(4)));
typedef float f32x16 __attribute__((ext_vector_type(16)));
#define LOG2E 1.4426950408889634f
__device__ __forceinline__ int crow(int r, int hi) { return (r & 3) + 8 * (r >> 2) + 4 * hi; }
__device__ __forceinline__ void glds16(const void* g, LAS void* l) { __builtin_amdgcn_global_load_lds((const unsigned*)g, (LAS unsigned*)l, 16, 0, 0); }
__device__ __forceinline__ s16x4 tr16(const LAS unsigned char* p) { return __builtin_bit_cast(s16x4, __builtin_amdgcn_ds_read_tr16_b64_v4i16((LAS s16x4*)p)); }
__device__ __forceinline__ float swap_max(float v) { auto rr = __builtin_amdgcn_permlane32_swap(__float_as_uint(v), __float_as_uint(v), false, false); return fmaxf(__uint_as_float(rr[0]), __uint_as_float(rr[1])); }
__device__ __forceinline__ float swap_add(float v) { auto rr = __builtin_amdgcn_permlane32_swap(__float_as_uint(v), __float_as_uint(v), false, false); return __uint_as_float(rr[0]) + __uint_as_float(rr[1]); }
__device__ __forceinline__ unsigned cvtpk(float lo, float hi) { unsigned r; asm("v_cvt_pk_bf16_f32 %0, %1, %2" : "=v"(r) : "v"(lo), "v"(hi)); return r; }
#define RAW_BARRIER() do { asm volatile("s_waitcnt lgkmcnt(0)" ::: "memory"); __builtin_amdgcn_s_barrier(); asm volatile("" ::: "memory"); } while (0)

__device__ __forceinline__ void mixB_fast(unsigned char* y, const float* T, const float* gsub, float lam, float one_m_li, LAS unsigned char* lds, int tid, int lane, int wave, int G) {
    asm volatile("" : "+v"(lane), "+v"(tid));
    bf16* BQ = (bf16*)(y + Y_BQ); const bf16* BK = (const bf16*)(y + Y_BK); const bf16* BV = (const bf16*)(y + Y_BV);
    const int r32 = lane & 31, hi = lane >> 5, m = wave >> 2, qs = wave & 3;
    LAS float* bt = (LAS float*)(lds + 65536);
    constexpr float C2 = 0.125f * LOG2E, THR = 8.0f;
    for (int item = blockIdx.x; item < CHB * 4 * 16; item += G) {
        const int bh = item >> 4, pr = item & 15, bb = bh >> 2, h = bh & 3, rb = bb * SEQ;
        RAW_BARRIER();
        for (int i = tid; i < 64 + 4096; i += NTHREADS) bt[i] = (i < 64) ? 0.f : T[(i - 64) * 24 + 8 + h] * LOG2E;
        for (int uu = 0; uu < 2; ++uu) {
            const int qb = (uu == 0) ? (31 - pr) : pr;
            const int q0w = qb * 128 + qs * 32, qpos = q0w + r32;
            bf16x8 qf[4];
#pragma unroll
            for (int ks = 0; ks < 4; ++ks) qf[ks] = *(const bf16x8*)(BQ + (size_t)(rb + qpos) * 512 + h * 128 + m * 64 + 16 * ks + 8 * hi);
            const int NT = 2 * (qb + 1);
            f32x16 O[4];
#pragma unroll
            for (int dq = 0; dq < 4; ++dq)
#pragma unroll
                for (int r = 0; r < 16; ++r) O[dq][r] = 0.f;
            float mref = -INFINITY, lsum = 0.f;
#define MB_STAGE(t_, buf_) do { const int kv0_ = (t_) * 64; LAS unsigned char* sb_ = lds + (buf_) * 32768; \
                glds16(BK + (size_t)(rb + kv0_ + lane) * 512 + h * 128 + wave * 8, sb_ + wave * 1024); \
                glds16(BK + (size_t)(rb + kv0_ + lane) * 512 + h * 128 + 64 + wave * 8, sb_ + 8192 + wave * 1024); \
                _Pragma("unroll") for (int i_ = 0; i_ < 2; ++i_) { const int p_ = 2 * wave + i_, dq_ = p_ >> 2, rg_ = p_ & 3; \
                    glds16(BV + (size_t)(rb + kv0_ + 16 * rg_ + (lane >> 2)) * 512 + h * 128 + dq_ * 32 + (lane & 3) * 8, sb_ + 16384 + p_ * 1024); } } while (0)
            MB_STAGE(0, 0);
            for (int t = 0; t < NT; ++t) {
                if (t + 1 < NT) { MB_STAGE(t + 1, (t + 1) & 1); asm volatile("s_waitcnt vmcnt(4)" ::: "memory"); }
                else asm volatile("s_waitcnt vmcnt(0)" ::: "memory");
                RAW_BARRIER();
                const int kv0 = t * 64;
                if (kv0 <= q0w + 31) {
                    const LAS unsigned char* sb = lds + (t & 1) * 32768;
                    const LAS unsigned char* kb = sb + m * 8192 + hi * 1024 + r32 * 16;
                    f32x16 s0, s1;
#pragma unroll
                    for (int r = 0; r < 16; ++r) { s0[r] = 0.f; s1[r] = 0.f; }
#pragma unroll
                    for (int ks = 0; ks < 4; ++ks) {
                        const bf16x8 k0 = *(const LAS bf16x8*)(kb + ks * 2048), k1 = *(const LAS bf16x8*)(kb + ks * 2048 + 512);
                        s0 = __builtin_amdgcn_mfma_f32_32x32x16_bf16(k0, qf[ks], s0, 0, 0, 0);
                        s1 = __builtin_amdgcn_mfma_f32_32x32x16_bf16(k1, qf[ks], s1, 0, 0, 0); }
                    const int dmin = q0w - (kv0 + 63), dmax = q0w + 31 - kv0;
                    if (dmin >= 0 && rel_bucket(dmin) == rel_bucket(dmax)) {
                        const float cb = bt[64 + dmin];
#pragma unroll
                        for (int r = 0; r < 16; ++r) { s0[r] = fmaf(s0[r], C2, cb); s1[r] = fmaf(s1[r], C2, cb); }
                    } else {
                        const LAS float* bp = bt + 64 + (qpos - kv0) - 4 * hi;
#pragma unroll
                        for (int r = 0; r < 16; ++r) { s0[r] = fmaf(s0[r], C2, bp[-((r & 3) + 8 * (r >> 2))]); s1[r] = fmaf(s1[r], C2, bp[-(32 + (r & 3) + 8 * (r >> 2))]); }
                    }
                    if (kv0 + 63 > q0w) {
#pragma unroll
                        for (int r = 0; r < 16; ++r) { const int kv = kv0 + crow(r, hi); if (kv > qpos) s0[r] = -INFINITY; if (kv + 32 > qpos) s1[r] = -INFINITY; }
                    }
                    float rm = fmaxf(s0[0], s1[0]);
#pragma unroll
                    for (int r = 1; r < 16; ++r) rm = fmaxf(rm, fmaxf(s0[r], s1[r]));
                    rm = swap_max(rm);
                    if (__any(rm > mref + THR)) {
                        const float mn = fmaxf(mref, rm), f = __builtin_amdgcn_exp2f(mref - mn);
                        lsum *= f; mref = mn;
#pragma unroll
                        for (int dq = 0; dq < 4; ++dq)
#pragma unroll
                            for (int r = 0; r < 16; ++r) O[dq][r] *= f;
                    }
                    float ps = 0.f;
#pragma unroll
                    for (int r = 0; r < 16; ++r) { s0[r] = __builtin_amdgcn_exp2f(s0[r] - mref); s1[r] = __builtin_amdgcn_exp2f(s1[r] - mref); ps += s0[r] + s1[r]; }
                    lsum += ps;
                    bf16x8 pf[4];
                    { v4u w;
                      w.x = cvtpk(s0[0], s0[1]); w.y = cvtpk(s0[2], s0[3]); w.z = cvtpk(s0[4], s0[5]); w.w = cvtpk(s0[6], s0[7]); pf[0] = __builtin_bit_cast(bf16x8, w);
                      w.x = cvtpk(s0[8], s0[9]); w.y = cvtpk(s0[10], s0[11]); w.z = cvtpk(s0[12], s0[13]); w.w = cvtpk(s0[14], s0[15]); pf[1] = __builtin_bit_cast(bf16x8, w);
                      w.x = cvtpk(s1[0], s1[1]); w.y = cvtpk(s1[2], s1[3]); w.z = cvtpk(s1[4], s1[5]); w.w = cvtpk(s1[6], s1[7]); pf[2] = __builtin_bit_cast(bf16x8, w);
                      w.x = cvtpk(s1[8], s1[9]); w.y = cvtpk(s1[10], s1[11]); w.z = cvtpk(s1[12], s1[13]); w.w = cvtpk(s1[14], s1[15]); pf[3] = __builtin_bit_cast(bf16x8, w); }
                    const LAS unsigned char* vb = sb + 16384 + ((lane >> 4) & 1) * 32 + (lane & 3) * 8 + (4 * hi + ((lane & 15) >> 2)) * 64;
#pragma unroll
                    for (int dq = 0; dq < 4; ++dq)
#pragma unroll
                        for (int sp = 0; sp < 4; ++sp) {
                            const s16x4 lo = tr16(vb + (dq * 4 + sp) * 1024), hh = tr16(vb + (dq * 4 + sp) * 1024 + 512);
                            const bf16x8 vf = (bf16x8){lo[0], lo[1], lo[2], lo[3], hh[0], hh[1], hh[2], hh[3]};
                            O[dq] = __builtin_amdgcn_mfma_f32_32x32x16_bf16(vf, pf[sp], O[dq], 0, 0, 0); }
                }
                RAW_BARRIER();
            }
#undef MB_STAGE
            const float inv = 1.0f / swap_add(lsum);
            LAS float* xb = (LAS float*)lds + qs * 4096;
            if (m == 1) {
#pragma unroll
                for (int dq = 0; dq < 4; ++dq)
#pragma unroll
                    for (int r = 0; r < 16; ++r) xb[(dq * 16 + r) * 64 + lane] = O[dq][r] * inv;
            }
            RAW_BARRIER();
            if (m == 0) {
                float ss = 0.f;
#pragma unroll
                for (int dq = 0; dq < 4; ++dq)
#pragma unroll
                    for (int r = 0; r < 16; ++r) { const float o = O[dq][r] * inv - lam * xb[(dq * 16 + r) * 64 + lane]; O[dq][r] = o; ss += o * o; }
                const float rstd = 1.0f / sqrtf(swap_add(ss) * (1.f / 128.f) + EPS) * one_m_li;
                bf16* orow = BQ + (size_t)(rb + qpos) * 512 + h * 128;
#pragma unroll
                for (int dq = 0; dq < 4; ++dq)
#pragma unroll
                    for (int g4 = 0; g4 < 4; ++g4) { const int d0 = dq * 32 + 8 * g4 + 4 * hi; const f32x4 gs = *(const f32x4*)(gsub + d0);
                        v2u w; w.x = pk2(O[dq][4 * g4] * rstd * gs.x, O[dq][4 * g4 + 1] * rstd * gs.y); w.y = pk2(O[dq][4 * g4 + 2] * rstd * gs.z, O[dq][4 * g4 + 3] * rstd * gs.w);
                        *(v2u*)(orow + d0) = w; }
            }
            asm volatile("s_waitcnt vmcnt(0)" ::: "memory");
            RAW_BARRIER();
        }
    }
}
__global__ void __launch_bounds__(NTHREADS, 2) fwd(Args a) {
    extern __shared__ __attribute__((aligned(16))) unsigned char lds_raw[];
    LAS unsigned char* lds = (LAS unsigned char*)lds_raw;
    const int tid = threadIdx.x, lane = tid & 63, wave = __builtin_amdgcn_readfirstlane(tid >> 6);
    const int G = gridDim.x, gw = blockIdx.x * NWAVES + wave, NGW = G * NWAVES;
    unsigned char* ws = a.ws;
    for (int u = tid; u < (LDS_BYTES - LDSCTL_OFF) / 4; u += NTHREADS) ((LAS unsigned*)(lds + LDSCTL_OFF))[u] = 0u;
    __syncthreads();
    XcdBarrier bar = xcd_barrier_post((unsigned*)(ws + WS_CTL) + CW_BAR, (volatile LAS unsigned*)(lds + LDSCTL_OFF));

    const float* x_in = a.in[0]; float* xo = a.out;
    float* mod = (float*)(ws + WS_MOD); const float* T = (const float*)(ws + WS_TAB); const float* lamp = (const float*)(ws + WS_LAM);
    bf16* H = (bf16*)(ws + WS_H); unsigned char* y = ws + WS_Y; bf16* KVN = (bf16*)(ws + WS_KVN);

    p0a_prologue(a, ws, lds, tid, lane, wave, G);
    xcd_barrier(bar);
    norm_rows(x_in, H, a.in[4], mod + 0 * 1024, mod + 1 * 1024, gw, NGW, lane);
    xcd_barrier(bar);

#pragma unroll
    for (int l = 0; l < NL; ++l) {
        unsigned char* wl = ws + WS_W + (size_t)l * W_LAYER;
        const float* modl = mod + (size_t)l * 8 * 6144;
#pragma unroll
        for (int ch = 0; ch < NCH; ++ch) {
            { pg8::Gemm g{H + (size_t)ch * CHR * 1024, (const bf16*)(wl + W_IN), CHR, NIN, 1024}; pg8::StaticOrder S; S.init(CHR, NIN, G, (int)blockIdx.x);
              pg8::EpiIn E{y};
              pg8::gemm_phase<pg8::EpiIn, pg8::StaticOrder, true, true>(lds, g, S, E); }
            xcd_barrier(bar);
            kvn_rows(y, KVN, a.in[8] + l * 128, gw, NGW, lane);
            mixC_v1(y, T, lds, gw, NGW, lane, wave);
            mixB_fast(y, T, a.in[13] + l * 128, lamp[l], (l == 0) ? 0.8f : 0.64449093f, lds, tid, lane, wave, G);
            xcd_barrier(bar);
            mixA_v1(y, KVN, T, lds, gw, NGW, lane, wave);
            xcd_barrier(bar);
            { pg8::StaticOrder S; S.init(CHR, 1024, G, (int)blockIdx.x);
              const bf16* Z = (const bf16*)(y + Y_Z); float* MF = (float*)(y + Y_MF32); bf16* MB = (bf16*)(y + Y_MBF);
              { pg8::Gemm g{(const bf16*)(y + Y_QLAT), (const bf16*)(wl + W_A), CHR, 1024, 1024}; pg8::EpiGate<0> E{Z, 0, MF, MB};
                pg8::gemm_phase<pg8::EpiGate<0>, pg8::StaticOrder, true, true>(lds, g, S, E); }
              { pg8::Gemm g{(const bf16*)(y + Y_BQ), (const bf16*)(wl + W_B), CHR, 1024, 512}; pg8::EpiGate<1> E{Z, 1024, MF, MB};
                pg8::gemm_phase<pg8::EpiGate<1>, pg8::StaticOrder, true, true>(lds, g, S, E); }
              { pg8::Gemm g{(const bf16*)(y + Y_OC), (const bf16*)(wl + W_C), CHR, 1024, 256}; pg8::EpiGate<2> E{Z, 2048, MF, MB};
                pg8::gemm_phase<pg8::EpiGate<2>, pg8::StaticOrder, true, true>(lds, g, S, E); } }
            xcd_barrier(bar);
            { pg8::Gemm g{(const bf16*)(y + Y_MBF), (const bf16*)(wl + W_OUT), CHR, 1024, 1024}; pg8::StaticOrder S; S.init(CHR, 1024, G, (int)blockIdx.x);
              pg8::EpiRes E{(l == 0) ? x_in : (const float*)xo, xo, modl + 2 * 1024, ch * CHR};
              pg8::gemm_phase<pg8::EpiRes, pg8::StaticOrder, true, true>(lds, g, S, E); }
            xcd_barrier(bar);
        }
        norm_rows(xo, H, a.in[18] + l * 1024, modl + 3 * 1024, modl + 4 * 1024, gw, NGW, lane);
        xcd_barrier(bar);
        { pg8::Gemm g{H, (const bf16*)(wl + W_GU), MT, NGU, 1024}; pg8::StaticOrder S; S.init(MT, NGU, G, (int)blockIdx.x);
          pg8::EpiSwiGLU E{(bf16*)(ws + WS_ACT)};
          pg8::gemm_phase<pg8::EpiSwiGLU, pg8::StaticOrder, true, true>(lds, g, S, E); }
        xcd_barrier(bar);
        { pg8::Gemm g{(const bf16*)(ws + WS_ACT), (const bf16*)(wl + W_D), MT, 1024, DFF}; pg8::StaticOrder S; S.init(MT, 1024, G, (int)blockIdx.x);
          pg8::EpiRes E{xo, xo, modl + 5 * 1024, 0};
          pg8::gemm_phase<pg8::EpiRes, pg8::StaticOrder, true, true>(lds, g, S, E); }
        xcd_barrier(bar);
        if (l + 1 < NL) { norm_rows(xo, H, a.in[4] + (l + 1) * 1024, modl + 8 * 6144 + 0 * 1024, modl + 8 * 6144 + 1 * 1024, gw, NGW, lane); xcd_barrier(bar); }
        else final_rows(xo, a.in[22], gw, NGW, lane);
    }
}

extern "C" void kernel_launch(void* const* d_in, const int* in_sizes, int n_in, void* d_out, int out_size, void* d_ws, size_t ws_size, hipStream_t stream) {
    static int grid = 0;
    if (grid == 0) {
        if (n_in != 23 || out_size != MT * DM || ws_size < WS_END) { fprintf(stderr, "kernel_launch: unexpected shapes (n_in %d out %d ws %zu)\n", n_in, out_size, ws_size); grid = -1; return; }
        int dev = 0, cus = 0, per_cu = 0;
        if (hipGetDevice(&dev) != hipSuccess || hipDeviceGetAttribute(&cus, hipDeviceAttributeMultiprocessorCount, dev) != hipSuccess) { grid = -1; return; }
        if (hipFuncSetAttribute((const void*)fwd, hipFuncAttributeMaxDynamicSharedMemorySize, LDS_BYTES) != hipSuccess) { fprintf(stderr, "kernel_launch: hipFuncSetAttribute failed\n"); grid = -1; return; }
        if (hipOccupancyMaxActiveBlocksPerMultiprocessor(&per_cu, (const void*)fwd, NTHREADS, LDS_BYTES) != hipSuccess || per_cu < 1) { fprintf(stderr, "kernel_launch: occupancy query says %d\n", per_cu); }
        (void)hipGetLastError();
        grid = cus;
    }
    if (grid < 0) return;
    (void)hipMemsetAsync((char*)d_ws + WS_CTL, 0, CTL_ZERO_BYTES, stream);
    Args a{};
    for (int i = 0; i < 23; ++i) a.in[i] = (const float*)d_in[i];
    a.out = (float*)d_out; a.ws = (unsigned char*)d_ws; a.pad0 = 0; a.pad1 = 0;
    hipLaunchKernelGGL(fwd, dim3(grid), dim3(NTHREADS), LDS_BYTES, stream, a);
}
```

```cpp
#include <hip/hip_runtime.h>
#include <cstdio>
#include <cstdint>
namespace pg8 {
#define PG8_LAS __attribute__((address_space(3)))
typedef unsigned short bf16_t;
typedef short bf16x8 __attribute__((ext_vector_type(8)));
typedef float f32x4 __attribute__((ext_vector_type(4)));
typedef unsigned u32x4 __attribute__((ext_vector_type(4)));
constexpr int BM = 256, BK = 64, HALF = 128, HTB = HALF * BK * 2  , STAGE_BYTES = 8 * HTB, NXCD = 8, WGM = 8;

__host__ __device__ __forceinline__ int lds_byte(int r, int c) { const int st = (r >> 4) * 2 + (c >> 5), rr = r & 15, cc = c & 31, ob = rr * 64 + cc * 2; return st * 1024 + (ob ^ (((ob >> 9) & 1) << 5)); }
__host__ __device__ __forceinline__ void stage_rc(int b, int& R, int& C) { const int st = b / 1024, sb = b % 1024, swz = sb ^ (((sb >> 9) & 1) << 5); R = (st >> 1) * 16 + swz / 64; C = (st & 1) * 32 + (swz % 64) / 2; }
__host__ __device__ __forceinline__ int perm32(int rho) { const int n = rho >> 4, i = rho & 15; return 8 * (i >> 2) + 4 * n + (i & 3); }

struct Unit { int pm, pn; };
struct Gemm { const bf16_t* A; const bf16_t* Bt; int M, N, K; };

struct StaticOrder {
    int nM, nN, nwg, G, c;
    __host__ __device__ void init(int M, int N, int G_, int c_) { nM = M / BM; nN = N / BM; nwg = nM * nN; G = G_; c = c_; }
    __host__ __device__ bool next(int i, Unit& u) const {
        const long L = (long)i * G + c; if (L >= nwg) return false;
        int wgid = (int)L; { const int q = nwg / NXCD, r = nwg % NXCD, xcd = wgid % NXCD, off = wgid / NXCD; wgid = (xcd < r ? xcd * (q + 1) : r * (q + 1) + (xcd - r) * q) + off; }
        const int nig = WGM * nN, gid = wgid / nig, fm = gid * WGM, gsz = (nM - fm) < WGM ? (nM - fm) : WGM;
        u.pm = fm + ((wgid % nig) % gsz); u.pn = (wgid % nig) / gsz; return true;
    }
    __device__ __forceinline__ void a_ready(const Unit&) const {}
    __device__ __forceinline__ void done(const Unit&) const {}
};

template <class Epi, class Sched, bool ALIGN_EPI = false, bool SP2 = false>
__device__ __forceinline__ void gemm_phase(PG8_LAS unsigned char* lds, const Gemm g, const Sched& S, const Epi& E) {
    int tid_l = threadIdx.x; asm volatile("" : "+v"(tid_l));
    const int tid = tid_l, wid = __builtin_amdgcn_readfirstlane(tid >> 6), lane = tid & 63, wr = wid >> 2, wc = wid & 3, fr = lane & 15, fq = lane >> 4;
    int K_l = g.K; asm volatile("" : "+s"(K_l));
    const int K = K_l, nt = K / BK;
    unsigned voffA[2], voffB[2];
#pragma unroll
    for (int i = 0; i < 2; ++i) { int R, C; stage_rc(tid * 16 + i * 8192, R, C); const int Rb = Epi::PERM ? ((R & ~31) + perm32(R & 31)) : R;
        voffA[i] = (unsigned)(R * K + C) * 2u; voffB[i] = (unsigned)(Rb * K + C) * 2u; }
    const size_t kstep = (size_t)(BK * 2);
    const size_t hstep = (size_t)HALF * K * 2;
    const size_t tstep = 2 * hstep;
    const unsigned ldsw = (unsigned)wid * 1024u;
    const int aoff = lds_byte(wr * 64 + fr, fq * 8), boff = lds_byte(wc * 32 + fr, fq * 8);
#define PG8_SA(b, h) (((b) * 2 + (h)) * HTB)
#define PG8_SB(b, h) ((4 + (b) * 2 + (h)) * HTB)
#define PG8_STAGE(bufoff, gbase, voff) do { _Pragma("unroll") for (int _i = 0; _i < 2; ++_i) \
        __builtin_amdgcn_global_load_lds((const unsigned*)((const char*)(gbase) + (voff)[_i]), (PG8_LAS unsigned*)(lds + (bufoff) + ldsw + _i * 8192), 16, 0, 0); } while (0)
#define PG8_LDA(dst, b, h) do { _Pragma("unroll") for (int m = 0; m < 4; ++m) _Pragma("unroll") for (int k = 0; k < 2; ++k) dst[m][k] = *(const PG8_LAS bf16x8*)(lds + PG8_SA(b, h) + aoff + m * 2048 + k * 1024); } while (0)
#define PG8_LDB(dst, b, h) do { _Pragma("unroll") for (int n = 0; n < 2; ++n) _Pragma("unroll") for (int k = 0; k < 2; ++k) dst[n][k] = *(const PG8_LAS bf16x8*)(lds + PG8_SB(b, h) + boff + n * 2048 + k * 1024); } while (0)
#define PG8_MMA(ai, bj, At, Bt) do { __builtin_amdgcn_s_setprio(1); _Pragma("unroll") for (int m = 0; m < 4; ++m) _Pragma("unroll") for (int n = 0; n < 2; ++n) _Pragma("unroll") for (int k = 0; k < 2; ++k) \
        acc[ai][bj][m][n] = __builtin_amdgcn_mfma_f32_16x16x32_bf16(Bt[n][k], At[m][k], acc[ai][bj][m][n], 0, 0, 0); __builtin_amdgcn_s_setprio(0); } while (0)
#define PG8_WAIT_V(n) asm volatile("s_waitcnt vmcnt(" #n ")" ::: "memory")
#define PG8_WAIT_L(n) asm volatile("s_waitcnt lgkmcnt(" #n ")" ::: "memory")
#define PG8_BAR __builtin_amdgcn_s_barrier()
#define PG8_SCHED __builtin_amdgcn_sched_barrier(0)
    Unit cur, nxt; int ui = 0;
    if (!S.next(0, cur)) return;
    f32x4 acc[2][2][4][2];
#pragma unroll
    for (int a = 0; a < 2; ++a)
#pragma unroll
        for (int b = 0; b < 2; ++b)
#pragma unroll
            for (int m = 0; m < 4; ++m)
#pragma unroll
                for (int n = 0; n < 2; ++n) acc[a][b][m][n] = (f32x4){0.f, 0.f, 0.f, 0.f};
    bf16x8 At[4][2], B0[2][2], B1[2][2];
    const char* cA = (const char*)g.A + (size_t)cur.pm * tstep; const char* cB = (const char*)g.Bt + (size_t)cur.pn * tstep;
    S.a_ready(cur);
    if constexpr (SP2) {
        PG8_STAGE(PG8_SB(0, 0), cB, voffB); PG8_STAGE(PG8_SB(0, 1), cB + hstep, voffB); PG8_STAGE(PG8_SA(0, 0), cA, voffA); PG8_STAGE(PG8_SA(0, 1), cA + hstep, voffA);
        if (wr == 1) PG8_BAR;
        PG8_WAIT_V(2); PG8_BAR;
        PG8_STAGE(PG8_SB(1, 0), cB + kstep, voffB); PG8_STAGE(PG8_SA(1, 0), cA + kstep, voffA); PG8_STAGE(PG8_SB(1, 1), cB + hstep + kstep, voffB);
        PG8_WAIT_V(6); PG8_BAR;
    } else {
        PG8_STAGE(PG8_SB(0, 0), cB, voffB); PG8_STAGE(PG8_SA(0, 0), cA, voffA); PG8_STAGE(PG8_SB(0, 1), cB + hstep, voffB); PG8_STAGE(PG8_SA(0, 1), cA + hstep, voffA);
        if (wr == 1) PG8_BAR;
        PG8_WAIT_V(4); PG8_BAR;
        PG8_STAGE(PG8_SB(1, 0), cB + kstep, voffB); PG8_STAGE(PG8_SA(1, 0), cA + kstep, voffA); PG8_STAGE(PG8_SB(1, 1), cB + hstep + kstep, voffB);
        PG8_WAIT_V(6); PG8_BAR;
    }
    for (;;) {
        const bool has_next = S.next(ui + 1, nxt);
        const char* nA = has_next ? (const char*)g.A + (size_t)nxt.pm * tstep : cA; const char* nB = has_next ? (const char*)g.Bt + (size_t)nxt.pn * tstep : cB;
        for (int t = 0; t < nt; t += 2) {
            const bool last = (t == nt - 2);
            const char* a1 = cA + (size_t)(t + 1) * kstep;
            const char* a2 = last ? nA : cA + (size_t)(t + 2) * kstep; const char* b2 = last ? nB : cB + (size_t)(t + 2) * kstep;
            const char* a3 = a2 + kstep; const char* b3 = b2 + kstep;
            if (last && has_next) S.a_ready(nxt);
            if constexpr (SP2) {
            PG8_LDB(B0, 0, 0); PG8_LDB(B1, 0, 1); PG8_SCHED; PG8_LDA(At, 0, 0); PG8_STAGE(PG8_SA(1, 1), a1 + hstep, voffA);
            PG8_WAIT_V(8); PG8_WAIT_L(0); PG8_BAR; PG8_MMA(0, 0, At, B0); PG8_MMA(0, 1, At, B1); PG8_BAR; PG8_SCHED;
            PG8_LDA(At, 0, 1); PG8_STAGE(PG8_SB(0, 0), b2, voffB); PG8_STAGE(PG8_SB(0, 1), b2 + hstep, voffB); PG8_STAGE(PG8_SA(0, 0), a2, voffA);
            PG8_WAIT_V(8); PG8_WAIT_L(0); PG8_BAR; PG8_MMA(1, 0, At, B0); PG8_MMA(1, 1, At, B1); PG8_BAR; PG8_SCHED;
            PG8_LDB(B0, 1, 0); PG8_LDB(B1, 1, 1); PG8_SCHED; PG8_LDA(At, 1, 0); PG8_STAGE(PG8_SA(0, 1), a2 + hstep, voffA);
            PG8_WAIT_V(8); PG8_WAIT_L(0); PG8_BAR; PG8_MMA(0, 0, At, B0); PG8_MMA(0, 1, At, B1); PG8_BAR; PG8_SCHED;
            PG8_LDA(At, 1, 1); PG8_STAGE(PG8_SB(1, 0), b3, voffB); PG8_STAGE(PG8_SB(1, 1), b3 + hstep, voffB); PG8_STAGE(PG8_SA(1, 0), a3, voffA);
            PG8_WAIT_V(8); PG8_WAIT_L(0); PG8_BAR; PG8_MMA(1, 0, At, B0); PG8_MMA(1, 1, At, B1); PG8_BAR; PG8_SCHED;
            } else {
            PG8_LDB(B0, 0, 0); PG8_SCHED; PG8_LDA(At, 0, 0); PG8_STAGE(PG8_SA(1, 1), a1 + hstep, voffA);
            PG8_WAIT_L(8); PG8_BAR; PG8_WAIT_L(0); PG8_MMA(0, 0, At, B0); PG8_BAR; PG8_SCHED;
            PG8_LDB(B1, 0, 1); PG8_STAGE(PG8_SB(0, 0), b2, voffB);
            PG8_BAR; PG8_WAIT_L(0); PG8_MMA(0, 1, At, B1); PG8_BAR;
            PG8_LDA(At, 0, 1); PG8_STAGE(PG8_SA(0, 0), a2, voffA);
            PG8_BAR; PG8_WAIT_L(0); PG8_MMA(1, 0, At, B0); PG8_BAR; PG8_SCHED;
            PG8_STAGE(PG8_SB(0, 1), b2 + hstep, voffB);
            PG8_WAIT_V(6); PG8_BAR; PG8_MMA(1, 1, At, B1); PG8_BAR;
            PG8_LDB(B0, 1, 0); PG8_SCHED; PG8_LDA(At, 1, 0); PG8_STAGE(PG8_SA(0, 1), a2 + hstep, voffA);
            PG8_WAIT_L(8); PG8_BAR; PG8_WAIT_L(0); PG8_MMA(0, 0, At, B0); PG8_BAR; PG8_SCHED;
            PG8_LDB(B1, 1, 1); PG8_STAGE(PG8_SB(1, 0), b3, voffB);
            PG8_BAR; PG8_WAIT_L(0); PG8_MMA(0, 1, At, B1); PG8_BAR;
            PG8_LDA(At, 1, 1); PG8_STAGE(PG8_SA(1, 0), a3, voffA);
            PG8_BAR; PG8_WAIT_L(0); PG8_MMA(1, 0, At, B0); PG8_BAR; PG8_SCHED;
            PG8_STAGE(PG8_SB(1, 1), b3 + hstep, voffB);
            PG8_WAIT_V(6); PG8_BAR; PG8_MMA(1, 1, At, B1); PG8_BAR;
            }
        }
        if constexpr (ALIGN_EPI) { if (wr == 0) PG8_BAR; }
        if constexpr (!Epi::AFTER_DRAIN) { E(acc, cur, wr, wc, fr, fq); S.done(cur); }
        if (!has_next) break;
#pragma unroll
        for (int a = 0; a < 2; ++a)
#pragma unroll
            for (int b = 0; b < 2; ++b)
#pragma unroll
                for (int m = 0; m < 4; ++m)
#pragma unroll
                    for (int n = 0; n < 2; ++n) acc[a][b][m][n] = (f32x4){0.f, 0.f, 0.f, 0.f};
        cur = nxt; cA = nA; cB = nB; ++ui;
        if constexpr (ALIGN_EPI) { if (wr == 1) PG8_BAR; }
    }
    PG8_WAIT_V(0);
    if constexpr (!ALIGN_EPI) { if (wr == 0) PG8_BAR; }
    PG8_BAR;
    if constexpr (Epi::AFTER_DRAIN) { E.fused(acc, cur, wr, wc, fr, fq, lds, wid, lane); S.done(cur); }
#undef PG8_SA
#undef PG8_SB
#undef PG8_STAGE
#undef PG8_LDA
#undef PG8_LDB
#undef PG8_MMA
#undef PG8_WAIT_V
#undef PG8_WAIT_L
#undef PG8_BAR
#undef PG8_SCHED
}
}

constexpr int NB = 8, SEQ = 4096, DM = 1024, MT = NB * SEQ, NL = 2;
constexpr int CHB = 4, CHR = CHB * SEQ, NCH = NB / CHB;
constexpr int NIN = 8704, DFF = 2816, NGU = 2 * DFF, WIN_SRC = 8136;
constexpr int TOPK = 256;
constexpr float EPS = 1e-6f;
constexpr int NWAVES = 8, NTHREADS = 512;

constexpr size_t MiB = 1u << 20;
constexpr size_t WS_CTL = 0, CTL_ZERO_BYTES = 1 * MiB;
constexpr size_t WS_MOD = 1 * MiB;
constexpr size_t WS_TAB = WS_MOD + 393216;
constexpr size_t WS_LAM = WS_TAB + 393216;
constexpr size_t WS_W = 2 * MiB, W_LAYER = 39 * MiB;
constexpr size_t W_IN = 0, W_A = 17 * MiB, W_B = 19 * MiB, W_C = 20 * MiB, W_OUT = 20 * MiB + 512 * 1024, W_GU = 22 * MiB + 512 * 1024, W_D = 33 * MiB + 512 * 1024;
constexpr size_t WS_H = 80 * MiB;
constexpr size_t WS_Y = 144 * MiB;
constexpr size_t Y_QLAT = 0, Y_MISC = 32 * MiB, Y_IQ = 40 * MiB, Y_BQ = 56 * MiB, Y_BK = 72 * MiB, Y_BV = 88 * MiB, Y_CQ = 104 * MiB, Y_CK = 128 * MiB, Y_CV = 152 * MiB, Y_Z = 176 * MiB, Y_OC = 272 * MiB;
constexpr size_t Y_MF32 = Y_CQ, Y_MBF = Y_BK;
constexpr size_t WS_ACT = WS_Y;
constexpr size_t WS_KVN = 424 * MiB;
constexpr size_t WS_END = 428 * MiB;
constexpr int CW_BAR = 4096;

#define GAS __attribute__((address_space(1)))
#define LAS __attribute__((address_space(3)))
typedef unsigned short bf16;
typedef unsigned v4u __attribute__((ext_vector_type(4)));
typedef unsigned v2u __attribute__((ext_vector_type(2)));
typedef float f32x4 __attribute__((ext_vector_type(4)));

__device__ __forceinline__ unsigned f2bf(float f) { unsigned u = __builtin_bit_cast(unsigned, f); return (u + 0x7fffu + ((u >> 16) & 1u)) >> 16; }
__device__ __forceinline__ unsigned pk2(float lo, float hi) { return f2bf(lo) | (f2bf(hi) << 16); }
__device__ __forceinline__ float bflo(unsigned w) { return __uint_as_float(w << 16); }
__device__ __forceinline__ float bfhi(unsigned w) { return __uint_as_float(w & 0xffff0000u); }
__device__ __forceinline__ float bf2f(bf16 h) { return __uint_as_float((unsigned)h << 16); }
__device__ __forceinline__ float wave_sum(float v) {
#pragma unroll
    for (int o = 1; o < 64; o <<= 1) v += __shfl_xor(v, o);
    return v;
}
__device__ __forceinline__ float wave_max(float v) {
#pragma unroll
    for (int o = 1; o < 64; o <<= 1) v = fmaxf(v, __shfl_xor(v, o));
    return v;
}
__device__ __forceinline__ float sigmoidf_(float v) { return 1.f / (1.f + __expf(-v)); }

namespace pg8 {
struct EpiIn {
    static constexpr bool PERM = true, AFTER_DRAIN = false;
    unsigned char* y;
    __device__ __forceinline__ void operator()(const f32x4 (&acc)[2][2][4][2], const Unit& u, int wr, int wc, int fr, int fq) const {
        const int pn = u.pn; size_t off; int ld, c0; bool sig = false;
        if (pn < 4)        { off = Y_QLAT; ld = 1024; c0 = pn * 256; }
        else if (pn == 4)  { off = Y_MISC; ld = 256;  c0 = 0; }
        else if (pn < 7)   { off = Y_IQ;   ld = 512;  c0 = (pn - 5) * 256; }
        else if (pn < 9)   { off = Y_BQ;   ld = 512;  c0 = (pn - 7) * 256; }
        else if (pn < 11)  { off = Y_BK;   ld = 512;  c0 = (pn - 9) * 256; }
        else if (pn < 13)  { off = Y_BV;   ld = 512;  c0 = (pn - 11) * 256; }
        else if (pn < 16)  { off = Y_CQ;   ld = 768;  c0 = (pn - 13) * 256; }
        else if (pn < 19)  { off = Y_CK;   ld = 768;  c0 = (pn - 16) * 256; }
        else if (pn < 22)  { off = Y_CV;   ld = 768;  c0 = (pn - 19) * 256; }
        else               { off = Y_Z;    ld = 3072; c0 = (pn - 22) * 256; sig = true; }
        bf16_t* base = (bf16_t*)(y + off);
        const int row0 = u.pm * BM + wr * 64 + fr, col0 = c0 + wc * 32 + 8 * fq;
#pragma unroll
        for (int ai = 0; ai < 2; ++ai)
#pragma unroll
            for (int m = 0; m < 4; ++m) { bf16_t* rowp = base + (size_t)(row0 + ai * HALF + m * 16) * ld + col0;
#pragma unroll
                for (int bj = 0; bj < 2; ++bj) { f32x4 v0 = acc[ai][bj][m][0], v1 = acc[ai][bj][m][1];
                    if (sig) {
#pragma unroll
                        for (int i = 0; i < 4; ++i) { v0[i] = sigmoidf_(v0[i]); v1[i] = sigmoidf_(v1[i]); } }
                    u32x4 w; w.x = pk2(v0[0], v0[1]); w.y = pk2(v0[2], v0[3]); w.z = pk2(v1[0], v1[1]); w.w = pk2(v1[2], v1[3]);
                    *(u32x4*)(rowp + bj * HALF) = w; } }
    }
};
template <int MODE> struct EpiGate {
    static constexpr bool PERM = true, AFTER_DRAIN = false;
    const bf16_t* z; int zc0; float* mf; bf16_t* mb;
    __device__ __forceinline__ void operator()(const f32x4 (&acc)[2][2][4][2], const Unit& u, int wr, int wc, int fr, int fq) const {
        const int row0 = u.pm * BM + wr * 64 + fr, col0 = u.pn * BM + wc * 32 + 8 * fq;
#pragma unroll
        for (int ai = 0; ai < 2; ++ai)
#pragma unroll
            for (int m = 0; m < 4; ++m) { const size_t row = (size_t)(row0 + ai * HALF + m * 16);
#pragma unroll
                for (int bj = 0; bj < 2; ++bj) { const int col = col0 + bj * HALF;
                    const u32x4 zw = *(const u32x4*)(z + row * 3072 + zc0 + col);
                    f32x4 v0 = acc[ai][bj][m][0], v1 = acc[ai][bj][m][1];
                    v0[0] *= __uint_as_float(zw.x << 16); v0[1] *= __uint_as_float(zw.x & 0xffff0000u); v0[2] *= __uint_as_float(zw.y << 16); v0[3] *= __uint_as_float(zw.y & 0xffff0000u);
                    v1[0] *= __uint_as_float(zw.z << 16); v1[1] *= __uint_as_float(zw.z & 0xffff0000u); v1[2] *= __uint_as_float(zw.w << 16); v1[3] *= __uint_as_float(zw.w & 0xffff0000u);
                    float* mp = mf + row * 1024 + col;
                    if (MODE >= 1) { v0 += *(const f32x4*)mp; v1 += *(const f32x4*)(mp + 4); }
                    if (MODE <= 1) { *(f32x4*)mp = v0; *(f32x4*)(mp + 4) = v1; }
                    else { u32x4 w; w.x = pk2(v0[0], v0[1]); w.y = pk2(v0[2], v0[3]); w.z = pk2(v1[0], v1[1]); w.w = pk2(v1[2], v1[3]); *(u32x4*)(mb + row * 1024 + col) = w; } }
                asm volatile("" ::: "memory"); }
    }
};
struct EpiRes {
    static constexpr bool PERM = true, AFTER_DRAIN = false;
    const float* xin; float* xout; const float* gate; int row_off;
    __device__ __forceinline__ void operator()(const f32x4 (&acc)[2][2][4][2], const Unit& u, int wr, int wc, int fr, int fq) const {
        const int row0 = row_off + u.pm * BM + wr * 64 + fr, col0 = u.pn * BM + wc * 32 + 8 * fq;
        const float* gp = gate + (size_t)((row_off + u.pm * BM) / SEQ) * 6144 + col0;
        f32x4 g[2][2];
#pragma unroll
        for (int bj = 0; bj < 2; ++bj) { g[bj][0] = *(const f32x4*)(gp + bj * HALF); g[bj][1] = *(const f32x4*)(gp + bj * HALF + 4); }
#pragma unroll
        for (int ai = 0; ai < 2; ++ai)
#pragma unroll
            for (int m = 0; m < 4; ++m) { const size_t o = (size_t)(row0 + ai * HALF + m * 16) * 1024 + col0;
#pragma unroll
                for (int bj = 0; bj < 2; ++bj) {
                    const f32x4 a0 = *(const f32x4*)(xin + o + bj * HALF), a1 = *(const f32x4*)(xin + o + bj * HALF + 4);
                    *(f32x4*)(xout + o + bj * HALF) = a0 + g[bj][0] * acc[ai][bj][m][0];
                    *(f32x4*)(xout + o + bj * HALF + 4) = a1 + g[bj][1] * acc[ai][bj][m][1]; }
                asm volatile("" ::: "memory"); }
    }
};
struct EpiSwiGLU {
    static constexpr bool PERM = true, AFTER_DRAIN = false;
    bf16_t* act;
    __device__ __forceinline__ void operator()(const f32x4 (&acc)[2][2][4][2], const Unit& u, int wr, int wc, int fr, int fq) const {
        const int row0 = u.pm * BM + wr * 64 + fr, col0 = u.pn * HALF + wc * 32 + 8 * fq;
#pragma unroll
        for (int ai = 0; ai < 2; ++ai)
#pragma unroll
            for (int m = 0; m < 4; ++m) { bf16_t* rowp = act + (size_t)(row0 + ai * HALF + m * 16) * DFF + col0;
                f32x4 v0, v1;
#pragma unroll
                for (int i = 0; i < 4; ++i) { const float g0 = acc[ai][0][m][0][i], g1 = acc[ai][0][m][1][i];
                    v0[i] = g0 * sigmoidf_(g0) * acc[ai][1][m][0][i]; v1[i] = g1 * sigmoidf_(g1) * acc[ai][1][m][1][i]; }
                u32x4 w; w.x = pk2(v0[0], v0[1]); w.y = pk2(v0[2], v0[3]); w.z = pk2(v1[0], v1[1]); w.w = pk2(v1[2], v1[3]);
                *(u32x4*)rowp = w; }
    }
};
}

#define XB_TMO      128
#define XB_XCNT(j)  (256  + 64 * (j))
#define XB_XSUB(j)  (1280 + 64 * (j))
#define XB_XGEN(j)  (2304 + 64 * (j))
#define XB_TOP      3328
#define XB_TOPGEN   3392
#define XCD_BAR_WORDS 3456
#define XB_SPIN_CAP (1u << 24)

__device__ __forceinline__ unsigned xb_ld(unsigned* p)              { return __hip_atomic_load(p, __ATOMIC_RELAXED, __HIP_MEMORY_SCOPE_AGENT); }
__device__ __forceinline__ unsigned xb_add(unsigned* p, unsigned v) { return __hip_atomic_fetch_add(p, v, __ATOMIC_RELAXED, __HIP_MEMORY_SCOPE_AGENT); }
__device__ __forceinline__ unsigned xb_xcc_id() { return (unsigned)__builtin_amdgcn_s_getreg((3 << 11) | 20) & 0xFu; }
#define XB_SPIN(cond, bar) do { unsigned _sp = 0; while (cond) { __builtin_amdgcn_s_sleep(1); \
    if ((++_sp & 255u) == 0u) { if (xb_ld(&(bar)[XB_TMO])) break; if (_sp > XB_SPIN_CAP) { atomicAdd(&(bar)[XB_TMO], 1u); break; } } } } while (0)

struct XcdBarrier { unsigned* bar; unsigned x; volatile LAS unsigned* st; };

__device__ __forceinline__ XcdBarrier xcd_barrier_post(unsigned* bar, volatile LAS unsigned* st) {
    XcdBarrier b; b.bar = bar; b.x = (unsigned)__builtin_amdgcn_readfirstlane((int)xb_xcc_id()); b.st = st;
    if (threadIdx.x == 0) (void)xb_add(&bar[XB_XCNT(b.x)], 1u);
    return b;
}
__device__ __forceinline__ void xcd_barrier_complete(unsigned* bar, unsigned x, unsigned& nloc, unsigned& nx) {
    const unsigned G = gridDim.x * gridDim.y * gridDim.z;
    unsigned sum, cnt, mine, sp = 0u;
    for (;;) {
        sum = 0u; cnt = 0u; mine = 0u;
#pragma unroll
        for (unsigned j = 0; j < 16; ++j) { const unsigned c = xb_ld(&bar[XB_XCNT(j)]); sum += c; cnt += (c > 0u) ? 1u : 0u; mine = (j == x) ? c : mine; }
        if (sum == G) break;
        __builtin_amdgcn_s_sleep(1);
        if ((++sp & 255u) == 0u) { if (xb_ld(&bar[XB_TMO])) break; if (sp > XB_SPIN_CAP) { atomicAdd(&bar[XB_TMO], 1u); break; } }
    }
    nloc = mine > 0u ? mine : 1u; nx = cnt > 0u ? cnt : 1u;
}
__device__ __forceinline__ void xcd_barrier(const XcdBarrier& b) {
    asm volatile("s_waitcnt vmcnt(0)" ::: "memory");
    __syncthreads();
    if (threadIdx.x == 0) {
        unsigned* bar = b.bar; unsigned bx = b.x; asm volatile("" : "+s"(bar), "+s"(bx));
        __builtin_amdgcn_s_waitcnt(0);
        unsigned nloc = b.st[0], nx = b.st[1];
        if (nloc == 0u) { xcd_barrier_complete(bar, bx, nloc, nx); b.st[0] = nloc; b.st[1] = nx; }
        const unsigned old = xb_add(&bar[XB_XSUB(bx)], 1u);
        const unsigned gen = old / nloc;
        if (old + 1u == (gen + 1u) * nloc) {
            __builtin_amdgcn_fence(__ATOMIC_RELEASE, "agent");
            asm volatile("s_waitcnt vmcnt(0)" ::: "memory");
            const unsigned og = xb_add(&bar[XB_TOP], 1u);
            const unsigned tg = og / nx;
            if (og + 1u == (tg + 1u) * nx) xb_add(&bar[XB_TOPGEN], 1u);
            else XB_SPIN(xb_ld(&bar[XB_TOPGEN]) == tg, bar);
            __builtin_amdgcn_fence(__ATOMIC_ACQUIRE, "agent");
            xb_add(&bar[XB_XGEN(bx)], 1u);
            asm volatile("s_waitcnt vmcnt(0)" ::: "memory");
        } else {
            XB_SPIN(xb_ld(&bar[XB_XGEN(bx)]) == gen, bar);
            __builtin_amdgcn_fence(__ATOMIC_ACQUIRE, "agent");
            asm volatile("s_waitcnt vmcnt(0)" ::: "memory");
        }
    }
    __syncthreads();
}

constexpr int RING_BYTES = 131072;
constexpr int LDSCTL_OFF = 155648;
constexpr int LDS_BYTES = 156672;

struct Args {
    const float* in[23]; float* out; unsigned char* ws; int pad0, pad1;
};

__device__ __forceinline__ int rel_bucket(int d) {
    if (d < 16) return d;
    int b = 16;
    b += (d >= 22); b += (d >= 30); b += (d >= 40); b += (d >= 54); b += (d >= 73); b += (d >= 99); b += (d >= 134); b += (d >= 182);
    b += (d >= 246); b += (d >= 332); b += (d >= 450); b += (d >= 609); b += (d >= 825); b += (d >= 1117); b += (d >= 1513);
    return b;
}
__device__ __forceinline__ int win_src_col(int n) {
    if (n < 1152) return 512 + (n - 1024);
    if (n < 1224) return n;
    if (n < 1280) return -1;
    if (n < 1792) return 640 + (n - 1280);
    return n - 568;
}
__device__ __forceinline__ void transpose_item(const float* W, int ldw, int K, bf16* WT, int kind, int kb, int nb, LAS float* scr, int lane) {
    const int k0 = 64 * kb, n0 = 32 * nb, nl = n0 + (lane & 31);
    int sc;
    if (kind == 0) sc = win_src_col(nl + 1024);
    else if (kind == 2) { const int j = nl >> 8, r = nl & 255; sc = (r < 128) ? (j * 128 + r) : (DFF + j * 128 + r - 128); }
    else sc = nl;
#pragma unroll 8
    for (int i = 0; i < 32; ++i) { const int kk = 2 * i + (lane >> 5); scr[kk * 33 + (lane & 31)] = (sc >= 0) ? W[(size_t)(k0 + kk) * ldw + sc] : 0.f; }
    asm volatile("s_waitcnt lgkmcnt(0)" ::: "memory");
    const int c = lane & 7;
    const int nrow0 = (kind == 0) ? 1024 : 0;
#pragma unroll
    for (int j = 0; j < 4; ++j) { const int n = (lane >> 3) + 8 * j; const LAS float* s = scr + (8 * c) * 33 + n;
        v4u o; o.x = pk2(s[0 * 33], s[1 * 33]); o.y = pk2(s[2 * 33], s[3 * 33]); o.z = pk2(s[4 * 33], s[5 * 33]); o.w = pk2(s[6 * 33], s[7 * 33]);
        *(v4u*)(WT + (size_t)(nrow0 + n0 + n) * K + k0 + 8 * c) = o; }
    asm volatile("s_waitcnt lgkmcnt(0)" ::: "memory");
}

__device__ __forceinline__ void p0a_prologue(const Args& a, unsigned char* ws, LAS unsigned char* lds, int tid, int lane, int wave, int G) {
    asm volatile("" : "+v"(lane), "+v"(tid));
    const float* c = a.in[1]; const float* w_ada = a.in[2]; const float* b_ada = a.in[3];
    float* mod = (float*)(ws + WS_MOD);
    if (blockIdx.x < 192) {
        LAS float* cs = (LAS float*)lds;
        LAS float* red = (LAS float*)(lds + 32768);
        for (int i = tid; i < 8192; i += NTHREADS) { const float v = c[i]; cs[i] = v / (1.f + __expf(-v)); }
        __syncthreads();
        for (int it = blockIdx.x; it < 192; it += G) {
            const int l = it / 96, cg = it % 96, n = cg * 64 + lane;
            float acc[8];
#pragma unroll
            for (int b = 0; b < 8; ++b) acc[b] = 0.f;
            const float* wp = w_ada + ((size_t)l * 1024 + wave * 128) * 6144 + n;
#pragma unroll 8
            for (int k = 0; k < 128; ++k) { const float wv = wp[(size_t)k * 6144];
#pragma unroll
                for (int b = 0; b < 8; ++b) acc[b] += cs[b * 1024 + wave * 128 + k] * wv; }
#pragma unroll
            for (int b = 0; b < 8; ++b) red[(wave * 8 + b) * 64 + lane] = acc[b];
            __syncthreads();
            { const int b = tid >> 6; float s = 0.f;
#pragma unroll
              for (int w = 0; w < 8; ++w) s += red[(w * 8 + b) * 64 + lane];
              mod[((size_t)l * 8 + b) * 6144 + n] = s + b_ada[l * 6144 + n]; }
            __syncthreads();
        }
    }
    { const float* rb = a.in[21]; float* T = (float*)(ws + WS_TAB);
      for (int d = blockIdx.x * NTHREADS + tid; d < 4096; d += G * NTHREADS) { const int bk = rel_bucket(d);
          for (int j = 0; j < 24; ++j) T[d * 24 + j] = rb[bk * 24 + j]; } }
    if (blockIdx.x == G - 1 && wave == 0) {
        float* lam = (float*)(ws + WS_LAM);
        for (int l = 0; l < NL; ++l) {
            const float s1 = wave_sum(a.in[9][l * 64 + lane] * a.in[10][l * 64 + lane]);
            const float s2 = wave_sum(a.in[11][l * 64 + lane] * a.in[12][l * 64 + lane]);
            const float lam_init = (l == 0) ? 0.2f : 0.35550907f;
            if (lane == 0) lam[l] = expf(s1) - expf(s2) + lam_init;
        }
    }
    {
        LAS float* scr = (LAS float*)(lds + 65536 + wave * 8448);
        const int gw = blockIdx.x * NWAVES + wave, NGW = G * NWAVES;
        constexpr int I_WIN = 16 * 240, I_B = 8 * 32, I_C = 4 * 32, I_OUT = 16 * 32, I_GU = 16 * 176, I_D = 44 * 32, I_FQ = 2048, I_FA = 2048;
        constexpr int I_LAYER = I_WIN + I_B + I_C + I_OUT + I_GU + I_D + I_FQ + I_FA;
        for (int it = gw; it < NL * I_LAYER; it += NGW) {
            const int l = it / I_LAYER; int r = it % I_LAYER;
            unsigned char* wl = ws + WS_W + (size_t)l * W_LAYER;
            const float* w_in = a.in[5] + (size_t)l * 1024 * WIN_SRC;
            if (r < I_WIN) { transpose_item(w_in, WIN_SRC, 1024, (bf16*)(wl + W_IN), 0, r / 240, r % 240, scr, lane); continue; } r -= I_WIN;
            if (r < I_B)   { transpose_item(a.in[15] + (size_t)l * 512 * 1024, 1024, 512, (bf16*)(wl + W_B), 1, r / 32, r % 32, scr, lane); continue; } r -= I_B;
            if (r < I_C)   { transpose_item(a.in[16] + (size_t)l * 256 * 1024, 1024, 256, (bf16*)(wl + W_C), 1, r / 32, r % 32, scr, lane); continue; } r -= I_C;
            if (r < I_OUT) { transpose_item(a.in[17] + (size_t)l * 1024 * 1024, 1024, 1024, (bf16*)(wl + W_OUT), 1, r / 32, r % 32, scr, lane); continue; } r -= I_OUT;
            if (r < I_GU)  { transpose_item(a.in[19] + (size_t)l * 1024 * NGU, NGU, 1024, (bf16*)(wl + W_GU), 2, r / 176, r % 176, scr, lane); continue; } r -= I_GU;
            if (r < I_D)   { transpose_item(a.in[20] + (size_t)l * DFF * 1024, 1024, DFF, (bf16*)(wl + W_D), 1, r / 32, r % 32, scr, lane); continue; } r -= I_D;
            if (r < I_FQ) {
                const int h = r >> 8, rem = r & 255, cc = (rem >> 7) * 64 + lane, k0 = (rem & 127) * 8;
                const float* uk = a.in[6] + ((size_t)(l * 8 + h) * 64) * 128 + cc;
                const float* wi = w_in + (size_t)k0 * WIN_SRC + h * 64;
                float acc[8];
#pragma unroll
                for (int j = 0; j < 8; ++j) acc[j] = 0.f;
                for (int d = 0; d < 64; ++d) { const float u = uk[d * 128];
#pragma unroll
                    for (int j = 0; j < 8; ++j) acc[j] += wi[(size_t)j * WIN_SRC + d] * u; }
                v4u o; o.x = pk2(acc[0], acc[1]); o.y = pk2(acc[2], acc[3]); o.z = pk2(acc[4], acc[5]); o.w = pk2(acc[6], acc[7]);
                *(v4u*)((bf16*)(wl + W_IN) + (size_t)(h * 128 + cc) * 1024 + k0) = o;
                continue; }
            r -= I_FQ;
            {
                const int ng = r >> 7, kg = r & 127, h = kg >> 4, c0 = (kg & 15) * 8, n = ng * 64 + lane;
                const float* uv = a.in[7] + ((size_t)(l * 8 + h) * 128 + c0) * 64;
                const float* wa = a.in[14] + ((size_t)l * 512 + h * 64) * 1024 + n;
                float acc[8];
#pragma unroll
                for (int j = 0; j < 8; ++j) acc[j] = 0.f;
                for (int e = 0; e < 64; ++e) { const float wv = wa[(size_t)e * 1024];
#pragma unroll
                    for (int j = 0; j < 8; ++j) acc[j] += uv[j * 64 + e] * wv; }
                v4u o; o.x = pk2(acc[0], acc[1]); o.y = pk2(acc[2], acc[3]); o.z = pk2(acc[4], acc[5]); o.w = pk2(acc[6], acc[7]);
                *(v4u*)((bf16*)(wl + W_A) + (size_t)n * 1024 + kg * 8) = o;
            }
        }
    }
}

__device__ __forceinline__ void norm_rows(const float* x, bf16* out, const float* g, const float* sh, const float* sc, int gw, int NGW, int lane) {
    asm volatile("" : "+v"(lane));
    for (int row = gw; row < MT; row += NGW) {
        const int b = row / SEQ;
        const f32x4* xr = (const f32x4*)(x + (size_t)row * 1024) + lane;
        f32x4 v[4]; float s = 0.f;
#pragma unroll
        for (int j = 0; j < 4; ++j) { v[j] = xr[64 * j]; s += (v[j].x * v[j].x + v[j].y * v[j].y) + (v[j].z * v[j].z + v[j].w * v[j].w); }
        const float rstd = 1.0f / sqrtf(wave_sum(s) * (1.f / 1024.f) + EPS);
        v2u* o8 = (v2u*)(out + (size_t)row * 1024) + lane;
#pragma unroll
        for (int j = 0; j < 4; ++j) { const int col = 256 * j + 4 * lane;
            const f32x4 gg = *(const f32x4*)(g + col), s1 = *(const f32x4*)(sc + (size_t)b * 6144 + col), s0 = *(const f32x4*)(sh + (size_t)b * 6144 + col);
            const f32x4 y = v[j] * rstd * gg * (s1 + 1.0f) + s0;
            v2u w; w.x = pk2(y.x, y.y); w.y = pk2(y.z, y.w); o8[64 * j] = w; }
    }
}
__device__ __forceinline__ void final_rows(float* x, const float* g, int gw, int NGW, int lane) {
    asm volatile("" : "+v"(lane));
    for (int row = gw; row < MT; row += NGW) {
        f32x4* xr = (f32x4*)(x + (size_t)row * 1024) + lane;
        f32x4 v[4]; float s = 0.f;
#pragma unroll
        for (int j = 0; j < 4; ++j) { v[j] = xr[64 * j]; s += (v[j].x * v[j].x + v[j].y * v[j].y) + (v[j].z * v[j].z + v[j].w * v[j].w); }
        const float rstd = 1.0f / sqrtf(wave_sum(s) * (1.f / 1024.f) + EPS);
#pragma unroll
        for (int j = 0; j < 4; ++j) { const f32x4 gg = *(const f32x4*)(g + 256 * j + 4 * lane); xr[64 * j] = v[j] * rstd * gg; }
    }
}

__device__ __forceinline__ float dot8(const LAS float* q, v4u w) {
    return q[0] * bflo(w.x) + q[1] * bfhi(w.x) + q[2] * bflo(w.y) + q[3] * bfhi(w.y) + q[4] * bflo(w.z) + q[5] * bfhi(w.z) + q[6] * bflo(w.w) + q[7] * bfhi(w.w);
}
__device__ __forceinline__ void kvn_rows(unsigned char* y, bf16* kvn, const float* gkv, unsigned* kmaxw, int gw, int NGW, int lane) {
    asm volatile("" : "+v"(lane));
    const bf16* misc = (const bf16*)(y + Y_MISC);
    float km0 = 0.f, km1 = 0.f, km2 = 0.f, km3 = 0.f;
    for (int r = gw; r < CHR; r += NGW) {
        const unsigned w = *(const unsigned*)(misc + (size_t)r * 256 + 2 * lane);
        const float a0 = bflo(w), a1 = bfhi(w);
        const float rstd = 1.0f / sqrtf(wave_sum(a0 * a0 + a1 * a1) * (1.f / 128.f) + EPS);
        *(unsigned*)(kvn + (size_t)r * 128 + 2 * lane) = pk2(a0 * rstd * gkv[2 * lane], a1 * rstd * gkv[2 * lane + 1]);
        const float kk = bf2f(misc[(size_t)r * 256 + 128 + lane]); const float ks = wave_sum(kk * kk); const int b = r / SEQ;
        km0 = (b == 0) ? fmaxf(km0, ks) : km0; km1 = (b == 1) ? fmaxf(km1, ks) : km1; km2 = (b == 2) ? fmaxf(km2, ks) : km2; km3 = (b == 3) ? fmaxf(km3, ks) : km3;
    }
    if (lane == 0) {
        __hip_atomic_fetch_max(kmaxw + 0, __float_as_uint(km0), __ATOMIC_RELAXED, __HIP_MEMORY_SCOPE_AGENT); __hip_atomic_fetch_max(kmaxw + 1, __float_as_uint(km1), __ATOMIC_RELAXED, __HIP_MEMORY_SCOPE_AGENT);
        __hip_atomic_fetch_max(kmaxw + 2, __float_as_uint(km2), __ATOMIC_RELAXED, __HIP_MEMORY_SCOPE_AGENT); __hip_atomic_fetch_max(kmaxw + 3, __float_as_uint(km3), __ATOMIC_RELAXED, __HIP_MEMORY_SCOPE_AGENT);
    }
}
__device__ __forceinline__ void mixC_v1(unsigned char* y, const float* T, LAS unsigned char* lds, int gw, int NGW, int lane, int wave) {
    asm volatile("" : "+v"(lane));
    const bf16* CQ = (const bf16*)(y + Y_CQ); const bf16* CK = (const bf16*)(y + Y_CK); const bf16* CV = (const bf16*)(y + Y_CV); bf16* OC = (bf16*)(y + Y_OC);
    LAS float* qs = (LAS float*)(lds + wave * 2048);
    LAS float* ps = qs + 64;
    for (int task = gw; task < CHR * 4; task += NGW) {
        const int r = task >> 2, hp = task & 3, t = r & (SEQ - 1), rb = r - t;
        float og[3], lse[3];
#pragma unroll
        for (int g = 0; g < 3; ++g) {
            const int dil = (g == 0) ? 1 : (g == 1) ? 4 : 16, hh = 4 * g + hp;
            qs[lane] = bf2f(CQ[(size_t)r * 768 + hh * 64 + lane]);
            asm volatile("s_waitcnt lgkmcnt(0)" ::: "memory");
            const int tq = t / dil, nv = (tq < 128 ? tq : 128) + 1;
            float lg[3];
#pragma unroll
            for (int rd = 0; rd < 3; ++rd) {
                const int j = lane + 64 * rd; float v = -INFINITY;
                if (j < nv) { const int s = t - j * dil; const bf16* kp = CK + (size_t)(rb + s) * 768 + hh * 64; float dot = 0.f;
#pragma unroll
                    for (int c8 = 0; c8 < 8; ++c8) dot += dot8(qs + 8 * c8, *(const v4u*)(kp + 8 * c8));
                    v = dot * 0.125f + T[(j * dil) * 24 + 12 + hh]; }
                lg[rd] = v;
            }
            const float m = wave_max(fmaxf(fmaxf(lg[0], lg[1]), lg[2]));
            float p[3], ls = 0.f;
#pragma unroll
            for (int rd = 0; rd < 3; ++rd) { p[rd] = (lane + 64 * rd < nv) ? __expf(lg[rd] - m) : 0.f; ls += p[rd]; ps[64 * rd + lane] = p[rd]; }
            const float l = wave_sum(ls);
            asm volatile("s_waitcnt lgkmcnt(0)" ::: "memory");
            float o = 0.f;
            for (int j = 0; j < nv; ++j) { const int s = t - j * dil; o += ps[j] * bf2f(CV[(size_t)(rb + s) * 768 + hh * 64 + lane]); }
            og[g] = o / l; lse[g] = m + __logf(l);
            asm volatile("s_waitcnt lgkmcnt(0)" ::: "memory");
        }
        const float M = fmaxf(fmaxf(lse[0], lse[1]), lse[2]);
        const float a0 = __expf(lse[0] - M), a1 = __expf(lse[1] - M), a2 = __expf(lse[2] - M);
        OC[(size_t)r * 256 + hp * 64 + lane] = (bf16)f2bf((a0 * og[0] + a1 * og[1] + a2 * og[2]) / (a0 + a1 + a2));
    }
}
__device__ __forceinline__ void mixB_v1(unsigned char* y, const float* T, const float* gsub, float lam, float one_m_li, LAS unsigned char* lds, int gw, int NGW, int lane, int wave) {
    asm volatile("" : "+v"(lane));
    bf16* BQ = (bf16*)(y + Y_BQ); const bf16* BK = (const bf16*)(y + Y_BK); const bf16* BV = (const bf16*)(y + Y_BV);
    LAS float* qs = (LAS float*)(lds + wave * 2048);
    LAS float* ps = qs + 128;
    for (int task = gw; task < CHR * 4; task += NGW) {
        const int r = task >> 2, h = task & 3, t = r & (SEQ - 1), rb = r - t;
        qs[lane] = bf2f(BQ[(size_t)r * 512 + h * 128 + lane]); qs[64 + lane] = bf2f(BQ[(size_t)r * 512 + h * 128 + 64 + lane]);
        asm volatile("s_waitcnt lgkmcnt(0)" ::: "memory");
        float m0 = -INFINITY, m1 = -INFINITY, l0 = 0.f, l1 = 0.f, o00 = 0.f, o01 = 0.f, o10 = 0.f, o11 = 0.f;
        for (int s0 = 0; s0 <= t; s0 += 64) {
            const int s = s0 + lane; float lg0 = -INFINITY, lg1 = -INFINITY;
            if (s <= t) { const bf16* kp = BK + (size_t)(rb + s) * 512 + h * 128; float d0 = 0.f, d1 = 0.f;
#pragma unroll
                for (int c8 = 0; c8 < 8; ++c8) { d0 += dot8(qs + 8 * c8, *(const v4u*)(kp + 8 * c8)); d1 += dot8(qs + 64 + 8 * c8, *(const v4u*)(kp + 64 + 8 * c8)); }
                const float bias = T[(t - s) * 24 + 8 + h]; lg0 = d0 * 0.125f + bias; lg1 = d1 * 0.125f + bias; }
            const float nm0 = fmaxf(m0, wave_max(lg0)), nm1 = fmaxf(m1, wave_max(lg1));
            const float f0 = __expf(m0 - nm0), f1 = __expf(m1 - nm1);
            const float p0 = (s <= t) ? __expf(lg0 - nm0) : 0.f, p1 = (s <= t) ? __expf(lg1 - nm1) : 0.f;
            l0 = l0 * f0 + wave_sum(p0); l1 = l1 * f1 + wave_sum(p1); o00 *= f0; o01 *= f0; o10 *= f1; o11 *= f1; m0 = nm0; m1 = nm1;
            ps[lane] = p0; ps[64 + lane] = p1;
            asm volatile("s_waitcnt lgkmcnt(0)" ::: "memory");
            const int nk = (t - s0 + 1 < 64) ? (t - s0 + 1) : 64;
            const bf16* vp = BV + (size_t)(rb + s0) * 512 + h * 128 + lane;
            for (int j = 0; j < nk; ++j) { const float v0 = bf2f(vp[(size_t)j * 512]), v1 = bf2f(vp[(size_t)j * 512 + 64]); const float pa = ps[j], pb = ps[64 + j];
                o00 += pa * v0; o01 += pa * v1; o10 += pb * v0; o11 += pb * v1; }
            asm volatile("s_waitcnt lgkmcnt(0)" ::: "memory");
        }
        const float oa = o00 / l0 - lam * (o10 / l1), ob = o01 / l0 - lam * (o11 / l1);
        const float rstd = 1.0f / sqrtf(wave_sum(oa * oa + ob * ob) * (1.f / 128.f) + EPS);
        BQ[(size_t)r * 512 + h * 128 + lane] = (bf16)f2bf(oa * rstd * gsub[lane] * one_m_li);
        BQ[(size_t)r * 512 + h * 128 + 64 + lane] = (bf16)f2bf(ob * rstd * gsub[64 + lane] * one_m_li);
    }
}
__device__ __forceinline__ unsigned mono_key(float f) { const unsigned u = __float_as_uint(f); return (u & 0x80000000u) ? ~u : (u | 0x80000000u); }
__device__ __forceinline__ void mixA_v1(unsigned char* y, const bf16* KVN, const float* T, LAS unsigned char* lds, int gw, int NGW, int lane, int wave) {
    asm volatile("" : "+v"(lane));
    bf16* QLAT = (bf16*)(y + Y_QLAT); const bf16* MISC = (const bf16*)(y + Y_MISC); const bf16* IQ = (const bf16*)(y + Y_IQ);
    LAS unsigned char* wb = lds + wave * 19456;
    LAS unsigned* scb = (LAS unsigned*)wb;
    LAS float* qi = (LAS float*)(wb + 16384);
    LAS unsigned* sel = (LAS unsigned*)(wb + 18432);
    LAS float* ql = (LAS float*)wb;
    LAS float* pb = (LAS float*)(wb + 4096);
    const unsigned long long lt_mask = (1ull << lane) - 1ull;
    for (int r = gw; r < CHR; r += NGW) {
        const int t = r & (SEQ - 1), rb = r - t, N = t + 1;
#pragma unroll
        for (int i = 0; i < 8; ++i) qi[i * 64 + lane] = bf2f(IQ[(size_t)r * 512 + i * 64 + lane]);
        const float wv = (lane < 8) ? bf2f(MISC[(size_t)r * 256 + 192 + lane]) * 0.044194173824159216f : 0.f;
        float wh[8];
#pragma unroll
        for (int h = 0; h < 8; ++h) wh[h] = __shfl(wv, h);
        asm volatile("s_waitcnt lgkmcnt(0)" ::: "memory");
        for (int s0 = 0; s0 < N; s0 += 64) {
            const int s = s0 + lane;
            if (s < N) { const bf16* kp = MISC + (size_t)(rb + s) * 256 + 128; v4u kw[8];
#pragma unroll
                for (int c8 = 0; c8 < 8; ++c8) kw[c8] = *(const v4u*)(kp + 8 * c8);
                float sc = 0.f;
#pragma unroll
                for (int h = 0; h < 8; ++h) { float d = 0.f;
#pragma unroll
                    for (int c8 = 0; c8 < 8; ++c8) d += dot8(qi + h * 64 + 8 * c8, kw[c8]);
                    sc += wh[h] * fmaxf(d, 0.f); }
                sc += 0.f;
                scb[s] = mono_key(sc); }
        }
        asm volatile("s_waitcnt lgkmcnt(0)" ::: "memory");
        int nsel;
        if (N <= TOPK) { for (int i = lane; i < N; i += 64) sel[i] = (unsigned)i; nsel = N; }
        else {
            unsigned tau = 0u;
            for (int bit = 31; bit >= 0; --bit) { const unsigned cand = tau | (1u << bit); int cnt = 0;
                for (int i = lane; i < N; i += 64) cnt += (scb[i] >= cand) ? 1 : 0;
#pragma unroll
                for (int o = 1; o < 64; o <<= 1) cnt += __shfl_xor(cnt, o);
                if (cnt >= TOPK) tau = cand; }
            int cgt = 0;
            for (int i = lane; i < N; i += 64) cgt += (scb[i] > tau) ? 1 : 0;
#pragma unroll
            for (int o = 1; o < 64; o <<= 1) cgt += __shfl_xor(cgt, o);
            const int need = TOPK - cgt; int pos = 0, eqt = 0;
            for (int s0 = 0; s0 < N; s0 += 64) { const int s = s0 + lane; const unsigned key = (s < N) ? scb[s] : 0u;
                const bool gt = (s < N) && key > tau, eq = (s < N) && key == tau;
                const unsigned long long beq = __ballot(eq);
                const bool take = gt || (eq && (eqt + __popcll(beq & lt_mask)) < need);
                const unsigned long long bt = __ballot(take);
                if (take) sel[pos + __popcll(bt & lt_mask)] = (unsigned)s;
                pos += __popcll(bt); eqt += __popcll(beq); }
            nsel = TOPK;
        }
        asm volatile("s_waitcnt lgkmcnt(0)" ::: "memory");
#pragma unroll
        for (int i = 0; i < 16; ++i) ql[i * 64 + lane] = bf2f(QLAT[(size_t)r * 1024 + i * 64 + lane]);
        asm volatile("s_waitcnt lgkmcnt(0)" ::: "memory");
        for (int rd = 0; rd < 4; ++rd) { const int jj = rd * 64 + lane;
            float acc[8];
#pragma unroll
            for (int h = 0; h < 8; ++h) acc[h] = -INFINITY;
            if (jj < nsel) { const int s = (int)sel[jj]; const bf16* kp = KVN + (size_t)(rb + s) * 128;
#pragma unroll
                for (int h = 0; h < 8; ++h) acc[h] = 0.f;
#pragma unroll 4
                for (int c8 = 0; c8 < 16; ++c8) { const v4u w = *(const v4u*)(kp + 8 * c8);
#pragma unroll
                    for (int h = 0; h < 8; ++h) acc[h] += dot8(ql + h * 128 + 8 * c8, w); }
                const float* tb = T + (t - s) * 24;
#pragma unroll
                for (int h = 0; h < 8; ++h) acc[h] = acc[h] * 0.125f + tb[h]; }
#pragma unroll
            for (int h = 0; h < 8; ++h) pb[h * 256 + jj] = acc[h];
        }
        asm volatile("s_waitcnt lgkmcnt(0)" ::: "memory");
#pragma unroll
        for (int h = 0; h < 8; ++h) { float v[4];
#pragma unroll
            for (int i = 0; i < 4; ++i) v[i] = pb[h * 256 + 64 * i + lane];
            const float m = wave_max(fmaxf(fmaxf(v[0], v[1]), fmaxf(v[2], v[3])));
#pragma unroll
            for (int i = 0; i < 4; ++i) v[i] = __expf(v[i] - m);
            const float inv = 1.0f / wave_sum((v[0] + v[1]) + (v[2] + v[3]));
#pragma unroll
            for (int i = 0; i < 4; ++i) pb[h * 256 + 64 * i + lane] = v[i] * inv; }
        asm volatile("s_waitcnt lgkmcnt(0)" ::: "memory");
        float o0[8], o1[8];
#pragma unroll
        for (int h = 0; h < 8; ++h) { o0[h] = 0.f; o1[h] = 0.f; }
        for (int jj = 0; jj < nsel; ++jj) { const int s = (int)sel[jj]; const bf16* vp = KVN + (size_t)(rb + s) * 128 + lane;
            const float v0 = bf2f(vp[0]), v1 = bf2f(vp[64]);
#pragma unroll
            for (int h = 0; h < 8; ++h) { const float p = pb[h * 256 + jj]; o0[h] += p * v0; o1[h] += p * v1; } }
#pragma unroll
        for (int h = 0; h < 8; ++h) { QLAT[(size_t)r * 1024 + h * 128 + lane] = (bf16)f2bf(o0[h]); QLAT[(size_t)r * 1024 + h * 128 + 64 + lane] = (bf16)f2bf(o1[h]); }
        asm volatile("s_waitcnt lgkmcnt(0)" ::: "memory");
    }
}

typedef short bf16x8 __attribute__((ext_vector_type(8)));
typedef short s16x4 __attribute__((ext_vector_type(4)));
typedef float f32x16 __attribute__((ext_vector_type(16)));
#define LOG2E 1.4426950408889634f
__device__ __forceinline__ int crow(int r, int hi) { return (r & 3) + 8 * (r >> 2) + 4 * hi; }
__device__ __forceinline__ void glds16(const void* g, LAS void* l) { __builtin_amdgcn_global_load_lds((const unsigned*)g, (LAS unsigned*)l, 16, 0, 0); }
__device__ __forceinline__ s16x4 tr16(const LAS unsigned char* p) { return __builtin_bit_cast(s16x4, __builtin_amdgcn_ds_read_tr16_b64_v4i16((LAS s16x4*)p)); }
__device__ __forceinline__ float swap_max(float v) { auto rr = __builtin_amdgcn_permlane32_swap(__float_as_uint(v), __float_as_uint(v), false, false); return fmaxf(__uint_as_float(rr[0]), __uint_as_float(rr[1])); }
__device__ __forceinline__ float swap_add(float v) { auto rr = __builtin_amdgcn_permlane32_swap(__float_as_uint(v), __float_as_uint(v), false, false); return __uint_as_float(rr[0]) + __uint_as_float(rr[1]); }
__device__ __forceinline__ unsigned cvtpk(float lo, float hi) { unsigned r; asm("v_cvt_pk_bf16_f32 %0, %1, %2" : "=v"(r) : "v"(lo), "v"(hi)); return r; }
#define RAW_BARRIER() do { asm volatile("s_waitcnt lgkmcnt(0)" ::: "memory"); __builtin_amdgcn_s_barrier(); asm volatile("" ::: "memory"); } while (0)

__device__ __forceinline__ void mixB_fast(unsigned char* y, const float* T, const float* gsub, float lam, float one_m_li, LAS unsigned char* lds, int tid, int lane, int wave, int G) {
    asm volatile("" : "+v"(lane), "+v"(tid));
    bf16* BQ = (bf16*)(y + Y_BQ); const bf16* BK = (const bf16*)(y + Y_BK); const bf16* BV = (const bf16*)(y + Y_BV);
    const int r32 = lane & 31, hi = lane >> 5, m = wave >> 2, qs = wave & 3;
    LAS float* bt = (LAS float*)(lds + 65536);
    constexpr float C2 = 0.125f * LOG2E, THR = 8.0f;
    for (int item = blockIdx.x; item < CHB * 4 * 16; item += G) {
        const int bh = item >> 4, pr = item & 15, bb = bh >> 2, h = bh & 3, rb = bb * SEQ;
        RAW_BARRIER();
        for (int i = tid; i < 64 + 4096; i += NTHREADS) bt[i] = (i < 64) ? 0.f : T[(i - 64) * 24 + 8 + h] * LOG2E;
        for (int uu = 0; uu < 2; ++uu) {
            const int qb = (uu == 0) ? (31 - pr) : pr;
            const int q0w = qb * 128 + qs * 32, qpos = q0w + r32;
            bf16x8 qf[4];
#pragma unroll
            for (int ks = 0; ks < 4; ++ks) qf[ks] = *(const bf16x8*)(BQ + (size_t)(rb + qpos) * 512 + h * 128 + m * 64 + 16 * ks + 8 * hi);
            const int NT = 2 * (qb + 1);
            f32x16 O[4];
#pragma unroll
            for (int dq = 0; dq < 4; ++dq)
#pragma unroll
                for (int r = 0; r < 16; ++r) O[dq][r] = 0.f;
            float mref = -INFINITY, lsum = 0.f;
#define MB_STAGE(t_, buf_) do { const int kv0_ = (t_) * 64; LAS unsigned char* sb_ = lds + (buf_) * 32768; \
                glds16(BK + (size_t)(rb + kv0_ + lane) * 512 + h * 128 + wave * 8, sb_ + wave * 1024); \
                glds16(BK + (size_t)(rb + kv0_ + lane) * 512 + h * 128 + 64 + wave * 8, sb_ + 8192 + wave * 1024); \
                _Pragma("unroll") for (int i_ = 0; i_ < 2; ++i_) { const int p_ = 2 * wave + i_, dq_ = p_ >> 2, rg_ = p_ & 3; \
                    glds16(BV + (size_t)(rb + kv0_ + 16 * rg_ + (lane >> 2)) * 512 + h * 128 + dq_ * 32 + (lane & 3) * 8, sb_ + 16384 + p_ * 1024); } } while (0)
            MB_STAGE(0, 0);
            for (int t = 0; t < NT; ++t) {
                if (t + 1 < NT) { MB_STAGE(t + 1, (t + 1) & 1); asm volatile("s_waitcnt vmcnt(4)" ::: "memory"); }
                else asm volatile("s_waitcnt vmcnt(0)" ::: "memory");
                RAW_BARRIER();
                const int kv0 = t * 64;
                if (kv0 <= q0w + 31) {
                    const LAS unsigned char* sb = lds + (t & 1) * 32768;
                    const LAS unsigned char* kb = sb + m * 8192 + hi * 1024 + r32 * 16;
                    f32x16 s0, s1;
#pragma unroll
                    for (int r = 0; r < 16; ++r) { s0[r] = 0.f; s1[r] = 0.f; }
#pragma unroll
                    for (int ks = 0; ks < 4; ++ks) {
                        const bf16x8 k0 = *(const LAS bf16x8*)(kb + ks * 2048), k1 = *(const LAS bf16x8*)(kb + ks * 2048 + 512);
                        s0 = __builtin_amdgcn_mfma_f32_32x32x16_bf16(k0, qf[ks], s0, 0, 0, 0);
                        s1 = __builtin_amdgcn_mfma_f32_32x32x16_bf16(k1, qf[ks], s1, 0, 0, 0); }
                    const int dmin = q0w - (kv0 + 63), dmax = q0w + 31 - kv0;
                    if (dmin >= 0 && rel_bucket(dmin) == rel_bucket(dmax)) {
                        const float cb = bt[64 + dmin];
#pragma unroll
                        for (int r = 0; r < 16; ++r) { s0[r] = fmaf(s0[r], C2, cb); s1[r] = fmaf(s1[r], C2, cb); }
                    } else {
                        const LAS float* bp = bt + 64 + (qpos - kv0) - 4 * hi;
#pragma unroll
                        for (int r = 0; r < 16; ++r) { s0[r] = fmaf(s0[r], C2, bp[-((r & 3) + 8 * (r >> 2))]); s1[r] = fmaf(s1[r], C2, bp[-(32 + (r & 3) + 8 * (r >> 2))]); }
                    }
                    if (kv0 + 63 > q0w) {
#pragma unroll
                        for (int r = 0; r < 16; ++r) { const int kv = kv0 + crow(r, hi); if (kv > qpos) s0[r] = -INFINITY; if (kv + 32 > qpos) s1[r] = -INFINITY; }
                    }
                    float rm = fmaxf(s0[0], s1[0]);
#pragma unroll
                    for (int r = 1; r < 16; ++r) rm = fmaxf(rm, fmaxf(s0[r], s1[r]));
                    rm = swap_max(rm);
                    if (__any(rm > mref + THR)) {
                        const float mn = fmaxf(mref, rm), f = __builtin_amdgcn_exp2f(mref - mn);
                        lsum *= f; mref = mn;
#pragma unroll
                        for (int dq = 0; dq < 4; ++dq)
#pragma unroll
                            for (int r = 0; r < 16; ++r) O[dq][r] *= f;
                    }
                    float ps = 0.f;
#pragma unroll
                    for (int r = 0; r < 16; ++r) { s0[r] = __builtin_amdgcn_exp2f(s0[r] - mref); s1[r] = __builtin_amdgcn_exp2f(s1[r] - mref); ps += s0[r] + s1[r]; }
                    lsum += ps;
                    bf16x8 pf[4];
                    { v4u w;
                      w.x = cvtpk(s0[0], s0[1]); w.y = cvtpk(s0[2], s0[3]); w.z = cvtpk(s0[4], s0[5]); w.w = cvtpk(s0[6], s0[7]); pf[0] = __builtin_bit_cast(bf16x8, w);
                      w.x = cvtpk(s0[8], s0[9]); w.y = cvtpk(s0[10], s0[11]); w.z = cvtpk(s0[12], s0[13]); w.w = cvtpk(s0[14], s0[15]); pf[1] = __builtin_bit_cast(bf16x8, w);
                      w.x = cvtpk(s1[0], s1[1]); w.y = cvtpk(s1[2], s1[3]); w.z = cvtpk(s1[4], s1[5]); w.w = cvtpk(s1[6], s1[7]); pf[2] = __builtin_bit_cast(bf16x8, w);
                      w.x = cvtpk(s1[8], s1[9]); w.y = cvtpk(s1[10], s1[11]); w.z = cvtpk(s1[12], s1[13]); w.w = cvtpk(s1[14], s1[15]); pf[3] = __builtin_bit_cast(bf16x8, w); }
                    const LAS unsigned char* vb = sb + 16384 + ((lane >> 4) & 1) * 32 + (lane & 3) * 8 + (4 * hi + ((lane & 15) >> 2)) * 64;
#pragma unroll
                    for (int dq = 0; dq < 4; ++dq)
#pragma unroll
                        for (int sp = 0; sp < 4; ++sp) {
                            const s16x4 lo = tr16(vb + (dq * 4 + sp) * 1024), hh = tr16(vb + (dq * 4 + sp) * 1024 + 512);
                            const bf16x8 vf = (bf16x8){lo[0], lo[1], lo[2], lo[3], hh[0], hh[1], hh[2], hh[3]};
                            O[dq] = __builtin_amdgcn_mfma_f32_32x32x16_bf16(vf, pf[sp], O[dq], 0, 0, 0); }
                }
                RAW_BARRIER();
            }
#undef MB_STAGE
            const float inv = 1.0f / swap_add(lsum);
            LAS float* xb = (LAS float*)lds + qs * 4096;
            if (m == 1) {
#pragma unroll
                for (int dq = 0; dq < 4; ++dq)
#pragma unroll
                    for (int r = 0; r < 16; ++r) xb[(dq * 16 + r) * 64 + lane] = O[dq][r] * inv;
            }
            RAW_BARRIER();
            if (m == 0) {
                float ss = 0.f;
#pragma unroll
                for (int dq = 0; dq < 4; ++dq)
#pragma unroll
                    for (int r = 0; r < 16; ++r) { const float o = O[dq][r] * inv - lam * xb[(dq * 16 + r) * 64 + lane]; O[dq][r] = o; ss += o * o; }
                const float rstd = 1.0f / sqrtf(swap_add(ss) * (1.f / 128.f) + EPS) * one_m_li;
                bf16* orow = BQ + (size_t)(rb + qpos) * 512 + h * 128;
#pragma unroll
                for (int dq = 0; dq < 4; ++dq)
#pragma unroll
                    for (int g4 = 0; g4 < 4; ++g4) { const int d0 = dq * 32 + 8 * g4 + 4 * hi; const f32x4 gs = *(const f32x4*)(gsub + d0);
                        v2u w; w.x = pk2(O[dq][4 * g4] * rstd * gs.x, O[dq][4 * g4 + 1] * rstd * gs.y); w.y = pk2(O[dq][4 * g4 + 2] * rstd * gs.z, O[dq][4 * g4 + 3] * rstd * gs.w);
                        *(v2u*)(orow + d0) = w; }
            }
            asm volatile("s_waitcnt vmcnt(0)" ::: "memory");
            RAW_BARRIER();
        }
    }
}

constexpr size_t WS_OG = 432 * MiB, WS_LSE = 480 * MiB;
__device__ __forceinline__ void mixC_fast(unsigned char* y, unsigned char* ws, const float* T, LAS unsigned char* lds, int tid, int lane, int wave, int G) {
    asm volatile("" : "+v"(lane), "+v"(tid));
    const bf16* CQ = (const bf16*)(y + Y_CQ); const bf16* CK = (const bf16*)(y + Y_CK); const bf16* CV = (const bf16*)(y + Y_CV);
    float* OG = (float*)(ws + WS_OG); float* LSE = (float*)(ws + WS_LSE);
    const int r32 = lane & 31, hi = lane >> 5;
    LAS unsigned char* Kl = lds;
    LAS unsigned char* Vl = lds + 49152;
    LAS float* bt = (LAS float*)(lds + 98304);
    constexpr float C2 = 0.125f * LOG2E;
    for (int item = blockIdx.x; item < CHB * 192; item += G) {
        const int bb = item / 192, u = item % 192, g = u >> 6, v = u & 63;
        const int hp = v >> 4, w16 = v & 15;
        const int dil = (g == 0) ? 1 : (g == 1) ? 4 : 16;
        const int rc = (g == 0) ? 0 : (g == 1) ? (w16 >> 2) : w16;
        const int seg = (g == 0) ? w16 : (g == 1) ? (w16 & 3) : 0;
        const int hh = 4 * g + hp, M0 = seg * 256, rb = bb * SEQ;
        RAW_BARRIER();
        if (tid < 192) { int rel = tid - 32; rel = rel < 0 ? 0 : (rel > 128 ? 128 : rel); bt[tid] = T[(rel * dil) * 24 + 12 + hh] * LOG2E; }
#pragma unroll
        for (int i = 0; i < 6; ++i) { const int p = wave * 6 + i, c = p / 6, rbk = p % 6;
            int mk = M0 - 128 + 64 * rbk + lane; mk = mk < 0 ? 0 : mk;
            glds16(CK + (size_t)(rb + mk * dil + rc) * 768 + hh * 64 + c * 8, Kl + c * 6144 + rbk * 1024); }
#pragma unroll
        for (int i = 0; i < 6; ++i) { const int p = wave * 6 + i, dq = p / 24, rg = p % 24;
            int mk = M0 - 128 + 16 * rg + (lane >> 2); mk = mk < 0 ? 0 : mk;
            glds16(CV + (size_t)(rb + mk * dil + rc) * 768 + hh * 64 + dq * 32 + (lane & 3) * 8, Vl + p * 1024); }
        const int mq = M0 + 32 * wave + r32, rowq = rb + mq * dil + rc;
        bf16x8 qf[4];
#pragma unroll
        for (int ks = 0; ks < 4; ++ks) qf[ks] = *(const bf16x8*)(CQ + (size_t)rowq * 768 + hh * 64 + 16 * ks + 8 * hi);
        asm volatile("s_waitcnt vmcnt(0)" ::: "memory");
        RAW_BARRIER();
        f32x16 O[2];
#pragma unroll
        for (int dq = 0; dq < 2; ++dq)
#pragma unroll
            for (int r = 0; r < 16; ++r) O[dq][r] = 0.f;
        float mref = -INFINITY, lsum = 0.f;
#pragma unroll 1
        for (int j = 0; j < 5; ++j) {
            const int lrow = 32 * wave + 32 * j;
            if (M0 - 128 + lrow + 31 < 0) continue;
            const LAS unsigned char* kb = Kl + hi * 6144 + (lrow + r32) * 16;
            f32x16 s0;
#pragma unroll
            for (int r = 0; r < 16; ++r) s0[r] = 0.f;
#pragma unroll
            for (int ks = 0; ks < 4; ++ks) { const bf16x8 k0 = *(const LAS bf16x8*)(kb + ks * 12288); s0 = __builtin_amdgcn_mfma_f32_32x32x16_bf16(k0, qf[ks], s0, 0, 0, 0); }
            const int relb = 128 - 32 * j + r32;
            const LAS float* bp = bt + 32 + relb - 4 * hi;
            const int mkb = M0 - 128 + lrow + 4 * hi;
#pragma unroll
            for (int r = 0; r < 16; ++r) { const int cr = (r & 3) + 8 * (r >> 2), rel = relb - 4 * hi - cr;
                const float vv = fmaf(s0[r], C2, bp[-cr]);
                s0[r] = (rel >= 0 && rel <= 128 && mkb + cr >= 0) ? vv : -INFINITY; }
            float rm = s0[0];
#pragma unroll
            for (int r = 1; r < 16; ++r) rm = fmaxf(rm, s0[r]);
            rm = swap_max(rm);
            const float mn = fmaxf(mref, rm);
            const float f = (mn == -INFINITY) ? 1.f : __builtin_amdgcn_exp2f(mref - mn);
            const float msub = (mn == -INFINITY) ? 0.f : mn;
            lsum *= f; mref = mn;
#pragma unroll
            for (int dq = 0; dq < 2; ++dq)
#pragma unroll
                for (int r = 0; r < 16; ++r) O[dq][r] *= f;
            float ps = 0.f;
#pragma unroll
            for (int r = 0; r < 16; ++r) { s0[r] = __builtin_amdgcn_exp2f(s0[r] - msub); ps += s0[r]; }
            lsum += ps;
            bf16x8 pf[2];
            { v4u w;
              w.x = cvtpk(s0[0], s0[1]); w.y = cvtpk(s0[2], s0[3]); w.z = cvtpk(s0[4], s0[5]); w.w = cvtpk(s0[6], s0[7]); pf[0] = __builtin_bit_cast(bf16x8, w);
              w.x = cvtpk(s0[8], s0[9]); w.y = cvtpk(s0[10], s0[11]); w.z = cvtpk(s0[12], s0[13]); w.w = cvtpk(s0[14], s0[15]); pf[1] = __builtin_bit_cast(bf16x8, w); }
            const LAS unsigned char* vb = Vl + ((lane >> 4) & 1) * 32 + (lane & 3) * 8 + (4 * hi + ((lane & 15) >> 2)) * 64 + (lrow >> 4) * 1024;
#pragma unroll
            for (int dq = 0; dq < 2; ++dq)
#pragma unroll
                for (int sp = 0; sp < 2; ++sp) {
                    const s16x4 lo = tr16(vb + (dq * 24 + sp) * 1024), hh2 = tr16(vb + (dq * 24 + sp) * 1024 + 512);
                    const bf16x8 vf = (bf16x8){lo[0], lo[1], lo[2], lo[3], hh2[0], hh2[1], hh2[2], hh2[3]};
                    O[dq] = __builtin_amdgcn_mfma_f32_32x32x16_bf16(vf, pf[sp], O[dq], 0, 0, 0); }
        }
        const float ltot = swap_add(lsum), inv = 1.0f / ltot;
        float* og = OG + ((size_t)g * CHR + rowq) * 256 + hp * 64;
#pragma unroll
        for (int dq = 0; dq < 2; ++dq)
#pragma unroll
            for (int g4 = 0; g4 < 4; ++g4) { const int d0 = dq * 32 + 8 * g4 + 4 * hi;
                *(f32x4*)(og + d0) = (f32x4){O[dq][4 * g4] * inv, O[dq][4 * g4 + 1] * inv, O[dq][4 * g4 + 2] * inv, O[dq][4 * g4 + 3] * inv}; }
        if (hi == 0) LSE[((size_t)g * CHR + rowq) * 4 + hp] = (mref + __log2f(ltot)) * 0.6931471805599453f;
    }
}
__device__ __forceinline__ void mergeC(unsigned char* y, unsigned char* ws, int gw, int NGW, int lane) {
    asm volatile("" : "+v"(lane));
    const float* OG = (const float*)(ws + WS_OG); const float* LSE = (const float*)(ws + WS_LSE); bf16* OC = (bf16*)(y + Y_OC);
    for (int r = gw; r < CHR; r += NGW) {
        const int hp = lane >> 4, d4 = (lane & 15) * 4;
        float l0 = LSE[((size_t)0 * CHR + r) * 4 + hp], l1 = LSE[((size_t)1 * CHR + r) * 4 + hp], l2 = LSE[((size_t)2 * CHR + r) * 4 + hp];
        const float M = fmaxf(fmaxf(l0, l1), l2);
        const float a0 = __expf(l0 - M), a1 = __expf(l1 - M), a2 = __expf(l2 - M), ia = 1.0f / (a0 + a1 + a2);
        const f32x4 o0 = *(const f32x4*)(OG + ((size_t)0 * CHR + r) * 256 + hp * 64 + d4), o1 = *(const f32x4*)(OG + ((size_t)1 * CHR + r) * 256 + hp * 64 + d4), o2 = *(const f32x4*)(OG + ((size_t)2 * CHR + r) * 256 + hp * 64 + d4);
        const f32x4 o = (o0 * a0 + o1 * a1 + o2 * a2) * ia;
        v2u w; w.x = pk2(o.x, o.y); w.y = pk2(o.z, o.w);
        *(v2u*)(OC + (size_t)r * 256 + hp * 64 + d4) = w;
    }
}

constexpr int CW_KMAX = 8192;
constexpr int A_KST = 0, A_HIST = 32768, A_CAND = 98304, A_SEL = 131072, A_BKT = 147456, A_BIAS = 151552;
__device__ __forceinline__ int a_bin(float s, int kb) {
    int k = (int)(__float_as_uint(fabsf(s)) >> 18) - kb; k = k < 0 ? 0 : (k > 511 ? 511 : k);
    return (s < 0.f) ? (511 - k) : (512 + k);
}
__device__ __forceinline__ void mixA_fast(unsigned char* y, const bf16* KVN, const float* T, const float* rel_bias, const unsigned* kmaxw, LAS unsigned char* lds, int tid, int lane, int wave, int G) {
    asm volatile("" : "+v"(lane), "+v"(tid));
    bf16* QLAT = (bf16*)(y + Y_QLAT); const bf16* MISC = (const bf16*)(y + Y_MISC); const bf16* IQ = (const bf16*)(y + Y_IQ);
    const int kl = lane & 31, hi = lane >> 5;
    constexpr float C2 = 0.125f * LOG2E, THR = 8.0f;
    LAS float* biasl = (LAS float*)(lds + A_BIAS);
    const unsigned lt32 = (1u << kl) - 1u;
    for (int item = blockIdx.x; item < CHB * 64; item += G) {
        const int bb = item >> 6, pr = item & 63, rb = bb * SEQ;
        const float kmax = sqrtf(__uint_as_float(kmaxw[bb]));
        for (int uu = 0; uu < 2; ++uu) {
            const int qb = (uu == 0) ? (127 - pr) : pr, t0 = qb * 32, tw = t0 + 4 * wave;
            RAW_BARRIER();
            if (tid < 256) biasl[tid] = rel_bias[(tid >> 3) * 24 + (tid & 7)] * LOG2E;
            bf16x8 aq[4];
            { const int rowq = kl >> 3, hr = kl & 7;
#pragma unroll
              for (int ks = 0; ks < 4; ++ks) aq[ks] = *(const bf16x8*)(IQ + (size_t)(rb + tw + rowq) * 512 + hr * 64 + 16 * ks + 8 * hi); }
            float wr[16];
#pragma unroll
            for (int r = 0; r < 16; ++r) wr[r] = bf2f(MISC[(size_t)(rb + tw + (r >> 2)) * 256 + 192 + (r & 3) + 4 * hi]) * 0.044194173824159216f;
            int kbX, kbY;
            { float ss = 0.f;
#pragma unroll
              for (int ks = 0; ks < 4; ++ks)
#pragma unroll
                  for (int j = 0; j < 8; ++j) { const float v = bf2f((bf16)aq[ks][j]); ss += v * v; }
              ss = swap_add(ss);
              const float wa = fabsf(bf2f(MISC[(size_t)(rb + tw + (kl >> 3)) * 256 + 192 + (kl & 7)])) * 0.044194173824159216f;
              float u = wa * sqrtf(ss) * kmax;
              u += __shfl_xor(u, 1); u += __shfl_xor(u, 2); u += __shfl_xor(u, 4);
              const float uX = __shfl(u, (2 * hi) * 8), uY = __shfl(u, (2 * hi + 1) * 8);
              kbX = (int)(__float_as_uint(uX) >> 18) - 511; kbY = (int)(__float_as_uint(uY) >> 18) - 511; }
            const int tX = tw + 2 * hi, tY = tw + 2 * hi + 1;
            const int qX = wave * 4 + 2 * hi, qY = qX + 1;
            LAS unsigned* histX = (LAS unsigned*)(lds + A_HIST + qX * 2048); LAS unsigned* histY = (LAS unsigned*)(lds + A_HIST + qY * 2048);
            { LAS v4u* hz = (LAS v4u*)(lds + A_HIST + wave * 8192);
#pragma unroll
              for (int i = 0; i < 8; ++i) hz[i * 64 + lane] = (v4u){0u, 0u, 0u, 0u}; }
            int thrX = -1, thrY = -1; unsigned cntX = 0, cntY = 0, ccX = 0, ccY = 0;
            const int NTK = qb + 1, NCK = (NTK + 3) >> 2;
#define MA_STAGE(ck_, buf_) do { _Pragma("unroll") for (int i_ = 0; i_ < 2; ++i_) { const int p_ = 2 * wave + i_, tl_ = p_ >> 2, ks_ = p_ & 3; \
                glds16(MISC + (size_t)(rb + 128 * (ck_) + 32 * tl_ + kl) * 256 + 128 + (2 * ks_ + hi) * 8, lds + A_KST + (buf_) * 16384 + tl_ * 4096 + ks_ * 1024); } } while (0)
#pragma unroll 1
            for (int pass = 0; pass < 2; ++pass) {
                MA_STAGE(0, 0);
#pragma unroll 1
                for (int ck = 0; ck < NCK; ++ck) {
                    if (ck + 1 < NCK) { MA_STAGE(ck + 1, (ck + 1) & 1); asm volatile("s_waitcnt vmcnt(2)" ::: "memory"); }
                    else asm volatile("s_waitcnt vmcnt(0)" ::: "memory");
                    RAW_BARRIER();
#pragma unroll 1
                    for (int tl = 0; tl < 4; ++tl) {
                        const int kt = 4 * ck + tl; if (kt >= NTK) break;
                        const LAS unsigned char* kbp = lds + A_KST + (ck & 1) * 16384 + tl * 4096 + hi * 512 + kl * 16;
                        f32x16 c;
#pragma unroll
                        for (int r = 0; r < 16; ++r) c[r] = 0.f;
#pragma unroll
                        for (int ks = 0; ks < 4; ++ks) { const bf16x8 kf = *(const LAS bf16x8*)(kbp + ks * 1024); c = __builtin_amdgcn_mfma_f32_32x32x16_bf16(aq[ks], kf, c, 0, 0, 0); }
                        float p0 = 0.f, p1 = 0.f, p2 = 0.f, p3 = 0.f;
#pragma unroll
                        for (int i = 0; i < 4; ++i) { p0 += wr[i] * fmaxf(c[i], 0.f); p1 += wr[4 + i] * fmaxf(c[4 + i], 0.f); p2 += wr[8 + i] * fmaxf(c[8 + i], 0.f); p3 += wr[12 + i] * fmaxf(c[12 + i], 0.f); }
                        float sX, sY;
                        { auto rr = __builtin_amdgcn_permlane32_swap(__float_as_uint(p0), __float_as_uint(p2), false, false); sX = __uint_as_float(rr[0]) + __uint_as_float(rr[1]) + 0.f; }
                        { auto rr = __builtin_amdgcn_permlane32_swap(__float_as_uint(p1), __float_as_uint(p3), false, false); sY = __uint_as_float(rr[0]) + __uint_as_float(rr[1]) + 0.f; }
                        const int s = kt * 32 + kl;
                        const bool vX = s <= tX, vY = s <= tY;
                        const int bX = a_bin(sX, kbX), bY = a_bin(sY, kbY);
                        if (pass == 0) {
                            if (vX) __hip_atomic_fetch_add(histX + (bX >> 1), 1u << ((bX & 1) * 16), __ATOMIC_RELAXED, __HIP_MEMORY_SCOPE_WORKGROUP);
                            if (vY) __hip_atomic_fetch_add(histY + (bY >> 1), 1u << ((bY & 1) * 16), __ATOMIC_RELAXED, __HIP_MEMORY_SCOPE_WORKGROUP);
                        } else {
                            {   const bool sel = vX && bX > thrX, cd = vX && bX == thrX;
                                const unsigned long long bs = __ballot(sel), bc = __ballot(cd);
                                const unsigned ms = hi ? (unsigned)(bs >> 32) : (unsigned)bs, mc = hi ? (unsigned)(bc >> 32) : (unsigned)bc;
                                if (sel) ((LAS bf16*)(lds + A_SEL + qX * 512))[cntX + __popc(ms & lt32)] = (bf16)s;
                                if (cd) { const unsigned cp = ccX + __popc(mc & lt32); if (cp < 128u) { ((LAS float*)(lds + A_CAND + qX * 768))[cp] = sX; ((LAS bf16*)(lds + A_CAND + qX * 768 + 512))[cp] = (bf16)s; } }
                                cntX += __popc(ms); ccX += __popc(mc); }
                            {   const bool sel = vY && bY > thrY, cd = vY && bY == thrY;
                                const unsigned long long bs = __ballot(sel), bc = __ballot(cd);
                                const unsigned ms = hi ? (unsigned)(bs >> 32) : (unsigned)bs, mc = hi ? (unsigned)(bc >> 32) : (unsigned)bc;
                                if (sel) ((LAS bf16*)(lds + A_SEL + qY * 512))[cntY + __popc(ms & lt32)] = (bf16)s;
                                if (cd) { const unsigned cp = ccY + __popc(mc & lt32); if (cp < 128u) { ((LAS float*)(lds + A_CAND + qY * 768))[cp] = sY; ((LAS bf16*)(lds + A_CAND + qY * 768 + 512))[cp] = (bf16)s; } }
                                cntY += __popc(ms); ccY += __popc(mc); }
                        }
                    }
                    RAW_BARRIER();
                }
                if (pass == 0) {
#pragma unroll 1
                    for (int q4 = 0; q4 < 4; ++q4) {
                        const LAS unsigned* hq = (const LAS unsigned*)(lds + A_HIST + (wave * 4 + q4) * 2048) + 504 - 8 * lane;
                        unsigned w8[8];
                        { const v4u a0 = *(const LAS v4u*)hq, a1 = *(const LAS v4u*)(hq + 4); w8[0] = a0.x; w8[1] = a0.y; w8[2] = a0.z; w8[3] = a0.w; w8[4] = a1.x; w8[5] = a1.y; w8[6] = a1.z; w8[7] = a1.w; }
                        unsigned loc = 0;
#pragma unroll
                        for (int j = 0; j < 8; ++j) loc += (w8[j] & 0xffffu) + (w8[j] >> 16);
                        unsigned inc = loc;
#pragma unroll
                        for (int o = 1; o < 64; o <<= 1) { const unsigned v = __shfl_up(inc, o); if (lane >= o) inc += v; }
                        unsigned run = inc - loc; int thr = -1; unsigned cab = 0;
#pragma unroll
                        for (int j = 7; j >= 0; --j)
#pragma unroll
                            for (int hh = 1; hh >= 0; --hh) { const unsigned cn = (w8[j] >> (16 * hh)) & 0xffffu;
                                if (thr < 0 && run + cn >= (unsigned)TOPK) { thr = 2 * (504 - 8 * lane + j) + hh; cab = run; }
                                run += cn; }
                        const unsigned long long bl = __ballot(inc >= (unsigned)TOPK);
                        int thq = -1; unsigned cbq = 0;
                        if (bl) { const int L = __ffsll((long long)bl) - 1; thq = __shfl(thr, L); cbq = __shfl(cab, L); }
                        (void)cbq;
                        if (q4 == 2 * hi) thrX = thq; if (q4 == 2 * hi + 1) thrY = thq;
                    }
                }
            }
#undef MA_STAGE
            {
                const unsigned c0 = (unsigned)__shfl((int)cntX, 0), c2 = (unsigned)__shfl((int)cntX, 32), c1 = (unsigned)__shfl((int)cntY, 0), c3 = (unsigned)__shfl((int)cntY, 32);
                const unsigned k0 = (unsigned)__shfl((int)ccX, 0), k2 = (unsigned)__shfl((int)ccX, 32), k1 = (unsigned)__shfl((int)ccY, 0), k3 = (unsigned)__shfl((int)ccY, 32);
#pragma unroll 1
                for (int q4 = 0; q4 < 4; ++q4) {
                    const unsigned cnt = (q4 == 0) ? c0 : (q4 == 1) ? c1 : (q4 == 2) ? c2 : c3; unsigned cc = (q4 == 0) ? k0 : (q4 == 1) ? k1 : (q4 == 2) ? k2 : k3;
                    if (cc > 128u) cc = 128u;
                    LAS unsigned* nfp = (LAS unsigned*)(lds + A_BIAS + 1024) + wave * 4 + q4;
                    if (lane == 0) *nfp = cnt;
                    if (cnt >= (unsigned)TOPK || cc == 0u) continue;
                    const unsigned need = (unsigned)TOPK - cnt;
                    const LAS float* cs = (const LAS float*)(lds + A_CAND + (wave * 4 + q4) * 768); const LAS bf16* ci = (const LAS bf16*)(lds + A_CAND + (wave * 4 + q4) * 768 + 512);
                    LAS bf16* so = (LAS bf16*)(lds + A_SEL + (wave * 4 + q4) * 512);
                    unsigned base = cnt;
#pragma unroll 1
                    for (unsigned r0 = 0; r0 < cc; r0 += 64) { const unsigned i = r0 + lane; const bool act = i < cc;
                        const float si = act ? cs[i] : 0.f; const unsigned ii = act ? ci[i] : 0u; unsigned rank = 0;
                        for (unsigned j = 0; j < cc; ++j) { const float sj = cs[j]; const unsigned ij = ci[j]; rank += (sj > si || (sj == si && ij < ii)) ? 1u : 0u; }
                        const bool take = act && rank < need;
                        const unsigned long long bt = __ballot(take);
                        if (take) so[base + __popcll(bt & ((1ull << lane) - 1ull))] = (bf16)ii;
                        base += __popcll(bt); }
                    if (lane == 0) *nfp = base;
                }
            }
            RAW_BARRIER();
            {
                LAS unsigned char* gb = lds + wave * 16384;
                LAS bf16* bkt = (LAS bf16*)(lds + A_BKT + wave * 512);
#pragma unroll 1
                for (int q4 = 0; q4 < 4; ++q4) { int ns = (int)((const LAS unsigned*)(lds + A_BIAS + 1024))[wave * 4 + q4]; ns = ns < TOPK ? ns : TOPK; LAS bf16* so = (LAS bf16*)(lds + A_SEL + (wave * 4 + q4) * 512);
                    for (int i = lane; i < TOPK; i += 64) if (i >= ns) so[i] = 0; }
                asm volatile("s_waitcnt lgkmcnt(0)" ::: "memory");
                const int Xk = ((kl & 3) << 2) | ((kl >> 2) & 3);
                const int q_ = (lane & 15) >> 2, p_ = lane & 3, g1 = (lane >> 4) & 1;
                const int hc = kl < 8 ? kl : 7;
#define MA_GATHER(q4_, c8_, buf_) do { const LAS bf16* so_ = (const LAS bf16*)(lds + A_SEL + (wave * 4 + (q4_)) * 512) + (c8_) * 32; \
                    _Pragma("unroll") for (int i_ = 0; i_ < 8; ++i_) { const int row_ = 4 * i_ + (lane >> 4); const int idx_ = so_[row_]; \
                        const int ch_ = (lane & 15) ^ (((row_ & 3) << 2) | ((row_ >> 2) & 3)); \
                        glds16(KVN + (size_t)(rb + idx_) * 128 + ch_ * 8, gb + (buf_) * 8192 + i_ * 1024); } } while (0)
                MA_GATHER(0, 0, 0);
#pragma unroll 1
                for (int q4 = 0; q4 < 4; ++q4) {
                    const int t = tw + q4; int ns = (int)((const LAS unsigned*)(lds + A_BIAS + 1024))[wave * 4 + q4]; ns = ns < TOPK ? ns : TOPK;
                    const LAS bf16* so = (const LAS bf16*)(lds + A_SEL + (wave * 4 + q4) * 512);
                    for (int i = lane; i < TOPK; i += 64) { const int d = t - (int)so[i]; bkt[i] = (bf16)(rel_bucket(d < 0 ? 0 : d) * 8); }
                    bf16x8 bq[8];
#pragma unroll
                    for (int ks = 0; ks < 8; ++ks) { bq[ks] = (bf16x8){0, 0, 0, 0, 0, 0, 0, 0}; if (kl < 8) bq[ks] = *(const bf16x8*)(QLAT + (size_t)(rb + t) * 1024 + kl * 128 + 16 * ks + 8 * hi); }
                    f32x16 O[4];
#pragma unroll
                    for (int dq = 0; dq < 4; ++dq)
#pragma unroll
                        for (int r = 0; r < 16; ++r) O[dq][r] = 0.f;
                    float mref = -INFINITY, lsum = 0.f;
#pragma unroll 1
                    for (int c8 = 0; c8 < 8; ++c8) {
                        const int step = q4 * 8 + c8, buf = step & 1;
                        asm volatile("s_waitcnt lgkmcnt(0)" ::: "memory");
                        if (step + 1 < 32) { MA_GATHER((step + 1) >> 3, (step + 1) & 7, buf ^ 1); asm volatile("s_waitcnt vmcnt(8)" ::: "memory"); }
                        else asm volatile("s_waitcnt vmcnt(0)" ::: "memory");
                        const LAS unsigned char* cb = gb + buf * 8192;
                        f32x16 s;
#pragma unroll
                        for (int r = 0; r < 16; ++r) s[r] = 0.f;
#pragma unroll
                        for (int ks = 0; ks < 8; ++ks) { const bf16x8 kf = *(const LAS bf16x8*)(cb + 256 * kl + 16 * ((2 * ks + hi) ^ Xk)); s = __builtin_amdgcn_mfma_f32_32x32x16_bf16(kf, bq[ks], s, 0, 0, 0); }
#pragma unroll
                        for (int r = 0; r < 16; ++r) { const int j = c8 * 32 + crow(r, hi); const float bv = biasl[(int)bkt[j] + hc];
                            const float vv = fmaf(s[r], C2, bv); s[r] = (j < ns) ? vv : -INFINITY; }
                        float rm = s[0];
#pragma unroll
                        for (int r = 1; r < 16; ++r) rm = fmaxf(rm, s[r]);
                        rm = swap_max(rm);
                        if (__any(rm > mref + THR)) {
                            const float mn = fmaxf(mref, rm), f = (mn == -INFINITY) ? 1.f : __builtin_amdgcn_exp2f(mref - mn);
                            lsum *= f; mref = mn;
#pragma unroll
                            for (int dq = 0; dq < 4; ++dq)
#pragma unroll
                                for (int r = 0; r < 16; ++r) O[dq][r] *= f;
                        }
                        const float msub = (mref == -INFINITY) ? 0.f : mref;
                        float ps = 0.f;
#pragma unroll
                        for (int r = 0; r < 16; ++r) { s[r] = __builtin_amdgcn_exp2f(s[r] - msub); ps += s[r]; }
                        lsum += ps;
                        bf16x8 pf[2];
                        { v4u w;
                          w.x = cvtpk(s[0], s[1]); w.y = cvtpk(s[2], s[3]); w.z = cvtpk(s[4], s[5]); w.w = cvtpk(s[6], s[7]); pf[0] = __builtin_bit_cast(bf16x8, w);
                          w.x = cvtpk(s[8], s[9]); w.y = cvtpk(s[10], s[11]); w.z = cvtpk(s[12], s[13]); w.w = cvtpk(s[14], s[15]); pf[1] = __builtin_bit_cast(bf16x8, w); }
#pragma unroll
                        for (int dq = 0; dq < 4; ++dq)
#pragma unroll
                            for (int sp = 0; sp < 2; ++sp) {
                                const int ch = 4 * dq + 2 * g1 + (p_ >> 1);
                                const int rlo = 16 * sp + 4 * hi + q_, rhi = rlo + 8;
                                const s16x4 lo = tr16(cb + 256 * rlo + 16 * (ch ^ ((q_ << 2) | (hi & 3))) + 8 * (p_ & 1));
                                const s16x4 hh2 = tr16(cb + 256 * rhi + 16 * (ch ^ ((q_ << 2) | ((hi + 2) & 3))) + 8 * (p_ & 1));
                                const bf16x8 vf = (bf16x8){lo[0], lo[1], lo[2], lo[3], hh2[0], hh2[1], hh2[2], hh2[3]};
                                O[dq] = __builtin_amdgcn_mfma_f32_32x32x16_bf16(vf, pf[sp], O[dq], 0, 0, 0); }
                    }
                    const float inv = 1.0f / swap_add(lsum);
                    if (kl < 8) { bf16* orow = QLAT + (size_t)(rb + t) * 1024 + kl * 128;
#pragma unroll
                        for (int dq = 0; dq < 4; ++dq)
#pragma unroll
                            for (int g4 = 0; g4 < 4; ++g4) { const int d0 = dq * 32 + 8 * g4 + 4 * hi;
                                v2u w; w.x = pk2(O[dq][4 * g4] * inv, O[dq][4 * g4 + 1] * inv); w.y = pk2(O[dq][4 * g4 + 2] * inv, O[dq][4 * g4 + 3] * inv);
                                *(v2u*)(orow + d0) = w; } }
                }
#undef MA_GATHER
                asm volatile("s_waitcnt vmcnt(0)" ::: "memory");
            }
        }
    }
}
__global__ void __launch_bounds__(NTHREADS, 2) fwd(Args a) {
    extern __shared__ __attribute__((aligned(16))) unsigned char lds_raw[];
    LAS unsigned char* lds = (LAS unsigned char*)lds_raw;
    const int tid = threadIdx.x, lane = tid & 63, wave = __builtin_amdgcn_readfirstlane(tid >> 6);
    const int G = gridDim.x, gw = blockIdx.x * NWAVES + wave, NGW = G * NWAVES;
    unsigned char* ws = a.ws;
    for (int u = tid; u < (LDS_BYTES - LDSCTL_OFF) / 4; u += NTHREADS) ((LAS unsigned*)(lds + LDSCTL_OFF))[u] = 0u;
    __syncthreads();
    XcdBarrier bar = xcd_barrier_post((unsigned*)(ws + WS_CTL) + CW_BAR, (volatile LAS unsigned*)(lds + LDSCTL_OFF));

    const float* x_in = a.in[0]; float* xo = a.out;
    float* mod = (float*)(ws + WS_MOD); const float* T = (const float*)(ws + WS_TAB); const float* lamp = (const float*)(ws + WS_LAM);
    bf16* H = (bf16*)(ws + WS_H); unsigned char* y = ws + WS_Y; bf16* KVN = (bf16*)(ws + WS_KVN);

    p0a_prologue(a, ws, lds, tid, lane, wave, G);
    xcd_barrier(bar);
    norm_rows(x_in, H, a.in[4], mod + 0 * 1024, mod + 1 * 1024, gw, NGW, lane);
    xcd_barrier(bar);

#pragma unroll
    for (int l = 0; l < NL; ++l) {
        unsigned char* wl = ws + WS_W + (size_t)l * W_LAYER;
        const float* modl = mod + (size_t)l * 8 * 6144;
#pragma unroll
        for (int ch = 0; ch < NCH; ++ch) {
            { pg8::Gemm g{H + (size_t)ch * CHR * 1024, (const bf16*)(wl + W_IN), CHR, NIN, 1024}; pg8::StaticOrder S; S.init(CHR, NIN, G, (int)blockIdx.x);
              pg8::EpiIn E{y};
              pg8::gemm_phase<pg8::EpiIn, pg8::StaticOrder, true, true>(lds, g, S, E); }
            xcd_barrier(bar);
            unsigned* kmaxw = (unsigned*)(ws + WS_CTL) + 8192 + (l * NCH + ch) * 64;
            kvn_rows(y, KVN, a.in[8] + l * 128, kmaxw, gw, NGW, lane);
            mixC_fast(y, ws, T, lds, tid, lane, wave, G);
            mixB_fast(y, T, a.in[13] + l * 128, lamp[l], (l == 0) ? 0.8f : 0.64449093f, lds, tid, lane, wave, G);
            xcd_barrier(bar);
            mergeC(y, ws, gw, NGW, lane);
            mixA_fast(y, KVN, T, a.in[21], kmaxw, lds, tid, lane, wave, G);
            xcd_barrier(bar);
            { pg8::StaticOrder S; S.init(CHR, 1024, G, (int)blockIdx.x);
              const bf16* Z = (const bf16*)(y + Y_Z); float* MF = (float*)(y + Y_MF32); bf16* MB = (bf16*)(y + Y_MBF);
              { pg8::Gemm g{(const bf16*)(y + Y_QLAT), (const bf16*)(wl + W_A), CHR, 1024, 1024}; pg8::EpiGate<0> E{Z, 0, MF, MB};
                pg8::gemm_phase<pg8::EpiGate<0>, pg8::StaticOrder, true, true>(lds, g, S, E); }
              { pg8::Gemm g{(const bf16*)(y + Y_BQ), (const bf16*)(wl + W_B), CHR, 1024, 512}; pg8::EpiGate<1> E{Z, 1024, MF, MB};
                pg8::gemm_phase<pg8::EpiGate<1>, pg8::StaticOrder, true, true>(lds, g, S, E); }
              { pg8::Gemm g{(const bf16*)(y + Y_OC), (const bf16*)(wl + W_C), CHR, 1024, 256}; pg8::EpiGate<2> E{Z, 2048, MF, MB};
                pg8::gemm_phase<pg8::EpiGate<2>, pg8::StaticOrder, true, true>(lds, g, S, E); } }
            xcd_barrier(bar);
            { pg8::Gemm g{(const bf16*)(y + Y_MBF), (const bf16*)(wl + W_OUT), CHR, 1024, 1024}; pg8::StaticOrder S; S.init(CHR, 1024, G, (int)blockIdx.x);
              pg8::EpiRes E{(l == 0) ? x_in : (const float*)xo, xo, modl + 2 * 1024, ch * CHR};
              pg8::gemm_phase<pg8::EpiRes, pg8::StaticOrder, true, true>(lds, g, S, E); }
            xcd_barrier(bar);
        }
        norm_rows(xo, H, a.in[18] + l * 1024, modl + 3 * 1024, modl + 4 * 1024, gw, NGW, lane);
        xcd_barrier(bar);
        { pg8::Gemm g{H, (const bf16*)(wl + W_GU), MT, NGU, 1024}; pg8::StaticOrder S; S.init(MT, NGU, G, (int)blockIdx.x);
          pg8::EpiSwiGLU E{(bf16*)(ws + WS_ACT)};
          pg8::gemm_phase<pg8::EpiSwiGLU, pg8::StaticOrder, true, true>(lds, g, S, E); }
        xcd_barrier(bar);
        { pg8::Gemm g{(const bf16*)(ws + WS_ACT), (const bf16*)(wl + W_D), MT, 1024, DFF}; pg8::StaticOrder S; S.init(MT, 1024, G, (int)blockIdx.x);
          pg8::EpiRes E{xo, xo, modl + 5 * 1024, 0};
          pg8::gemm_phase<pg8::EpiRes, pg8::StaticOrder, true, true>(lds, g, S, E); }
        xcd_barrier(bar);
        if (l + 1 < NL) { norm_rows(xo, H, a.in[4] + (l + 1) * 1024, modl + 8 * 6144 + 0 * 1024, modl + 8 * 6144 + 1 * 1024, gw, NGW, lane); xcd_barrier(bar); }
        else final_rows(xo, a.in[22], gw, NGW, lane);
    }
}

extern "C" void kernel_launch(void* const* d_in, const int* in_sizes, int n_in, void* d_out, int out_size, void* d_ws, size_t ws_size, hipStream_t stream) {
    static int grid = 0;
    if (grid == 0) {
        if (n_in != 23 || out_size != MT * DM || ws_size < WS_END) { fprintf(stderr, "kernel_launch: unexpected shapes (n_in %d out %d ws %zu)\n", n_in, out_size, ws_size); grid = -1; return; }
        int dev = 0, cus = 0, per_cu = 0;
        if (hipGetDevice(&dev) != hipSuccess || hipDeviceGetAttribute(&cus, hipDeviceAttributeMultiprocessorCount, dev) != hipSuccess) { grid = -1; return; }
        if (hipFuncSetAttribute((const void*)fwd, hipFuncAttributeMaxDynamicSharedMemorySize, LDS_BYTES) != hipSuccess) { fprintf(stderr, "kernel_launch: hipFuncSetAttribute failed\n"); grid = -1; return; }
        if (hipOccupancyMaxActiveBlocksPerMultiprocessor(&per_cu, (const void*)fwd, NTHREADS, LDS_BYTES) != hipSuccess || per_cu < 1) { fprintf(stderr, "kernel_launch: occupancy query says %d\n", per_cu); }
        (void)hipGetLastError();
        grid = cus;
    }
    if (grid < 0) return;
    (void)hipMemsetAsync((char*)d_ws + WS_CTL, 0, CTL_ZERO_BYTES, stream);
    Args a{};
    for (int i = 0; i < 23; ++i) a.in[i] = (const float*)d_in[i];
    a.out = (float*)d_out; a.ws = (unsigned char*)d_ws; a.pad0 = 0; a.pad1 = 0;
    hipLaunchKernelGGL(fwd, dim3(grid), dim3(NTHREADS), LDS_BYTES, stream, a);
}
```

```cpp
#include <hip/hip_runtime.h>
#include <cstdio>
#include <cstdint>
#ifndef PROBE
#define PROBE 0
#endif
namespace pg8 {
#define PG8_LAS __attribute__((address_space(3)))
typedef unsigned short bf16_t;
typedef short bf16x8 __attribute__((ext_vector_type(8)));
typedef float f32x4 __attribute__((ext_vector_type(4)));
typedef unsigned u32x4 __attribute__((ext_vector_type(4)));
constexpr int BM = 256, BK = 64, HALF = 128, HTB = HALF * BK * 2  , STAGE_BYTES = 8 * HTB, NXCD = 8, WGM = 8;

__host__ __device__ __forceinline__ int lds_byte(int r, int c) { const int st = (r >> 4) * 2 + (c >> 5), rr = r & 15, cc = c & 31, ob = rr * 64 + cc * 2; return st * 1024 + (ob ^ (((ob >> 9) & 1) << 5)); }
__host__ __device__ __forceinline__ void stage_rc(int b, int& R, int& C) { const int st = b / 1024, sb = b % 1024, swz = sb ^ (((sb >> 9) & 1) << 5); R = (st >> 1) * 16 + swz / 64; C = (st & 1) * 32 + (swz % 64) / 2; }
__host__ __device__ __forceinline__ int perm32(int rho) { const int n = rho >> 4, i = rho & 15; return 8 * (i >> 2) + 4 * n + (i & 3); }

struct Unit { int pm, pn; };
struct Gemm { const bf16_t* A; const bf16_t* Bt; int M, N, K; };

struct StaticOrder {
    int nM, nN, nwg, G, c;
    __host__ __device__ void init(int M, int N, int G_, int c_) { nM = M / BM; nN = N / BM; nwg = nM * nN; G = G_; c = c_; }
    __host__ __device__ bool next(int i, Unit& u) const {
        const long L = (long)i * G + c; if (L >= nwg) return false;
        int wgid = (int)L; { const int q = nwg / NXCD, r = nwg % NXCD, xcd = wgid % NXCD, off = wgid / NXCD; wgid = (xcd < r ? xcd * (q + 1) : r * (q + 1) + (xcd - r) * q) + off; }
        const int nig = WGM * nN, gid = wgid / nig, fm = gid * WGM, gsz = (nM - fm) < WGM ? (nM - fm) : WGM;
        u.pm = fm + ((wgid % nig) % gsz); u.pn = (wgid % nig) / gsz; return true;
    }
    __device__ __forceinline__ void a_ready(const Unit&) const {}
    __device__ __forceinline__ void done(const Unit&) const {}
};

template <class Epi, class Sched, bool ALIGN_EPI = false, bool SP2 = false>
__device__ __forceinline__ void gemm_phase(PG8_LAS unsigned char* lds, const Gemm g, const Sched& S, const Epi& E) {
    int tid_l = threadIdx.x; asm volatile("" : "+v"(tid_l));
    const int tid = tid_l, wid = __builtin_amdgcn_readfirstlane(tid >> 6), lane = tid & 63, wr = wid >> 2, wc = wid & 3, fr = lane & 15, fq = lane >> 4;
    int K_l = g.K; asm volatile("" : "+s"(K_l));
    const int K = K_l, nt = K / BK;
    unsigned voffA[2], voffB[2];
#pragma unroll
    for (int i = 0; i < 2; ++i) { int R, C; stage_rc(tid * 16 + i * 8192, R, C); const int Rb = Epi::PERM ? ((R & ~31) + perm32(R & 31)) : R;
        voffA[i] = (unsigned)(R * K + C) * 2u; voffB[i] = (unsigned)(Rb * K + C) * 2u; }
    const size_t kstep = (size_t)(BK * 2);
    const size_t hstep = (size_t)HALF * K * 2;
    const size_t tstep = 2 * hstep;
    const unsigned ldsw = (unsigned)wid * 1024u;
    const int aoff = lds_byte(wr * 64 + fr, fq * 8), boff = lds_byte(wc * 32 + fr, fq * 8);
#define PG8_SA(b, h) (((b) * 2 + (h)) * HTB)
#define PG8_SB(b, h) ((4 + (b) * 2 + (h)) * HTB)
#define PG8_STAGE(bufoff, gbase, voff) do { _Pragma("unroll") for (int _i = 0; _i < 2; ++_i) \
        __builtin_amdgcn_global_load_lds((const unsigned*)((const char*)(gbase) + (voff)[_i]), (PG8_LAS unsigned*)(lds + (bufoff) + ldsw + _i * 8192), 16, 0, 0); } while (0)
#define PG8_LDA(dst, b, h) do { _Pragma("unroll") for (int m = 0; m < 4; ++m) _Pragma("unroll") for (int k = 0; k < 2; ++k) dst[m][k] = *(const PG8_LAS bf16x8*)(lds + PG8_SA(b, h) + aoff + m * 2048 + k * 1024); } while (0)
#define PG8_LDB(dst, b, h) do { _Pragma("unroll") for (int n = 0; n < 2; ++n) _Pragma("unroll") for (int k = 0; k < 2; ++k) dst[n][k] = *(const PG8_LAS bf16x8*)(lds + PG8_SB(b, h) + boff + n * 2048 + k * 1024); } while (0)
#define PG8_MMA(ai, bj, At, Bt) do { __builtin_amdgcn_s_setprio(1); _Pragma("unroll") for (int m = 0; m < 4; ++m) _Pragma("unroll") for (int n = 0; n < 2; ++n) _Pragma("unroll") for (int k = 0; k < 2; ++k) \
        acc[ai][bj][m][n] = __builtin_amdgcn_mfma_f32_16x16x32_bf16(Bt[n][k], At[m][k], acc[ai][bj][m][n], 0, 0, 0); __builtin_amdgcn_s_setprio(0); } while (0)
#define PG8_WAIT_V(n) asm volatile("s_waitcnt vmcnt(" #n ")" ::: "memory")
#define PG8_WAIT_L(n) asm volatile("s_waitcnt lgkmcnt(" #n ")" ::: "memory")
#define PG8_BAR __builtin_amdgcn_s_barrier()
#define PG8_SCHED __builtin_amdgcn_sched_barrier(0)
    Unit cur, nxt; int ui = 0;
    if (!S.next(0, cur)) return;
    f32x4 acc[2][2][4][2];
#pragma unroll
    for (int a = 0; a < 2; ++a)
#pragma unroll
        for (int b = 0; b < 2; ++b)
#pragma unroll
            for (int m = 0; m < 4; ++m)
#pragma unroll
                for (int n = 0; n < 2; ++n) acc[a][b][m][n] = (f32x4){0.f, 0.f, 0.f, 0.f};
    bf16x8 At[4][2], B0[2][2], B1[2][2];
    const char* cA = (const char*)g.A + (size_t)cur.pm * tstep; const char* cB = (const char*)g.Bt + (size_t)cur.pn * tstep;
    S.a_ready(cur);
    if constexpr (SP2) {
        PG8_STAGE(PG8_SB(0, 0), cB, voffB); PG8_STAGE(PG8_SB(0, 1), cB + hstep, voffB); PG8_STAGE(PG8_SA(0, 0), cA, voffA); PG8_STAGE(PG8_SA(0, 1), cA + hstep, voffA);
        if (wr == 1) PG8_BAR;
        PG8_WAIT_V(2); PG8_BAR;
        PG8_STAGE(PG8_SB(1, 0), cB + kstep, voffB); PG8_STAGE(PG8_SA(1, 0), cA + kstep, voffA); PG8_STAGE(PG8_SB(1, 1), cB + hstep + kstep, voffB);
        PG8_WAIT_V(6); PG8_BAR;
    } else {
        PG8_STAGE(PG8_SB(0, 0), cB, voffB); PG8_STAGE(PG8_SA(0, 0), cA, voffA); PG8_STAGE(PG8_SB(0, 1), cB + hstep, voffB); PG8_STAGE(PG8_SA(0, 1), cA + hstep, voffA);
        if (wr == 1) PG8_BAR;
        PG8_WAIT_V(4); PG8_BAR;
        PG8_STAGE(PG8_SB(1, 0), cB + kstep, voffB); PG8_STAGE(PG8_SA(1, 0), cA + kstep, voffA); PG8_STAGE(PG8_SB(1, 1), cB + hstep + kstep, voffB);
        PG8_WAIT_V(6); PG8_BAR;
    }
    for (;;) {
        const bool has_next = S.next(ui + 1, nxt);
        const char* nA = has_next ? (const char*)g.A + (size_t)nxt.pm * tstep : cA; const char* nB = has_next ? (const char*)g.Bt + (size_t)nxt.pn * tstep : cB;
        for (int t = 0; t < nt; t += 2) {
            const bool last = (t == nt - 2);
            const char* a1 = cA + (size_t)(t + 1) * kstep;
            const char* a2 = last ? nA : cA + (size_t)(t + 2) * kstep; const char* b2 = last ? nB : cB + (size_t)(t + 2) * kstep;
            const char* a3 = a2 + kstep; const char* b3 = b2 + kstep;
            if (last && has_next) S.a_ready(nxt);
            if constexpr (SP2) {
            PG8_LDB(B0, 0, 0); PG8_LDB(B1, 0, 1); PG8_SCHED; PG8_LDA(At, 0, 0); PG8_STAGE(PG8_SA(1, 1), a1 + hstep, voffA);
            PG8_WAIT_V(8); PG8_WAIT_L(0); PG8_BAR; PG8_MMA(0, 0, At, B0); PG8_MMA(0, 1, At, B1); PG8_BAR; PG8_SCHED;
            PG8_LDA(At, 0, 1); PG8_STAGE(PG8_SB(0, 0), b2, voffB); PG8_STAGE(PG8_SB(0, 1), b2 + hstep, voffB); PG8_STAGE(PG8_SA(0, 0), a2, voffA);
            PG8_WAIT_V(8); PG8_WAIT_L(0); PG8_BAR; PG8_MMA(1, 0, At, B0); PG8_MMA(1, 1, At, B1); PG8_BAR; PG8_SCHED;
            PG8_LDB(B0, 1, 0); PG8_LDB(B1, 1, 1); PG8_SCHED; PG8_LDA(At, 1, 0); PG8_STAGE(PG8_SA(0, 1), a2 + hstep, voffA);
            PG8_WAIT_V(8); PG8_WAIT_L(0); PG8_BAR; PG8_MMA(0, 0, At, B0); PG8_MMA(0, 1, At, B1); PG8_BAR; PG8_SCHED;
            PG8_LDA(At, 1, 1); PG8_STAGE(PG8_SB(1, 0), b3, voffB); PG8_STAGE(PG8_SB(1, 1), b3 + hstep, voffB); PG8_STAGE(PG8_SA(1, 0), a3, voffA);
            PG8_WAIT_V(8); PG8_WAIT_L(0); PG8_BAR; PG8_MMA(1, 0, At, B0); PG8_MMA(1, 1, At, B1); PG8_BAR; PG8_SCHED;
            } else {
            PG8_LDB(B0, 0, 0); PG8_SCHED; PG8_LDA(At, 0, 0); PG8_STAGE(PG8_SA(1, 1), a1 + hstep, voffA);
            PG8_WAIT_L(8); PG8_BAR; PG8_WAIT_L(0); PG8_MMA(0, 0, At, B0); PG8_BAR; PG8_SCHED;
            PG8_LDB(B1, 0, 1); PG8_STAGE(PG8_SB(0, 0), b2, voffB);
            PG8_BAR; PG8_WAIT_L(0); PG8_MMA(0, 1, At, B1); PG8_BAR;
            PG8_LDA(At, 0, 1); PG8_STAGE(PG8_SA(0, 0), a2, voffA);
            PG8_BAR; PG8_WAIT_L(0); PG8_MMA(1, 0, At, B0); PG8_BAR; PG8_SCHED;
            PG8_STAGE(PG8_SB(0, 1), b2 + hstep, voffB);
            PG8_WAIT_V(6); PG8_BAR; PG8_MMA(1, 1, At, B1); PG8_BAR;
            PG8_LDB(B0, 1, 0); PG8_SCHED; PG8_LDA(At, 1, 0); PG8_STAGE(PG8_SA(0, 1), a2 + hstep, voffA);
            PG8_WAIT_L(8); PG8_BAR; PG8_WAIT_L(0); PG8_MMA(0, 0, At, B0); PG8_BAR; PG8_SCHED;
            PG8_LDB(B1, 1, 1); PG8_STAGE(PG8_SB(1, 0), b3, voffB);
            PG8_BAR; PG8_WAIT_L(0); PG8_MMA(0, 1, At, B1); PG8_BAR;
            PG8_LDA(At, 1, 1); PG8_STAGE(PG8_SA(1, 0), a3, voffA);
            PG8_BAR; PG8_WAIT_L(0); PG8_MMA(1, 0, At, B0); PG8_BAR; PG8_SCHED;
            PG8_STAGE(PG8_SB(1, 1), b3 + hstep, voffB);
            PG8_WAIT_V(6); PG8_BAR; PG8_MMA(1, 1, At, B1); PG8_BAR;
            }
        }
        if constexpr (ALIGN_EPI) { if (wr == 0) PG8_BAR; }
        if constexpr (!Epi::AFTER_DRAIN) { E(acc, cur, wr, wc, fr, fq); S.done(cur); }
        if (!has_next) break;
#pragma unroll
        for (int a = 0; a < 2; ++a)
#pragma unroll
            for (int b = 0; b < 2; ++b)
#pragma unroll
                for (int m = 0; m < 4; ++m)
#pragma unroll
                    for (int n = 0; n < 2; ++n) acc[a][b][m][n] = (f32x4){0.f, 0.f, 0.f, 0.f};
        cur = nxt; cA = nA; cB = nB; ++ui;
        if constexpr (ALIGN_EPI) { if (wr == 1) PG8_BAR; }
    }
    PG8_WAIT_V(0);
    if constexpr (!ALIGN_EPI) { if (wr == 0) PG8_BAR; }
    PG8_BAR;
    if constexpr (Epi::AFTER_DRAIN) { E.fused(acc, cur, wr, wc, fr, fq, lds, wid, lane); S.done(cur); }
#undef PG8_SA
#undef PG8_SB
#undef PG8_STAGE
#undef PG8_LDA
#undef PG8_LDB
#undef PG8_MMA
#undef PG8_WAIT_V
#undef PG8_WAIT_L
#undef PG8_BAR
#undef PG8_SCHED
}
}

constexpr int NB = 8, SEQ = 4096, DM = 1024, MT = NB * SEQ, NL = 2;
constexpr int CHB = 4, CHR = CHB * SEQ, NCH = NB / CHB;
constexpr int NIN = 8704, DFF = 2816, NGU = 2 * DFF, WIN_SRC = 8136;
constexpr int TOPK = 256;
constexpr float EPS = 1e-6f;
constexpr int NWAVES = 8, NTHREADS = 512;

constexpr size_t MiB = 1u << 20;
constexpr size_t WS_CTL = 0, CTL_ZERO_BYTES = 1 * MiB;
constexpr size_t WS_MOD = 1 * MiB;
constexpr size_t WS_TAB = WS_MOD + 393216;
constexpr size_t WS_LAM = WS_TAB + 393216;
constexpr size_t WS_W = 2 * MiB, W_LAYER = 39 * MiB;
constexpr size_t W_IN = 0, W_A = 17 * MiB, W_B = 19 * MiB, W_C = 20 * MiB, W_OUT = 20 * MiB + 512 * 1024, W_GU = 22 * MiB + 512 * 1024, W_D = 33 * MiB + 512 * 1024;
constexpr size_t WS_H = 80 * MiB;
constexpr size_t WS_Y = 144 * MiB;
constexpr size_t Y_QLAT = 0, Y_MISC = 32 * MiB, Y_IQ = 40 * MiB, Y_BQ = 56 * MiB, Y_BK = 72 * MiB, Y_BV = 88 * MiB, Y_CQ = 104 * MiB, Y_CK = 128 * MiB, Y_CV = 152 * MiB, Y_Z = 176 * MiB, Y_OC = 272 * MiB;
constexpr size_t Y_MF32 = Y_CQ, Y_MBF = Y_BK;
constexpr size_t WS_ACT = WS_Y;
constexpr size_t WS_KVN = 424 * MiB;
constexpr size_t WS_END = 428 * MiB;
constexpr int CW_BAR = 4096;

#define GAS __attribute__((address_space(1)))
#define LAS __attribute__((address_space(3)))
typedef unsigned short bf16;
typedef unsigned v4u __attribute__((ext_vector_type(4)));
typedef unsigned v2u __attribute__((ext_vector_type(2)));
typedef float f32x4 __attribute__((ext_vector_type(4)));

__device__ __forceinline__ unsigned f2bf(float f) { unsigned u = __builtin_bit_cast(unsigned, f); return (u + 0x7fffu + ((u >> 16) & 1u)) >> 16; }
__device__ __forceinline__ unsigned pk2(float lo, float hi) { return f2bf(lo) | (f2bf(hi) << 16); }
__device__ __forceinline__ float bflo(unsigned w) { return __uint_as_float(w << 16); }
__device__ __forceinline__ float bfhi(unsigned w) { return __uint_as_float(w & 0xffff0000u); }
__device__ __forceinline__ float bf2f(bf16 h) { return __uint_as_float((unsigned)h << 16); }
__device__ __forceinline__ float wave_sum(float v) {
#pragma unroll
    for (int o = 1; o < 64; o <<= 1) v += __shfl_xor(v, o);
    return v;
}
__device__ __forceinline__ float wave_max(float v) {
#pragma unroll
    for (int o = 1; o < 64; o <<= 1) v = fmaxf(v, __shfl_xor(v, o));
    return v;
}
__device__ __forceinline__ float sigmoidf_(float v) { return 1.f / (1.f + __expf(-v)); }

namespace pg8 {
struct EpiIn {
    static constexpr bool PERM = true, AFTER_DRAIN = false;
    unsigned char* y;
    __device__ __forceinline__ void operator()(const f32x4 (&acc)[2][2][4][2], const Unit& u, int wr, int wc, int fr, int fq) const {
        const int pn = u.pn; size_t off; int ld, c0; bool sig = false;
        if (pn < 4)        { off = Y_QLAT; ld = 1024; c0 = pn * 256; }
        else if (pn == 4)  { off = Y_MISC; ld = 256;  c0 = 0; }
        else if (pn < 7)   { off = Y_IQ;   ld = 512;  c0 = (pn - 5) * 256; }
        else if (pn < 9)   { off = Y_BQ;   ld = 512;  c0 = (pn - 7) * 256; }
        else if (pn < 11)  { off = Y_BK;   ld = 512;  c0 = (pn - 9) * 256; }
        else if (pn < 13)  { off = Y_BV;   ld = 512;  c0 = (pn - 11) * 256; }
        else if (pn < 16)  { off = Y_CQ;   ld = 768;  c0 = (pn - 13) * 256; }
        else if (pn < 19)  { off = Y_CK;   ld = 768;  c0 = (pn - 16) * 256; }
        else if (pn < 22)  { off = Y_CV;   ld = 768;  c0 = (pn - 19) * 256; }
        else               { off = Y_Z;    ld = 3072; c0 = (pn - 22) * 256; sig = true; }
        bf16_t* base = (bf16_t*)(y + off);
        const int row0 = u.pm * BM + wr * 64 + fr, col0 = c0 + wc * 32 + 8 * fq;
#pragma unroll
        for (int ai = 0; ai < 2; ++ai)
#pragma unroll
            for (int m = 0; m < 4; ++m) { bf16_t* rowp = base + (size_t)(row0 + ai * HALF + m * 16) * ld + col0;
#pragma unroll
                for (int bj = 0; bj < 2; ++bj) { f32x4 v0 = acc[ai][bj][m][0], v1 = acc[ai][bj][m][1];
                    if (sig) {
#pragma unroll
                        for (int i = 0; i < 4; ++i) { v0[i] = sigmoidf_(v0[i]); v1[i] = sigmoidf_(v1[i]); } }
                    u32x4 w; w.x = pk2(v0[0], v0[1]); w.y = pk2(v0[2], v0[3]); w.z = pk2(v1[0], v1[1]); w.w = pk2(v1[2], v1[3]);
                    *(u32x4*)(rowp + bj * HALF) = w; } }
    }
};
template <int MODE> struct EpiGate {
    static constexpr bool PERM = true, AFTER_DRAIN = false;
    const bf16_t* z; int zc0; float* mf; bf16_t* mb;
    __device__ __forceinline__ void operator()(const f32x4 (&acc)[2][2][4][2], const Unit& u, int wr, int wc, int fr, int fq) const {
        const int row0 = u.pm * BM + wr * 64 + fr, col0 = u.pn * BM + wc * 32 + 8 * fq;
#pragma unroll
        for (int ai = 0; ai < 2; ++ai)
#pragma unroll
            for (int m = 0; m < 4; ++m) { const size_t row = (size_t)(row0 + ai * HALF + m * 16);
#pragma unroll
                for (int bj = 0; bj < 2; ++bj) { const int col = col0 + bj * HALF;
                    const u32x4 zw = *(const u32x4*)(z + row * 3072 + zc0 + col);
                    f32x4 v0 = acc[ai][bj][m][0], v1 = acc[ai][bj][m][1];
                    v0[0] *= __uint_as_float(zw.x << 16); v0[1] *= __uint_as_float(zw.x & 0xffff0000u); v0[2] *= __uint_as_float(zw.y << 16); v0[3] *= __uint_as_float(zw.y & 0xffff0000u);
                    v1[0] *= __uint_as_float(zw.z << 16); v1[1] *= __uint_as_float(zw.z & 0xffff0000u); v1[2] *= __uint_as_float(zw.w << 16); v1[3] *= __uint_as_float(zw.w & 0xffff0000u);
                    bf16_t* mp = mb + row * 1024 + col;
                    if (MODE >= 1) { const u32x4 pw = *(const u32x4*)mp;
                        v0[0] += __uint_as_float(pw.x << 16); v0[1] += __uint_as_float(pw.x & 0xffff0000u); v0[2] += __uint_as_float(pw.y << 16); v0[3] += __uint_as_float(pw.y & 0xffff0000u);
                        v1[0] += __uint_as_float(pw.z << 16); v1[1] += __uint_as_float(pw.z & 0xffff0000u); v1[2] += __uint_as_float(pw.w << 16); v1[3] += __uint_as_float(pw.w & 0xffff0000u); }
                    { u32x4 w; w.x = pk2(v0[0], v0[1]); w.y = pk2(v0[2], v0[3]); w.z = pk2(v1[0], v1[1]); w.w = pk2(v1[2], v1[3]); *(u32x4*)mp = w; } }
                asm volatile("" ::: "memory"); }
    }
};
struct EpiRes {
    static constexpr bool PERM = true, AFTER_DRAIN = false;
    const float* xin; float* xout; const float* gate; int row_off;
    __device__ __forceinline__ void operator()(const f32x4 (&acc)[2][2][4][2], const Unit& u, int wr, int wc, int fr, int fq) const {
        const int row0 = row_off + u.pm * BM + wr * 64 + fr, col0 = u.pn * BM + wc * 32 + 8 * fq;
        const float* gp = gate + (size_t)((row_off + u.pm * BM) / SEQ) * 6144 + col0;
        f32x4 g[2][2];
#pragma unroll
        for (int bj = 0; bj < 2; ++bj) { g[bj][0] = *(const f32x4*)(gp + bj * HALF); g[bj][1] = *(const f32x4*)(gp + bj * HALF + 4); }
#pragma unroll
        for (int ai = 0; ai < 2; ++ai)
#pragma unroll
            for (int m = 0; m < 4; ++m) { const size_t o = (size_t)(row0 + ai * HALF + m * 16) * 1024 + col0;
#pragma unroll
                for (int bj = 0; bj < 2; ++bj) {
                    const f32x4 a0 = *(const f32x4*)(xin + o + bj * HALF), a1 = *(const f32x4*)(xin + o + bj * HALF + 4);
                    *(f32x4*)(xout + o + bj * HALF) = a0 + g[bj][0] * acc[ai][bj][m][0];
                    *(f32x4*)(xout + o + bj * HALF + 4) = a1 + g[bj][1] * acc[ai][bj][m][1]; }
                asm volatile("" ::: "memory"); }
    }
};
struct EpiSwiGLU {
    static constexpr bool PERM = true, AFTER_DRAIN = false;
    bf16_t* act;
    __device__ __forceinline__ void operator()(const f32x4 (&acc)[2][2][4][2], const Unit& u, int wr, int wc, int fr, int fq) const {
        const int row0 = u.pm * BM + wr * 64 + fr, col0 = u.pn * HALF + wc * 32 + 8 * fq;
#pragma unroll
        for (int ai = 0; ai < 2; ++ai)
#pragma unroll
            for (int m = 0; m < 4; ++m) { bf16_t* rowp = act + (size_t)(row0 + ai * HALF + m * 16) * DFF + col0;
                f32x4 v0, v1;
#pragma unroll
                for (int i = 0; i < 4; ++i) { const float g0 = acc[ai][0][m][0][i], g1 = acc[ai][0][m][1][i];
                    v0[i] = g0 * sigmoidf_(g0) * acc[ai][1][m][0][i]; v1[i] = g1 * sigmoidf_(g1) * acc[ai][1][m][1][i]; }
                u32x4 w; w.x = pk2(v0[0], v0[1]); w.y = pk2(v0[2], v0[3]); w.z = pk2(v1[0], v1[1]); w.w = pk2(v1[2], v1[3]);
                *(u32x4*)rowp = w; }
    }
};
}

#define XB_TMO      128
#define XB_XCNT(j)  (256  + 64 * (j))
#define XB_XSUB(j)  (1280 + 64 * (j))
#define XB_XGEN(j)  (2304 + 64 * (j))
#define XB_TOP      3328
#define XB_TOPGEN   3392
#define XCD_BAR_WORDS 3456
#define XB_SPIN_CAP (1u << 24)

__device__ __forceinline__ unsigned xb_ld(unsigned* p)              { return __hip_atomic_load(p, __ATOMIC_RELAXED, __HIP_MEMORY_SCOPE_AGENT); }
__device__ __forceinline__ unsigned xb_add(unsigned* p, unsigned v) { return __hip_atomic_fetch_add(p, v, __ATOMIC_RELAXED, __HIP_MEMORY_SCOPE_AGENT); }
__device__ __forceinline__ unsigned xb_xcc_id() { return (unsigned)__builtin_amdgcn_s_getreg((3 << 11) | 20) & 0xFu; }
#define XB_SPIN(cond, bar) do { unsigned _sp = 0; while (cond) { __builtin_amdgcn_s_sleep(1); \
    if ((++_sp & 255u) == 0u) { if (xb_ld(&(bar)[XB_TMO])) break; if (_sp > XB_SPIN_CAP) { atomicAdd(&(bar)[XB_TMO], 1u); break; } } } } while (0)

struct XcdBarrier { unsigned* bar; unsigned x; volatile LAS unsigned* st; };

__device__ __forceinline__ XcdBarrier xcd_barrier_post(unsigned* bar, volatile LAS unsigned* st) {
    XcdBarrier b; b.bar = bar; b.x = (unsigned)__builtin_amdgcn_readfirstlane((int)xb_xcc_id()); b.st = st;
    if (threadIdx.x == 0) (void)xb_add(&bar[XB_XCNT(b.x)], 1u);
    return b;
}
__device__ __forceinline__ void xcd_barrier_complete(unsigned* bar, unsigned x, unsigned& nloc, unsigned& nx) {
    const unsigned G = gridDim.x * gridDim.y * gridDim.z;
    unsigned sum, cnt, mine, sp = 0u;
    for (;;) {
        sum = 0u; cnt = 0u; mine = 0u;
#pragma unroll
        for (unsigned j = 0; j < 16; ++j) { const unsigned c = xb_ld(&bar[XB_XCNT(j)]); sum += c; cnt += (c > 0u) ? 1u : 0u; mine = (j == x) ? c : mine; }
        if (sum == G) break;
        __builtin_amdgcn_s_sleep(1);
        if ((++sp & 255u) == 0u) { if (xb_ld(&bar[XB_TMO])) break; if (sp > XB_SPIN_CAP) { atomicAdd(&bar[XB_TMO], 1u); break; } }
    }
    nloc = mine > 0u ? mine : 1u; nx = cnt > 0u ? cnt : 1u;
}
__device__ __forceinline__ void xcd_barrier(const XcdBarrier& b) {
    asm volatile("s_waitcnt vmcnt(0)" ::: "memory");
    __syncthreads();
    if (threadIdx.x == 0) {
        unsigned* bar = b.bar; unsigned bx = b.x; asm volatile("" : "+s"(bar), "+s"(bx));
        __builtin_amdgcn_s_waitcnt(0);
        unsigned nloc = b.st[0], nx = b.st[1];
        if (nloc == 0u) { xcd_barrier_complete(bar, bx, nloc, nx); b.st[0] = nloc; b.st[1] = nx; }
        const unsigned old = xb_add(&bar[XB_XSUB(bx)], 1u);
        const unsigned gen = old / nloc;
        if (old + 1u == (gen + 1u) * nloc) {
            __builtin_amdgcn_fence(__ATOMIC_RELEASE, "agent");
            asm volatile("s_waitcnt vmcnt(0)" ::: "memory");
            const unsigned og = xb_add(&bar[XB_TOP], 1u);
            const unsigned tg = og / nx;
            if (og + 1u == (tg + 1u) * nx) xb_add(&bar[XB_TOPGEN], 1u);
            else XB_SPIN(xb_ld(&bar[XB_TOPGEN]) == tg, bar);
            __builtin_amdgcn_fence(__ATOMIC_ACQUIRE, "agent");
            xb_add(&bar[XB_XGEN(bx)], 1u);
            asm volatile("s_waitcnt vmcnt(0)" ::: "memory");
        } else {
            XB_SPIN(xb_ld(&bar[XB_XGEN(bx)]) == gen, bar);
            __builtin_amdgcn_fence(__ATOMIC_ACQUIRE, "agent");
            asm volatile("s_waitcnt vmcnt(0)" ::: "memory");
        }
    }
    __syncthreads();
}

constexpr int RING_BYTES = 131072;
constexpr int LDSCTL_OFF = 155648;
constexpr int LDS_BYTES = 156672;

struct Args {
    const float* in[23]; float* out; unsigned char* ws; int pad0, pad1;
};
__device__ __forceinline__ const void* ld_karg(unsigned off) {
    asm volatile("" : "+s"(off));
    return *(const void* const __attribute__((address_space(4)))*)((const __attribute__((address_space(4))) char*)__builtin_amdgcn_kernarg_segment_ptr() + off);
}
#define ARG(k) ((const float*)ld_karg(8u * (k)))
#define OUTP() ((float*)ld_karg(184u))
#define WSP() ((unsigned char*)ld_karg(192u))

__device__ __forceinline__ int rel_bucket(int d) {
    if (d < 16) return d;
    int b = 16;
    b += (d >= 22); b += (d >= 30); b += (d >= 40); b += (d >= 54); b += (d >= 73); b += (d >= 99); b += (d >= 134); b += (d >= 182);
    b += (d >= 246); b += (d >= 332); b += (d >= 450); b += (d >= 609); b += (d >= 825); b += (d >= 1117); b += (d >= 1513);
    return b;
}
__device__ __forceinline__ int win_src_col(int n) {
    if (n < 1152) return 512 + (n - 1024);
    if (n < 1224) return n;
    if (n < 1280) return -1;
    if (n < 1792) return 640 + (n - 1280);
    return n - 568;
}
__device__ __forceinline__ void transpose_item(const float* W, int ldw, int K, bf16* WT, int kind, int kb, int nb, LAS float* scr, int lane) {
    const int k0 = 64 * kb, n0 = 32 * nb, nl = n0 + (lane & 31);
    int sc;
    if (kind == 0) sc = win_src_col(nl + 1024);
    else if (kind == 2) { const int j = nl >> 8, r = nl & 255; sc = (r < 128) ? (j * 128 + r) : (DFF + j * 128 + r - 128); }
    else sc = nl;
#pragma unroll 8
    for (int i = 0; i < 32; ++i) { const int kk = 2 * i + (lane >> 5); scr[kk * 33 + (lane & 31)] = (sc >= 0) ? W[(size_t)(k0 + kk) * ldw + sc] : 0.f; }
    asm volatile("s_waitcnt lgkmcnt(0)" ::: "memory");
    const int c = lane & 7;
    const int nrow0 = (kind == 0) ? 1024 : 0;
#pragma unroll
    for (int j = 0; j < 4; ++j) { const int n = (lane >> 3) + 8 * j; const LAS float* s = scr + (8 * c) * 33 + n;
        v4u o; o.x = pk2(s[0 * 33], s[1 * 33]); o.y = pk2(s[2 * 33], s[3 * 33]); o.z = pk2(s[4 * 33], s[5 * 33]); o.w = pk2(s[6 * 33], s[7 * 33]);
        *(v4u*)(WT + (size_t)(nrow0 + n0 + n) * K + k0 + 8 * c) = o; }
    asm volatile("s_waitcnt lgkmcnt(0)" ::: "memory");
}

__device__ __forceinline__ void p0a_prologue(unsigned char* ws, LAS unsigned char* lds, int tid, int lane, int wave, int G) {
    asm volatile("" : "+v"(lane), "+v"(tid));
    const float* c = ARG(1); const float* w_ada = ARG(2); const float* b_ada = ARG(3);
    float* mod = (float*)(ws + WS_MOD);
    if (blockIdx.x < 192) {
        LAS float* cs = (LAS float*)lds;
        LAS float* red = (LAS float*)(lds + 32768);
        for (int i = tid; i < 8192; i += NTHREADS) { const float v = c[i]; cs[i] = v / (1.f + __expf(-v)); }
        __syncthreads();
        for (int it = blockIdx.x; it < 192; it += G) {
            const int l = it / 96, cg = it % 96, n = cg * 64 + lane;
            float acc[8];
#pragma unroll
            for (int b = 0; b < 8; ++b) acc[b] = 0.f;
            const float* wp = w_ada + ((size_t)l * 1024 + wave * 128) * 6144 + n;
#pragma unroll 8
            for (int k = 0; k < 128; ++k) { const float wv = wp[(size_t)k * 6144];
#pragma unroll
                for (int b = 0; b < 8; ++b) acc[b] += cs[b * 1024 + wave * 128 + k] * wv; }
#pragma unroll
            for (int b = 0; b < 8; ++b) red[(wave * 8 + b) * 64 + lane] = acc[b];
            __syncthreads();
            { const int b = tid >> 6; float s = 0.f;
#pragma unroll
              for (int w = 0; w < 8; ++w) s += red[(w * 8 + b) * 64 + lane];
              mod[((size_t)l * 8 + b) * 6144 + n] = s + b_ada[l * 6144 + n]; }
            __syncthreads();
        }
    }
    { const float* rb = ARG(21); float* T = (float*)(ws + WS_TAB);
      for (int d = blockIdx.x * NTHREADS + tid; d < 4096; d += G * NTHREADS) { const int bk = rel_bucket(d);
          for (int j = 0; j < 24; ++j) T[d * 24 + j] = rb[bk * 24 + j]; } }
    if (blockIdx.x == G - 1 && wave == 0) {
        float* lam = (float*)(ws + WS_LAM);
        for (int l = 0; l < NL; ++l) {
            const float s1 = wave_sum(ARG(9)[l * 64 + lane] * ARG(10)[l * 64 + lane]);
            const float s2 = wave_sum(ARG(11)[l * 64 + lane] * ARG(12)[l * 64 + lane]);
            const float lam_init = (l == 0) ? 0.2f : 0.35550907f;
            if (lane == 0) lam[l] = expf(s1) - expf(s2) + lam_init;
        }
    }
    {
        LAS float* scr = (LAS float*)(lds + 65536 + wave * 8448);
        const int gw = blockIdx.x * NWAVES + wave, NGW = G * NWAVES;
        constexpr int I_WIN = 16 * 240, I_B = 8 * 32, I_C = 4 * 32, I_OUT = 16 * 32, I_GU = 16 * 176, I_D = 44 * 32, I_FQ = 2048, I_FA = 2048;
        constexpr int I_LAYER = I_WIN + I_B + I_C + I_OUT + I_GU + I_D + I_FQ + I_FA;
        for (int it = gw; it < NL * I_LAYER; it += NGW) {
            const int l = it / I_LAYER; int r = it % I_LAYER;
            unsigned char* wl = ws + WS_W + (size_t)l * W_LAYER;
            const float* w_in = ARG(5) + (size_t)l * 1024 * WIN_SRC;
            if (r < I_WIN) { transpose_item(w_in, WIN_SRC, 1024, (bf16*)(wl + W_IN), 0, r / 240, r % 240, scr, lane); continue; } r -= I_WIN;
            if (r < I_B)   { transpose_item(ARG(15) + (size_t)l * 512 * 1024, 1024, 512, (bf16*)(wl + W_B), 1, r / 32, r % 32, scr, lane); continue; } r -= I_B;
            if (r < I_C)   { transpose_item(ARG(16) + (size_t)l * 256 * 1024, 1024, 256, (bf16*)(wl + W_C), 1, r / 32, r % 32, scr, lane); continue; } r -= I_C;
            if (r < I_OUT) { transpose_item(ARG(17) + (size_t)l * 1024 * 1024, 1024, 1024, (bf16*)(wl + W_OUT), 1, r / 32, r % 32, scr, lane); continue; } r -= I_OUT;
            if (r < I_GU)  { transpose_item(ARG(19) + (size_t)l * 1024 * NGU, NGU, 1024, (bf16*)(wl + W_GU), 2, r / 176, r % 176, scr, lane); continue; } r -= I_GU;
            if (r < I_D)   { transpose_item(ARG(20) + (size_t)l * DFF * 1024, 1024, DFF, (bf16*)(wl + W_D), 1, r / 32, r % 32, scr, lane); continue; } r -= I_D;
            if (r < I_FQ) {
                const int h = r >> 8, rem = r & 255, cc = (rem >> 7) * 64 + lane, k0 = (rem & 127) * 8;
                const float* uk = ARG(6) + ((size_t)(l * 8 + h) * 64) * 128 + cc;
                const float* wi = w_in + (size_t)k0 * WIN_SRC + h * 64;
                float acc[8];
#pragma unroll
                for (int j = 0; j < 8; ++j) acc[j] = 0.f;
#pragma unroll 8
                for (int d = 0; d < 64; ++d) { const float u = uk[d * 128];
#pragma unroll
                    for (int j = 0; j < 8; ++j) acc[j] += wi[(size_t)j * WIN_SRC + d] * u; }
                v4u o; o.x = pk2(acc[0], acc[1]); o.y = pk2(acc[2], acc[3]); o.z = pk2(acc[4], acc[5]); o.w = pk2(acc[6], acc[7]);
                *(v4u*)((bf16*)(wl + W_IN) + (size_t)(h * 128 + cc) * 1024 + k0) = o;
                continue; }
            r -= I_FQ;
            {
                const int ng = r >> 7, kg = r & 127, h = kg >> 4, c0 = (kg & 15) * 8, n = ng * 64 + lane;
                const float* uv = ARG(7) + ((size_t)(l * 8 + h) * 128 + c0) * 64;
                const float* wa = ARG(14) + ((size_t)l * 512 + h * 64) * 1024 + n;
                float acc[8];
#pragma unroll
                for (int j = 0; j < 8; ++j) acc[j] = 0.f;
#pragma unroll 8
                for (int e = 0; e < 64; ++e) { const float wv = wa[(size_t)e * 1024];
#pragma unroll
                    for (int j = 0; j < 8; ++j) acc[j] += uv[j * 64 + e] * wv; }
                v4u o; o.x = pk2(acc[0], acc[1]); o.y = pk2(acc[2], acc[3]); o.z = pk2(acc[4], acc[5]); o.w = pk2(acc[6], acc[7]);
                *(v4u*)((bf16*)(wl + W_A) + (size_t)n * 1024 + kg * 8) = o;
            }
        }
    }
}

__device__ __forceinline__ void norm_rows(const float* x, bf16* out, const float* g, const float* sh, const float* sc, int gw, int NGW, int lane) {
    asm volatile("" : "+v"(lane));
    for (int row = gw; row < MT; row += NGW) {
        const int b = row / SEQ;
        const f32x4* xr = (const f32x4*)(x + (size_t)row * 1024) + lane;
        f32x4 v[4]; float s = 0.f;
#pragma unroll
        for (int j = 0; j < 4; ++j) { v[j] = xr[64 * j]; s += (v[j].x * v[j].x + v[j].y * v[j].y) + (v[j].z * v[j].z + v[j].w * v[j].w); }
        const float rstd = 1.0f / sqrtf(wave_sum(s) * (1.f / 1024.f) + EPS);
        v2u* o8 = (v2u*)(out + (size_t)row * 1024) + lane;
#pragma unroll
        for (int j = 0; j < 4; ++j) { const int col = 256 * j + 4 * lane;
            const f32x4 gg = *(const f32x4*)(g + col), s1 = *(const f32x4*)(sc + (size_t)b * 6144 + col), s0 = *(const f32x4*)(sh + (size_t)b * 6144 + col);
            const f32x4 y = v[j] * rstd * gg * (s1 + 1.0f) + s0;
            v2u w; w.x = pk2(y.x, y.y); w.y = pk2(y.z, y.w); o8[64 * j] = w; }
    }
}
__device__ __forceinline__ void final_rows(float* x, const float* g, int gw, int NGW, int lane) {
    asm volatile("" : "+v"(lane));
    for (int row = gw; row < MT; row += NGW) {
        f32x4* xr = (f32x4*)(x + (size_t)row * 1024) + lane;
        f32x4 v[4]; float s = 0.f;
#pragma unroll
        for (int j = 0; j < 4; ++j) { v[j] = xr[64 * j]; s += (v[j].x * v[j].x + v[j].y * v[j].y) + (v[j].z * v[j].z + v[j].w * v[j].w); }
        const float rstd = 1.0f / sqrtf(wave_sum(s) * (1.f / 1024.f) + EPS);
#pragma unroll
        for (int j = 0; j < 4; ++j) { const f32x4 gg = *(const f32x4*)(g + 256 * j + 4 * lane); xr[64 * j] = v[j] * rstd * gg; }
    }
}

__device__ __forceinline__ float dot8(const LAS float* q, v4u w) {
    return q[0] * bflo(w.x) + q[1] * bfhi(w.x) + q[2] * bflo(w.y) + q[3] * bfhi(w.y) + q[4] * bflo(w.z) + q[5] * bfhi(w.z) + q[6] * bflo(w.w) + q[7] * bfhi(w.w);
}
__device__ __forceinline__ void kvn_rows(unsigned char* y, bf16* kvn, const float* gkv, unsigned* kmaxw, int gw, int NGW, int lane) {
    asm volatile("" : "+v"(lane));
    const bf16* misc = (const bf16*)(y + Y_MISC);
    float km0 = 0.f, km1 = 0.f, km2 = 0.f, km3 = 0.f;
    for (int r = gw; r < CHR; r += NGW) {
        const unsigned w = *(const unsigned*)(misc + (size_t)r * 256 + 2 * lane);
        const float a0 = bflo(w), a1 = bfhi(w);
        const float rstd = 1.0f / sqrtf(wave_sum(a0 * a0 + a1 * a1) * (1.f / 128.f) + EPS);
        *(unsigned*)(kvn + (size_t)r * 128 + 2 * lane) = pk2(a0 * rstd * gkv[2 * lane], a1 * rstd * gkv[2 * lane + 1]);
        const float kk = bf2f(misc[(size_t)r * 256 + 128 + lane]); const float ks = wave_sum(kk * kk); const int b = r / SEQ;
        km0 = (b == 0) ? fmaxf(km0, ks) : km0; km1 = (b == 1) ? fmaxf(km1, ks) : km1; km2 = (b == 2) ? fmaxf(km2, ks) : km2; km3 = (b == 3) ? fmaxf(km3, ks) : km3;
    }
    if (lane == 0) {
        __hip_atomic_fetch_max(kmaxw + 0, __float_as_uint(km0), __ATOMIC_RELAXED, __HIP_MEMORY_SCOPE_AGENT); __hip_atomic_fetch_max(kmaxw + 1, __float_as_uint(km1), __ATOMIC_RELAXED, __HIP_MEMORY_SCOPE_AGENT);
        __hip_atomic_fetch_max(kmaxw + 2, __float_as_uint(km2), __ATOMIC_RELAXED, __HIP_MEMORY_SCOPE_AGENT); __hip_atomic_fetch_max(kmaxw + 3, __float_as_uint(km3), __ATOMIC_RELAXED, __HIP_MEMORY_SCOPE_AGENT);
    }
}
__device__ __forceinline__ void mixC_v1(unsigned char* y, const float* T, LAS unsigned char* lds, int gw, int NGW, int lane, int wave) {
    asm volatile("" : "+v"(lane));
    const bf16* CQ = (const bf16*)(y + Y_CQ); const bf16* CK = (const bf16*)(y + Y_CK); const bf16* CV = (const bf16*)(y + Y_CV); bf16* OC = (bf16*)(y + Y_OC);
    LAS float* qs = (LAS float*)(lds + wave * 2048);
    LAS float* ps = qs + 64;
    for (int task = gw; task < CHR * 4; task += NGW) {
        const int r = task >> 2, hp = task & 3, t = r & (SEQ - 1), rb = r - t;
        float og[3], lse[3];
#pragma unroll
        for (int g = 0; g < 3; ++g) {
            const int dil = (g == 0) ? 1 : (g == 1) ? 4 : 16, hh = 4 * g + hp;
            qs[lane] = bf2f(CQ[(size_t)r * 768 + hh * 64 + lane]);
            asm volatile("s_waitcnt lgkmcnt(0)" ::: "memory");
            const int tq = t / dil, nv = (tq < 128 ? tq : 128) + 1;
            float lg[3];
#pragma unroll
            for (int rd = 0; rd < 3; ++rd) {
                const int j = lane + 64 * rd; float v = -INFINITY;
                if (j < nv) { const int s = t - j * dil; const bf16* kp = CK + (size_t)(rb + s) * 768 + hh * 64; float dot = 0.f;
#pragma unroll
                    for (int c8 = 0; c8 < 8; ++c8) dot += dot8(qs + 8 * c8, *(const v4u*)(kp + 8 * c8));
                    v = dot * 0.125f + T[(j * dil) * 24 + 12 + hh]; }
                lg[rd] = v;
            }
            const float m = wave_max(fmaxf(fmaxf(lg[0], lg[1]), lg[2]));
            float p[3], ls = 0.f;
#pragma unroll
            for (int rd = 0; rd < 3; ++rd) { p[rd] = (lane + 64 * rd < nv) ? __expf(lg[rd] - m) : 0.f; ls += p[rd]; ps[64 * rd + lane] = p[rd]; }
            const float l = wave_sum(ls);
            asm volatile("s_waitcnt lgkmcnt(0)" ::: "memory");
            float o = 0.f;
            for (int j = 0; j < nv; ++j) { const int s = t - j * dil; o += ps[j] * bf2f(CV[(size_t)(rb + s) * 768 + hh * 64 + lane]); }
            og[g] = o / l; lse[g] = m + __logf(l);
            asm volatile("s_waitcnt lgkmcnt(0)" ::: "memory");
        }
        const float M = fmaxf(fmaxf(lse[0], lse[1]), lse[2]);
        const float a0 = __expf(lse[0] - M), a1 = __expf(lse[1] - M), a2 = __expf(lse[2] - M);
        OC[(size_t)r * 256 + hp * 64 + lane] = (bf16)f2bf((a0 * og[0] + a1 * og[1] + a2 * og[2]) / (a0 + a1 + a2));
    }
}
__device__ __forceinline__ void mixB_v1(unsigned char* y, const float* T, const float* gsub, float lam, float one_m_li, LAS unsigned char* lds, int gw, int NGW, int lane, int wave) {
    asm volatile("" : "+v"(lane));
    bf16* BQ = (bf16*)(y + Y_BQ); const bf16* BK = (const bf16*)(y + Y_BK); const bf16* BV = (const bf16*)(y + Y_BV);
    LAS float* qs = (LAS float*)(lds + wave * 2048);
    LAS float* ps = qs + 128;
    for (int task = gw; task < CHR * 4; task += NGW) {
        const int r = task >> 2, h = task & 3, t = r & (SEQ - 1), rb = r - t;
        qs[lane] = bf2f(BQ[(size_t)r * 512 + h * 128 + lane]); qs[64 + lane] = bf2f(BQ[(size_t)r * 512 + h * 128 + 64 + lane]);
        asm volatile("s_waitcnt lgkmcnt(0)" ::: "memory");
        float m0 = -INFINITY, m1 = -INFINITY, l0 = 0.f, l1 = 0.f, o00 = 0.f, o01 = 0.f, o10 = 0.f, o11 = 0.f;
        for (int s0 = 0; s0 <= t; s0 += 64) {
            const int s = s0 + lane; float lg0 = -INFINITY, lg1 = -INFINITY;
            if (s <= t) { const bf16* kp = BK + (size_t)(rb + s) * 512 + h * 128; float d0 = 0.f, d1 = 0.f;
#pragma unroll
                for (int c8 = 0; c8 < 8; ++c8) { d0 += dot8(qs + 8 * c8, *(const v4u*)(kp + 8 * c8)); d1 += dot8(qs + 64 + 8 * c8, *(const v4u*)(kp + 64 + 8 * c8)); }
                const float bias = T[(t - s) * 24 + 8 + h]; lg0 = d0 * 0.125f + bias; lg1 = d1 * 0.125f + bias; }
            const float nm0 = fmaxf(m0, wave_max(lg0)), nm1 = fmaxf(m1, wave_max(lg1));
            const float f0 = __expf(m0 - nm0), f1 = __expf(m1 - nm1);
            const float p0 = (s <= t) ? __expf(lg0 - nm0) : 0.f, p1 = (s <= t) ? __expf(lg1 - nm1) : 0.f;
            l0 = l0 * f0 + wave_sum(p0); l1 = l1 * f1 + wave_sum(p1); o00 *= f0; o01 *= f0; o10 *= f1; o11 *= f1; m0 = nm0; m1 = nm1;
            ps[lane] = p0; ps[64 + lane] = p1;
            asm volatile("s_waitcnt lgkmcnt(0)" ::: "memory");
            const int nk = (t - s0 + 1 < 64) ? (t - s0 + 1) : 64;
            const bf16* vp = BV + (size_t)(rb + s0) * 512 + h * 128 + lane;
            for (int j = 0; j < nk; ++j) { const float v0 = bf2f(vp[(size_t)j * 512]), v1 = bf2f(vp[(size_t)j * 512 + 64]); const float pa = ps[j], pb = ps[64 + j];
                o00 += pa * v0; o01 += pa * v1; o10 += pb * v0; o11 += pb * v1; }
            asm volatile("s_waitcnt lgkmcnt(0)" ::: "memory");
        }
        const float oa = o00 / l0 - lam * (o10 / l1), ob = o01 / l0 - lam * (o11 / l1);
        const float rstd = 1.0f / sqrtf(wave_sum(oa * oa + ob * ob) * (1.f / 128.f) + EPS);
        BQ[(size_t)r * 512 + h * 128 + lane] = (bf16)f2bf(oa * rstd * gsub[lane] * one_m_li);
        BQ[(size_t)r * 512 + h * 128 + 64 + lane] = (bf16)f2bf(ob * rstd * gsub[64 + lane] * one_m_li);
    }
}
__device__ __forceinline__ unsigned mono_key(float f) { const unsigned u = __float_as_uint(f); return (u & 0x80000000u) ? ~u : (u | 0x80000000u); }
__device__ __forceinline__ void mixA_v1(unsigned char* y, const bf16* KVN, const float* T, LAS unsigned char* lds, int gw, int NGW, int lane, int wave) {
    asm volatile("" : "+v"(lane));
    bf16* QLAT = (bf16*)(y + Y_QLAT); const bf16* MISC = (const bf16*)(y + Y_MISC); const bf16* IQ = (const bf16*)(y + Y_IQ);
    LAS unsigned char* wb = lds + wave * 19456;
    LAS unsigned* scb = (LAS unsigned*)wb;
    LAS float* qi = (LAS float*)(wb + 16384);
    LAS unsigned* sel = (LAS unsigned*)(wb + 18432);
    LAS float* ql = (LAS float*)wb;
    LAS float* pb = (LAS float*)(wb + 4096);
    const unsigned long long lt_mask = (1ull << lane) - 1ull;
    for (int r = gw; r < CHR; r += NGW) {
        const int t = r & (SEQ - 1), rb = r - t, N = t + 1;
#pragma unroll
        for (int i = 0; i < 8; ++i) qi[i * 64 + lane] = bf2f(IQ[(size_t)r * 512 + i * 64 + lane]);
        const float wv = (lane < 8) ? bf2f(MISC[(size_t)r * 256 + 192 + lane]) * 0.044194173824159216f : 0.f;
        float wh[8];
#pragma unroll
        for (int h = 0; h < 8; ++h) wh[h] = __shfl(wv, h);
        asm volatile("s_waitcnt lgkmcnt(0)" ::: "memory");
        for (int s0 = 0; s0 < N; s0 += 64) {
            const int s = s0 + lane;
            if (s < N) { const bf16* kp = MISC + (size_t)(rb + s) * 256 + 128; v4u kw[8];
#pragma unroll
                for (int c8 = 0; c8 < 8; ++c8) kw[c8] = *(const v4u*)(kp + 8 * c8);
                float sc = 0.f;
#pragma unroll
                for (int h = 0; h < 8; ++h) { float d = 0.f;
#pragma unroll
                    for (int c8 = 0; c8 < 8; ++c8) d += dot8(qi + h * 64 + 8 * c8, kw[c8]);
                    sc += wh[h] * fmaxf(d, 0.f); }
                sc += 0.f;
                scb[s] = mono_key(sc); }
        }
        asm volatile("s_waitcnt lgkmcnt(0)" ::: "memory");
        int nsel;
        if (N <= TOPK) { for (int i = lane; i < N; i += 64) sel[i] = (unsigned)i; nsel = N; }
        else {
            unsigned tau = 0u;
            for (int bit = 31; bit >= 0; --bit) { const unsigned cand = tau | (1u << bit); int cnt = 0;
                for (int i = lane; i < N; i += 64) cnt += (scb[i] >= cand) ? 1 : 0;
#pragma unroll
                for (int o = 1; o < 64; o <<= 1) cnt += __shfl_xor(cnt, o);
                if (cnt >= TOPK) tau = cand; }
            int cgt = 0;
            for (int i = lane; i < N; i += 64) cgt += (scb[i] > tau) ? 1 : 0;
#pragma unroll
            for (int o = 1; o < 64; o <<= 1) cgt += __shfl_xor(cgt, o);
            const int need = TOPK - cgt; int pos = 0, eqt = 0;
            for (int s0 = 0; s0 < N; s0 += 64) { const int s = s0 + lane; const unsigned key = (s < N) ? scb[s] : 0u;
                const bool gt = (s < N) && key > tau, eq = (s < N) && key == tau;
                const unsigned long long beq = __ballot(eq);
                const bool take = gt || (eq && (eqt + __popcll(beq & lt_mask)) < need);
                const unsigned long long bt = __ballot(take);
                if (take) sel[pos + __popcll(bt & lt_mask)] = (unsigned)s;
                pos += __popcll(bt); eqt += __popcll(beq); }
            nsel = TOPK;
        }
        asm volatile("s_waitcnt lgkmcnt(0)" ::: "memory");
#pragma unroll
        for (int i = 0; i < 16; ++i) ql[i * 64 + lane] = bf2f(QLAT[(size_t)r * 1024 + i * 64 + lane]);
        asm volatile("s_waitcnt lgkmcnt(0)" ::: "memory");
        for (int rd = 0; rd < 4; ++rd) { const int jj = rd * 64 + lane;
            float acc[8];
#pragma unroll
            for (int h = 0; h < 8; ++h) acc[h] = -INFINITY;
            if (jj < nsel) { const int s = (int)sel[jj]; const bf16* kp = KVN + (size_t)(rb + s) * 128;
#pragma unroll
                for (int h = 0; h < 8; ++h) acc[h] = 0.f;
#pragma unroll 4
                for (int c8 = 0; c8 < 16; ++c8) { const v4u w = *(const v4u*)(kp + 8 * c8);
#pragma unroll
                    for (int h = 0; h < 8; ++h) acc[h] += dot8(ql + h * 128 + 8 * c8, w); }
                const float* tb = T + (t - s) * 24;
#pragma unroll
                for (int h = 0; h < 8; ++h) acc[h] = acc[h] * 0.125f + tb[h]; }
#pragma unroll
            for (int h = 0; h < 8; ++h) pb[h * 256 + jj] = acc[h];
        }
        asm volatile("s_waitcnt lgkmcnt(0)" ::: "memory");
#pragma unroll
        for (int h = 0; h < 8; ++h) { float v[4];
#pragma unroll
            for (int i = 0; i < 4; ++i) v[i] = pb[h * 256 + 64 * i + lane];
            const float m = wave_max(fmaxf(fmaxf(v[0], v[1]), fmaxf(v[2], v[3])));
#pragma unroll
            for (int i = 0; i < 4; ++i) v[i] = __expf(v[i] - m);
            const float inv = 1.0f / wave_sum((v[0] + v[1]) + (v[2] + v[3]));
#pragma unroll
            for (int i = 0; i < 4; ++i) pb[h * 256 + 64 * i + lane] = v[i] * inv; }
        asm volatile("s_waitcnt lgkmcnt(0)" ::: "memory");
        float o0[8], o1[8];
#pragma unroll
        for (int h = 0; h < 8; ++h) { o0[h] = 0.f; o1[h] = 0.f; }
        for (int jj = 0; jj < nsel; ++jj) { const int s = (int)sel[jj]; const bf16* vp = KVN + (size_t)(rb + s) * 128 + lane;
            const float v0 = bf2f(vp[0]), v1 = bf2f(vp[64]);
#pragma unroll
            for (int h = 0; h < 8; ++h) { const float p = pb[h * 256 + jj]; o0[h] += p * v0; o1[h] += p * v1; } }
#pragma unroll
        for (int h = 0; h < 8; ++h) { QLAT[(size_t)r * 1024 + h * 128 + lane] = (bf16)f2bf(o0[h]); QLAT[(size_t)r * 1024 + h * 128 + 64 + lane] = (bf16)f2bf(o1[h]); }
        asm volatile("s_waitcnt lgkmcnt(0)" ::: "memory");
    }
}

typedef short bf16x8 __attribute__((ext_vector_type(8)));
typedef short s16x4 __attribute__((ext_vector_type(4)));
typedef float f32x16 __attribute__((ext_vector_type(16)));
#define LOG2E 1.4426950408889634f
__device__ __forceinline__ int crow(int r, int hi) { return (r & 3) + 8 * (r >> 2) + 4 * hi; }
__device__ __forceinline__ void glds16(const void* g, LAS void* l) { __builtin_amdgcn_global_load_lds((const unsigned*)g, (LAS unsigned*)l, 16, 0, 0); }
__device__ __forceinline__ s16x4 tr16(const LAS unsigned char* p) { return __builtin_bit_cast(s16x4, __builtin_amdgcn_ds_read_tr16_b64_v4i16((LAS s16x4*)p)); }
__device__ __forceinline__ float swap_max(float v) { auto rr = __builtin_amdgcn_permlane32_swap(__float_as_uint(v), __float_as_uint(v), false, false); return fmaxf(__uint_as_float(rr[0]), __uint_as_float(rr[1])); }
__device__ __forceinline__ float swap_add(float v) { auto rr = __builtin_amdgcn_permlane32_swap(__float_as_uint(v), __float_as_uint(v), false, false); return __uint_as_float(rr[0]) + __uint_as_float(rr[1]); }
__device__ __forceinline__ unsigned cvtpk(float lo, float hi) { unsigned r; asm("v_cvt_pk_bf16_f32 %0, %1, %2" : "=v"(r) : "v"(lo), "v"(hi)); return r; }
__device__ __forceinline__ void lds_add_u32_asm(LAS void* p, unsigned v) { asm volatile("ds_add_u32 %0, %1" :: "v"((unsigned)(uintptr_t)p), "v"(v) : "memory"); }
__device__ __forceinline__ void lds_st_b16_asm(LAS void* p, unsigned v) { asm volatile("ds_write_b16 %0, %1" :: "v"((unsigned)(uintptr_t)p), "v"(v) : "memory"); }
__device__ __forceinline__ void lds_st_b32_asm(LAS void* p, unsigned v) { asm volatile("ds_write_b32 %0, %1" :: "v"((unsigned)(uintptr_t)p), "v"(v) : "memory"); }
__device__ __forceinline__ s16x4 tr16_asm(const LAS unsigned char* p) { s16x4 v; asm volatile("ds_read_b64_tr_b16 %0, %1" : "=v"(v) : "v"((unsigned)(uintptr_t)p) : "memory"); return v; }
#define TRV(dst, base, off) asm volatile("ds_read_b64_tr_b16 %0, %1 offset:%c2" : "=&v"(dst) : "v"(base), "i"(off) : "memory")
#define LGKM_WAIT8(n, f) asm volatile("s_waitcnt lgkmcnt(" #n ")" : "+v"(f[0]), "+v"(f[1]), "+v"(f[2]), "+v"(f[3]), "+v"(f[4]), "+v"(f[5]), "+v"(f[6]), "+v"(f[7]) :: "memory")
#define VFRAG(f, i) ((bf16x8){f[2 * (i)][0], f[2 * (i)][1], f[2 * (i)][2], f[2 * (i)][3], f[2 * (i) + 1][0], f[2 * (i) + 1][1], f[2 * (i) + 1][2], f[2 * (i) + 1][3]})
#define RAW_BARRIER() do { asm volatile("s_waitcnt lgkmcnt(0)" ::: "memory"); __builtin_amdgcn_s_barrier(); asm volatile("" ::: "memory"); } while (0)

template <int MODE> __device__ __forceinline__ void mixB_fast(unsigned char* y, bf16* OUTB, const float* T, const float* gsub, float lam, float one_m_li, LAS unsigned char* lds, int tid, int lane, int wave, int G) {
    asm volatile("" : "+v"(lane), "+v"(tid));
    bf16* BQ = (bf16*)(y + Y_BQ); const bf16* BK = (const bf16*)(y + Y_BK); const bf16* BV = (const bf16*)(y + Y_BV);
    const int r32 = lane & 31, hi = lane >> 5, m = wave >> 2, qs = wave & 3;
    LAS float* bt = (LAS float*)(lds + 131072);
    constexpr float C2 = 0.125f * LOG2E, THR = 8.0f;
    for (int item = blockIdx.x; item < CHB * 4 * 16; item += G) {
        const int bh = (G == 256) ? (2 * (item & 7) + (item >> 7)) : (item >> 4), pr = (G == 256) ? ((item >> 3) & 15) : (item & 15), bb = bh >> 2, h = bh & 3, rb = bb * SEQ;
        RAW_BARRIER();
        for (int i = tid; i < 64 + 4096; i += NTHREADS) bt[i] = (i < 64) ? 0.f : T[(i - 64) * 24 + 8 + h] * LOG2E;
        if (tid < 128) bt[64 + 4096 + tid] = gsub[tid];
        for (int uu = 0; uu < 2; ++uu) {
            const int qb = (uu == 0) ? (31 - pr) : pr;
            const int q0w = qb * 128 + qs * 32, qpos = q0w + r32;
            bf16x8 qf[4];
#pragma unroll
            for (int ks = 0; ks < 4; ++ks) qf[ks] = *(const bf16x8*)(BQ + (size_t)(rb + qpos) * 512 + h * 128 + m * 64 + 16 * ks + 8 * hi);
            const int NT = 2 * (qb + 1);
            f32x16 O[4];
#pragma unroll
            for (int dq = 0; dq < 4; ++dq)
#pragma unroll
                for (int r = 0; r < 16; ++r) O[dq][r] = 0.f;
            float mref = -INFINITY, lsum = 0.f;
#define MB_STAGE(t_, buf_) do { const int kv0_ = (t_) * 64; LAS unsigned char* sb_ = lds + (buf_) * 32768; \
                glds16(BK + (size_t)(rb + kv0_ + lane) * 512 + h * 128 + wave * 8, sb_ + wave * 1024); \
                glds16(BK + (size_t)(rb + kv0_ + lane) * 512 + h * 128 + 64 + wave * 8, sb_ + 8192 + wave * 1024); \
                _Pragma("unroll") for (int i_ = 0; i_ < 2; ++i_) { const int p_ = 2 * wave + i_, dq_ = p_ >> 2, rg_ = p_ & 3; \
                    glds16(BV + (size_t)(rb + kv0_ + 16 * rg_ + (lane >> 2)) * 512 + h * 128 + dq_ * 32 + (lane & 3) * 8, sb_ + 16384 + p_ * 1024); } } while (0)
            MB_STAGE(0, 0); MB_STAGE(1, 1);
            if (NT > 2) MB_STAGE(2, 2);
            for (int t = 0; t < NT; ++t) {
                if (t + 2 < NT) asm volatile("s_waitcnt vmcnt(8)" ::: "memory");
                else if (t + 1 < NT) asm volatile("s_waitcnt vmcnt(4)" ::: "memory");
                else asm volatile("s_waitcnt vmcnt(0)" ::: "memory");
                RAW_BARRIER();
                if (t + 3 < NT) MB_STAGE(t + 3, (t + 3) & 3);
                const int kv0 = t * 64;
                if (MODE != 2 && kv0 <= q0w + 31) {
                    const LAS unsigned char* sb = lds + (t & 3) * 32768;
                    const LAS unsigned char* kb = sb + m * 8192 + hi * 1024 + r32 * 16;
                    f32x16 s0, s1;
#pragma unroll
                    for (int r = 0; r < 16; ++r) { s0[r] = 0.f; s1[r] = 0.f; }
                    if (MODE != 3)
#pragma unroll
                    for (int ks = 0; ks < 4; ++ks) {
                        const bf16x8 k0 = *(const LAS bf16x8*)(kb + ks * 2048), k1 = *(const LAS bf16x8*)(kb + ks * 2048 + 512);
                        s0 = __builtin_amdgcn_mfma_f32_32x32x16_bf16(k0, qf[ks], s0, 0, 0, 0);
                        s1 = __builtin_amdgcn_mfma_f32_32x32x16_bf16(k1, qf[ks], s1, 0, 0, 0); }
                    const int dmin = q0w - (kv0 + 63), dmax = q0w + 31 - kv0;
                    if (MODE != 3) {
                    if (dmin >= 0 && rel_bucket(dmin) == rel_bucket(dmax)) {
                        const float cb = bt[64 + dmin];
#pragma unroll
                        for (int r = 0; r < 16; ++r) { s0[r] = fmaf(s0[r], C2, cb); s1[r] = fmaf(s1[r], C2, cb); }
                    } else {
                        const LAS float* bp = bt + 64 + (qpos - kv0) - 4 * hi;
#pragma unroll
                        for (int r = 0; r < 16; ++r) { s0[r] = fmaf(s0[r], C2, bp[-((r & 3) + 8 * (r >> 2))]); s1[r] = fmaf(s1[r], C2, bp[-(32 + (r & 3) + 8 * (r >> 2))]); }
                    }
                    if (kv0 + 63 > q0w) {
#pragma unroll
                        for (int r = 0; r < 16; ++r) { const int kv = kv0 + crow(r, hi); if (kv > qpos) s0[r] = -INFINITY; if (kv + 32 > qpos) s1[r] = -INFINITY; }
                    }
                    float rm = fmaxf(s0[0], s1[0]);
#pragma unroll
                    for (int r = 1; r < 16; ++r) rm = fmaxf(rm, fmaxf(s0[r], s1[r]));
                    rm = swap_max(rm);
                    if (__any(rm > mref + THR)) {
                        const float mn = fmaxf(mref, rm), f = __builtin_amdgcn_exp2f(mref - mn);
                        lsum *= f; mref = mn;
#pragma unroll
                        for (int dq = 0; dq < 4; ++dq)
#pragma unroll
                            for (int r = 0; r < 16; ++r) O[dq][r] *= f;
                    }
                    float ps = 0.f;
#pragma unroll
                    for (int r = 0; r < 16; ++r) { s0[r] = __builtin_amdgcn_exp2f(s0[r] - mref); s1[r] = __builtin_amdgcn_exp2f(s1[r] - mref); ps += s0[r] + s1[r]; }
                    lsum += ps;
                    }
                    bf16x8 pf[4];
                    { v4u w;
                      w.x = cvtpk(s0[0], s0[1]); w.y = cvtpk(s0[2], s0[3]); w.z = cvtpk(s0[4], s0[5]); w.w = cvtpk(s0[6], s0[7]); pf[0] = __builtin_bit_cast(bf16x8, w);
                      w.x = cvtpk(s0[8], s0[9]); w.y = cvtpk(s0[10], s0[11]); w.z = cvtpk(s0[12], s0[13]); w.w = cvtpk(s0[14], s0[15]); pf[1] = __builtin_bit_cast(bf16x8, w);
                      w.x = cvtpk(s1[0], s1[1]); w.y = cvtpk(s1[2], s1[3]); w.z = cvtpk(s1[4], s1[5]); w.w = cvtpk(s1[6], s1[7]); pf[2] = __builtin_bit_cast(bf16x8, w);
                      w.x = cvtpk(s1[8], s1[9]); w.y = cvtpk(s1[10], s1[11]); w.z = cvtpk(s1[12], s1[13]); w.w = cvtpk(s1[14], s1[15]); pf[3] = __builtin_bit_cast(bf16x8, w); }
                    const unsigned vb = (unsigned)(uintptr_t)(sb + 16384 + ((lane >> 4) & 1) * 32 + (lane & 3) * 8 + (4 * hi + ((lane & 15) >> 2)) * 64);
                    s16x4 fa[8], fb[8];
#define MB_RD(f, dq_) do { _Pragma("unroll") for (int sp_ = 0; sp_ < 4; ++sp_) { TRV(f[2 * sp_], vb, ((dq_) * 4 + sp_) * 1024); TRV(f[2 * sp_ + 1], vb, ((dq_) * 4 + sp_) * 1024 + 512); } } while (0)
#define MB_MM(f, dq_) do { _Pragma("unroll") for (int sp_ = 0; sp_ < 4; ++sp_) O[dq_] = __builtin_amdgcn_mfma_f32_32x32x16_bf16(VFRAG(f, sp_), pf[sp_], O[dq_], 0, 0, 0); } while (0)
                    if (MODE != 1) {
                    MB_RD(fa, 0); MB_RD(fb, 1); LGKM_WAIT8(8, fa); MB_MM(fa, 0);
                    MB_RD(fa, 2); LGKM_WAIT8(8, fb); MB_MM(fb, 1);
                    MB_RD(fb, 3); LGKM_WAIT8(8, fa); MB_MM(fa, 2);
                    LGKM_WAIT8(0, fb); MB_MM(fb, 3); }
#undef MB_RD
#undef MB_MM
                }
            }
            RAW_BARRIER();
#undef MB_STAGE
            const float inv = 1.0f / swap_add(lsum);
            LAS float* xb = (LAS float*)lds + qs * 4096;
            if (m == 1) {
#pragma unroll
                for (int dq = 0; dq < 4; ++dq)
#pragma unroll
                    for (int r = 0; r < 16; ++r) xb[(dq * 16 + r) * 64 + lane] = O[dq][r] * inv;
            }
            RAW_BARRIER();
            if (m == 0) {
                float ss = 0.f;
#pragma unroll
                for (int dq = 0; dq < 4; ++dq)
#pragma unroll
                    for (int r = 0; r < 16; ++r) { const float o = O[dq][r] * inv - lam * xb[(dq * 16 + r) * 64 + lane]; O[dq][r] = o; ss += o * o; }
                const float rstd = 1.0f / sqrtf(swap_add(ss) * (1.f / 128.f) + EPS) * one_m_li;
                bf16* orow = OUTB + (size_t)(rb + qpos) * 512 + h * 128;
#pragma unroll
                for (int dq = 0; dq < 4; ++dq)
#pragma unroll
                    for (int g4 = 0; g4 < 4; ++g4) { const int d0 = dq * 32 + 8 * g4 + 4 * hi; const f32x4 gs = *(const LAS f32x4*)(bt + 64 + 4096 + d0);
                        v2u w; w.x = pk2(O[dq][4 * g4] * rstd * gs.x, O[dq][4 * g4 + 1] * rstd * gs.y); w.y = pk2(O[dq][4 * g4 + 2] * rstd * gs.z, O[dq][4 * g4 + 3] * rstd * gs.w);
                        *(v2u*)(orow + d0) = w; }
            }
            asm volatile("s_waitcnt vmcnt(0)" ::: "memory");
            RAW_BARRIER();
        }
    }
}

constexpr size_t WS_OG = 432 * MiB, WS_LSE = 480 * MiB;
__device__ __forceinline__ void mixC_fast(unsigned char* y, unsigned char* ws, const float* T, LAS unsigned char* lds, int tid, int lane, int wave, int G) {
    asm volatile("" : "+v"(lane), "+v"(tid));
    const bf16* CQ = (const bf16*)(y + Y_CQ); const bf16* CK = (const bf16*)(y + Y_CK); const bf16* CV = (const bf16*)(y + Y_CV);
    float* OG = (float*)(ws + WS_OG); float* LSE = (float*)(ws + WS_LSE);
    const int r32 = lane & 31, hi = lane >> 5;
    LAS unsigned char* Kl = lds;
    LAS unsigned char* Vl = lds + 49152;
    LAS float* bt = (LAS float*)(lds + 98304);
    constexpr float C2 = 0.125f * LOG2E;
    for (int item = blockIdx.x; item < CHB * 192; item += G) {
        const int bb = item / 192, u = item % 192, g = u >> 6, v = u & 63;
        const int hp = v >> 4, w16 = v & 15;
        const int dil = (g == 0) ? 1 : (g == 1) ? 4 : 16;
        const int rc = (g == 0) ? 0 : (g == 1) ? (w16 >> 2) : w16;
        const int seg = (g == 0) ? w16 : (g == 1) ? (w16 & 3) : 0;
        const int hh = 4 * g + hp, M0 = seg * 256, rb = bb * SEQ;
        RAW_BARRIER();
        if (tid < 192) { int rel = tid - 32; rel = rel < 0 ? 0 : (rel > 128 ? 128 : rel); bt[tid] = T[(rel * dil) * 24 + 12 + hh] * LOG2E; }
#pragma unroll
        for (int i = 0; i < 6; ++i) { const int p = wave * 6 + i, c = p / 6, rbk = p % 6;
            int mk = M0 - 128 + 64 * rbk + lane; mk = mk < 0 ? 0 : mk;
            glds16(CK + (size_t)(rb + mk * dil + rc) * 768 + hh * 64 + c * 8, Kl + c * 6144 + rbk * 1024); }
#pragma unroll
        for (int i = 0; i < 6; ++i) { const int p = wave * 6 + i, dq = p / 24, rg = p % 24;
            int mk = M0 - 128 + 16 * rg + (lane >> 2); mk = mk < 0 ? 0 : mk;
            glds16(CV + (size_t)(rb + mk * dil + rc) * 768 + hh * 64 + dq * 32 + (lane & 3) * 8, Vl + p * 1024); }
        const int mq = M0 + 32 * wave + r32, rowq = rb + mq * dil + rc;
        bf16x8 qf[4];
#pragma unroll
        for (int ks = 0; ks < 4; ++ks) qf[ks] = *(const bf16x8*)(CQ + (size_t)rowq * 768 + hh * 64 + 16 * ks + 8 * hi);
        asm volatile("s_waitcnt vmcnt(0)" ::: "memory");
        RAW_BARRIER();
        f32x16 O[2];
#pragma unroll
        for (int dq = 0; dq < 2; ++dq)
#pragma unroll
            for (int r = 0; r < 16; ++r) O[dq][r] = 0.f;
        float mref = -INFINITY, lsum = 0.f;
#pragma unroll 1
        for (int j = 0; j < 5; ++j) {
            const int lrow = 32 * wave + 32 * j;
            if (M0 - 128 + lrow + 31 < 0) continue;
            const LAS unsigned char* kb = Kl + hi * 6144 + (lrow + r32) * 16;
            f32x16 s0;
#pragma unroll
            for (int r = 0; r < 16; ++r) s0[r] = 0.f;
#pragma unroll
            for (int ks = 0; ks < 4; ++ks) { const bf16x8 k0 = *(const LAS bf16x8*)(kb + ks * 12288); s0 = __builtin_amdgcn_mfma_f32_32x32x16_bf16(k0, qf[ks], s0, 0, 0, 0); }
            const int relb = 128 - 32 * j + r32;
            const LAS float* bp = bt + 32 + relb - 4 * hi;
            const int mkb = M0 - 128 + lrow + 4 * hi;
#pragma unroll
            for (int r = 0; r < 16; ++r) { const int cr = (r & 3) + 8 * (r >> 2), rel = relb - 4 * hi - cr;
                const float vv = fmaf(s0[r], C2, bp[-cr]);
                s0[r] = (rel >= 0 && rel <= 128 && mkb + cr >= 0) ? vv : -INFINITY; }
            float rm = s0[0];
#pragma unroll
            for (int r = 1; r < 16; ++r) rm = fmaxf(rm, s0[r]);
            rm = swap_max(rm);
            const float mn = fmaxf(mref, rm);
            const float f = (mn == -INFINITY) ? 1.f : __builtin_amdgcn_exp2f(mref - mn);
            const float msub = (mn == -INFINITY) ? 0.f : mn;
            lsum *= f; mref = mn;
#pragma unroll
            for (int dq = 0; dq < 2; ++dq)
#pragma unroll
                for (int r = 0; r < 16; ++r) O[dq][r] *= f;
            float ps = 0.f;
#pragma unroll
            for (int r = 0; r < 16; ++r) { s0[r] = __builtin_amdgcn_exp2f(s0[r] - msub); ps += s0[r]; }
            lsum += ps;
            bf16x8 pf[2];
            { v4u w;
              w.x = cvtpk(s0[0], s0[1]); w.y = cvtpk(s0[2], s0[3]); w.z = cvtpk(s0[4], s0[5]); w.w = cvtpk(s0[6], s0[7]); pf[0] = __builtin_bit_cast(bf16x8, w);
              w.x = cvtpk(s0[8], s0[9]); w.y = cvtpk(s0[10], s0[11]); w.z = cvtpk(s0[12], s0[13]); w.w = cvtpk(s0[14], s0[15]); pf[1] = __builtin_bit_cast(bf16x8, w); }
            const unsigned vb = (unsigned)(uintptr_t)(Vl + ((lane >> 4) & 1) * 32 + (lane & 3) * 8 + (4 * hi + ((lane & 15) >> 2)) * 64 + (lrow >> 4) * 1024);
            s16x4 fa[8];
#pragma unroll
            for (int dq = 0; dq < 2; ++dq)
#pragma unroll
                for (int sp = 0; sp < 2; ++sp) { TRV(fa[4 * dq + 2 * sp], vb, (dq * 24 + sp) * 1024); TRV(fa[4 * dq + 2 * sp + 1], vb, (dq * 24 + sp) * 1024 + 512); }
            LGKM_WAIT8(0, fa);
#pragma unroll
            for (int dq = 0; dq < 2; ++dq)
#pragma unroll
                for (int sp = 0; sp < 2; ++sp) O[dq] = __builtin_amdgcn_mfma_f32_32x32x16_bf16(VFRAG(fa, 2 * dq + sp), pf[sp], O[dq], 0, 0, 0);
        }
        const float ltot = swap_add(lsum), inv = 1.0f / ltot;
        float* og = OG + ((size_t)g * CHR + rowq) * 256 + hp * 64;
#pragma unroll
        for (int dq = 0; dq < 2; ++dq)
#pragma unroll
            for (int g4 = 0; g4 < 4; ++g4) { const int d0 = dq * 32 + 8 * g4 + 4 * hi;
                *(f32x4*)(og + d0) = (f32x4){O[dq][4 * g4] * inv, O[dq][4 * g4 + 1] * inv, O[dq][4 * g4 + 2] * inv, O[dq][4 * g4 + 3] * inv}; }
        if (hi == 0) LSE[((size_t)g * CHR + rowq) * 4 + hp] = (mref + __log2f(ltot)) * 0.6931471805599453f;
    }
}
__device__ __forceinline__ void mergeC(unsigned char* y, unsigned char* ws, int gw, int NGW, int lane) {
    asm volatile("" : "+v"(lane));
    const float* OG = (const float*)(ws + WS_OG); const float* LSE = (const float*)(ws + WS_LSE); bf16* OC = (bf16*)(y + Y_OC);
    for (int r = gw; r < CHR; r += NGW) {
        const int hp = lane >> 4, d4 = (lane & 15) * 4;
        float l0 = LSE[((size_t)0 * CHR + r) * 4 + hp], l1 = LSE[((size_t)1 * CHR + r) * 4 + hp], l2 = LSE[((size_t)2 * CHR + r) * 4 + hp];
        const float M = fmaxf(fmaxf(l0, l1), l2);
        const float a0 = __expf(l0 - M), a1 = __expf(l1 - M), a2 = __expf(l2 - M), ia = 1.0f / (a0 + a1 + a2);
        const f32x4 o0 = *(const f32x4*)(OG + ((size_t)0 * CHR + r) * 256 + hp * 64 + d4), o1 = *(const f32x4*)(OG + ((size_t)1 * CHR + r) * 256 + hp * 64 + d4), o2 = *(const f32x4*)(OG + ((size_t)2 * CHR + r) * 256 + hp * 64 + d4);
        const f32x4 o = (o0 * a0 + o1 * a1 + o2 * a2) * ia;
        v2u w; w.x = pk2(o.x, o.y); w.y = pk2(o.z, o.w);
        *(v2u*)(OC + (size_t)r * 256 + hp * 64 + d4) = w;
    }
}

constexpr int CW_KMAX = 8192;
constexpr int A_KST = 0, A_HIST = 32768, A_CAND = 98304, A_SEL = 131072, A_BKT = 147456, A_BIAS = 151552;
__device__ __forceinline__ int a_bin(float s, int kb) {
    int k = (int)(__float_as_uint(fabsf(s)) >> 18) - kb; k = k < 0 ? 0 : (k > 511 ? 511 : k);
    return (s < 0.f) ? (511 - k) : (512 + k);
}
__device__ __forceinline__ void mixA_fast(unsigned char* y, bf16* OUTA, bf16* OUTA2, const bf16* KVN, const float* T, const float* rel_bias, const unsigned* kmaxw, LAS unsigned char* lds, int tid, int lane, int wave, int G) {
    asm volatile("" : "+v"(lane), "+v"(tid));
    bf16* QLAT = (bf16*)(y + Y_QLAT); const bf16* MISC = (const bf16*)(y + Y_MISC); const bf16* IQ = (const bf16*)(y + Y_IQ);
    const int kl = lane & 31, hi = lane >> 5;
    constexpr float C2 = 0.125f * LOG2E, THR = 8.0f;
    LAS float* biasl = (LAS float*)(lds + A_BIAS);
    const unsigned lt32 = (1u << kl) - 1u;
    for (int item = blockIdx.x; item < CHB * 64; item += G) {
        const int bb = (G == 256) ? (item & 3) : (item >> 6), pr = (G == 256) ? (((item >> 2) & 1) * 32 + (item >> 3)) : (item & 63), rb = bb * SEQ;
        const float kmax = sqrtf(__uint_as_float(kmaxw[bb]));
        for (int uu = 0; uu < 2; ++uu) {
            const int qb = (uu == 0) ? (127 - pr) : pr, t0 = qb * 32, tw = t0 + 4 * wave;
            RAW_BARRIER();
            if (tid < 256) biasl[tid] = rel_bias[(tid >> 3) * 24 + (tid & 7)] * LOG2E;
            bf16x8 aq[4];
            { const int rowq = kl >> 3, hr = kl & 7;
#pragma unroll
              for (int ks = 0; ks < 4; ++ks) aq[ks] = *(const bf16x8*)(IQ + (size_t)(rb + tw + rowq) * 512 + hr * 64 + 16 * ks + 8 * hi); }
            float wr[16];
#pragma unroll
            for (int r = 0; r < 16; ++r) wr[r] = bf2f(MISC[(size_t)(rb + tw + (r >> 2)) * 256 + 192 + (r & 3) + 4 * hi]) * 0.044194173824159216f;
            int kbX, kbY;
            { float ss = 0.f;
#pragma unroll
              for (int ks = 0; ks < 4; ++ks)
#pragma unroll
                  for (int j = 0; j < 8; ++j) { const float v = bf2f((bf16)aq[ks][j]); ss += v * v; }
              ss = swap_add(ss);
              const float wa = fabsf(bf2f(MISC[(size_t)(rb + tw + (kl >> 3)) * 256 + 192 + (kl & 7)])) * 0.044194173824159216f;
              float u = wa * sqrtf(ss) * kmax;
              u += __shfl_xor(u, 1); u += __shfl_xor(u, 2); u += __shfl_xor(u, 4);
              const float uX = __shfl(u, (2 * hi) * 8), uY = __shfl(u, (2 * hi + 1) * 8);
              kbX = (int)(__float_as_uint(uX) >> 18) - 511; kbY = (int)(__float_as_uint(uY) >> 18) - 511; }
            const int tX = tw + 2 * hi, tY = tw + 2 * hi + 1;
            const int qX = wave * 4 + 2 * hi, qY = qX + 1;
            LAS unsigned* histX = (LAS unsigned*)(lds + A_HIST + qX * 2048); LAS unsigned* histY = (LAS unsigned*)(lds + A_HIST + qY * 2048);
            int thrX = -1, thrY = -1; unsigned cntX = 0, cntY = 0, ccX = 0, ccY = 0;
#pragma unroll 1
            for (int rep8 = 0; rep8 < ((PROBE == 8 || PROBE == 15) ? 2 : 1); ++rep8) {
            thrX = -1; thrY = -1; cntX = 0; cntY = 0; ccX = 0; ccY = 0;
            { LAS v4u* hz = (LAS v4u*)(lds + A_HIST + wave * 8192);
#pragma unroll
              for (int i = 0; i < 8; ++i) hz[i * 64 + lane] = (v4u){0u, 0u, 0u, 0u}; }
            const int NTK = qb + 1, NCK = (NTK + 3) >> 2;
#define MA_STAGE(ck_, buf_) do { _Pragma("unroll") for (int i_ = 0; i_ < 2; ++i_) { const int p_ = 2 * wave + i_, tl_ = p_ >> 2, ks_ = p_ & 3; \
                glds16(MISC + (size_t)(rb + 128 * (ck_) + 32 * tl_ + kl) * 256 + 128 + (2 * ks_ + hi) * 8, lds + A_KST + (buf_) * 16384 + tl_ * 4096 + ks_ * 1024); } } while (0)
#pragma unroll 1
            for (int pass = 0; pass < 2; ++pass) {
                MA_STAGE(0, 0);
#pragma unroll 1
                for (int ck = 0; ck < NCK; ++ck) {
                    if (ck + 1 < NCK) { MA_STAGE(ck + 1, (ck + 1) & 1); asm volatile("s_waitcnt vmcnt(2)" ::: "memory"); }
                    else asm volatile("s_waitcnt vmcnt(0)" ::: "memory");
                    RAW_BARRIER();
#pragma unroll 1
                    for (int tl = 0; tl < 4; ++tl) {
                        const int kt = 4 * ck + tl; if (kt >= NTK) break;
                        if (PROBE == 15 && rep8 == 0) continue;
                        const LAS unsigned char* kbp = lds + A_KST + (ck & 1) * 16384 + tl * 4096 + hi * 512 + kl * 16;
                        f32x16 c;
#pragma unroll
                        for (int r = 0; r < 16; ++r) c[r] = 0.f;
#pragma unroll
                        for (int ks = 0; ks < 4; ++ks) { const bf16x8 kf = *(const LAS bf16x8*)(kbp + ks * 1024); c = __builtin_amdgcn_mfma_f32_32x32x16_bf16(aq[ks], kf, c, 0, 0, 0); }
                        float p0 = 0.f, p1 = 0.f, p2 = 0.f, p3 = 0.f;
#pragma unroll
                        for (int i = 0; i < 4; ++i) { p0 += wr[i] * fmaxf(c[i], 0.f); p1 += wr[4 + i] * fmaxf(c[4 + i], 0.f); p2 += wr[8 + i] * fmaxf(c[8 + i], 0.f); p3 += wr[12 + i] * fmaxf(c[12 + i], 0.f); }
                        float sX, sY;
                        { auto rr = __builtin_amdgcn_permlane32_swap(__float_as_uint(p0), __float_as_uint(p2), false, false); sX = __uint_as_float(rr[0]) + __uint_as_float(rr[1]) + 0.f; }
                        { auto rr = __builtin_amdgcn_permlane32_swap(__float_as_uint(p1), __float_as_uint(p3), false, false); sY = __uint_as_float(rr[0]) + __uint_as_float(rr[1]) + 0.f; }
                        const int s = kt * 32 + kl;
                        const bool vX = s <= tX, vY = s <= tY;
                        const int bX = a_bin(sX, kbX), bY = a_bin(sY, kbY);
                        if (pass == 0) {
                            if (vX) lds_add_u32_asm(histX + (bX >> 1), 1u << ((bX & 1) * 16));
                            if (vY) lds_add_u32_asm(histY + (bY >> 1), 1u << ((bY & 1) * 16));
                        } else {
                            {   const bool sel = vX && bX > thrX, cd = vX && bX == thrX;
                                const unsigned long long bs = __ballot(sel), bc = __ballot(cd);
                                const unsigned ms = hi ? (unsigned)(bs >> 32) : (unsigned)bs, mc = hi ? (unsigned)(bc >> 32) : (unsigned)bc;
                                if (sel) lds_st_b16_asm((LAS bf16*)(lds + A_SEL + qX * 512) + cntX + __popc(ms & lt32), (unsigned)s);
                                if (cd) { const unsigned cp = ccX + __popc(mc & lt32); if (cp < 128u) { lds_st_b32_asm((LAS float*)(lds + A_CAND + qX * 768) + cp, __float_as_uint(sX)); lds_st_b16_asm((LAS bf16*)(lds + A_CAND + qX * 768 + 512) + cp, (unsigned)s); } }
                                cntX += __popc(ms); ccX += __popc(mc); }
                            {   const bool sel = vY && bY > thrY, cd = vY && bY == thrY;
                                const unsigned long long bs = __ballot(sel), bc = __ballot(cd);
                                const unsigned ms = hi ? (unsigned)(bs >> 32) : (unsigned)bs, mc = hi ? (unsigned)(bc >> 32) : (unsigned)bc;
                                if (sel) lds_st_b16_asm((LAS bf16*)(lds + A_SEL + qY * 512) + cntY + __popc(ms & lt32), (unsigned)s);
                                if (cd) { const unsigned cp = ccY + __popc(mc & lt32); if (cp < 128u) { lds_st_b32_asm((LAS float*)(lds + A_CAND + qY * 768) + cp, __float_as_uint(sY)); lds_st_b16_asm((LAS bf16*)(lds + A_CAND + qY * 768 + 512) + cp, (unsigned)s); } }
                                cntY += __popc(ms); ccY += __popc(mc); }
                        }
                    }
                    RAW_BARRIER();
                }
                if (pass == 0) {
#pragma unroll 1
                    for (int q4 = 0; q4 < 4; ++q4) {
                        const LAS unsigned* hq = (const LAS unsigned*)(lds + A_HIST + (wave * 4 + q4) * 2048) + 504 - 8 * lane;
                        unsigned w8[8];
                        { const v4u a0 = *(const LAS v4u*)hq, a1 = *(const LAS v4u*)(hq + 4); w8[0] = a0.x; w8[1] = a0.y; w8[2] = a0.z; w8[3] = a0.w; w8[4] = a1.x; w8[5] = a1.y; w8[6] = a1.z; w8[7] = a1.w; }
                        unsigned loc = 0;
#pragma unroll
                        for (int j = 0; j < 8; ++j) loc += (w8[j] & 0xffffu) + (w8[j] >> 16);
                        unsigned inc = loc;
#pragma unroll
                        for (int o = 1; o < 64; o <<= 1) { const unsigned v = __shfl_up(inc, o); if (lane >= o) inc += v; }
                        unsigned run = inc - loc; int thr = -1; unsigned cab = 0;
#pragma unroll
                        for (int j = 7; j >= 0; --j)
#pragma unroll
                            for (int hh = 1; hh >= 0; --hh) { const unsigned cn = (w8[j] >> (16 * hh)) & 0xffffu;
                                if (thr < 0 && run + cn >= (unsigned)TOPK) { thr = 2 * (504 - 8 * lane + j) + hh; cab = run; }
                                run += cn; }
                        const unsigned long long bl = __ballot(inc >= (unsigned)TOPK);
                        int thq = -1; unsigned cbq = 0;
                        if (bl) { const int L = __ffsll((long long)bl) - 1; thq = __shfl(thr, L); cbq = __shfl(cab, L); }
                        (void)cbq;
                        if (q4 == 2 * hi) thrX = thq; if (q4 == 2 * hi + 1) thrY = thq;
                    }
                }
            }
            }
#undef MA_STAGE
            {
                const unsigned c0 = (unsigned)__shfl((int)cntX, 0), c2 = (unsigned)__shfl((int)cntX, 32), c1 = (unsigned)__shfl((int)cntY, 0), c3 = (unsigned)__shfl((int)cntY, 32);
                const unsigned k0 = (unsigned)__shfl((int)ccX, 0), k2 = (unsigned)__shfl((int)ccX, 32), k1 = (unsigned)__shfl((int)ccY, 0), k3 = (unsigned)__shfl((int)ccY, 32);
#pragma unroll 1
                for (int q4 = 0; q4 < 4; ++q4) {
                    const unsigned cnt = (q4 == 0) ? c0 : (q4 == 1) ? c1 : (q4 == 2) ? c2 : c3; unsigned cc = (q4 == 0) ? k0 : (q4 == 1) ? k1 : (q4 == 2) ? k2 : k3;
                    if (cc > 128u) cc = 128u;
                    LAS unsigned* nfp = (LAS unsigned*)(lds + A_BIAS + 1024) + wave * 4 + q4;
                    if (lane == 0) *nfp = cnt;
                    if (cnt >= (unsigned)TOPK || cc == 0u) continue;
                    const unsigned need = (unsigned)TOPK - cnt;
                    const LAS float* cs = (const LAS float*)(lds + A_CAND + (wave * 4 + q4) * 768); const LAS bf16* ci = (const LAS bf16*)(lds + A_CAND + (wave * 4 + q4) * 768 + 512);
                    LAS bf16* so = (LAS bf16*)(lds + A_SEL + (wave * 4 + q4) * 512);
                    unsigned base = cnt;
#pragma unroll 1
                    for (unsigned r0 = 0; r0 < cc; r0 += 64) { const unsigned i = r0 + lane; const bool act = i < cc;
                        const float si = act ? cs[i] : 0.f; const unsigned ii = act ? ci[i] : 0u; unsigned rank = 0;
                        for (unsigned j = 0; j < cc; ++j) { const float sj = cs[j]; const unsigned ij = ci[j]; rank += (sj > si || (sj == si && ij < ii)) ? 1u : 0u; }
                        const bool take = act && rank < need;
                        const unsigned long long bt = __ballot(take);
                        if (take) so[base + __popcll(bt & ((1ull << lane) - 1ull))] = (bf16)ii;
                        base += __popcll(bt); }
                    if (lane == 0) *nfp = base;
                }
            }
            RAW_BARRIER();
#pragma unroll 1
            for (int rep9 = 0; rep9 < ((PROBE == 9 || PROBE == 10 || PROBE == 11) ? 2 : 1); ++rep9) {
                bf16* OUTP_ = ((PROBE == 9 || PROBE == 10 || PROBE == 11) && rep9 == 0) ? OUTA2 : OUTA;
                LAS unsigned char* gb = lds + wave * 16384;
                LAS bf16* bkt = (LAS bf16*)(lds + A_BKT + wave * 512);
#pragma unroll 1
                for (int q4 = 0; q4 < 4; ++q4) { int ns = (int)((const LAS unsigned*)(lds + A_BIAS + 1024))[wave * 4 + q4]; ns = ns < TOPK ? ns : TOPK; LAS bf16* so = (LAS bf16*)(lds + A_SEL + (wave * 4 + q4) * 512);
                    for (int i = lane; i < TOPK; i += 64) if (i >= ns) so[i] = 0; }
                asm volatile("s_waitcnt lgkmcnt(0)" ::: "memory");
                const int Xk = ((kl & 3) << 2) | ((kl >> 2) & 3);
                const int q_ = (lane & 15) >> 2, p_ = lane & 3, g1 = (lane >> 4) & 1;
                const int hc = kl < 8 ? kl : 7;
#define MA_GATHER(q4_, c8_, buf_) do { const LAS bf16* so_ = (const LAS bf16*)(lds + A_SEL + (wave * 4 + (q4_)) * 512) + (c8_) * 32; \
                    _Pragma("unroll") for (int i_ = 0; i_ < 8; ++i_) { const int row_ = 4 * i_ + (lane >> 4); const int idx_ = (PROBE == 10 && rep9 == 0) ? row_ : (int)so_[row_]; \
                        const int ch_ = (lane & 15) ^ (((row_ & 3) << 2) | ((row_ >> 2) & 3)); \
                        glds16(KVN + (size_t)(rb + idx_) * 128 + ch_ * 8, gb + (buf_) * 8192 + i_ * 1024); } } while (0)
                MA_GATHER(0, 0, 0);
#pragma unroll 1
                for (int q4 = 0; q4 < 4; ++q4) {
                    const int t = tw + q4; int ns = (int)((const LAS unsigned*)(lds + A_BIAS + 1024))[wave * 4 + q4]; ns = ns < TOPK ? ns : TOPK;
                    const LAS bf16* so = (const LAS bf16*)(lds + A_SEL + (wave * 4 + q4) * 512);
                    for (int i = lane; i < TOPK; i += 64) { const int d = t - (int)so[i]; lds_st_b16_asm(bkt + i, (unsigned)(rel_bucket(d < 0 ? 0 : d) * 8)); }
                    bf16x8 bq[8];
#pragma unroll
                    for (int ks = 0; ks < 8; ++ks) { bq[ks] = (bf16x8){0, 0, 0, 0, 0, 0, 0, 0}; if (kl < 8) bq[ks] = *(const bf16x8*)(QLAT + (size_t)(rb + t) * 1024 + kl * 128 + 16 * ks + 8 * hi); }
                    f32x16 O[4];
#pragma unroll
                    for (int dq = 0; dq < 4; ++dq)
#pragma unroll
                        for (int r = 0; r < 16; ++r) O[dq][r] = 0.f;
                    float mref = -INFINITY, lsum = 0.f;
#pragma unroll 1
                    for (int c8 = 0; c8 < 8; ++c8) {
                        const int step = q4 * 8 + c8, buf = step & 1;
                        asm volatile("s_waitcnt lgkmcnt(0)" ::: "memory");
                        if (step + 1 < 32) { MA_GATHER((step + 1) >> 3, (step + 1) & 7, buf ^ 1); asm volatile("s_waitcnt vmcnt(8)" ::: "memory"); }
                        else asm volatile("s_waitcnt vmcnt(0)" ::: "memory");
                        const LAS unsigned char* cb = gb + buf * 8192;
                        if (PROBE == 11 && rep9 == 0) continue;
                        f32x16 s;
#pragma unroll
                        for (int r = 0; r < 16; ++r) s[r] = 0.f;
#pragma unroll
                        for (int ks = 0; ks < 8; ++ks) { const bf16x8 kf = *(const LAS bf16x8*)(cb + 256 * kl + 16 * ((2 * ks + hi) ^ Xk)); s = __builtin_amdgcn_mfma_f32_32x32x16_bf16(kf, bq[ks], s, 0, 0, 0); }
#pragma unroll
                        for (int r = 0; r < 16; ++r) { const int j = c8 * 32 + crow(r, hi); const float bv = biasl[(int)bkt[j] + hc];
                            const float vv = fmaf(s[r], C2, bv); s[r] = (j < ns) ? vv : -INFINITY; }
                        float rm = s[0];
#pragma unroll
                        for (int r = 1; r < 16; ++r) rm = fmaxf(rm, s[r]);
                        rm = swap_max(rm);
                        if (__any(rm > mref + THR)) {
                            const float mn = fmaxf(mref, rm), f = (mn == -INFINITY) ? 1.f : __builtin_amdgcn_exp2f(mref - mn);
                            lsum *= f; mref = mn;
#pragma unroll
                            for (int dq = 0; dq < 4; ++dq)
#pragma unroll
                                for (int r = 0; r < 16; ++r) O[dq][r] *= f;
                        }
                        const float msub = (mref == -INFINITY) ? 0.f : mref;
                        float ps = 0.f;
#pragma unroll
                        for (int r = 0; r < 16; ++r) { s[r] = __builtin_amdgcn_exp2f(s[r] - msub); ps += s[r]; }
                        lsum += ps;
                        bf16x8 pf[2];
                        { v4u w;
                          w.x = cvtpk(s[0], s[1]); w.y = cvtpk(s[2], s[3]); w.z = cvtpk(s[4], s[5]); w.w = cvtpk(s[6], s[7]); pf[0] = __builtin_bit_cast(bf16x8, w);
                          w.x = cvtpk(s[8], s[9]); w.y = cvtpk(s[10], s[11]); w.z = cvtpk(s[12], s[13]); w.w = cvtpk(s[14], s[15]); pf[1] = __builtin_bit_cast(bf16x8, w); }
                        {
                            s16x4 fa[8];
#define MA_RD(f, sp_) do { const int rlo_ = 16 * (sp_) + 4 * hi + q_, rhi_ = rlo_ + 8; \
                                _Pragma("unroll") for (int dq_ = 0; dq_ < 4; ++dq_) { const int ch_ = 4 * dq_ + 2 * g1 + (p_ >> 1); \
                                    f[2 * dq_] = tr16_asm(cb + 256 * rlo_ + 16 * (ch_ ^ ((q_ << 2) | (hi & 3))) + 8 * (p_ & 1)); \
                                    f[2 * dq_ + 1] = tr16_asm(cb + 256 * rhi_ + 16 * (ch_ ^ ((q_ << 2) | ((hi + 2) & 3))) + 8 * (p_ & 1)); } } while (0)
                            MA_RD(fa, 0);
                            LGKM_WAIT8(0, fa);
#pragma unroll
                            for (int dq = 0; dq < 4; ++dq) O[dq] = __builtin_amdgcn_mfma_f32_32x32x16_bf16(VFRAG(fa, dq), pf[0], O[dq], 0, 0, 0);
                            MA_RD(fa, 1);
                            LGKM_WAIT8(0, fa);
#pragma unroll
                            for (int dq = 0; dq < 4; ++dq) O[dq] = __builtin_amdgcn_mfma_f32_32x32x16_bf16(VFRAG(fa, dq), pf[1], O[dq], 0, 0, 0);
#undef MA_RD
                        }
                    }
                    const float inv = 1.0f / swap_add(lsum);
                    if (kl < 8) { bf16* orow = OUTP_ + (size_t)(rb + t) * 1024 + kl * 128;
#pragma unroll
                        for (int dq = 0; dq < 4; ++dq)
#pragma unroll
                            for (int g4 = 0; g4 < 4; ++g4) { const int d0 = dq * 32 + 8 * g4 + 4 * hi;
                                v2u w; w.x = pk2(O[dq][4 * g4] * inv, O[dq][4 * g4 + 1] * inv); w.y = pk2(O[dq][4 * g4 + 2] * inv, O[dq][4 * g4 + 3] * inv);
                                *(v2u*)(orow + d0) = w; } }
                }
#undef MA_GATHER
                asm volatile("s_waitcnt vmcnt(0)" ::: "memory");
            }
        }
    }
}
#define Y_() (WSP() + WS_Y)
#define WL_(l) (WSP() + WS_W + (size_t)(l) * W_LAYER)
#define MOD_(l) ((const float*)(WSP() + WS_MOD) + (size_t)(l) * 8 * 6144)
#define T_() ((const float*)(WSP() + WS_TAB))
#define H_() ((bf16*)(WSP() + WS_H))
#define KVN_() ((bf16*)(WSP() + WS_KVN))
#define KMAXW_(l, ch) ((unsigned*)(WSP() + WS_CTL) + 8192 + ((l) * NCH + (ch)) * 64)
#define LAMI_(l) (((l) == 0) ? 0.8f : 0.64449093f)
__device__ __forceinline__ int tidx() { int t = (int)threadIdx.x; asm volatile("" : "+v"(t)); return t; }
#define TID_ tidx()
#define LANE_ (tidx() & 63)
__global__ void __launch_bounds__(NTHREADS, 2) fwd(Args a) {
    extern __shared__ __attribute__((aligned(16))) unsigned char lds_raw[];
    LAS unsigned char* lds = (LAS unsigned char*)lds_raw;
    const int wave = __builtin_amdgcn_readfirstlane((int)threadIdx.x >> 6);
    const int G = gridDim.x, gw = blockIdx.x * NWAVES + wave, NGW = G * NWAVES;
    for (int u = (int)threadIdx.x; u < (LDS_BYTES - LDSCTL_OFF) / 4; u += NTHREADS) ((LAS unsigned*)(lds + LDSCTL_OFF))[u] = 0u;
    __syncthreads();
    XcdBarrier bar = xcd_barrier_post((unsigned*)(WSP() + WS_CTL) + CW_BAR, (volatile LAS unsigned*)(lds + LDSCTL_OFF));

#pragma unroll 1
    for (int rep = 0; rep < (PROBE == 5 ? 2 : 1); ++rep) {
    p0a_prologue(WSP(), lds, TID_, LANE_, wave, G);
    xcd_barrier(bar); }
    norm_rows(ARG(0), H_(), ARG(4), MOD_(0) + 0 * 1024, MOD_(0) + 1 * 1024, gw, NGW, LANE_);
    xcd_barrier(bar);

#pragma unroll 1
    for (int l = 0; l < NL; ++l) {
#pragma unroll 1
        for (int ch = 0; ch < NCH; ++ch) {
            { pg8::Gemm g{H_() + (size_t)ch * CHR * 1024, (const bf16*)(WL_(l) + W_IN), CHR, NIN, 1024}; pg8::StaticOrder S; S.init(CHR, NIN, G, (int)blockIdx.x);
              pg8::EpiIn E{Y_()};
#pragma unroll 1
              for (int rep = 0; rep < (PROBE == 1 ? 2 : 1); ++rep)
              pg8::gemm_phase<pg8::EpiIn, pg8::StaticOrder, true, true>(lds, g, S, E);
            }
            xcd_barrier(bar);
            kvn_rows(Y_(), KVN_(), ARG(8) + l * 128, KMAXW_(l, ch), gw, NGW, LANE_);
#if PROBE == 4
            mixC_fast(Y_(), WSP(), T_(), lds, TID_, LANE_, wave, G);
#endif
            mixC_fast(Y_(), WSP(), T_(), lds, TID_, LANE_, wave, G);
#if PROBE == 2 || (PROBE >= 12 && PROBE <= 14)
            mixB_fast<(PROBE == 2 ? 0 : PROBE - 11)>(Y_(), (bf16*)(WSP() + 484 * MiB), T_(), ARG(13) + l * 128, ((const float*)(WSP() + WS_LAM))[l], LAMI_(l), lds, TID_, LANE_, wave, G);
#endif
            mixB_fast<0>(Y_(), (bf16*)(Y_() + Y_BQ), T_(), ARG(13) + l * 128, ((const float*)(WSP() + WS_LAM))[l], LAMI_(l), lds, TID_, LANE_, wave, G);
            xcd_barrier(bar);
            mergeC(Y_(), WSP(), gw, NGW, LANE_);
#if PROBE == 3 || PROBE == 9 || PROBE == 10 || PROBE == 11
            xcd_barrier(bar);
#endif
#if PROBE == 3
            mixA_fast(Y_(), (bf16*)(WSP() + WS_OG), (bf16*)(WSP() + WS_OG), KVN_(), T_(), ARG(21), KMAXW_(l, ch), lds, TID_, LANE_, wave, G);
#endif
            mixA_fast(Y_(), (bf16*)(Y_() + Y_QLAT), (bf16*)(WSP() + WS_OG), KVN_(), T_(), ARG(21), KMAXW_(l, ch), lds, TID_, LANE_, wave, G);
            xcd_barrier(bar);
#pragma unroll 1
            for (int rep = 0; rep < (PROBE == 7 ? 2 : 1); ++rep)
            { pg8::StaticOrder S; S.init(CHR, 1024, G, (int)blockIdx.x);
              { unsigned char* y = Y_(); pg8::Gemm g{(const bf16*)(y + Y_QLAT), (const bf16*)(WL_(l) + W_A), CHR, 1024, 1024}; pg8::EpiGate<0> E{(const bf16*)(y + Y_Z), 0, (float*)(y + Y_MF32), (bf16*)(y + Y_MBF)};
                pg8::gemm_phase<pg8::EpiGate<0>, pg8::StaticOrder, true, true>(lds, g, S, E); }
              { unsigned char* y = Y_(); pg8::Gemm g{(const bf16*)(y + Y_BQ), (const bf16*)(WL_(l) + W_B), CHR, 1024, 512}; pg8::EpiGate<1> E{(const bf16*)(y + Y_Z), 1024, (float*)(y + Y_MF32), (bf16*)(y + Y_MBF)};
                pg8::gemm_phase<pg8::EpiGate<1>, pg8::StaticOrder, true, true>(lds, g, S, E); }
              { unsigned char* y = Y_(); pg8::Gemm g{(const bf16*)(y + Y_OC), (const bf16*)(WL_(l) + W_C), CHR, 1024, 256}; pg8::EpiGate<2> E{(const bf16*)(y + Y_Z), 2048, (float*)(y + Y_MF32), (bf16*)(y + Y_MBF)};
                pg8::gemm_phase<pg8::EpiGate<2>, pg8::StaticOrder, true, true>(lds, g, S, E); } }
            xcd_barrier(bar);
            { pg8::Gemm g{(const bf16*)(Y_() + Y_MBF), (const bf16*)(WL_(l) + W_OUT), CHR, 1024, 1024}; pg8::StaticOrder S; S.init(CHR, 1024, G, (int)blockIdx.x);
              pg8::EpiRes E{(l == 0) ? ARG(0) : (const float*)OUTP(), OUTP(), MOD_(l) + 2 * 1024, ch * CHR};
              pg8::gemm_phase<pg8::EpiRes, pg8::StaticOrder, true, true>(lds, g, S, E); }
            xcd_barrier(bar);
        }
#pragma unroll 1
        for (int rep = 0; rep < (PROBE == 6 ? 2 : 1); ++rep) {
        norm_rows(OUTP(), H_(), ARG(18) + l * 1024, MOD_(l) + 3 * 1024, MOD_(l) + 4 * 1024, gw, NGW, LANE_);
        xcd_barrier(bar); }
        { pg8::Gemm g{H_(), (const bf16*)(WL_(l) + W_GU), MT, NGU, 1024}; pg8::StaticOrder S; S.init(MT, NGU, G, (int)blockIdx.x);
          pg8::EpiSwiGLU E{(bf16*)(WSP() + WS_ACT)};
#pragma unroll 1
          for (int rep = 0; rep < (PROBE == 1 ? 2 : 1); ++rep)
          pg8::gemm_phase<pg8::EpiSwiGLU, pg8::StaticOrder, true, true>(lds, g, S, E);
        }
        xcd_barrier(bar);
        { pg8::Gemm g{(const bf16*)(WSP() + WS_ACT), (const bf16*)(WL_(l) + W_D), MT, 1024, DFF}; pg8::StaticOrder S; S.init(MT, 1024, G, (int)blockIdx.x);
          pg8::EpiRes E{OUTP(), OUTP(), MOD_(l) + 5 * 1024, 0};
          pg8::gemm_phase<pg8::EpiRes, pg8::StaticOrder, true, true>(lds, g, S, E); }
        xcd_barrier(bar);
        if (l + 1 < NL) { norm_rows(OUTP(), H_(), ARG(4) + (l + 1) * 1024, MOD_(l + 1) + 0 * 1024, MOD_(l + 1) + 1 * 1024, gw, NGW, LANE_); xcd_barrier(bar); }
        else final_rows(OUTP(), ARG(22), gw, NGW, LANE_);
    }
}

extern "C" void kernel_launch(void* const* d_in, const int* in_sizes, int n_in, void* d_out, int out_size, void* d_ws, size_t ws_size, hipStream_t stream) {
    static int grid = 0;
    if (grid == 0) {
        if (n_in != 23 || out_size != MT * DM || ws_size < WS_END) { fprintf(stderr, "kernel_launch: unexpected shapes (n_in %d out %d ws %zu)\n", n_in, out_size, ws_size); grid = -1; return; }
        int dev = 0, cus = 0, per_cu = 0;
        if (hipGetDevice(&dev) != hipSuccess || hipDeviceGetAttribute(&cus, hipDeviceAttributeMultiprocessorCount, dev) != hipSuccess) { grid = -1; return; }
        if (hipFuncSetAttribute((const void*)fwd, hipFuncAttributeMaxDynamicSharedMemorySize, LDS_BYTES) != hipSuccess) { fprintf(stderr, "kernel_launch: hipFuncSetAttribute failed\n"); grid = -1; return; }
        if (hipOccupancyMaxActiveBlocksPerMultiprocessor(&per_cu, (const void*)fwd, NTHREADS, LDS_BYTES) != hipSuccess || per_cu < 1) { fprintf(stderr, "kernel_launch: occupancy query says %d\n", per_cu); }
        (void)hipGetLastError();
        grid = cus;
    }
    if (grid < 0) return;
    (void)hipMemsetAsync((char*)d_ws + WS_CTL, 0, CTL_ZERO_BYTES, stream);
    Args a{};
    for (int i = 0; i < 23; ++i) a.in[i] = (const float*)d_in[i];
    a.out = (float*)d_out; a.ws = (unsigned char*)d_ws; a.pad0 = 0; a.pad1 = 0;
    hipLaunchKernelGGL(fwd, dim3(grid), dim3(NTHREADS), LDS_BYTES, stream, a);
}
```

```cpp
#include <hip/hip_runtime.h>
#include <cstdio>
#include <cstdint>
#ifndef PROBE
#define PROBE 0
#endif
namespace pg8 {
#define PG8_LAS __attribute__((address_space(3)))
typedef unsigned short bf16_t;
typedef short bf16x8 __attribute__((ext_vector_type(8)));
typedef float f32x4 __attribute__((ext_vector_type(4)));
typedef unsigned u32x4 __attribute__((ext_vector_type(4)));
constexpr int BM = 256, BK = 64, HALF = 128, HTB = HALF * BK * 2  , STAGE_BYTES = 8 * HTB, NXCD = 8, WGM = 8;

__host__ __device__ __forceinline__ int lds_byte(int r, int c) { const int st = (r >> 4) * 2 + (c >> 5), rr = r & 15, cc = c & 31, ob = rr * 64 + cc * 2; return st * 1024 + (ob ^ (((ob >> 9) & 1) << 5)); }
__host__ __device__ __forceinline__ void stage_rc(int b, int& R, int& C) { const int st = b / 1024, sb = b % 1024, swz = sb ^ (((sb >> 9) & 1) << 5); R = (st >> 1) * 16 + swz / 64; C = (st & 1) * 32 + (swz % 64) / 2; }
__host__ __device__ __forceinline__ int perm32(int rho) { const int n = rho >> 4, i = rho & 15; return 8 * (i >> 2) + 4 * n + (i & 3); }

struct Unit { int pm, pn; };
struct Gemm { const bf16_t* A; const bf16_t* Bt; int M, N, K; };

struct StaticOrder {
    int nM, nN, nwg, G, c;
    __host__ __device__ void init(int M, int N, int G_, int c_) { nM = M / BM; nN = N / BM; nwg = nM * nN; G = G_; c = c_; }
    __host__ __device__ bool next(int i, Unit& u) const {
        const long L = (long)i * G + c; if (L >= nwg) return false;
        int wgid = (int)L; { const int q = nwg / NXCD, r = nwg % NXCD, xcd = wgid % NXCD, off = wgid / NXCD; wgid = (xcd < r ? xcd * (q + 1) : r * (q + 1) + (xcd - r) * q) + off; }
        const int nig = WGM * nN, gid = wgid / nig, fm = gid * WGM, gsz = (nM - fm) < WGM ? (nM - fm) : WGM;
        u.pm = fm + ((wgid % nig) % gsz); u.pn = (wgid % nig) / gsz; return true;
    }
    __device__ __forceinline__ void a_ready(const Unit&) const {}
    __device__ __forceinline__ void done(const Unit&) const {}
};

template <class Epi, class Sched, bool ALIGN_EPI = false, bool SP2 = false>
__device__ __forceinline__ void gemm_phase(PG8_LAS unsigned char* lds, const Gemm g, const Sched& S, const Epi& E) {
    int tid_l = threadIdx.x; asm volatile("" : "+v"(tid_l));
    const int tid = tid_l, wid = __builtin_amdgcn_readfirstlane(tid >> 6), lane = tid & 63, wr = wid >> 2, wc = wid & 3, fr = lane & 15, fq = lane >> 4;
    int K_l = g.K; asm volatile("" : "+s"(K_l));
    const int K = K_l, nt = K / BK;
    unsigned voffA[2], voffB[2];
#pragma unroll
    for (int i = 0; i < 2; ++i) { int R, C; stage_rc(tid * 16 + i * 8192, R, C); const int Rb = Epi::PERM ? ((R & ~31) + perm32(R & 31)) : R;
        voffA[i] = (unsigned)(R * K + C) * 2u; voffB[i] = (unsigned)(Rb * K + C) * 2u; }
    const size_t kstep = (size_t)(BK * 2);
    const size_t hstep = (size_t)HALF * K * 2;
    const size_t tstep = 2 * hstep;
    const unsigned ldsw = (unsigned)wid * 1024u;
    const int aoff = lds_byte(wr * 64 + fr, fq * 8), boff = lds_byte(wc * 32 + fr, fq * 8);
#define PG8_SA(b, h) (((b) * 2 + (h)) * HTB)
#define PG8_SB(b, h) ((4 + (b) * 2 + (h)) * HTB)
#define PG8_STAGE(bufoff, gbase, voff) do { _Pragma("unroll") for (int _i = 0; _i < 2; ++_i) \
        __builtin_amdgcn_global_load_lds((const unsigned*)((const char*)(gbase) + (voff)[_i]), (PG8_LAS unsigned*)(lds + (bufoff) + ldsw + _i * 8192), 16, 0, 0); } while (0)
#define PG8_LDA(dst, b, h) do { _Pragma("unroll") for (int m = 0; m < 4; ++m) _Pragma("unroll") for (int k = 0; k < 2; ++k) dst[m][k] = *(const PG8_LAS bf16x8*)(lds + PG8_SA(b, h) + aoff + m * 2048 + k * 1024); } while (0)
#define PG8_LDB(dst, b, h) do { _Pragma("unroll") for (int n = 0; n < 2; ++n) _Pragma("unroll") for (int k = 0; k < 2; ++k) dst[n][k] = *(const PG8_LAS bf16x8*)(lds + PG8_SB(b, h) + boff + n * 2048 + k * 1024); } while (0)
#define PG8_MMA(ai, bj, At, Bt) do { __builtin_amdgcn_s_setprio(1); _Pragma("unroll") for (int m = 0; m < 4; ++m) _Pragma("unroll") for (int n = 0; n < 2; ++n) _Pragma("unroll") for (int k = 0; k < 2; ++k) \
        acc[ai][bj][m][n] = __builtin_amdgcn_mfma_f32_16x16x32_bf16(Bt[n][k], At[m][k], acc[ai][bj][m][n], 0, 0, 0); __builtin_amdgcn_s_setprio(0); } while (0)
#define PG8_WAIT_V(n) asm volatile("s_waitcnt vmcnt(" #n ")" ::: "memory")
#define PG8_WAIT_L(n) asm volatile("s_waitcnt lgkmcnt(" #n ")" ::: "memory")
#define PG8_BAR __builtin_amdgcn_s_barrier()
#define PG8_SCHED __builtin_amdgcn_sched_barrier(0)
    Unit cur, nxt; int ui = 0;
    if (!S.next(0, cur)) return;
    f32x4 acc[2][2][4][2];
#pragma unroll
    for (int a = 0; a < 2; ++a)
#pragma unroll
        for (int b = 0; b < 2; ++b)
#pragma unroll
            for (int m = 0; m < 4; ++m)
#pragma unroll
                for (int n = 0; n < 2; ++n) acc[a][b][m][n] = (f32x4){0.f, 0.f, 0.f, 0.f};
    bf16x8 At[4][2], B0[2][2], B1[2][2];
    const char* cA = (const char*)g.A + (size_t)cur.pm * tstep; const char* cB = (const char*)g.Bt + (size_t)cur.pn * tstep;
    S.a_ready(cur);
    if constexpr (SP2) {
        PG8_STAGE(PG8_SB(0, 0), cB, voffB); PG8_STAGE(PG8_SB(0, 1), cB + hstep, voffB); PG8_STAGE(PG8_SA(0, 0), cA, voffA); PG8_STAGE(PG8_SA(0, 1), cA + hstep, voffA);
        if (wr == 1) PG8_BAR;
        PG8_WAIT_V(2); PG8_BAR;
        PG8_STAGE(PG8_SB(1, 0), cB + kstep, voffB); PG8_STAGE(PG8_SA(1, 0), cA + kstep, voffA); PG8_STAGE(PG8_SB(1, 1), cB + hstep + kstep, voffB);
        PG8_WAIT_V(6); PG8_BAR;
    } else {
        PG8_STAGE(PG8_SB(0, 0), cB, voffB); PG8_STAGE(PG8_SA(0, 0), cA, voffA); PG8_STAGE(PG8_SB(0, 1), cB + hstep, voffB); PG8_STAGE(PG8_SA(0, 1), cA + hstep, voffA);
        if (wr == 1) PG8_BAR;
        PG8_WAIT_V(4); PG8_BAR;
        PG8_STAGE(PG8_SB(1, 0), cB + kstep, voffB); PG8_STAGE(PG8_SA(1, 0), cA + kstep, voffA); PG8_STAGE(PG8_SB(1, 1), cB + hstep + kstep, voffB);
        PG8_WAIT_V(6); PG8_BAR;
    }
    for (;;) {
        const bool has_next = S.next(ui + 1, nxt);
        const char* nA = has_next ? (const char*)g.A + (size_t)nxt.pm * tstep : cA; const char* nB = has_next ? (const char*)g.Bt + (size_t)nxt.pn * tstep : cB;
        for (int t = 0; t < nt; t += 2) {
            const bool last = (t == nt - 2);
            const char* a1 = cA + (size_t)(t + 1) * kstep;
            const char* a2 = last ? nA : cA + (size_t)(t + 2) * kstep; const char* b2 = last ? nB : cB + (size_t)(t + 2) * kstep;
            const char* a3 = a2 + kstep; const char* b3 = b2 + kstep;
            if (last && has_next) S.a_ready(nxt);
            if constexpr (SP2) {
            PG8_LDB(B0, 0, 0); PG8_LDB(B1, 0, 1); PG8_SCHED; PG8_LDA(At, 0, 0); PG8_STAGE(PG8_SA(1, 1), a1 + hstep, voffA);
            PG8_WAIT_V(8); PG8_WAIT_L(0); PG8_BAR; PG8_MMA(0, 0, At, B0); PG8_MMA(0, 1, At, B1); PG8_BAR; PG8_SCHED;
            PG8_LDA(At, 0, 1); PG8_STAGE(PG8_SB(0, 0), b2, voffB); PG8_STAGE(PG8_SB(0, 1), b2 + hstep, voffB); PG8_STAGE(PG8_SA(0, 0), a2, voffA);
            PG8_WAIT_V(8); PG8_WAIT_L(0); PG8_BAR; PG8_MMA(1, 0, At, B0); PG8_MMA(1, 1, At, B1); PG8_BAR; PG8_SCHED;
            PG8_LDB(B0, 1, 0); PG8_LDB(B1, 1, 1); PG8_SCHED; PG8_LDA(At, 1, 0); PG8_STAGE(PG8_SA(0, 1), a2 + hstep, voffA);
            PG8_WAIT_V(8); PG8_WAIT_L(0); PG8_BAR; PG8_MMA(0, 0, At, B0); PG8_MMA(0, 1, At, B1); PG8_BAR; PG8_SCHED;
            PG8_LDA(At, 1, 1); PG8_STAGE(PG8_SB(1, 0), b3, voffB); PG8_STAGE(PG8_SB(1, 1), b3 + hstep, voffB); PG8_STAGE(PG8_SA(1, 0), a3, voffA);
            PG8_WAIT_V(8); PG8_WAIT_L(0); PG8_BAR; PG8_MMA(1, 0, At, B0); PG8_MMA(1, 1, At, B1); PG8_BAR; PG8_SCHED;
            } else {
            PG8_LDB(B0, 0, 0); PG8_SCHED; PG8_LDA(At, 0, 0); PG8_STAGE(PG8_SA(1, 1), a1 + hstep, voffA);
            PG8_WAIT_L(8); PG8_BAR; PG8_WAIT_L(0); PG8_MMA(0, 0, At, B0); PG8_BAR; PG8_SCHED;
            PG8_LDB(B1, 0, 1); PG8_STAGE(PG8_SB(0, 0), b2, voffB);
            PG8_BAR; PG8_WAIT_L(0); PG8_MMA(0, 1, At, B1); PG8_BAR;
            PG8_LDA(At, 0, 1); PG8_STAGE(PG8_SA(0, 0), a2, voffA);
            PG8_BAR; PG8_WAIT_L(0); PG8_MMA(1, 0, At, B0); PG8_BAR; PG8_SCHED;
            PG8_STAGE(PG8_SB(0, 1), b2 + hstep, voffB);
            PG8_WAIT_V(6); PG8_BAR; PG8_MMA(1, 1, At, B1); PG8_BAR;
            PG8_LDB(B0, 1, 0); PG8_SCHED; PG8_LDA(At, 1, 0); PG8_STAGE(PG8_SA(0, 1), a2 + hstep, voffA);
            PG8_WAIT_L(8); PG8_BAR; PG8_WAIT_L(0); PG8_MMA(0, 0, At, B0); PG8_BAR; PG8_SCHED;
            PG8_LDB(B1, 1, 1); PG8_STAGE(PG8_SB(1, 0), b3, voffB);
            PG8_BAR; PG8_WAIT_L(0); PG8_MMA(0, 1, At, B1); PG8_BAR;
            PG8_LDA(At, 1, 1); PG8_STAGE(PG8_SA(1, 0), a3, voffA);
            PG8_BAR; PG8_WAIT_L(0); PG8_MMA(1, 0, At, B0); PG8_BAR; PG8_SCHED;
            PG8_STAGE(PG8_SB(1, 1), b3 + hstep, voffB);
            PG8_WAIT_V(6); PG8_BAR; PG8_MMA(1, 1, At, B1); PG8_BAR;
            }
        }
        if constexpr (ALIGN_EPI) { if (wr == 0) PG8_BAR; }
        if constexpr (!Epi::AFTER_DRAIN) { E(acc, cur, wr, wc, fr, fq); S.done(cur); }
        if (!has_next) break;
#pragma unroll
        for (int a = 0; a < 2; ++a)
#pragma unroll
            for (int b = 0; b < 2; ++b)
#pragma unroll
                for (int m = 0; m < 4; ++m)
#pragma unroll
                    for (int n = 0; n < 2; ++n) acc[a][b][m][n] = (f32x4){0.f, 0.f, 0.f, 0.f};
        cur = nxt; cA = nA; cB = nB; ++ui;
        if constexpr (ALIGN_EPI) { if (wr == 1) PG8_BAR; }
    }
    PG8_WAIT_V(0);
    if constexpr (!ALIGN_EPI) { if (wr == 0) PG8_BAR; }
    PG8_BAR;
    if constexpr (Epi::AFTER_DRAIN) { E.fused(acc, cur, wr, wc, fr, fq, lds, wid, lane); S.done(cur); }
#undef PG8_SA
#undef PG8_SB
#undef PG8_STAGE
#undef PG8_LDA
#undef PG8_LDB
#undef PG8_MMA
#undef PG8_WAIT_V
#undef PG8_WAIT_L
#undef PG8_BAR
#undef PG8_SCHED
}
}

constexpr int NB = 8, SEQ = 4096, DM = 1024, MT = NB * SEQ, NL = 2;
constexpr int CHB = 4, CHR = CHB * SEQ, NCH = NB / CHB;
constexpr int NIN = 8704, DFF = 2816, NGU = 2 * DFF, WIN_SRC = 8136;
constexpr int TOPK = 256;
constexpr float EPS = 1e-6f;
constexpr int NWAVES = 8, NTHREADS = 512;

constexpr size_t MiB = 1u << 20;
constexpr size_t WS_CTL = 0, CTL_ZERO_BYTES = 1 * MiB;
constexpr size_t WS_MOD = 1 * MiB;
constexpr size_t WS_TAB = WS_MOD + 393216;
constexpr size_t WS_LAM = WS_TAB + 393216;
constexpr size_t WS_W = 2 * MiB, W_LAYER = 39 * MiB;
constexpr size_t W_IN = 0, W_A = 17 * MiB, W_B = 19 * MiB, W_C = 20 * MiB, W_OUT = 20 * MiB + 512 * 1024, W_GU = 22 * MiB + 512 * 1024, W_D = 33 * MiB + 512 * 1024;
constexpr size_t WS_H = 80 * MiB;
constexpr size_t WS_Y = 144 * MiB;
constexpr size_t Y_QLAT = 0, Y_MISC = 32 * MiB, Y_IQ = 40 * MiB, Y_BQ = 56 * MiB, Y_BK = 72 * MiB, Y_BV = 88 * MiB, Y_CQ = 104 * MiB, Y_CK = 128 * MiB, Y_CV = 152 * MiB, Y_Z = 176 * MiB, Y_OC = 272 * MiB;
constexpr size_t Y_MF32 = Y_CQ, Y_MBF = Y_BK;
constexpr size_t WS_ACT = WS_Y;
constexpr size_t WS_KVN = 424 * MiB;
constexpr size_t WS_END = 428 * MiB;
constexpr int CW_BAR = 4096;

#define GAS __attribute__((address_space(1)))
#define LAS __attribute__((address_space(3)))
typedef unsigned short bf16;
typedef unsigned v4u __attribute__((ext_vector_type(4)));
typedef unsigned v2u __attribute__((ext_vector_type(2)));
typedef float f32x4 __attribute__((ext_vector_type(4)));

__device__ __forceinline__ unsigned f2bf(float f) { unsigned u = __builtin_bit_cast(unsigned, f); return (u + 0x7fffu + ((u >> 16) & 1u)) >> 16; }
typedef float f32x2_c __attribute__((ext_vector_type(2))); typedef __bf16 bf16x2_c __attribute__((ext_vector_type(2)));
__device__ __forceinline__ unsigned pk2(float lo, float hi) { const f32x2_c v = {lo, hi}; const bf16x2_c b = __builtin_convertvector(v, bf16x2_c); return __builtin_bit_cast(unsigned, b); }
__device__ __forceinline__ float bflo(unsigned w) { return __uint_as_float(w << 16); }
__device__ __forceinline__ float bfhi(unsigned w) { return __uint_as_float(w & 0xffff0000u); }
__device__ __forceinline__ float bf2f(bf16 h) { return __uint_as_float((unsigned)h << 16); }
__device__ __forceinline__ float wave_sum(float v) {
#pragma unroll
    for (int o = 1; o < 64; o <<= 1) v += __shfl_xor(v, o);
    return v;
}
__device__ __forceinline__ float wave_max(float v) {
#pragma unroll
    for (int o = 1; o < 64; o <<= 1) v = fmaxf(v, __shfl_xor(v, o));
    return v;
}
__device__ __forceinline__ float sigmoidf_(float v) { return __builtin_amdgcn_rcpf(1.f + __expf(-v)); }

namespace pg8 {
struct EpiIn {
    static constexpr bool PERM = true, AFTER_DRAIN = false;
    unsigned char* y;
    __device__ __forceinline__ void operator()(const f32x4 (&acc)[2][2][4][2], const Unit& u, int wr, int wc, int fr, int fq) const {
        const int pn = u.pn; size_t off; int ld, c0; bool sig = false;
        if (pn < 4)        { off = Y_QLAT; ld = 1024; c0 = pn * 256; }
        else if (pn == 4)  { off = Y_MISC; ld = 256;  c0 = 0; }
        else if (pn < 7)   { off = Y_IQ;   ld = 512;  c0 = (pn - 5) * 256; }
        else if (pn < 9)   { off = Y_BQ;   ld = 512;  c0 = (pn - 7) * 256; }
        else if (pn < 11)  { off = Y_BK;   ld = 512;  c0 = (pn - 9) * 256; }
        else if (pn < 13)  { off = Y_BV;   ld = 512;  c0 = (pn - 11) * 256; }
        else if (pn < 16)  { off = Y_CQ;   ld = 768;  c0 = (pn - 13) * 256; }
        else if (pn < 19)  { off = Y_CK;   ld = 768;  c0 = (pn - 16) * 256; }
        else if (pn < 22)  { off = Y_CV;   ld = 768;  c0 = (pn - 19) * 256; }
        else               { off = Y_Z;    ld = 3072; c0 = (pn - 22) * 256; sig = true; }
        bf16_t* base = (bf16_t*)(y + off);
        const int row0 = u.pm * BM + wr * 64 + fr, col0 = c0 + wc * 32 + 8 * fq;
#pragma unroll
        for (int ai = 0; ai < 2; ++ai)
#pragma unroll
            for (int m = 0; m < 4; ++m) { bf16_t* rowp = base + (size_t)(row0 + ai * HALF + m * 16) * ld + col0;
#pragma unroll
                for (int bj = 0; bj < 2; ++bj) { f32x4 v0 = acc[ai][bj][m][0], v1 = acc[ai][bj][m][1];
                    if (sig) {
#pragma unroll
                        for (int i = 0; i < 4; ++i) { v0[i] = sigmoidf_(v0[i]); v1[i] = sigmoidf_(v1[i]); } }
                    u32x4 w; w.x = pk2(v0[0], v0[1]); w.y = pk2(v0[2], v0[3]); w.z = pk2(v1[0], v1[1]); w.w = pk2(v1[2], v1[3]);
                    *(u32x4*)(rowp + bj * HALF) = w; } }
    }
};
template <int MODE> struct EpiGate {
    static constexpr bool PERM = true, AFTER_DRAIN = false;
    const bf16_t* z; int zc0; float* mf; bf16_t* mb;
    __device__ __forceinline__ void operator()(const f32x4 (&acc)[2][2][4][2], const Unit& u, int wr, int wc, int fr, int fq) const {
        const int row0 = u.pm * BM + wr * 64 + fr, col0 = u.pn * BM + wc * 32 + 8 * fq;
#pragma unroll
        for (int ai = 0; ai < 2; ++ai)
#pragma unroll
            for (int m = 0; m < 4; ++m) { const size_t row = (size_t)(row0 + ai * HALF + m * 16);
#pragma unroll
                for (int bj = 0; bj < 2; ++bj) { const int col = col0 + bj * HALF;
                    const u32x4 zw = *(const u32x4*)(z + row * 3072 + zc0 + col);
                    f32x4 v0 = acc[ai][bj][m][0], v1 = acc[ai][bj][m][1];
                    v0[0] *= __uint_as_float(zw.x << 16); v0[1] *= __uint_as_float(zw.x & 0xffff0000u); v0[2] *= __uint_as_float(zw.y << 16); v0[3] *= __uint_as_float(zw.y & 0xffff0000u);
                    v1[0] *= __uint_as_float(zw.z << 16); v1[1] *= __uint_as_float(zw.z & 0xffff0000u); v1[2] *= __uint_as_float(zw.w << 16); v1[3] *= __uint_as_float(zw.w & 0xffff0000u);
                    bf16_t* mp = mb + row * 1024 + col;
                    if (MODE >= 1) { const u32x4 pw = *(const u32x4*)mp;
                        v0[0] += __uint_as_float(pw.x << 16); v0[1] += __uint_as_float(pw.x & 0xffff0000u); v0[2] += __uint_as_float(pw.y << 16); v0[3] += __uint_as_float(pw.y & 0xffff0000u);
                        v1[0] += __uint_as_float(pw.z << 16); v1[1] += __uint_as_float(pw.z & 0xffff0000u); v1[2] += __uint_as_float(pw.w << 16); v1[3] += __uint_as_float(pw.w & 0xffff0000u); }
                    { u32x4 w; w.x = pk2(v0[0], v0[1]); w.y = pk2(v0[2], v0[3]); w.z = pk2(v1[0], v1[1]); w.w = pk2(v1[2], v1[3]); *(u32x4*)mp = w; } }
                asm volatile("" ::: "memory"); }
    }
};
struct EpiRes {
    static constexpr bool PERM = true, AFTER_DRAIN = false;
    const float* xin; float* xout; const float* gate; int row_off;
    __device__ __forceinline__ void operator()(const f32x4 (&acc)[2][2][4][2], const Unit& u, int wr, int wc, int fr, int fq) const {
        const int row0 = row_off + u.pm * BM + wr * 64 + fr, col0 = u.pn * BM + wc * 32 + 8 * fq;
        const float* gp = gate + (size_t)((row_off + u.pm * BM) / SEQ) * 6144 + col0;
        f32x4 g[2][2];
#pragma unroll
        for (int bj = 0; bj < 2; ++bj) { g[bj][0] = *(const f32x4*)(gp + bj * HALF); g[bj][1] = *(const f32x4*)(gp + bj * HALF + 4); }
#pragma unroll
        for (int ai = 0; ai < 2; ++ai)
#pragma unroll
            for (int m = 0; m < 4; ++m) { const size_t o = (size_t)(row0 + ai * HALF + m * 16) * 1024 + col0;
#pragma unroll
                for (int bj = 0; bj < 2; ++bj) {
                    const f32x4 a0 = *(const f32x4*)(xin + o + bj * HALF), a1 = *(const f32x4*)(xin + o + bj * HALF + 4);
                    *(f32x4*)(xout + o + bj * HALF) = a0 + g[bj][0] * acc[ai][bj][m][0];
                    *(f32x4*)(xout + o + bj * HALF + 4) = a1 + g[bj][1] * acc[ai][bj][m][1]; }
                asm volatile("" ::: "memory"); }
    }
};
struct EpiSwiGLU {
    static constexpr bool PERM = true, AFTER_DRAIN = false;
    bf16_t* act;
    __device__ __forceinline__ void operator()(const f32x4 (&acc)[2][2][4][2], const Unit& u, int wr, int wc, int fr, int fq) const {
        const int row0 = u.pm * BM + wr * 64 + fr, col0 = u.pn * HALF + wc * 32 + 8 * fq;
#pragma unroll
        for (int ai = 0; ai < 2; ++ai)
#pragma unroll
            for (int m = 0; m < 4; ++m) { bf16_t* rowp = act + (size_t)(row0 + ai * HALF + m * 16) * DFF + col0;
                f32x4 v0, v1;
#pragma unroll
                for (int i = 0; i < 4; ++i) { const float g0 = acc[ai][0][m][0][i], g1 = acc[ai][0][m][1][i];
                    v0[i] = g0 * sigmoidf_(g0) * acc[ai][1][m][0][i]; v1[i] = g1 * sigmoidf_(g1) * acc[ai][1][m][1][i]; }
                u32x4 w; w.x = pk2(v0[0], v0[1]); w.y = pk2(v0[2], v0[3]); w.z = pk2(v1[0], v1[1]); w.w = pk2(v1[2], v1[3]);
                *(u32x4*)rowp = w; }
    }
};
}

#define XB_TMO      128
#define XB_XCNT(j)  (256  + 64 * (j))
#define XB_XSUB(j)  (1280 + 64 * (j))
#define XB_XGEN(j)  (2304 + 64 * (j))
#define XB_TOP      3328
#define XB_TOPGEN   3392
#define XCD_BAR_WORDS 3456
#define XB_SPIN_CAP (1u << 24)

__device__ __forceinline__ unsigned xb_ld(unsigned* p)              { return __hip_atomic_load(p, __ATOMIC_RELAXED, __HIP_MEMORY_SCOPE_AGENT); }
__device__ __forceinline__ unsigned xb_add(unsigned* p, unsigned v) { return __hip_atomic_fetch_add(p, v, __ATOMIC_RELAXED, __HIP_MEMORY_SCOPE_AGENT); }
__device__ __forceinline__ unsigned xb_xcc_id() { return (unsigned)__builtin_amdgcn_s_getreg((3 << 11) | 20) & 0xFu; }
#define XB_SPIN(cond, bar) do { unsigned _sp = 0; while (cond) { __builtin_amdgcn_s_sleep(1); \
    if ((++_sp & 255u) == 0u) { if (xb_ld(&(bar)[XB_TMO])) break; if (_sp > XB_SPIN_CAP) { atomicAdd(&(bar)[XB_TMO], 1u); break; } } } } while (0)

struct XcdBarrier { unsigned* bar; unsigned x; volatile LAS unsigned* st; };

__device__ __forceinline__ XcdBarrier xcd_barrier_post(unsigned* bar, volatile LAS unsigned* st) {
    XcdBarrier b; b.bar = bar; b.x = (unsigned)__builtin_amdgcn_readfirstlane((int)xb_xcc_id()); b.st = st;
    if (threadIdx.x == 0) (void)xb_add(&bar[XB_XCNT(b.x)], 1u);
    return b;
}
__device__ __forceinline__ void xcd_barrier_complete(unsigned* bar, unsigned x, unsigned& nloc, unsigned& nx) {
    const unsigned G = gridDim.x * gridDim.y * gridDim.z;
    unsigned sum, cnt, mine, sp = 0u;
    for (;;) {
        sum = 0u; cnt = 0u; mine = 0u;
#pragma unroll
        for (unsigned j = 0; j < 16; ++j) { const unsigned c = xb_ld(&bar[XB_XCNT(j)]); sum += c; cnt += (c > 0u) ? 1u : 0u; mine = (j == x) ? c : mine; }
        if (sum == G) break;
        __builtin_amdgcn_s_sleep(1);
        if ((++sp & 255u) == 0u) { if (xb_ld(&bar[XB_TMO])) break; if (sp > XB_SPIN_CAP) { atomicAdd(&bar[XB_TMO], 1u); break; } }
    }
    nloc = mine > 0u ? mine : 1u; nx = cnt > 0u ? cnt : 1u;
}
__device__ __forceinline__ void xcd_barrier(const XcdBarrier& b) {
    asm volatile("s_waitcnt vmcnt(0)" ::: "memory");
    __syncthreads();
    if (threadIdx.x == 0) {
        unsigned* bar = b.bar; unsigned bx = b.x; asm volatile("" : "+s"(bar), "+s"(bx));
        __builtin_amdgcn_s_waitcnt(0);
        unsigned nloc = b.st[0], nx = b.st[1];
        if (nloc == 0u) { xcd_barrier_complete(bar, bx, nloc, nx); b.st[0] = nloc; b.st[1] = nx; }
        const unsigned old = xb_add(&bar[XB_XSUB(bx)], 1u);
        const unsigned gen = old / nloc;
        if (old + 1u == (gen + 1u) * nloc) {
            __builtin_amdgcn_fence(__ATOMIC_RELEASE, "agent");
            asm volatile("s_waitcnt vmcnt(0)" ::: "memory");
            const unsigned og = xb_add(&bar[XB_TOP], 1u);
            const unsigned tg = og / nx;
            if (og + 1u == (tg + 1u) * nx) xb_add(&bar[XB_TOPGEN], 1u);
            else XB_SPIN(xb_ld(&bar[XB_TOPGEN]) == tg, bar);
            __builtin_amdgcn_fence(__ATOMIC_ACQUIRE, "agent");
            xb_add(&bar[XB_XGEN(bx)], 1u);
            asm volatile("s_waitcnt vmcnt(0)" ::: "memory");
        } else {
            XB_SPIN(xb_ld(&bar[XB_XGEN(bx)]) == gen, bar);
            __builtin_amdgcn_fence(__ATOMIC_ACQUIRE, "agent");
            asm volatile("s_waitcnt vmcnt(0)" ::: "memory");
        }
    }
    __syncthreads();
}

constexpr int RING_BYTES = 131072;
constexpr int LDSCTL_OFF = 155648;
constexpr int LDS_BYTES = 156672;

struct Args {
    const float* in[23]; float* out; unsigned char* ws; int pad0, pad1;
};
__device__ __forceinline__ const void* ld_karg(unsigned off) {
    asm volatile("" : "+s"(off));
    return *(const void* const __attribute__((address_space(4)))*)((const __attribute__((address_space(4))) char*)__builtin_amdgcn_kernarg_segment_ptr() + off);
}
#define ARG(k) ((const float*)ld_karg(8u * (k)))
#define OUTP() ((float*)ld_karg(184u))
#define WSP() ((unsigned char*)ld_karg(192u))

__device__ __forceinline__ int rel_bucket(int d) {
    if (d < 16) return d;
    int b = 16;
    b += (d >= 22); b += (d >= 30); b += (d >= 40); b += (d >= 54); b += (d >= 73); b += (d >= 99); b += (d >= 134); b += (d >= 182);
    b += (d >= 246); b += (d >= 332); b += (d >= 450); b += (d >= 609); b += (d >= 825); b += (d >= 1117); b += (d >= 1513);
    return b;
}
__device__ __forceinline__ int win_src_col(int n) {
    if (n < 1152) return 512 + (n - 1024);
    if (n < 1224) return n;
    if (n < 1280) return -1;
    if (n < 1792) return 640 + (n - 1280);
    return n - 568;
}
__device__ __forceinline__ void transpose_item(const float* W, int ldw, int K, bf16* WT, int kind, int kb, int nb, LAS float* scr, int lane) {
    const int k0 = 64 * kb, n0 = 32 * nb, nl = n0 + (lane & 31);
    int sc;
    if (kind == 0) sc = win_src_col(nl + 1024);
    else if (kind == 2) { const int j = nl >> 8, r = nl & 255; sc = (r < 128) ? (j * 128 + r) : (DFF + j * 128 + r - 128); }
    else sc = nl;
#pragma unroll 8
    for (int i = 0; i < 32; ++i) { const int kk = 2 * i + (lane >> 5); scr[kk * 33 + (lane & 31)] = (sc >= 0) ? W[(size_t)(k0 + kk) * ldw + sc] : 0.f; }
    asm volatile("s_waitcnt lgkmcnt(0)" ::: "memory");
    const int c = lane & 7;
    const int nrow0 = (kind == 0) ? 1024 : 0;
#pragma unroll
    for (int j = 0; j < 4; ++j) { const int n = (lane >> 3) + 8 * j; const LAS float* s = scr + (8 * c) * 33 + n;
        v4u o; o.x = pk2(s[0 * 33], s[1 * 33]); o.y = pk2(s[2 * 33], s[3 * 33]); o.z = pk2(s[4 * 33], s[5 * 33]); o.w = pk2(s[6 * 33], s[7 * 33]);
        *(v4u*)(WT + (size_t)(nrow0 + n0 + n) * K + k0 + 8 * c) = o; }
    asm volatile("s_waitcnt lgkmcnt(0)" ::: "memory");
}

__device__ __forceinline__ void p0a_prologue(unsigned char* ws, LAS unsigned char* lds, int tid, int lane, int wave, int G) {
    asm volatile("" : "+v"(lane), "+v"(tid));
    const float* c = ARG(1); const float* w_ada = ARG(2); const float* b_ada = ARG(3);
    float* mod = (float*)(ws + WS_MOD);
    if (blockIdx.x < 192) {
        LAS float* cs = (LAS float*)lds;
        LAS float* red = (LAS float*)(lds + 32768);
        for (int i = tid; i < 8192; i += NTHREADS) { const float v = c[i]; cs[i] = v / (1.f + __expf(-v)); }
        __syncthreads();
        for (int it = blockIdx.x; it < 192; it += G) {
            const int l = it / 96, cg = it % 96, n = cg * 64 + lane;
            float acc[8];
#pragma unroll
            for (int b = 0; b < 8; ++b) acc[b] = 0.f;
            const float* wp = w_ada + ((size_t)l * 1024 + wave * 128) * 6144 + n;
#pragma unroll 8
            for (int k = 0; k < 128; ++k) { const float wv = wp[(size_t)k * 6144];
#pragma unroll
                for (int b = 0; b < 8; ++b) acc[b] += cs[b * 1024 + wave * 128 + k] * wv; }
#pragma unroll
            for (int b = 0; b < 8; ++b) red[(wave * 8 + b) * 64 + lane] = acc[b];
            __syncthreads();
            { const int b = tid >> 6; float s = 0.f;
#pragma unroll
              for (int w = 0; w < 8; ++w) s += red[(w * 8 + b) * 64 + lane];
              mod[((size_t)l * 8 + b) * 6144 + n] = s + b_ada[l * 6144 + n]; }
            __syncthreads();
        }
    }
    { const float* rb = ARG(21); float* T = (float*)(ws + WS_TAB);
      for (int d = blockIdx.x * NTHREADS + tid; d < 4096; d += G * NTHREADS) { const int bk = rel_bucket(d);
          for (int j = 0; j < 24; ++j) T[d * 24 + j] = rb[bk * 24 + j]; } }
    if (blockIdx.x == G - 1 && wave == 0) {
        float* lam = (float*)(ws + WS_LAM);
        for (int l = 0; l < NL; ++l) {
            const float s1 = wave_sum(ARG(9)[l * 64 + lane] * ARG(10)[l * 64 + lane]);
            const float s2 = wave_sum(ARG(11)[l * 64 + lane] * ARG(12)[l * 64 + lane]);
            const float lam_init = (l == 0) ? 0.2f : 0.35550907f;
            if (lane == 0) lam[l] = expf(s1) - expf(s2) + lam_init;
        }
    }
    {
        LAS float* scr = (LAS float*)(lds + 65536 + wave * 8448);
        const int gw = blockIdx.x * NWAVES + wave, NGW = G * NWAVES;
        constexpr int I_WIN = 16 * 240, I_B = 8 * 32, I_C = 4 * 32, I_OUT = 16 * 32, I_GU = 16 * 176, I_D = 44 * 32, I_FQ = 2048, I_FA = 2048;
        constexpr int I_LAYER = I_WIN + I_B + I_C + I_OUT + I_GU + I_D + I_FQ + I_FA;
        for (int it = gw; it < NL * I_LAYER; it += NGW) {
            const int l = it / I_LAYER; int r = it % I_LAYER;
            unsigned char* wl = ws + WS_W + (size_t)l * W_LAYER;
            const float* w_in = ARG(5) + (size_t)l * 1024 * WIN_SRC;
            if (r < I_WIN) { transpose_item(w_in, WIN_SRC, 1024, (bf16*)(wl + W_IN), 0, r / 240, r % 240, scr, lane); continue; } r -= I_WIN;
            if (r < I_B)   { transpose_item(ARG(15) + (size_t)l * 512 * 1024, 1024, 512, (bf16*)(wl + W_B), 1, r / 32, r % 32, scr, lane); continue; } r -= I_B;
            if (r < I_C)   { transpose_item(ARG(16) + (size_t)l * 256 * 1024, 1024, 256, (bf16*)(wl + W_C), 1, r / 32, r % 32, scr, lane); continue; } r -= I_C;
            if (r < I_OUT) { transpose_item(ARG(17) + (size_t)l * 1024 * 1024, 1024, 1024, (bf16*)(wl + W_OUT), 1, r / 32, r % 32, scr, lane); continue; } r -= I_OUT;
            if (r < I_GU)  { transpose_item(ARG(19) + (size_t)l * 1024 * NGU, NGU, 1024, (bf16*)(wl + W_GU), 2, r / 176, r % 176, scr, lane); continue; } r -= I_GU;
            if (r < I_D)   { transpose_item(ARG(20) + (size_t)l * DFF * 1024, 1024, DFF, (bf16*)(wl + W_D), 1, r / 32, r % 32, scr, lane); continue; } r -= I_D;
            if (r < I_FQ) {
                const int h = r >> 8, rem = r & 255, cc = (rem >> 7) * 64 + lane, k0 = (rem & 127) * 8;
                const float* uk = ARG(6) + ((size_t)(l * 8 + h) * 64) * 128 + cc;
                const float* wi = w_in + (size_t)k0 * WIN_SRC + h * 64;
                float acc[8];
#pragma unroll
                for (int j = 0; j < 8; ++j) acc[j] = 0.f;
#pragma unroll 8
                for (int d = 0; d < 64; ++d) { const float u = uk[d * 128];
#pragma unroll
                    for (int j = 0; j < 8; ++j) acc[j] += wi[(size_t)j * WIN_SRC + d] * u; }
                v4u o; o.x = pk2(acc[0], acc[1]); o.y = pk2(acc[2], acc[3]); o.z = pk2(acc[4], acc[5]); o.w = pk2(acc[6], acc[7]);
                *(v4u*)((bf16*)(wl + W_IN) + (size_t)(h * 128 + cc) * 1024 + k0) = o;
                continue; }
            r -= I_FQ;
            {
                const int ng = r >> 7, kg = r & 127, h = kg >> 4, c0 = (kg & 15) * 8, n = ng * 64 + lane;
                const float* uv = ARG(7) + ((size_t)(l * 8 + h) * 128 + c0) * 64;
                const float* wa = ARG(14) + ((size_t)l * 512 + h * 64) * 1024 + n;
                float acc[8];
#pragma unroll
                for (int j = 0; j < 8; ++j) acc[j] = 0.f;
#pragma unroll 8
                for (int e = 0; e < 64; ++e) { const float wv = wa[(size_t)e * 1024];
#pragma unroll
                    for (int j = 0; j < 8; ++j) acc[j] += uv[j * 64 + e] * wv; }
                v4u o; o.x = pk2(acc[0], acc[1]); o.y = pk2(acc[2], acc[3]); o.z = pk2(acc[4], acc[5]); o.w = pk2(acc[6], acc[7]);
                *(v4u*)((bf16*)(wl + W_A) + (size_t)n * 1024 + kg * 8) = o;
            }
        }
    }
}

__device__ __forceinline__ void norm_rows(const float* x, bf16* out, const float* g, const float* sh, const float* sc, int gw, int NGW, int lane) {
    asm volatile("" : "+v"(lane));
    for (int row = gw; row < MT; row += NGW) {
        const int b = row / SEQ;
        const f32x4* xr = (const f32x4*)(x + (size_t)row * 1024) + lane;
        f32x4 v[4]; float s = 0.f;
#pragma unroll
        for (int j = 0; j < 4; ++j) { v[j] = xr[64 * j]; s += (v[j].x * v[j].x + v[j].y * v[j].y) + (v[j].z * v[j].z + v[j].w * v[j].w); }
        const float rstd = 1.0f / sqrtf(wave_sum(s) * (1.f / 1024.f) + EPS);
        v2u* o8 = (v2u*)(out + (size_t)row * 1024) + lane;
#pragma unroll
        for (int j = 0; j < 4; ++j) { const int col = 256 * j + 4 * lane;
            const f32x4 gg = *(const f32x4*)(g + col), s1 = *(const f32x4*)(sc + (size_t)b * 6144 + col), s0 = *(const f32x4*)(sh + (size_t)b * 6144 + col);
            const f32x4 y = v[j] * rstd * gg * (s1 + 1.0f) + s0;
            v2u w; w.x = pk2(y.x, y.y); w.y = pk2(y.z, y.w); o8[64 * j] = w; }
    }
}
__device__ __forceinline__ void final_rows(float* x, const float* g, int gw, int NGW, int lane) {
    asm volatile("" : "+v"(lane));
    for (int row = gw; row < MT; row += NGW) {
        f32x4* xr = (f32x4*)(x + (size_t)row * 1024) + lane;
        f32x4 v[4]; float s = 0.f;
#pragma unroll
        for (int j = 0; j < 4; ++j) { v[j] = xr[64 * j]; s += (v[j].x * v[j].x + v[j].y * v[j].y) + (v[j].z * v[j].z + v[j].w * v[j].w); }
        const float rstd = 1.0f / sqrtf(wave_sum(s) * (1.f / 1024.f) + EPS);
#pragma unroll
        for (int j = 0; j < 4; ++j) { const f32x4 gg = *(const f32x4*)(g + 256 * j + 4 * lane); xr[64 * j] = v[j] * rstd * gg; }
    }
}

__device__ __forceinline__ float dot8(const LAS float* q, v4u w) {
    return q[0] * bflo(w.x) + q[1] * bfhi(w.x) + q[2] * bflo(w.y) + q[3] * bfhi(w.y) + q[4] * bflo(w.z) + q[5] * bfhi(w.z) + q[6] * bflo(w.w) + q[7] * bfhi(w.w);
}
__device__ __forceinline__ void kvn_rows(unsigned char* y, bf16* kvn, const float* gkv, unsigned* kmaxw, int gw, int NGW, int lane) {
    asm volatile("" : "+v"(lane));
    const bf16* misc = (const bf16*)(y + Y_MISC);
    float km0 = 0.f, km1 = 0.f, km2 = 0.f, km3 = 0.f;
    for (int r = gw; r < CHR; r += NGW) {
        const unsigned w = *(const unsigned*)(misc + (size_t)r * 256 + 2 * lane);
        const float a0 = bflo(w), a1 = bfhi(w);
        const float rstd = 1.0f / sqrtf(wave_sum(a0 * a0 + a1 * a1) * (1.f / 128.f) + EPS);
        *(unsigned*)(kvn + (size_t)r * 128 + 2 * lane) = pk2(a0 * rstd * gkv[2 * lane], a1 * rstd * gkv[2 * lane + 1]);
        const float kk = bf2f(misc[(size_t)r * 256 + 128 + lane]); const float ks = wave_sum(kk * kk); const int b = r / SEQ;
        km0 = (b == 0) ? fmaxf(km0, ks) : km0; km1 = (b == 1) ? fmaxf(km1, ks) : km1; km2 = (b == 2) ? fmaxf(km2, ks) : km2; km3 = (b == 3) ? fmaxf(km3, ks) : km3;
    }
    if (lane == 0) {
        __hip_atomic_fetch_max(kmaxw + 0, __float_as_uint(km0), __ATOMIC_RELAXED, __HIP_MEMORY_SCOPE_AGENT); __hip_atomic_fetch_max(kmaxw + 1, __float_as_uint(km1), __ATOMIC_RELAXED, __HIP_MEMORY_SCOPE_AGENT);
        __hip_atomic_fetch_max(kmaxw + 2, __float_as_uint(km2), __ATOMIC_RELAXED, __HIP_MEMORY_SCOPE_AGENT); __hip_atomic_fetch_max(kmaxw + 3, __float_as_uint(km3), __ATOMIC_RELAXED, __HIP_MEMORY_SCOPE_AGENT);
    }
}
__device__ __forceinline__ void mixC_v1(unsigned char* y, const float* T, LAS unsigned char* lds, int gw, int NGW, int lane, int wave) {
    asm volatile("" : "+v"(lane));
    const bf16* CQ = (const bf16*)(y + Y_CQ); const bf16* CK = (const bf16*)(y + Y_CK); const bf16* CV = (const bf16*)(y + Y_CV); bf16* OC = (bf16*)(y + Y_OC);
    LAS float* qs = (LAS float*)(lds + wave * 2048);
    LAS float* ps = qs + 64;
    for (int task = gw; task < CHR * 4; task += NGW) {
        const int r = task >> 2, hp = task & 3, t = r & (SEQ - 1), rb = r - t;
        float og[3], lse[3];
#pragma unroll
        for (int g = 0; g < 3; ++g) {
            const int dil = (g == 0) ? 1 : (g == 1) ? 4 : 16, hh = 4 * g + hp;
            qs[lane] = bf2f(CQ[(size_t)r * 768 + hh * 64 + lane]);
            asm volatile("s_waitcnt lgkmcnt(0)" ::: "memory");
            const int tq = t / dil, nv = (tq < 128 ? tq : 128) + 1;
            float lg[3];
#pragma unroll
            for (int rd = 0; rd < 3; ++rd) {
                const int j = lane + 64 * rd; float v = -INFINITY;
                if (j < nv) { const int s = t - j * dil; const bf16* kp = CK + (size_t)(rb + s) * 768 + hh * 64; float dot = 0.f;
#pragma unroll
                    for (int c8 = 0; c8 < 8; ++c8) dot += dot8(qs + 8 * c8, *(const v4u*)(kp + 8 * c8));
                    v = dot * 0.125f + T[(j * dil) * 24 + 12 + hh]; }
                lg[rd] = v;
            }
            const float m = wave_max(fmaxf(fmaxf(lg[0], lg[1]), lg[2]));
            float p[3], ls = 0.f;
#pragma unroll
            for (int rd = 0; rd < 3; ++rd) { p[rd] = (lane + 64 * rd < nv) ? __expf(lg[rd] - m) : 0.f; ls += p[rd]; ps[64 * rd + lane] = p[rd]; }
            const float l = wave_sum(ls);
            asm volatile("s_waitcnt lgkmcnt(0)" ::: "memory");
            float o = 0.f;
            for (int j = 0; j < nv; ++j) { const int s = t - j * dil; o += ps[j] * bf2f(CV[(size_t)(rb + s) * 768 + hh * 64 + lane]); }
            og[g] = o / l; lse[g] = m + __logf(l);
            asm volatile("s_waitcnt lgkmcnt(0)" ::: "memory");
        }
        const float M = fmaxf(fmaxf(lse[0], lse[1]), lse[2]);
        const float a0 = __expf(lse[0] - M), a1 = __expf(lse[1] - M), a2 = __expf(lse[2] - M);
        OC[(size_t)r * 256 + hp * 64 + lane] = (bf16)f2bf((a0 * og[0] + a1 * og[1] + a2 * og[2]) / (a0 + a1 + a2));
    }
}
__device__ __forceinline__ void mixB_v1(unsigned char* y, const float* T, const float* gsub, float lam, float one_m_li, LAS unsigned char* lds, int gw, int NGW, int lane, int wave) {
    asm volatile("" : "+v"(lane));
    bf16* BQ = (bf16*)(y + Y_BQ); const bf16* BK = (const bf16*)(y + Y_BK); const bf16* BV = (const bf16*)(y + Y_BV);
    LAS float* qs = (LAS float*)(lds + wave * 2048);
    LAS float* ps = qs + 128;
    for (int task = gw; task < CHR * 4; task += NGW) {
        const int r = task >> 2, h = task & 3, t = r & (SEQ - 1), rb = r - t;
        qs[lane] = bf2f(BQ[(size_t)r * 512 + h * 128 + lane]); qs[64 + lane] = bf2f(BQ[(size_t)r * 512 + h * 128 + 64 + lane]);
        asm volatile("s_waitcnt lgkmcnt(0)" ::: "memory");
        float m0 = -INFINITY, m1 = -INFINITY, l0 = 0.f, l1 = 0.f, o00 = 0.f, o01 = 0.f, o10 = 0.f, o11 = 0.f;
        for (int s0 = 0; s0 <= t; s0 += 64) {
            const int s = s0 + lane; float lg0 = -INFINITY, lg1 = -INFINITY;
            if (s <= t) { const bf16* kp = BK + (size_t)(rb + s) * 512 + h * 128; float d0 = 0.f, d1 = 0.f;
#pragma unroll
                for (int c8 = 0; c8 < 8; ++c8) { d0 += dot8(qs + 8 * c8, *(const v4u*)(kp + 8 * c8)); d1 += dot8(qs + 64 + 8 * c8, *(const v4u*)(kp + 64 + 8 * c8)); }
                const float bias = T[(t - s) * 24 + 8 + h]; lg0 = d0 * 0.125f + bias; lg1 = d1 * 0.125f + bias; }
            const float nm0 = fmaxf(m0, wave_max(lg0)), nm1 = fmaxf(m1, wave_max(lg1));
            const float f0 = __expf(m0 - nm0), f1 = __expf(m1 - nm1);
            const float p0 = (s <= t) ? __expf(lg0 - nm0) : 0.f, p1 = (s <= t) ? __expf(lg1 - nm1) : 0.f;
            l0 = l0 * f0 + wave_sum(p0); l1 = l1 * f1 + wave_sum(p1); o00 *= f0; o01 *= f0; o10 *= f1; o11 *= f1; m0 = nm0; m1 = nm1;
            ps[lane] = p0; ps[64 + lane] = p1;
            asm volatile("s_waitcnt lgkmcnt(0)" ::: "memory");
            const int nk = (t - s0 + 1 < 64) ? (t - s0 + 1) : 64;
            const bf16* vp = BV + (size_t)(rb + s0) * 512 + h * 128 + lane;
            for (int j = 0; j < nk; ++j) { const float v0 = bf2f(vp[(size_t)j * 512]), v1 = bf2f(vp[(size_t)j * 512 + 64]); const float pa = ps[j], pb = ps[64 + j];
                o00 += pa * v0; o01 += pa * v1; o10 += pb * v0; o11 += pb * v1; }
            asm volatile("s_waitcnt lgkmcnt(0)" ::: "memory");
        }
        const float oa = o00 / l0 - lam * (o10 / l1), ob = o01 / l0 - lam * (o11 / l1);
        const float rstd = 1.0f / sqrtf(wave_sum(oa * oa + ob * ob) * (1.f / 128.f) + EPS);
        BQ[(size_t)r * 512 + h * 128 + lane] = (bf16)f2bf(oa * rstd * gsub[lane] * one_m_li);
        BQ[(size_t)r * 512 + h * 128 + 64 + lane] = (bf16)f2bf(ob * rstd * gsub[64 + lane] * one_m_li);
    }
}
__device__ __forceinline__ unsigned mono_key(float f) { const unsigned u = __float_as_uint(f); return (u & 0x80000000u) ? ~u : (u | 0x80000000u); }
__device__ __forceinline__ void mixA_v1(unsigned char* y, const bf16* KVN, const float* T, LAS unsigned char* lds, int gw, int NGW, int lane, int wave) {
    asm volatile("" : "+v"(lane));
    bf16* QLAT = (bf16*)(y + Y_QLAT); const bf16* MISC = (const bf16*)(y + Y_MISC); const bf16* IQ = (const bf16*)(y + Y_IQ);
    LAS unsigned char* wb = lds + wave * 19456;
    LAS unsigned* scb = (LAS unsigned*)wb;
    LAS float* qi = (LAS float*)(wb + 16384);
    LAS unsigned* sel = (LAS unsigned*)(wb + 18432);
    LAS float* ql = (LAS float*)wb;
    LAS float* pb = (LAS float*)(wb + 4096);
    const unsigned long long lt_mask = (1ull << lane) - 1ull;
    for (int r = gw; r < CHR; r += NGW) {
        const int t = r & (SEQ - 1), rb = r - t, N = t + 1;
#pragma unroll
        for (int i = 0; i < 8; ++i) qi[i * 64 + lane] = bf2f(IQ[(size_t)r * 512 + i * 64 + lane]);
        const float wv = (lane < 8) ? bf2f(MISC[(size_t)r * 256 + 192 + lane]) * 0.044194173824159216f : 0.f;
        float wh[8];
#pragma unroll
        for (int h = 0; h < 8; ++h) wh[h] = __shfl(wv, h);
        asm volatile("s_waitcnt lgkmcnt(0)" ::: "memory");
        for (int s0 = 0; s0 < N; s0 += 64) {
            const int s = s0 + lane;
            if (s < N) { const bf16* kp = MISC + (size_t)(rb + s) * 256 + 128; v4u kw[8];
#pragma unroll
                for (int c8 = 0; c8 < 8; ++c8) kw[c8] = *(const v4u*)(kp + 8 * c8);
                float sc = 0.f;
#pragma unroll
                for (int h = 0; h < 8; ++h) { float d = 0.f;
#pragma unroll
                    for (int c8 = 0; c8 < 8; ++c8) d += dot8(qi + h * 64 + 8 * c8, kw[c8]);
                    sc += wh[h] * fmaxf(d, 0.f); }
                sc += 0.f;
                scb[s] = mono_key(sc); }
        }
        asm volatile("s_waitcnt lgkmcnt(0)" ::: "memory");
        int nsel;
        if (N <= TOPK) { for (int i = lane; i < N; i += 64) sel[i] = (unsigned)i; nsel = N; }
        else {
            unsigned tau = 0u;
            for (int bit = 31; bit >= 0; --bit) { const unsigned cand = tau | (1u << bit); int cnt = 0;
                for (int i = lane; i < N; i += 64) cnt += (scb[i] >= cand) ? 1 : 0;
#pragma unroll
                for (int o = 1; o < 64; o <<= 1) cnt += __shfl_xor(cnt, o);
                if (cnt >= TOPK) tau = cand; }
            int cgt = 0;
            for (int i = lane; i < N; i += 64) cgt += (scb[i] > tau) ? 1 : 0;
#pragma unroll
            for (int o = 1; o < 64; o <<= 1) cgt += __shfl_xor(cgt, o);
            const int need = TOPK - cgt; int pos = 0, eqt = 0;
            for (int s0 = 0; s0 < N; s0 += 64) { const int s = s0 + lane; const unsigned key = (s < N) ? scb[s] : 0u;
                const bool gt = (s < N) && key > tau, eq = (s < N) && key == tau;
                const unsigned long long beq = __ballot(eq);
                const bool take = gt || (eq && (eqt + __popcll(beq & lt_mask)) < need);
                const unsigned long long bt = __ballot(take);
                if (take) sel[pos + __popcll(bt & lt_mask)] = (unsigned)s;
                pos += __popcll(bt); eqt += __popcll(beq); }
            nsel = TOPK;
        }
        asm volatile("s_waitcnt lgkmcnt(0)" ::: "memory");
#pragma unroll
        for (int i = 0; i < 16; ++i) ql[i * 64 + lane] = bf2f(QLAT[(size_t)r * 1024 + i * 64 + lane]);
        asm volatile("s_waitcnt lgkmcnt(0)" ::: "memory");
        for (int rd = 0; rd < 4; ++rd) { const int jj = rd * 64 + lane;
            float acc[8];
#pragma unroll
            for (int h = 0; h < 8; ++h) acc[h] = -INFINITY;
            if (jj < nsel) { const int s = (int)sel[jj]; const bf16* kp = KVN + (size_t)(rb + s) * 128;
#pragma unroll
                for (int h = 0; h < 8; ++h) acc[h] = 0.f;
#pragma unroll 4
                for (int c8 = 0; c8 < 16; ++c8) { const v4u w = *(const v4u*)(kp + 8 * c8);
#pragma unroll
                    for (int h = 0; h < 8; ++h) acc[h] += dot8(ql + h * 128 + 8 * c8, w); }
                const float* tb = T + (t - s) * 24;
#pragma unroll
                for (int h = 0; h < 8; ++h) acc[h] = acc[h] * 0.125f + tb[h]; }
#pragma unroll
            for (int h = 0; h < 8; ++h) pb[h * 256 + jj] = acc[h];
        }
        asm volatile("s_waitcnt lgkmcnt(0)" ::: "memory");
#pragma unroll
        for (int h = 0; h < 8; ++h) { float v[4];
#pragma unroll
            for (int i = 0; i < 4; ++i) v[i] = pb[h * 256 + 64 * i + lane];
            const float m = wave_max(fmaxf(fmaxf(v[0], v[1]), fmaxf(v[2], v[3])));
#pragma unroll
            for (int i = 0; i < 4; ++i) v[i] = __expf(v[i] - m);
            const float inv = 1.0f / wave_sum((v[0] + v[1]) + (v[2] + v[3]));
#pragma unroll
            for (int i = 0; i < 4; ++i) pb[h * 256 + 64 * i + lane] = v[i] * inv; }
        asm volatile("s_waitcnt lgkmcnt(0)" ::: "memory");
        float o0[8], o1[8];
#pragma unroll
        for (int h = 0; h < 8; ++h) { o0[h] = 0.f; o1[h] = 0.f; }
        for (int jj = 0; jj < nsel; ++jj) { const int s = (int)sel[jj]; const bf16* vp = KVN + (size_t)(rb + s) * 128 + lane;
            const float v0 = bf2f(vp[0]), v1 = bf2f(vp[64]);
#pragma unroll
            for (int h = 0; h < 8; ++h) { const float p = pb[h * 256 + jj]; o0[h] += p * v0; o1[h] += p * v1; } }
#pragma unroll
        for (int h = 0; h < 8; ++h) { QLAT[(size_t)r * 1024 + h * 128 + lane] = (bf16)f2bf(o0[h]); QLAT[(size_t)r * 1024 + h * 128 + 64 + lane] = (bf16)f2bf(o1[h]); }
        asm volatile("s_waitcnt lgkmcnt(0)" ::: "memory");
    }
}

typedef short bf16x8 __attribute__((ext_vector_type(8)));
typedef short s16x4 __attribute__((ext_vector_type(4)));
typedef float f32x16 __attribute__((ext_vector_type(16)));
#define LOG2E 1.4426950408889634f
__device__ __forceinline__ int crow(int r, int hi) { return (r & 3) + 8 * (r >> 2) + 4 * hi; }
__device__ __forceinline__ void glds16(const void* g, LAS void* l) { __builtin_amdgcn_global_load_lds((const unsigned*)g, (LAS unsigned*)l, 16, 0, 0); }
__device__ __forceinline__ s16x4 tr16(const LAS unsigned char* p) { return __builtin_bit_cast(s16x4, __builtin_amdgcn_ds_read_tr16_b64_v4i16((LAS s16x4*)p)); }
__device__ __forceinline__ float swap_max(float v) { auto rr = __builtin_amdgcn_permlane32_swap(__float_as_uint(v), __float_as_uint(v), false, false); return fmaxf(__uint_as_float(rr[0]), __uint_as_float(rr[1])); }
__device__ __forceinline__ float swap_add(float v) { auto rr = __builtin_amdgcn_permlane32_swap(__float_as_uint(v), __float_as_uint(v), false, false); return __uint_as_float(rr[0]) + __uint_as_float(rr[1]); }
typedef float f32x2_t __attribute__((ext_vector_type(2))); typedef __bf16 bf16x2_t __attribute__((ext_vector_type(2)));
__device__ __forceinline__ unsigned cvtpk(float lo, float hi) { const f32x2_t v = {lo, hi}; const bf16x2_t b = __builtin_convertvector(v, bf16x2_t); return __builtin_bit_cast(unsigned, b); }
__device__ __forceinline__ void lds_add_u32_asm(LAS void* p, unsigned v) { asm volatile("ds_add_u32 %0, %1" :: "v"((unsigned)(uintptr_t)p), "v"(v) : "memory"); }
__device__ __forceinline__ void lds_st_b16_asm(LAS void* p, unsigned v) { asm volatile("ds_write_b16 %0, %1" :: "v"((unsigned)(uintptr_t)p), "v"(v) : "memory"); }
__device__ __forceinline__ void lds_st_b32_asm(LAS void* p, unsigned v) { asm volatile("ds_write_b32 %0, %1" :: "v"((unsigned)(uintptr_t)p), "v"(v) : "memory"); }
__device__ __forceinline__ s16x4 tr16_asm(const LAS unsigned char* p) { s16x4 v; asm volatile("ds_read_b64_tr_b16 %0, %1" : "=v"(v) : "v"((unsigned)(uintptr_t)p) : "memory"); return v; }
#define TRV(dst, base, off) asm volatile("ds_read_b64_tr_b16 %0, %1 offset:%c2" : "=&v"(dst) : "v"(base), "i"(off) : "memory")
#define LGKM_WAIT8(n, f) asm volatile("s_waitcnt lgkmcnt(" #n ")" : "+v"(f[0]), "+v"(f[1]), "+v"(f[2]), "+v"(f[3]), "+v"(f[4]), "+v"(f[5]), "+v"(f[6]), "+v"(f[7]) :: "memory")
#define VFRAG(f, i) ((bf16x8){f[2 * (i)][0], f[2 * (i)][1], f[2 * (i)][2], f[2 * (i)][3], f[2 * (i) + 1][0], f[2 * (i) + 1][1], f[2 * (i) + 1][2], f[2 * (i) + 1][3]})
#define RAW_BARRIER() do { asm volatile("s_waitcnt lgkmcnt(0)" ::: "memory"); __builtin_amdgcn_s_barrier(); asm volatile("" ::: "memory"); } while (0)

template <int MODE> __device__ __forceinline__ void mixB_fast(unsigned char* y, bf16* OUTB, const float* T, const float* gsub, float lam, float one_m_li, LAS unsigned char* lds, int tid, int lane, int wave, int G) {
    asm volatile("" : "+v"(lane), "+v"(tid));
    bf16* BQ = (bf16*)(y + Y_BQ); const bf16* BK = (const bf16*)(y + Y_BK); const bf16* BV = (const bf16*)(y + Y_BV);
    const int r32 = lane & 31, hi = lane >> 5, m = wave >> 2, qs = wave & 3;
    LAS float* bt = (LAS float*)(lds + 131072);
    constexpr float C2 = 0.125f * LOG2E, THR = 8.0f;
    for (int item = blockIdx.x; item < CHB * 4 * 16; item += G) {
        const int bh = (G == 256) ? (2 * (item & 7) + (item >> 7)) : (item >> 4), pr = (G == 256) ? ((item >> 3) & 15) : (item & 15), bb = bh >> 2, h = bh & 3, rb = bb * SEQ;
        RAW_BARRIER();
        for (int i = tid; i < 64 + 4096; i += NTHREADS) bt[i] = (i < 64) ? 0.f : T[(i - 64) * 24 + 8 + h] * LOG2E;
        if (tid < 128) bt[64 + 4096 + tid] = gsub[tid];
        for (int uu = 0; uu < 2; ++uu) {
            const int qb = (uu == 0) ? (31 - pr) : pr;
            const int q0w = qb * 128 + qs * 32, qpos = q0w + r32;
            bf16x8 qf[4];
#pragma unroll
            for (int ks = 0; ks < 4; ++ks) qf[ks] = *(const bf16x8*)(BQ + (size_t)(rb + qpos) * 512 + h * 128 + m * 64 + 16 * ks + 8 * hi);
            const int NT = 2 * (qb + 1);
            f32x16 O[4];
#pragma unroll
            for (int dq = 0; dq < 4; ++dq)
#pragma unroll
                for (int r = 0; r < 16; ++r) O[dq][r] = 0.f;
            float mref = -INFINITY, lsum = 0.f;
#define MB_STAGE(t_, buf_) do { const int kv0_ = (t_) * 64; LAS unsigned char* sb_ = lds + (buf_) * 32768; \
                glds16(BK + (size_t)(rb + kv0_ + lane) * 512 + h * 128 + wave * 8, sb_ + wave * 1024); \
                glds16(BK + (size_t)(rb + kv0_ + lane) * 512 + h * 128 + 64 + wave * 8, sb_ + 8192 + wave * 1024); \
                _Pragma("unroll") for (int i_ = 0; i_ < 2; ++i_) { const int p_ = 2 * wave + i_, dq_ = p_ >> 2, rg_ = p_ & 3; \
                    glds16(BV + (size_t)(rb + kv0_ + 16 * rg_ + (lane >> 2)) * 512 + h * 128 + dq_ * 32 + (lane & 3) * 8, sb_ + 16384 + p_ * 1024); } } while (0)
            MB_STAGE(0, 0); MB_STAGE(1, 1);
            if (NT > 2) MB_STAGE(2, 2);
            for (int t = 0; t < NT; ++t) {
                if (t + 2 < NT) asm volatile("s_waitcnt vmcnt(8)" ::: "memory");
                else if (t + 1 < NT) asm volatile("s_waitcnt vmcnt(4)" ::: "memory");
                else asm volatile("s_waitcnt vmcnt(0)" ::: "memory");
                RAW_BARRIER();
                if (t + 3 < NT) MB_STAGE(t + 3, (t + 3) & 3);
                const int kv0 = t * 64;
                if (MODE != 2 && kv0 <= q0w + 31) {
                    const LAS unsigned char* sb = lds + (t & 3) * 32768;
                    const LAS unsigned char* kb = sb + m * 8192 + hi * 1024 + r32 * 16;
                    f32x16 s0, s1;
#pragma unroll
                    for (int r = 0; r < 16; ++r) { s0[r] = 0.f; s1[r] = 0.f; }
                    if (MODE != 3)
#pragma unroll
                    for (int ks = 0; ks < 4; ++ks) {
                        const bf16x8 k0 = *(const LAS bf16x8*)(kb + ks * 2048), k1 = *(const LAS bf16x8*)(kb + ks * 2048 + 512);
                        s0 = __builtin_amdgcn_mfma_f32_32x32x16_bf16(k0, qf[ks], s0, 0, 0, 0);
                        s1 = __builtin_amdgcn_mfma_f32_32x32x16_bf16(k1, qf[ks], s1, 0, 0, 0); }
                    const int dmin = q0w - (kv0 + 63), dmax = q0w + 31 - kv0;
                    if (MODE != 3) {
                    if (dmin >= 0 && rel_bucket(dmin) == rel_bucket(dmax)) {
                        const float cb = bt[64 + dmin];
#pragma unroll
                        for (int r = 0; r < 16; ++r) { s0[r] = fmaf(s0[r], C2, cb); s1[r] = fmaf(s1[r], C2, cb); }
                    } else {
                        const LAS float* bp = bt + 64 + (qpos - kv0) - 4 * hi;
#pragma unroll
                        for (int r = 0; r < 16; ++r) { s0[r] = fmaf(s0[r], C2, bp[-((r & 3) + 8 * (r >> 2))]); s1[r] = fmaf(s1[r], C2, bp[-(32 + (r & 3) + 8 * (r >> 2))]); }
                    }
                    if (kv0 + 63 > q0w) {
#pragma unroll
                        for (int r = 0; r < 16; ++r) { const int kv = kv0 + crow(r, hi); if (kv > qpos) s0[r] = -INFINITY; if (kv + 32 > qpos) s1[r] = -INFINITY; }
                    }
                    float rm = fmaxf(s0[0], s1[0]);
#pragma unroll
                    for (int r = 1; r < 16; ++r) rm = fmaxf(rm, fmaxf(s0[r], s1[r]));
                    rm = swap_max(rm);
                    if (__any(rm > mref + THR)) {
                        const float mn = fmaxf(mref, rm), f = __builtin_amdgcn_exp2f(mref - mn);
                        lsum *= f; mref = mn;
#pragma unroll
                        for (int dq = 0; dq < 4; ++dq)
#pragma unroll
                            for (int r = 0; r < 16; ++r) O[dq][r] *= f;
                    }
                    float ps = 0.f;
#pragma unroll
                    for (int r = 0; r < 16; ++r) { s0[r] = __builtin_amdgcn_exp2f(s0[r] - mref); s1[r] = __builtin_amdgcn_exp2f(s1[r] - mref); ps += s0[r] + s1[r]; }
                    lsum += ps;
                    }
                    bf16x8 pf[4];
                    { v4u w;
                      w.x = cvtpk(s0[0], s0[1]); w.y = cvtpk(s0[2], s0[3]); w.z = cvtpk(s0[4], s0[5]); w.w = cvtpk(s0[6], s0[7]); pf[0] = __builtin_bit_cast(bf16x8, w);
                      w.x = cvtpk(s0[8], s0[9]); w.y = cvtpk(s0[10], s0[11]); w.z = cvtpk(s0[12], s0[13]); w.w = cvtpk(s0[14], s0[15]); pf[1] = __builtin_bit_cast(bf16x8, w);
                      w.x = cvtpk(s1[0], s1[1]); w.y = cvtpk(s1[2], s1[3]); w.z = cvtpk(s1[4], s1[5]); w.w = cvtpk(s1[6], s1[7]); pf[2] = __builtin_bit_cast(bf16x8, w);
                      w.x = cvtpk(s1[8], s1[9]); w.y = cvtpk(s1[10], s1[11]); w.z = cvtpk(s1[12], s1[13]); w.w = cvtpk(s1[14], s1[15]); pf[3] = __builtin_bit_cast(bf16x8, w); }
                    const unsigned vb = (unsigned)(uintptr_t)(sb + 16384 + ((lane >> 4) & 1) * 32 + (lane & 3) * 8 + (4 * hi + ((lane & 15) >> 2)) * 64);
                    s16x4 fa[8], fb[8];
#define MB_RD(f, dq_) do { _Pragma("unroll") for (int sp_ = 0; sp_ < 4; ++sp_) { TRV(f[2 * sp_], vb, ((dq_) * 4 + sp_) * 1024); TRV(f[2 * sp_ + 1], vb, ((dq_) * 4 + sp_) * 1024 + 512); } } while (0)
#define MB_MM(f, dq_) do { _Pragma("unroll") for (int sp_ = 0; sp_ < 4; ++sp_) O[dq_] = __builtin_amdgcn_mfma_f32_32x32x16_bf16(VFRAG(f, sp_), pf[sp_], O[dq_], 0, 0, 0); } while (0)
                    if (MODE != 1) {
                    MB_RD(fa, 0); MB_RD(fb, 1); LGKM_WAIT8(8, fa); MB_MM(fa, 0);
                    MB_RD(fa, 2); LGKM_WAIT8(8, fb); MB_MM(fb, 1);
                    MB_RD(fb, 3); LGKM_WAIT8(8, fa); MB_MM(fa, 2);
                    LGKM_WAIT8(0, fb); MB_MM(fb, 3); }
#undef MB_RD
#undef MB_MM
                }
            }
            RAW_BARRIER();
#undef MB_STAGE
            const float inv = 1.0f / swap_add(lsum);
            LAS float* xb = (LAS float*)lds + qs * 4096;
            if (m == 1) {
#pragma unroll
                for (int dq = 0; dq < 4; ++dq)
#pragma unroll
                    for (int r = 0; r < 16; ++r) xb[(dq * 16 + r) * 64 + lane] = O[dq][r] * inv;
            }
            RAW_BARRIER();
            if (m == 0) {
                float ss = 0.f;
#pragma unroll
                for (int dq = 0; dq < 4; ++dq)
#pragma unroll
                    for (int r = 0; r < 16; ++r) { const float o = O[dq][r] * inv - lam * xb[(dq * 16 + r) * 64 + lane]; O[dq][r] = o; ss += o * o; }
                const float rstd = 1.0f / sqrtf(swap_add(ss) * (1.f / 128.f) + EPS) * one_m_li;
                bf16* orow = OUTB + (size_t)(rb + qpos) * 512 + h * 128;
#pragma unroll
                for (int dq = 0; dq < 4; ++dq)
#pragma unroll
                    for (int g4 = 0; g4 < 4; ++g4) { const int d0 = dq * 32 + 8 * g4 + 4 * hi; const f32x4 gs = *(const LAS f32x4*)(bt + 64 + 4096 + d0);
                        v2u w; w.x = pk2(O[dq][4 * g4] * rstd * gs.x, O[dq][4 * g4 + 1] * rstd * gs.y); w.y = pk2(O[dq][4 * g4 + 2] * rstd * gs.z, O[dq][4 * g4 + 3] * rstd * gs.w);
                        *(v2u*)(orow + d0) = w; }
            }
            asm volatile("s_waitcnt vmcnt(0)" ::: "memory");
            RAW_BARRIER();
        }
    }
}

constexpr size_t WS_OG = 432 * MiB, WS_LSE = 480 * MiB;
__device__ __forceinline__ void mixC_fast(unsigned char* y, unsigned char* ws, const float* T, LAS unsigned char* lds, int tid, int lane, int wave, int G) {
    asm volatile("" : "+v"(lane), "+v"(tid));
    const bf16* CQ = (const bf16*)(y + Y_CQ); const bf16* CK = (const bf16*)(y + Y_CK); const bf16* CV = (const bf16*)(y + Y_CV);
    float* OG = (float*)(ws + WS_OG); float* LSE = (float*)(ws + WS_LSE);
    const int r32 = lane & 31, hi = lane >> 5;
    LAS unsigned char* Kl = lds;
    LAS unsigned char* Vl = lds + 49152;
    LAS float* bt = (LAS float*)(lds + 98304);
    constexpr float C2 = 0.125f * LOG2E;
    for (int item = blockIdx.x; item < CHB * 192; item += G) {
        const int bb = item / 192, u = item % 192, g = u >> 6, v = u & 63;
        const int hp = v >> 4, w16 = v & 15;
        const int dil = (g == 0) ? 1 : (g == 1) ? 4 : 16;
        const int rc = (g == 0) ? 0 : (g == 1) ? (w16 >> 2) : w16;
        const int seg = (g == 0) ? w16 : (g == 1) ? (w16 & 3) : 0;
        const int hh = 4 * g + hp, M0 = seg * 256, rb = bb * SEQ;
        RAW_BARRIER();
        if (tid < 192) { int rel = tid - 32; rel = rel < 0 ? 0 : (rel > 128 ? 128 : rel); bt[tid] = T[(rel * dil) * 24 + 12 + hh] * LOG2E; }
#pragma unroll
        for (int i = 0; i < 6; ++i) { const int p = wave * 6 + i, c = p / 6, rbk = p % 6;
            int mk = M0 - 128 + 64 * rbk + lane; mk = mk < 0 ? 0 : mk;
            glds16(CK + (size_t)(rb + mk * dil + rc) * 768 + hh * 64 + c * 8, Kl + c * 6144 + rbk * 1024); }
#pragma unroll
        for (int i = 0; i < 6; ++i) { const int p = wave * 6 + i, dq = p / 24, rg = p % 24;
            int mk = M0 - 128 + 16 * rg + (lane >> 2); mk = mk < 0 ? 0 : mk;
            glds16(CV + (size_t)(rb + mk * dil + rc) * 768 + hh * 64 + dq * 32 + (lane & 3) * 8, Vl + p * 1024); }
        const int mq = M0 + 32 * wave + r32, rowq = rb + mq * dil + rc;
        bf16x8 qf[4];
#pragma unroll
        for (int ks = 0; ks < 4; ++ks) qf[ks] = *(const bf16x8*)(CQ + (size_t)rowq * 768 + hh * 64 + 16 * ks + 8 * hi);
        asm volatile("s_waitcnt vmcnt(0)" ::: "memory");
        RAW_BARRIER();
        f32x16 O[2];
#pragma unroll
        for (int dq = 0; dq < 2; ++dq)
#pragma unroll
            for (int r = 0; r < 16; ++r) O[dq][r] = 0.f;
        float mref = -INFINITY, lsum = 0.f;
#pragma unroll 1
        for (int j = 0; j < 5; ++j) {
            const int lrow = 32 * wave + 32 * j;
            if (M0 - 128 + lrow + 31 < 0) continue;
            const LAS unsigned char* kb = Kl + hi * 6144 + (lrow + r32) * 16;
            f32x16 s0;
#pragma unroll
            for (int r = 0; r < 16; ++r) s0[r] = 0.f;
#pragma unroll
            for (int ks = 0; ks < 4; ++ks) { const bf16x8 k0 = *(const LAS bf16x8*)(kb + ks * 12288); s0 = __builtin_amdgcn_mfma_f32_32x32x16_bf16(k0, qf[ks], s0, 0, 0, 0); }
            const int relb = 128 - 32 * j + r32;
            const LAS float* bp = bt + 32 + relb - 4 * hi;
            const int mkb = M0 - 128 + lrow + 4 * hi;
#pragma unroll
            for (int r = 0; r < 16; ++r) { const int cr = (r & 3) + 8 * (r >> 2), rel = relb - 4 * hi - cr;
                const float vv = fmaf(s0[r], C2, bp[-cr]);
                s0[r] = (rel >= 0 && rel <= 128 && mkb + cr >= 0) ? vv : -INFINITY; }
            float rm = s0[0];
#pragma unroll
            for (int r = 1; r < 16; ++r) rm = fmaxf(rm, s0[r]);
            rm = swap_max(rm);
            const float mn = fmaxf(mref, rm);
            const float f = (mn == -INFINITY) ? 1.f : __builtin_amdgcn_exp2f(mref - mn);
            const float msub = (mn == -INFINITY) ? 0.f : mn;
            lsum *= f; mref = mn;
#pragma unroll
            for (int dq = 0; dq < 2; ++dq)
#pragma unroll
                for (int r = 0; r < 16; ++r) O[dq][r] *= f;
            float ps = 0.f;
#pragma unroll
            for (int r = 0; r < 16; ++r) { s0[r] = __builtin_amdgcn_exp2f(s0[r] - msub); ps += s0[r]; }
            lsum += ps;
            bf16x8 pf[2];
            { v4u w;
              w.x = cvtpk(s0[0], s0[1]); w.y = cvtpk(s0[2], s0[3]); w.z = cvtpk(s0[4], s0[5]); w.w = cvtpk(s0[6], s0[7]); pf[0] = __builtin_bit_cast(bf16x8, w);
              w.x = cvtpk(s0[8], s0[9]); w.y = cvtpk(s0[10], s0[11]); w.z = cvtpk(s0[12], s0[13]); w.w = cvtpk(s0[14], s0[15]); pf[1] = __builtin_bit_cast(bf16x8, w); }
            const unsigned vb = (unsigned)(uintptr_t)(Vl + ((lane >> 4) & 1) * 32 + (lane & 3) * 8 + (4 * hi + ((lane & 15) >> 2)) * 64 + (lrow >> 4) * 1024);
            s16x4 fa[8];
#pragma unroll
            for (int dq = 0; dq < 2; ++dq)
#pragma unroll
                for (int sp = 0; sp < 2; ++sp) { TRV(fa[4 * dq + 2 * sp], vb, (dq * 24 + sp) * 1024); TRV(fa[4 * dq + 2 * sp + 1], vb, (dq * 24 + sp) * 1024 + 512); }
            LGKM_WAIT8(0, fa);
#pragma unroll
            for (int dq = 0; dq < 2; ++dq)
#pragma unroll
                for (int sp = 0; sp < 2; ++sp) O[dq] = __builtin_amdgcn_mfma_f32_32x32x16_bf16(VFRAG(fa, 2 * dq + sp), pf[sp], O[dq], 0, 0, 0);
        }
        const float ltot = swap_add(lsum), inv = 1.0f / ltot;
        float* og = OG + ((size_t)g * CHR + rowq) * 256 + hp * 64;
#pragma unroll
        for (int dq = 0; dq < 2; ++dq)
#pragma unroll
            for (int g4 = 0; g4 < 4; ++g4) { const int d0 = dq * 32 + 8 * g4 + 4 * hi;
                *(f32x4*)(og + d0) = (f32x4){O[dq][4 * g4] * inv, O[dq][4 * g4 + 1] * inv, O[dq][4 * g4 + 2] * inv, O[dq][4 * g4 + 3] * inv}; }
        if (hi == 0) LSE[((size_t)g * CHR + rowq) * 4 + hp] = (mref + __log2f(ltot)) * 0.6931471805599453f;
    }
}
__device__ __forceinline__ void mergeC(unsigned char* y, unsigned char* ws, int gw, int NGW, int lane) {
    asm volatile("" : "+v"(lane));
    const float* OG = (const float*)(ws + WS_OG); const float* LSE = (const float*)(ws + WS_LSE); bf16* OC = (bf16*)(y + Y_OC);
    for (int r = gw; r < CHR; r += NGW) {
        const int hp = lane >> 4, d4 = (lane & 15) * 4;
        float l0 = LSE[((size_t)0 * CHR + r) * 4 + hp], l1 = LSE[((size_t)1 * CHR + r) * 4 + hp], l2 = LSE[((size_t)2 * CHR + r) * 4 + hp];
        const float M = fmaxf(fmaxf(l0, l1), l2);
        const float a0 = __expf(l0 - M), a1 = __expf(l1 - M), a2 = __expf(l2 - M), ia = 1.0f / (a0 + a1 + a2);
        const f32x4 o0 = *(const f32x4*)(OG + ((size_t)0 * CHR + r) * 256 + hp * 64 + d4), o1 = *(const f32x4*)(OG + ((size_t)1 * CHR + r) * 256 + hp * 64 + d4), o2 = *(const f32x4*)(OG + ((size_t)2 * CHR + r) * 256 + hp * 64 + d4);
        const f32x4 o = (o0 * a0 + o1 * a1 + o2 * a2) * ia;
        v2u w; w.x = pk2(o.x, o.y); w.y = pk2(o.z, o.w);
        *(v2u*)(OC + (size_t)r * 256 + hp * 64 + d4) = w;
    }
}

constexpr int CW_KMAX = 8192;
constexpr int A_KST = 0, A_HIST = 32768, A_CAND = 98304, A_SEL = 131072, A_BKT = 147456, A_BIAS = 151552;
__device__ __forceinline__ int a_bin(float s, int kb) {
    int k = (int)(__float_as_uint(fabsf(s)) >> 18) - kb; k = k < 0 ? 0 : (k > 511 ? 511 : k);
    return (s < 0.f) ? (511 - k) : (512 + k);
}
__device__ __forceinline__ void mixA_fast(unsigned char* y, bf16* OUTA, bf16* OUTA2, const bf16* KVN, const float* T, const float* rel_bias, const unsigned* kmaxw, LAS unsigned char* lds, int tid, int lane, int wave, int G) {
    asm volatile("" : "+v"(lane), "+v"(tid));
    bf16* QLAT = (bf16*)(y + Y_QLAT); const bf16* MISC = (const bf16*)(y + Y_MISC); const bf16* IQ = (const bf16*)(y + Y_IQ);
    const int kl = lane & 31, hi = lane >> 5;
    constexpr float C2 = 0.125f * LOG2E, THR = 8.0f;
    LAS float* biasl = (LAS float*)(lds + A_BIAS);
    const unsigned lt32 = (1u << kl) - 1u;
    for (int item = blockIdx.x; item < CHB * 64; item += G) {
        const int bb = (G == 256) ? (item & 3) : (item >> 6), pr = (G == 256) ? (((item >> 2) & 1) * 32 + (item >> 3)) : (item & 63), rb = bb * SEQ;
        const float kmax = sqrtf(__uint_as_float(kmaxw[bb]));
        for (int uu = 0; uu < 2; ++uu) {
            const int qb = (uu == 0) ? (127 - pr) : pr, t0 = qb * 32, tw = t0 + 4 * wave;
            RAW_BARRIER();
            if (tid < 256) biasl[tid] = rel_bias[(tid >> 3) * 24 + (tid & 7)] * LOG2E;
            bf16x8 aq[4];
            { const int rowq = kl >> 3, hr = kl & 7;
#pragma unroll
              for (int ks = 0; ks < 4; ++ks) aq[ks] = *(const bf16x8*)(IQ + (size_t)(rb + tw + rowq) * 512 + hr * 64 + 16 * ks + 8 * hi); }
            float wr[16];
#pragma unroll
            for (int r = 0; r < 16; ++r) wr[r] = bf2f(MISC[(size_t)(rb + tw + (r >> 2)) * 256 + 192 + (r & 3) + 4 * hi]) * 0.044194173824159216f;
            int kbX, kbY;
            { float ss = 0.f;
#pragma unroll
              for (int ks = 0; ks < 4; ++ks)
#pragma unroll
                  for (int j = 0; j < 8; ++j) { const float v = bf2f((bf16)aq[ks][j]); ss += v * v; }
              ss = swap_add(ss);
              const float wa = fabsf(bf2f(MISC[(size_t)(rb + tw + (kl >> 3)) * 256 + 192 + (kl & 7)])) * 0.044194173824159216f;
              float u = wa * sqrtf(ss) * kmax;
              u += __shfl_xor(u, 1); u += __shfl_xor(u, 2); u += __shfl_xor(u, 4);
              const float uX = __shfl(u, (2 * hi) * 8), uY = __shfl(u, (2 * hi + 1) * 8);
              kbX = (int)(__float_as_uint(uX) >> 18) - 511; kbY = (int)(__float_as_uint(uY) >> 18) - 511; }
            const int tX = tw + 2 * hi, tY = tw + 2 * hi + 1;
            const int qX = wave * 4 + 2 * hi, qY = qX + 1;
            LAS unsigned* histX = (LAS unsigned*)(lds + A_HIST + qX * 2048); LAS unsigned* histY = (LAS unsigned*)(lds + A_HIST + qY * 2048);
            int thrX = -1, thrY = -1; unsigned cntX = 0, cntY = 0, ccX = 0, ccY = 0;
#pragma unroll 1
            for (int rep8 = 0; rep8 < ((PROBE == 8 || PROBE == 15) ? 2 : 1); ++rep8) {
            thrX = -1; thrY = -1; cntX = 0; cntY = 0; ccX = 0; ccY = 0;
            { LAS v4u* hz = (LAS v4u*)(lds + A_HIST + wave * 8192);
#pragma unroll
              for (int i = 0; i < 8; ++i) hz[i * 64 + lane] = (v4u){0u, 0u, 0u, 0u}; }
            const int NTK = qb + 1, NCK = (NTK + 3) >> 2;
#define MA_STAGE(ck_, buf_) do { _Pragma("unroll") for (int i_ = 0; i_ < 2; ++i_) { const int p_ = 2 * wave + i_, tl_ = p_ >> 2, ks_ = p_ & 3; \
                glds16(MISC + (size_t)(rb + 128 * (ck_) + 32 * tl_ + kl) * 256 + 128 + (2 * ks_ + hi) * 8, lds + A_KST + (buf_) * 16384 + tl_ * 4096 + ks_ * 1024); } } while (0)
#pragma unroll 1
            for (int pass = 0; pass < 2; ++pass) {
                MA_STAGE(0, 0);
#pragma unroll 1
                for (int ck = 0; ck < NCK; ++ck) {
                    if (ck + 1 < NCK) { MA_STAGE(ck + 1, (ck + 1) & 1); asm volatile("s_waitcnt vmcnt(2)" ::: "memory"); }
                    else asm volatile("s_waitcnt vmcnt(0)" ::: "memory");
                    RAW_BARRIER();
#pragma unroll 1
                    for (int tl = 0; tl < 4; ++tl) {
                        const int kt = 4 * ck + tl; if (kt >= NTK) break;
                        if (PROBE == 15 && rep8 == 0) continue;
                        const LAS unsigned char* kbp = lds + A_KST + (ck & 1) * 16384 + tl * 4096 + hi * 512 + kl * 16;
                        f32x16 c;
#pragma unroll
                        for (int r = 0; r < 16; ++r) c[r] = 0.f;
#pragma unroll
                        for (int ks = 0; ks < 4; ++ks) { const bf16x8 kf = *(const LAS bf16x8*)(kbp + ks * 1024); c = __builtin_amdgcn_mfma_f32_32x32x16_bf16(aq[ks], kf, c, 0, 0, 0); }
                        float p0 = 0.f, p1 = 0.f, p2 = 0.f, p3 = 0.f;
#pragma unroll
                        for (int i = 0; i < 4; ++i) { p0 += wr[i] * fmaxf(c[i], 0.f); p1 += wr[4 + i] * fmaxf(c[4 + i], 0.f); p2 += wr[8 + i] * fmaxf(c[8 + i], 0.f); p3 += wr[12 + i] * fmaxf(c[12 + i], 0.f); }
                        float sX, sY;
                        { auto rr = __builtin_amdgcn_permlane32_swap(__float_as_uint(p0), __float_as_uint(p2), false, false); sX = __uint_as_float(rr[0]) + __uint_as_float(rr[1]) + 0.f; }
                        { auto rr = __builtin_amdgcn_permlane32_swap(__float_as_uint(p1), __float_as_uint(p3), false, false); sY = __uint_as_float(rr[0]) + __uint_as_float(rr[1]) + 0.f; }
                        const int s = kt * 32 + kl;
                        const bool vX = s <= tX, vY = s <= tY;
                        const int bX = a_bin(sX, kbX), bY = a_bin(sY, kbY);
                        if (pass == 0) {
                            if (vX) lds_add_u32_asm(histX + (bX >> 1), 1u << ((bX & 1) * 16));
                            if (vY) lds_add_u32_asm(histY + (bY >> 1), 1u << ((bY & 1) * 16));
                        } else {
                            {   const bool sel = vX && bX > thrX, cd = vX && bX == thrX;
                                const unsigned long long bs = __ballot(sel), bc = __ballot(cd);
                                const unsigned ms = hi ? (unsigned)(bs >> 32) : (unsigned)bs, mc = hi ? (unsigned)(bc >> 32) : (unsigned)bc;
                                if (sel) lds_st_b16_asm((LAS bf16*)(lds + A_SEL + qX * 512) + cntX + __popc(ms & lt32), (unsigned)s);
                                if (cd) { const unsigned cp = ccX + __popc(mc & lt32); if (cp < 128u) { lds_st_b32_asm((LAS float*)(lds + A_CAND + qX * 768) + cp, __float_as_uint(sX)); lds_st_b16_asm((LAS bf16*)(lds + A_CAND + qX * 768 + 512) + cp, (unsigned)s); } }
                                cntX += __popc(ms); ccX += __popc(mc); }
                            {   const bool sel = vY && bY > thrY, cd = vY && bY == thrY;
                                const unsigned long long bs = __ballot(sel), bc = __ballot(cd);
                                const unsigned ms = hi ? (unsigned)(bs >> 32) : (unsigned)bs, mc = hi ? (unsigned)(bc >> 32) : (unsigned)bc;
                                if (sel) lds_st_b16_asm((LAS bf16*)(lds + A_SEL + qY * 512) + cntY + __popc(ms & lt32), (unsigned)s);
                                if (cd) { const unsigned cp = ccY + __popc(mc & lt32); if (cp < 128u) { lds_st_b32_asm((LAS float*)(lds + A_CAND + qY * 768) + cp, __float_as_uint(sY)); lds_st_b16_asm((LAS bf16*)(lds + A_CAND + qY * 768 + 512) + cp, (unsigned)s); } }
                                cntY += __popc(ms); ccY += __popc(mc); }
                        }
                    }
                    RAW_BARRIER();
                }
                if (pass == 0) {
#pragma unroll 1
                    for (int q4 = 0; q4 < 4; ++q4) {
                        const LAS unsigned* hq = (const LAS unsigned*)(lds + A_HIST + (wave * 4 + q4) * 2048) + 504 - 8 * lane;
                        unsigned w8[8];
                        { const v4u a0 = *(const LAS v4u*)hq, a1 = *(const LAS v4u*)(hq + 4); w8[0] = a0.x; w8[1] = a0.y; w8[2] = a0.z; w8[3] = a0.w; w8[4] = a1.x; w8[5] = a1.y; w8[6] = a1.z; w8[7] = a1.w; }
                        unsigned loc = 0;
#pragma unroll
                        for (int j = 0; j < 8; ++j) loc += (w8[j] & 0xffffu) + (w8[j] >> 16);
                        unsigned inc = loc;
#pragma unroll
                        for (int o = 1; o < 64; o <<= 1) { const unsigned v = __shfl_up(inc, o); if (lane >= o) inc += v; }
                        unsigned run = inc - loc; int thr = -1; unsigned cab = 0;
#pragma unroll
                        for (int j = 7; j >= 0; --j)
#pragma unroll
                            for (int hh = 1; hh >= 0; --hh) { const unsigned cn = (w8[j] >> (16 * hh)) & 0xffffu;
                                if (thr < 0 && run + cn >= (unsigned)TOPK) { thr = 2 * (504 - 8 * lane + j) + hh; cab = run; }
                                run += cn; }
                        const unsigned long long bl = __ballot(inc >= (unsigned)TOPK);
                        int thq = -1; unsigned cbq = 0;
                        if (bl) { const int L = __ffsll((long long)bl) - 1; thq = __shfl(thr, L); cbq = __shfl(cab, L); }
                        (void)cbq;
                        if (q4 == 2 * hi) thrX = thq; if (q4 == 2 * hi + 1) thrY = thq;
                    }
                }
            }
            }
#undef MA_STAGE
            {
                const unsigned c0 = (unsigned)__shfl((int)cntX, 0), c2 = (unsigned)__shfl((int)cntX, 32), c1 = (unsigned)__shfl((int)cntY, 0), c3 = (unsigned)__shfl((int)cntY, 32);
                const unsigned k0 = (unsigned)__shfl((int)ccX, 0), k2 = (unsigned)__shfl((int)ccX, 32), k1 = (unsigned)__shfl((int)ccY, 0), k3 = (unsigned)__shfl((int)ccY, 32);
#pragma unroll 1
                for (int q4 = 0; q4 < 4; ++q4) {
                    const unsigned cnt = (q4 == 0) ? c0 : (q4 == 1) ? c1 : (q4 == 2) ? c2 : c3; unsigned cc = (q4 == 0) ? k0 : (q4 == 1) ? k1 : (q4 == 2) ? k2 : k3;
                    if (cc > 128u) cc = 128u;
                    LAS unsigned* nfp = (LAS unsigned*)(lds + A_BIAS + 1024) + wave * 4 + q4;
                    if (lane == 0) *nfp = cnt;
                    if (cnt >= (unsigned)TOPK || cc == 0u) continue;
                    const unsigned need = (unsigned)TOPK - cnt;
                    const LAS float* cs = (const LAS float*)(lds + A_CAND + (wave * 4 + q4) * 768); const LAS bf16* ci = (const LAS bf16*)(lds + A_CAND + (wave * 4 + q4) * 768 + 512);
                    LAS bf16* so = (LAS bf16*)(lds + A_SEL + (wave * 4 + q4) * 512);
                    unsigned base = cnt;
#pragma unroll 1
                    for (unsigned r0 = 0; r0 < cc; r0 += 64) { const unsigned i = r0 + lane; const bool act = i < cc;
                        const float si = act ? cs[i] : 0.f; const unsigned ii = act ? ci[i] : 0u; unsigned rank = 0;
                        for (unsigned j = 0; j < cc; ++j) { const float sj = cs[j]; const unsigned ij = ci[j]; rank += (sj > si || (sj == si && ij < ii)) ? 1u : 0u; }
                        const bool take = act && rank < need;
                        const unsigned long long bt = __ballot(take);
                        if (take) so[base + __popcll(bt & ((1ull << lane) - 1ull))] = (bf16)ii;
                        base += __popcll(bt); }
                    if (lane == 0) *nfp = base;
                }
            }
            RAW_BARRIER();
#pragma unroll 1
            for (int rep9 = 0; rep9 < ((PROBE == 9 || PROBE == 10 || PROBE == 11) ? 2 : 1); ++rep9) {
                bf16* OUTP_ = ((PROBE == 9 || PROBE == 10 || PROBE == 11) && rep9 == 0) ? OUTA2 : OUTA;
                LAS unsigned char* gb = lds + wave * 16384;
                LAS bf16* bkt = (LAS bf16*)(lds + A_BKT + wave * 512);
#pragma unroll 1
                for (int q4 = 0; q4 < 4; ++q4) { int ns = (int)((const LAS unsigned*)(lds + A_BIAS + 1024))[wave * 4 + q4]; ns = ns < TOPK ? ns : TOPK; LAS bf16* so = (LAS bf16*)(lds + A_SEL + (wave * 4 + q4) * 512);
                    for (int i = lane; i < TOPK; i += 64) if (i >= ns) so[i] = 0; }
                asm volatile("s_waitcnt lgkmcnt(0)" ::: "memory");
                const int c15 = lane & 15, g = lane >> 4, q_ = c15 >> 2, p_ = c15 & 3, hc = c15 < 8 ? c15 : 7;
                const int Xr = ((c15 & 3) << 2) | ((c15 >> 2) & 3), Xt = (q_ << 2) | g;
                unsigned ra[4], ta[8];
#pragma unroll
                for (int ks = 0; ks < 4; ++ks) ra[ks] = (unsigned)(256 * c15 + 16 * ((4 * ks + g) ^ Xr));
#pragma unroll
                for (int dt = 0; dt < 8; ++dt) ta[dt] = (unsigned)(256 * (4 * g + q_) + 16 * ((2 * dt + (p_ >> 1)) ^ Xt) + 8 * (p_ & 1));
                bf16x8 bbf;
                { v4u w; const LAS float* bl = biasl + (8 * g) * 8 + hc;
                  constexpr float BS = 8.0f / LOG2E;
                  w.x = pk2(bl[0] * BS, bl[8] * BS); w.y = pk2(bl[16] * BS, bl[24] * BS); w.z = pk2(bl[32] * BS, bl[40] * BS); w.w = pk2(bl[48] * BS, bl[56] * BS); bbf = __builtin_bit_cast(bf16x8, w); }
#define MA_GATHER(q4_, c8_, buf_) do { const LAS bf16* so_ = (const LAS bf16*)(lds + A_SEL + (wave * 4 + (q4_)) * 512) + (c8_) * 32; \
                    int idx_[8]; _Pragma("unroll") for (int i_ = 0; i_ < 8; ++i_) idx_[i_] = (PROBE == 10 && rep9 == 0) ? (4 * i_ + (lane >> 4)) : (int)so_[4 * i_ + (lane >> 4)]; \
                    asm volatile("s_waitcnt lgkmcnt(0)" : "+v"(idx_[0]), "+v"(idx_[1]), "+v"(idx_[2]), "+v"(idx_[3]), "+v"(idx_[4]), "+v"(idx_[5]), "+v"(idx_[6]), "+v"(idx_[7]) :: "memory"); \
                    _Pragma("unroll") for (int i_ = 0; i_ < 8; ++i_) { const int row_ = 4 * i_ + (lane >> 4); \
                        const int ch_ = (lane & 15) ^ (((row_ & 3) << 2) | ((row_ >> 2) & 3)); \
                        glds16(KVN + (size_t)(rb + idx_[i_]) * 128 + ch_ * 8, gb + (buf_) * 8192 + i_ * 1024); } } while (0)
                MA_GATHER(0, 0, 0);
#pragma unroll 1
                for (int q4 = 0; q4 < 4; ++q4) {
                    const int t = tw + q4; int ns = (int)((const LAS unsigned*)(lds + A_BIAS + 1024))[wave * 4 + q4]; ns = ns < TOPK ? ns : TOPK;
                    const LAS bf16* so = (const LAS bf16*)(lds + A_SEL + (wave * 4 + q4) * 512);
                    for (int i = lane; i < TOPK; i += 64) { const int d = t - (int)so[i]; lds_st_b16_asm(bkt + i, (unsigned)rel_bucket(d < 0 ? 0 : d)); }
                    bf16x8 bq[4];
#pragma unroll
                    for (int ks = 0; ks < 4; ++ks) { bq[ks] = (bf16x8){0, 0, 0, 0, 0, 0, 0, 0}; if (c15 < 8) bq[ks] = *(const bf16x8*)(QLAT + (size_t)(rb + t) * 1024 + c15 * 128 + 32 * ks + 8 * g); }
                    f32x4 O[8];
#pragma unroll
                    for (int dt = 0; dt < 8; ++dt) O[dt] = (f32x4){0.f, 0.f, 0.f, 0.f};
                    float mref = -INFINITY, lsum = 0.f;
#pragma unroll 1
                    for (int c8 = 0; c8 < 8; ++c8) {
                        const int step = q4 * 8 + c8, buf = step & 1;
                        asm volatile("s_waitcnt lgkmcnt(0)" ::: "memory");
                        if (step + 1 < 32) { MA_GATHER((step + 1) >> 3, (step + 1) & 7, buf ^ 1); asm volatile("s_waitcnt vmcnt(8)" ::: "memory"); }
                        else asm volatile("s_waitcnt vmcnt(0)" ::: "memory");
                        const LAS unsigned char* cb = gb + buf * 8192;
                        if (PROBE == 11 && rep9 == 0) continue;
                        f32x4 sv[2];
#pragma unroll
                        for (int tau = 0; tau < 2; ++tau) {
                            f32x4 sa = (f32x4){0.f, 0.f, 0.f, 0.f};
#pragma unroll
                            for (int ks = 0; ks < 4; ++ks) { const bf16x8 kf = *(const LAS bf16x8*)(cb + ra[ks] + 4096 * tau); sa = __builtin_amdgcn_mfma_f32_16x16x32_bf16(kf, bq[ks], sa, 0, 0, 0); }
                            const int b = (int)bkt[c8 * 32 + 16 * tau + c15];
                            const unsigned val = ((b >> 3) == g) ? (0x3F80u << ((b & 1) * 16)) : 0u; const int di = (b >> 1) & 3;
                            v4u oh; oh.x = (di == 0) ? val : 0u; oh.y = (di == 1) ? val : 0u; oh.z = (di == 2) ? val : 0u; oh.w = (di == 3) ? val : 0u;
                            sa = __builtin_amdgcn_mfma_f32_16x16x32_bf16(__builtin_bit_cast(bf16x8, oh), bbf, sa, 0, 0, 0);
                            sv[tau] = sa * C2;
                        }
                        if (ns < TOPK) {
#pragma unroll
                            for (int tau = 0; tau < 2; ++tau)
#pragma unroll
                                for (int r = 0; r < 4; ++r) if (c8 * 32 + 16 * tau + 4 * g + r >= ns) sv[tau][r] = -INFINITY;
                        }
                        float rm = fmaxf(fmaxf(fmaxf(sv[0][0], sv[0][1]), fmaxf(sv[0][2], sv[0][3])), fmaxf(fmaxf(sv[1][0], sv[1][1]), fmaxf(sv[1][2], sv[1][3])));
                        rm = fmaxf(rm, __shfl_xor(rm, 16)); rm = fmaxf(rm, __shfl_xor(rm, 32));
                        if (__any(rm > mref + THR)) {
                            const float mn = fmaxf(mref, rm), f = (mn == -INFINITY) ? 1.f : __builtin_amdgcn_exp2f(mref - mn);
                            lsum *= f; mref = mn;
#pragma unroll
                            for (int dt = 0; dt < 8; ++dt) O[dt] = O[dt] * f;
                        }
                        const float msub = (mref == -INFINITY) ? 0.f : mref;
                        float ps = 0.f;
#pragma unroll
                        for (int tau = 0; tau < 2; ++tau)
#pragma unroll
                            for (int r = 0; r < 4; ++r) { sv[tau][r] = __builtin_amdgcn_exp2f(sv[tau][r] - msub); ps += sv[tau][r]; }
                        lsum += ps;
                        bf16x8 pf;
                        { v4u w; w.x = cvtpk(sv[0][0], sv[0][1]); w.y = cvtpk(sv[0][2], sv[0][3]); w.z = cvtpk(sv[1][0], sv[1][1]); w.w = cvtpk(sv[1][2], sv[1][3]); pf = __builtin_bit_cast(bf16x8, w); }
                        {
                            const unsigned cbu = (unsigned)(uintptr_t)cb;
                            s16x4 fa[8], fb[8];
#pragma unroll
                            for (int dt = 0; dt < 4; ++dt) { TRV(fa[2 * dt], cbu + ta[dt], 0); TRV(fa[2 * dt + 1], cbu + ta[dt], 4096); }
#pragma unroll
                            for (int dt = 0; dt < 4; ++dt) { TRV(fb[2 * dt], cbu + ta[4 + dt], 0); TRV(fb[2 * dt + 1], cbu + ta[4 + dt], 4096); }
                            LGKM_WAIT8(8, fa);
#pragma unroll
                            for (int dt = 0; dt < 4; ++dt) O[dt] = __builtin_amdgcn_mfma_f32_16x16x32_bf16(VFRAG(fa, dt), pf, O[dt], 0, 0, 0);
                            LGKM_WAIT8(0, fb);
#pragma unroll
                            for (int dt = 0; dt < 4; ++dt) O[4 + dt] = __builtin_amdgcn_mfma_f32_16x16x32_bf16(VFRAG(fb, dt), pf, O[4 + dt], 0, 0, 0);
                        }
                    }
                    float lt = lsum; lt += __shfl_xor(lt, 16); lt += __shfl_xor(lt, 32);
                    const float inv = 1.0f / lt;
                    if (c15 < 8) { bf16* orow = OUTP_ + (size_t)(rb + t) * 1024 + c15 * 128 + 4 * g;
#pragma unroll
                        for (int dt = 0; dt < 8; ++dt) { v2u w; w.x = pk2(O[dt][0] * inv, O[dt][1] * inv); w.y = pk2(O[dt][2] * inv, O[dt][3] * inv); *(v2u*)(orow + 16 * dt) = w; } }
                }
#undef MA_GATHER
                asm volatile("s_waitcnt vmcnt(0)" ::: "memory");
            }
        }
    }
}
#define Y_() (WSP() + WS_Y)
#define WL_(l) (WSP() + WS_W + (size_t)(l) * W_LAYER)
#define MOD_(l) ((const float*)(WSP() + WS_MOD) + (size_t)(l) * 8 * 6144)
#define T_() ((const float*)(WSP() + WS_TAB))
#define H_() ((bf16*)(WSP() + WS_H))
#define KVN_() ((bf16*)(WSP() + WS_KVN))
#define KMAXW_(l, ch) ((unsigned*)(WSP() + WS_CTL) + 8192 + ((l) * NCH + (ch)) * 64)
#define LAMI_(l) (((l) == 0) ? 0.8f : 0.64449093f)
__device__ __forceinline__ int tidx() { int t = (int)threadIdx.x; asm volatile("" : "+v"(t)); return t; }
#define TID_ tidx()
#define LANE_ (tidx() & 63)
__global__ void __launch_bounds__(NTHREADS, 2) fwd(Args a) {
    extern __shared__ __attribute__((aligned(16))) unsigned char lds_raw[];
    LAS unsigned char* lds = (LAS unsigned char*)lds_raw;
    const int wave = __builtin_amdgcn_readfirstlane((int)threadIdx.x >> 6);
    const int G = gridDim.x, gw = blockIdx.x * NWAVES + wave, NGW = G * NWAVES;
    for (int u = (int)threadIdx.x; u < (LDS_BYTES - LDSCTL_OFF) / 4; u += NTHREADS) ((LAS unsigned*)(lds + LDSCTL_OFF))[u] = 0u;
    __syncthreads();
    XcdBarrier bar = xcd_barrier_post((unsigned*)(WSP() + WS_CTL) + CW_BAR, (volatile LAS unsigned*)(lds + LDSCTL_OFF));

#pragma unroll 1
    for (int rep = 0; rep < (PROBE == 5 ? 2 : 1); ++rep) {
    p0a_prologue(WSP(), lds, TID_, LANE_, wave, G);
    xcd_barrier(bar); }
    norm_rows(ARG(0), H_(), ARG(4), MOD_(0) + 0 * 1024, MOD_(0) + 1 * 1024, gw, NGW, LANE_);
    xcd_barrier(bar);

#pragma unroll 1
    for (int l = 0; l < NL; ++l) {
#pragma unroll 1
        for (int ch = 0; ch < NCH; ++ch) {
            { pg8::Gemm g{H_() + (size_t)ch * CHR * 1024, (const bf16*)(WL_(l) + W_IN), CHR, NIN, 1024}; pg8::StaticOrder S; S.init(CHR, NIN, G, (int)blockIdx.x);
              pg8::EpiIn E{Y_()};
#pragma unroll 1
              for (int rep = 0; rep < (PROBE == 1 ? 2 : 1); ++rep)
              pg8::gemm_phase<pg8::EpiIn, pg8::StaticOrder, true, true>(lds, g, S, E);
            }
            xcd_barrier(bar);
            kvn_rows(Y_(), KVN_(), ARG(8) + l * 128, KMAXW_(l, ch), gw, NGW, LANE_);
#if PROBE == 4
            mixC_fast(Y_(), WSP(), T_(), lds, TID_, LANE_, wave, G);
#endif
            mixC_fast(Y_(), WSP(), T_(), lds, TID_, LANE_, wave, G);
#if PROBE == 2 || (PROBE >= 12 && PROBE <= 14)
            mixB_fast<(PROBE == 2 ? 0 : PROBE - 11)>(Y_(), (bf16*)(WSP() + 484 * MiB), T_(), ARG(13) + l * 128, ((const float*)(WSP() + WS_LAM))[l], LAMI_(l), lds, TID_, LANE_, wave, G);
#endif
            mixB_fast<0>(Y_(), (bf16*)(Y_() + Y_BQ), T_(), ARG(13) + l * 128, ((const float*)(WSP() + WS_LAM))[l], LAMI_(l), lds, TID_, LANE_, wave, G);
            xcd_barrier(bar);
            mergeC(Y_(), WSP(), gw, NGW, LANE_);
#if PROBE == 3 || PROBE == 9 || PROBE == 10 || PROBE == 11
            xcd_barrier(bar);
#endif
#if PROBE == 3
            mixA_fast(Y_(), (bf16*)(WSP() + WS_OG), (bf16*)(WSP() + WS_OG), KVN_(), T_(), ARG(21), KMAXW_(l, ch), lds, TID_, LANE_, wave, G);
#endif
            mixA_fast(Y_(), (bf16*)(Y_() + Y_QLAT), (bf16*)(WSP() + WS_OG), KVN_(), T_(), ARG(21), KMAXW_(l, ch), lds, TID_, LANE_, wave, G);
            xcd_barrier(bar);
#pragma unroll 1
            for (int rep = 0; rep < (PROBE == 7 ? 2 : 1); ++rep)
            { pg8::StaticOrder S; S.init(CHR, 1024, G, (int)blockIdx.x);
              { unsigned char* y = Y_(); pg8::Gemm g{(const bf16*)(y + Y_QLAT), (const bf16*)(WL_(l) + W_A), CHR, 1024, 1024}; pg8::EpiGate<0> E{(const bf16*)(y + Y_Z), 0, (float*)(y + Y_MF32), (bf16*)(y + Y_MBF)};
                pg8::gemm_phase<pg8::EpiGate<0>, pg8::StaticOrder, true, true>(lds, g, S, E); }
              { unsigned char* y = Y_(); pg8::Gemm g{(const bf16*)(y + Y_BQ), (const bf16*)(WL_(l) + W_B), CHR, 1024, 512}; pg8::EpiGate<1> E{(const bf16*)(y + Y_Z), 1024, (float*)(y + Y_MF32), (bf16*)(y + Y_MBF)};
                pg8::gemm_phase<pg8::EpiGate<1>, pg8::StaticOrder, true, true>(lds, g, S, E); }
              { unsigned char* y = Y_(); pg8::Gemm g{(const bf16*)(y + Y_OC), (const bf16*)(WL_(l) + W_C), CHR, 1024, 256}; pg8::EpiGate<2> E{(const bf16*)(y + Y_Z), 2048, (float*)(y + Y_MF32), (bf16*)(y + Y_MBF)};
                pg8::gemm_phase<pg8::EpiGate<2>, pg8::StaticOrder, true, true>(lds, g, S, E); } }
            xcd_barrier(bar);
            { pg8::Gemm g{(const bf16*)(Y_() + Y_MBF), (const bf16*)(WL_(l) + W_OUT), CHR, 1024, 1024}; pg8::StaticOrder S; S.init(CHR, 1024, G, (int)blockIdx.x);
              pg8::EpiRes E{(l == 0) ? ARG(0) : (const float*)OUTP(), OUTP(), MOD_(l) + 2 * 1024, ch * CHR};
              pg8::gemm_phase<pg8::EpiRes, pg8::StaticOrder, true, true>(lds, g, S, E); }
            xcd_barrier(bar);
        }
#pragma unroll 1
        for (int rep = 0; rep < (PROBE == 6 ? 2 : 1); ++rep) {
        norm_rows(OUTP(), H_(), ARG(18) + l * 1024, MOD_(l) + 3 * 1024, MOD_(l) + 4 * 1024, gw, NGW, LANE_);
        xcd_barrier(bar); }
        { pg8::Gemm g{H_(), (const bf16*)(WL_(l) + W_GU), MT, NGU, 1024}; pg8::StaticOrder S; S.init(MT, NGU, G, (int)blockIdx.x);
          pg8::EpiSwiGLU E{(bf16*)(WSP() + WS_ACT)};
#pragma unroll 1
          for (int rep = 0; rep < (PROBE == 1 ? 2 : 1); ++rep)
          pg8::gemm_phase<pg8::EpiSwiGLU, pg8::StaticOrder, true, true>(lds, g, S, E);
        }
        xcd_barrier(bar);
        { pg8::Gemm g{(const bf16*)(WSP() + WS_ACT), (const bf16*)(WL_(l) + W_D), MT, 1024, DFF}; pg8::StaticOrder S; S.init(MT, 1024, G, (int)blockIdx.x);
          pg8::EpiRes E{OUTP(), OUTP(), MOD_(l) + 5 * 1024, 0};
          pg8::gemm_phase<pg8::EpiRes, pg8::StaticOrder, true, true>(lds, g, S, E); }
        xcd_barrier(bar);
        if (l + 1 < NL) { norm_rows(OUTP(), H_(), ARG(4) + (l + 1) * 1024, MOD_(l + 1) + 0 * 1024, MOD_(l + 1) + 1 * 1024, gw, NGW, LANE_); xcd_barrier(bar); }
        else final_rows(OUTP(), ARG(22), gw, NGW, LANE_);
    }
}

extern "C" void kernel_launch(void* const* d_in, const int* in_sizes, int n_in, void* d_out, int out_size, void* d_ws, size_t ws_size, hipStream_t stream) {
    static int grid = 0;
    if (grid == 0) {
        if (n_in != 23 || out_size != MT * DM || ws_size < WS_END) { fprintf(stderr, "kernel_launch: unexpected shapes (n_in %d out %d ws %zu)\n", n_in, out_size, ws_size); grid = -1; return; }
        int dev = 0, cus = 0, per_cu = 0;
        if (hipGetDevice(&dev) != hipSuccess || hipDeviceGetAttribute(&cus, hipDeviceAttributeMultiprocessorCount, dev) != hipSuccess) { grid = -1; return; }
        if (hipFuncSetAttribute((const void*)fwd, hipFuncAttributeMaxDynamicSharedMemorySize, LDS_BYTES) != hipSuccess) { fprintf(stderr, "kernel_launch: hipFuncSetAttribute failed\n"); grid = -1; return; }
        if (hipOccupancyMaxActiveBlocksPerMultiprocessor(&per_cu, (const void*)fwd, NTHREADS, LDS_BYTES) != hipSuccess || per_cu < 1) { fprintf(stderr, "kernel_launch: occupancy query says %d\n", per_cu); }
        (void)hipGetLastError();
        grid = cus;
    }
    if (grid < 0) return;
    (void)hipMemsetAsync((char*)d_ws + WS_CTL, 0, CTL_ZERO_BYTES, stream);
    Args a{};
    for (int i = 0; i < 23; ++i) a.in[i] = (const float*)d_in[i];
    a.out = (float*)d_out; a.ws = (unsigned char*)d_ws; a.pad0 = 0; a.pad1 = 0;
    hipLaunchKernelGGL(fwd, dim3(grid), dim3(NTHREADS), LDS_BYTES, stream, a);
}
```

```cpp
#include <hip/hip_runtime.h>
#include <cstdio>
#include <cstdint>
#ifndef PROBE
#define PROBE 0
#endif
namespace pg8 {
#define PG8_LAS __attribute__((address_space(3)))
typedef unsigned short bf16_t;
typedef short bf16x8 __attribute__((ext_vector_type(8)));
typedef float f32x4 __attribute__((ext_vector_type(4)));
typedef unsigned u32x4 __attribute__((ext_vector_type(4)));
constexpr int BM = 256, BK = 64, HALF = 128, HTB = HALF * BK * 2  , STAGE_BYTES = 8 * HTB, NXCD = 8, WGM = 8;

__host__ __device__ __forceinline__ int lds_byte(int r, int c) { const int st = (r >> 4) * 2 + (c >> 5), rr = r & 15, cc = c & 31, ob = rr * 64 + cc * 2; return st * 1024 + (ob ^ (((ob >> 9) & 1) << 5)); }
__host__ __device__ __forceinline__ void stage_rc(int b, int& R, int& C) { const int st = b / 1024, sb = b % 1024, swz = sb ^ (((sb >> 9) & 1) << 5); R = (st >> 1) * 16 + swz / 64; C = (st & 1) * 32 + (swz % 64) / 2; }
__host__ __device__ __forceinline__ int perm32(int rho) { const int n = rho >> 4, i = rho & 15; return 8 * (i >> 2) + 4 * n + (i & 3); }

struct Unit { int pm, pn; };
struct Gemm { const bf16_t* A; const bf16_t* Bt; int M, N, K; };

struct StaticOrder {
    int nM, nN, nwg, G, c;
    __host__ __device__ void init(int M, int N, int G_, int c_) { nM = M / BM; nN = N / BM; nwg = nM * nN; G = G_; c = c_; }
    __host__ __device__ bool next(int i, Unit& u) const {
        const long L = (long)i * G + c; if (L >= nwg) return false;
        int wgid = (int)L; { const int q = nwg / NXCD, r = nwg % NXCD, xcd = wgid % NXCD, off = wgid / NXCD; wgid = (xcd < r ? xcd * (q + 1) : r * (q + 1) + (xcd - r) * q) + off; }
        const int nig = WGM * nN, gid = wgid / nig, fm = gid * WGM, gsz = (nM - fm) < WGM ? (nM - fm) : WGM;
        u.pm = fm + ((wgid % nig) % gsz); u.pn = (wgid % nig) / gsz; return true;
    }
    __device__ __forceinline__ void a_ready(const Unit&) const {}
    __device__ __forceinline__ void done(const Unit&) const {}
};

template <class Epi, class Sched, bool ALIGN_EPI = false, bool SP2 = false>
__device__ __forceinline__ void gemm_phase(PG8_LAS unsigned char* lds, const Gemm g, const Sched& S, const Epi& E) {
    int tid_l = threadIdx.x; asm volatile("" : "+v"(tid_l));
    const int tid = tid_l, wid = __builtin_amdgcn_readfirstlane(tid >> 6), lane = tid & 63, wr = wid >> 2, wc = wid & 3, fr = lane & 15, fq = lane >> 4;
    int K_l = g.K; asm volatile("" : "+s"(K_l));
    const int K = K_l, nt = K / BK;
    unsigned voffA[2], voffB[2];
#pragma unroll
    for (int i = 0; i < 2; ++i) { int R, C; stage_rc(tid * 16 + i * 8192, R, C); const int Rb = Epi::PERM ? ((R & ~31) + perm32(R & 31)) : R;
        voffA[i] = (unsigned)(R * K + C) * 2u; voffB[i] = (unsigned)(Rb * K + C) * 2u; }
    const size_t kstep = (size_t)(BK * 2);
    const size_t hstep = (size_t)HALF * K * 2;
    const size_t tstep = 2 * hstep;
    const unsigned ldsw = (unsigned)wid * 1024u;
    const int aoff = lds_byte(wr * 64 + fr, fq * 8), boff = lds_byte(wc * 32 + fr, fq * 8);
#define PG8_SA(b, h) (((b) * 2 + (h)) * HTB)
#define PG8_SB(b, h) ((4 + (b) * 2 + (h)) * HTB)
#define PG8_STAGE(bufoff, gbase, voff) do { _Pragma("unroll") for (int _i = 0; _i < 2; ++_i) \
        __builtin_amdgcn_global_load_lds((const unsigned*)((const char*)(gbase) + (voff)[_i]), (PG8_LAS unsigned*)(lds + (bufoff) + ldsw + _i * 8192), 16, 0, 0); } while (0)
#define PG8_LDA(dst, b, h) do { _Pragma("unroll") for (int m = 0; m < 4; ++m) _Pragma("unroll") for (int k = 0; k < 2; ++k) dst[m][k] = *(const PG8_LAS bf16x8*)(lds + PG8_SA(b, h) + aoff + m * 2048 + k * 1024); } while (0)
#define PG8_LDB(dst, b, h) do { _Pragma("unroll") for (int n = 0; n < 2; ++n) _Pragma("unroll") for (int k = 0; k < 2; ++k) dst[n][k] = *(const PG8_LAS bf16x8*)(lds + PG8_SB(b, h) + boff + n * 2048 + k * 1024); } while (0)
#define PG8_MMA(ai, bj, At, Bt) do { __builtin_amdgcn_s_setprio(1); _Pragma("unroll") for (int m = 0; m < 4; ++m) _Pragma("unroll") for (int n = 0; n < 2; ++n) _Pragma("unroll") for (int k = 0; k < 2; ++k) \
        acc[ai][bj][m][n] = __builtin_amdgcn_mfma_f32_16x16x32_bf16(Bt[n][k], At[m][k], acc[ai][bj][m][n], 0, 0, 0); __builtin_amdgcn_s_setprio(0); } while (0)
#define PG8_WAIT_V(n) asm volatile("s_waitcnt vmcnt(" #n ")" ::: "memory")
#define PG8_WAIT_L(n) asm volatile("s_waitcnt lgkmcnt(" #n ")" ::: "memory")
#define PG8_BAR __builtin_amdgcn_s_barrier()
#define PG8_SCHED __builtin_amdgcn_sched_barrier(0)
    Unit cur, nxt; int ui = 0;
    if (!S.next(0, cur)) return;
    f32x4 acc[2][2][4][2];
#pragma unroll
    for (int a = 0; a < 2; ++a)
#pragma unroll
        for (int b = 0; b < 2; ++b)
#pragma unroll
            for (int m = 0; m < 4; ++m)
#pragma unroll
                for (int n = 0; n < 2; ++n) acc[a][b][m][n] = (f32x4){0.f, 0.f, 0.f, 0.f};
    bf16x8 At[4][2], B0[2][2], B1[2][2];
    const char* cA = (const char*)g.A + (size_t)cur.pm * tstep; const char* cB = (const char*)g.Bt + (size_t)cur.pn * tstep;
    S.a_ready(cur);
    if constexpr (SP2) {
        PG8_STAGE(PG8_SB(0, 0), cB, voffB); PG8_STAGE(PG8_SB(0, 1), cB + hstep, voffB); PG8_STAGE(PG8_SA(0, 0), cA, voffA); PG8_STAGE(PG8_SA(0, 1), cA + hstep, voffA);
        if (wr == 1) PG8_BAR;
        PG8_WAIT_V(2); PG8_BAR;
        PG8_STAGE(PG8_SB(1, 0), cB + kstep, voffB); PG8_STAGE(PG8_SA(1, 0), cA + kstep, voffA); PG8_STAGE(PG8_SB(1, 1), cB + hstep + kstep, voffB);
        PG8_WAIT_V(6); PG8_BAR;
    } else {
        PG8_STAGE(PG8_SB(0, 0), cB, voffB); PG8_STAGE(PG8_SA(0, 0), cA, voffA); PG8_STAGE(PG8_SB(0, 1), cB + hstep, voffB); PG8_STAGE(PG8_SA(0, 1), cA + hstep, voffA);
        if (wr == 1) PG8_BAR;
        PG8_WAIT_V(4); PG8_BAR;
        PG8_STAGE(PG8_SB(1, 0), cB + kstep, voffB); PG8_STAGE(PG8_SA(1, 0), cA + kstep, voffA); PG8_STAGE(PG8_SB(1, 1), cB + hstep + kstep, voffB);
        PG8_WAIT_V(6); PG8_BAR;
    }
    for (;;) {
        const bool has_next = S.next(ui + 1, nxt);
        const char* nA = has_next ? (const char*)g.A + (size_t)nxt.pm * tstep : cA; const char* nB = has_next ? (const char*)g.Bt + (size_t)nxt.pn * tstep : cB;
        for (int t = 0; t < nt; t += 2) {
            const bool last = (t == nt - 2);
            const char* a1 = cA + (size_t)(t + 1) * kstep;
            const char* a2 = last ? nA : cA + (size_t)(t + 2) * kstep; const char* b2 = last ? nB : cB + (size_t)(t + 2) * kstep;
            const char* a3 = a2 + kstep; const char* b3 = b2 + kstep;
            if (last && has_next) S.a_ready(nxt);
            if constexpr (SP2) {
            PG8_LDB(B0, 0, 0); PG8_LDB(B1, 0, 1); PG8_SCHED; PG8_LDA(At, 0, 0); PG8_STAGE(PG8_SA(1, 1), a1 + hstep, voffA);
            PG8_WAIT_V(8); PG8_WAIT_L(0); PG8_BAR; PG8_MMA(0, 0, At, B0); PG8_MMA(0, 1, At, B1); PG8_BAR; PG8_SCHED;
            PG8_LDA(At, 0, 1); PG8_STAGE(PG8_SB(0, 0), b2, voffB); PG8_STAGE(PG8_SB(0, 1), b2 + hstep, voffB); PG8_STAGE(PG8_SA(0, 0), a2, voffA);
            PG8_WAIT_V(8); PG8_WAIT_L(0); PG8_BAR; PG8_MMA(1, 0, At, B0); PG8_MMA(1, 1, At, B1); PG8_BAR; PG8_SCHED;
            PG8_LDB(B0, 1, 0); PG8_LDB(B1, 1, 1); PG8_SCHED; PG8_LDA(At, 1, 0); PG8_STAGE(PG8_SA(0, 1), a2 + hstep, voffA);
            PG8_WAIT_V(8); PG8_WAIT_L(0); PG8_BAR; PG8_MMA(0, 0, At, B0); PG8_MMA(0, 1, At, B1); PG8_BAR; PG8_SCHED;
            PG8_LDA(At, 1, 1); PG8_STAGE(PG8_SB(1, 0), b3, voffB); PG8_STAGE(PG8_SB(1, 1), b3 + hstep, voffB); PG8_STAGE(PG8_SA(1, 0), a3, voffA);
            PG8_WAIT_V(8); PG8_WAIT_L(0); PG8_BAR; PG8_MMA(1, 0, At, B0); PG8_MMA(1, 1, At, B1); PG8_BAR; PG8_SCHED;
            } else {
            PG8_LDB(B0, 0, 0); PG8_SCHED; PG8_LDA(At, 0, 0); PG8_STAGE(PG8_SA(1, 1), a1 + hstep, voffA);
            PG8_WAIT_L(8); PG8_BAR; PG8_WAIT_L(0); PG8_MMA(0, 0, At, B0); PG8_BAR; PG8_SCHED;
            PG8_LDB(B1, 0, 1); PG8_STAGE(PG8_SB(0, 0), b2, voffB);
            PG8_BAR; PG8_WAIT_L(0); PG8_MMA(0, 1, At, B1); PG8_BAR;
            PG8_LDA(At, 0, 1); PG8_STAGE(PG8_SA(0, 0), a2, voffA);
            PG8_BAR; PG8_WAIT_L(0); PG8_MMA(1, 0, At, B0); PG8_BAR; PG8_SCHED;
            PG8_STAGE(PG8_SB(0, 1), b2 + hstep, voffB);
            PG8_WAIT_V(6); PG8_BAR; PG8_MMA(1, 1, At, B1); PG8_BAR;
            PG8_LDB(B0, 1, 0); PG8_SCHED; PG8_LDA(At, 1, 0); PG8_STAGE(PG8_SA(0, 1), a2 + hstep, voffA);
            PG8_WAIT_L(8); PG8_BAR; PG8_WAIT_L(0); PG8_MMA(0, 0, At, B0); PG8_BAR; PG8_SCHED;
            PG8_LDB(B1, 1, 1); PG8_STAGE(PG8_SB(1, 0), b3, voffB);
            PG8_BAR; PG8_WAIT_L(0); PG8_MMA(0, 1, At, B1); PG8_BAR;
            PG8_LDA(At, 1, 1); PG8_STAGE(PG8_SA(1, 0), a3, voffA);
            PG8_BAR; PG8_WAIT_L(0); PG8_MMA(1, 0, At, B0); PG8_BAR; PG8_SCHED;
            PG8_STAGE(PG8_SB(1, 1), b3 + hstep, voffB);
            PG8_WAIT_V(6); PG8_BAR; PG8_MMA(1, 1, At, B1); PG8_BAR;
            }
        }
        if constexpr (ALIGN_EPI) { if (wr == 0) PG8_BAR; }
        if constexpr (!Epi::AFTER_DRAIN) { E(acc, cur, wr, wc, fr, fq); S.done(cur); }
        if (!has_next) break;
#pragma unroll
        for (int a = 0; a < 2; ++a)
#pragma unroll
            for (int b = 0; b < 2; ++b)
#pragma unroll
                for (int m = 0; m < 4; ++m)
#pragma unroll
                    for (int n = 0; n < 2; ++n) acc[a][b][m][n] = (f32x4){0.f, 0.f, 0.f, 0.f};
        cur = nxt; cA = nA; cB = nB; ++ui;
        if constexpr (ALIGN_EPI) { if (wr == 1) PG8_BAR; }
    }
    PG8_WAIT_V(0);
    if constexpr (!ALIGN_EPI) { if (wr == 0) PG8_BAR; }
    PG8_BAR;
    if constexpr (Epi::AFTER_DRAIN) { E.fused(acc, cur, wr, wc, fr, fq, lds, wid, lane); S.done(cur); }
#undef PG8_SA
#undef PG8_SB
#undef PG8_STAGE
#undef PG8_LDA
#undef PG8_LDB
#undef PG8_MMA
#undef PG8_WAIT_V
#undef PG8_WAIT_L
#undef PG8_BAR
#undef PG8_SCHED
}
}

constexpr int NB = 8, SEQ = 4096, DM = 1024, MT = NB * SEQ, NL = 2;
constexpr int CHB = 4, CHR = CHB * SEQ, NCH = NB / CHB;
constexpr int NIN = 8704, DFF = 2816, NGU = 2 * DFF, WIN_SRC = 8136;
constexpr int TOPK = 256;
constexpr float EPS = 1e-6f;
constexpr int NWAVES = 8, NTHREADS = 512;

constexpr size_t MiB = 1u << 20;
constexpr size_t WS_CTL = 0, CTL_ZERO_BYTES = 1 * MiB;
constexpr size_t WS_MOD = 1 * MiB;
constexpr size_t WS_TAB = WS_MOD + 393216;
constexpr size_t WS_LAM = WS_TAB + 393216;
constexpr size_t WS_W = 2 * MiB, W_LAYER = 39 * MiB;
constexpr size_t W_IN = 0, W_A = 17 * MiB, W_B = 19 * MiB, W_C = 20 * MiB, W_OUT = 20 * MiB + 512 * 1024, W_GU = 22 * MiB + 512 * 1024, W_D = 33 * MiB + 512 * 1024;
constexpr size_t WS_H = 80 * MiB;
constexpr size_t WS_Y = 144 * MiB;
constexpr size_t Y_QLAT = 0, Y_MISC = 32 * MiB, Y_IQ = 40 * MiB, Y_BQ = 56 * MiB, Y_BK = 72 * MiB, Y_BV = 88 * MiB, Y_CQ = 104 * MiB, Y_CK = 128 * MiB, Y_CV = 152 * MiB, Y_Z = 176 * MiB, Y_OC = 272 * MiB;
constexpr size_t Y_MF32 = Y_CQ, Y_MBF = Y_BK;
constexpr size_t WS_ACT = WS_Y;
constexpr size_t WS_KVN = 424 * MiB;
constexpr size_t WS_END = 428 * MiB;
constexpr int CW_BAR = 4096;

#define GAS __attribute__((address_space(1)))
#define LAS __attribute__((address_space(3)))
typedef unsigned short bf16;
typedef unsigned v4u __attribute__((ext_vector_type(4)));
typedef unsigned v2u __attribute__((ext_vector_type(2)));
typedef float f32x4 __attribute__((ext_vector_type(4)));

__device__ __forceinline__ unsigned f2bf(float f) { unsigned u = __builtin_bit_cast(unsigned, f); return (u + 0x7fffu + ((u >> 16) & 1u)) >> 16; }
typedef float f32x2_c __attribute__((ext_vector_type(2))); typedef __bf16 bf16x2_c __attribute__((ext_vector_type(2)));
__device__ __forceinline__ unsigned pk2(float lo, float hi) { const f32x2_c v = {lo, hi}; const bf16x2_c b = __builtin_convertvector(v, bf16x2_c); return __builtin_bit_cast(unsigned, b); }
__device__ __forceinline__ float bflo(unsigned w) { return __uint_as_float(w << 16); }
__device__ __forceinline__ float bfhi(unsigned w) { return __uint_as_float(w & 0xffff0000u); }
__device__ __forceinline__ float bf2f(bf16 h) { return __uint_as_float((unsigned)h << 16); }
__device__ __forceinline__ float wave_sum(float v) {
#pragma unroll
    for (int o = 1; o < 64; o <<= 1) v += __shfl_xor(v, o);
    return v;
}
__device__ __forceinline__ float wave_max(float v) {
#pragma unroll
    for (int o = 1; o < 64; o <<= 1) v = fmaxf(v, __shfl_xor(v, o));
    return v;
}
__device__ __forceinline__ float sigmoidf_(float v) { return __builtin_amdgcn_rcpf(1.f + __expf(-v)); }

namespace pg8 {
struct EpiIn {
    static constexpr bool PERM = true, AFTER_DRAIN = false;
    unsigned char* y;
    __device__ __forceinline__ void operator()(const f32x4 (&acc)[2][2][4][2], const Unit& u, int wr, int wc, int fr, int fq) const {
        const int pn = u.pn; size_t off; int ld, c0; bool sig = false;
        if (pn < 4)        { off = Y_QLAT; ld = 1024; c0 = pn * 256; }
        else if (pn == 4)  { off = Y_MISC; ld = 256;  c0 = 0; }
        else if (pn < 7)   { off = Y_IQ;   ld = 512;  c0 = (pn - 5) * 256; }
        else if (pn < 9)   { off = Y_BQ;   ld = 512;  c0 = (pn - 7) * 256; }
        else if (pn < 11)  { off = Y_BK;   ld = 512;  c0 = (pn - 9) * 256; }
        else if (pn < 13)  { off = Y_BV;   ld = 512;  c0 = (pn - 11) * 256; }
        else if (pn < 16)  { off = Y_CQ;   ld = 768;  c0 = (pn - 13) * 256; }
        else if (pn < 19)  { off = Y_CK;   ld = 768;  c0 = (pn - 16) * 256; }
        else if (pn < 22)  { off = Y_CV;   ld = 768;  c0 = (pn - 19) * 256; }
        else               { off = Y_Z;    ld = 3072; c0 = (pn - 22) * 256; sig = true; }
        bf16_t* base = (bf16_t*)(y + off);
        const int row0 = u.pm * BM + wr * 64 + fr, col0 = c0 + wc * 32 + 8 * fq;
#pragma unroll
        for (int ai = 0; ai < 2; ++ai)
#pragma unroll
            for (int m = 0; m < 4; ++m) { bf16_t* rowp = base + (size_t)(row0 + ai * HALF + m * 16) * ld + col0;
#pragma unroll
                for (int bj = 0; bj < 2; ++bj) { f32x4 v0 = acc[ai][bj][m][0], v1 = acc[ai][bj][m][1];
                    if (sig) {
#pragma unroll
                        for (int i = 0; i < 4; ++i) { v0[i] = sigmoidf_(v0[i]); v1[i] = sigmoidf_(v1[i]); } }
                    u32x4 w; w.x = pk2(v0[0], v0[1]); w.y = pk2(v0[2], v0[3]); w.z = pk2(v1[0], v1[1]); w.w = pk2(v1[2], v1[3]);
                    *(u32x4*)(rowp + bj * HALF) = w; } }
    }
};
template <int MODE> struct EpiGate {
    static constexpr bool PERM = true, AFTER_DRAIN = false;
    const bf16_t* z; int zc0; float* mf; bf16_t* mb;
    __device__ __forceinline__ void operator()(const f32x4 (&acc)[2][2][4][2], const Unit& u, int wr, int wc, int fr, int fq) const {
        const int row0 = u.pm * BM + wr * 64 + fr, col0 = u.pn * BM + wc * 32 + 8 * fq;
#pragma unroll
        for (int ai = 0; ai < 2; ++ai)
#pragma unroll
            for (int m = 0; m < 4; ++m) { const size_t row = (size_t)(row0 + ai * HALF + m * 16);
#pragma unroll
                for (int bj = 0; bj < 2; ++bj) { const int col = col0 + bj * HALF;
                    const u32x4 zw = *(const u32x4*)(z + row * 3072 + zc0 + col);
                    f32x4 v0 = acc[ai][bj][m][0], v1 = acc[ai][bj][m][1];
                    v0[0] *= __uint_as_float(zw.x << 16); v0[1] *= __uint_as_float(zw.x & 0xffff0000u); v0[2] *= __uint_as_float(zw.y << 16); v0[3] *= __uint_as_float(zw.y & 0xffff0000u);
                    v1[0] *= __uint_as_float(zw.z << 16); v1[1] *= __uint_as_float(zw.z & 0xffff0000u); v1[2] *= __uint_as_float(zw.w << 16); v1[3] *= __uint_as_float(zw.w & 0xffff0000u);
                    bf16_t* mp = mb + row * 1024 + col;
                    if (MODE >= 1) { const u32x4 pw = *(const u32x4*)mp;
                        v0[0] += __uint_as_float(pw.x << 16); v0[1] += __uint_as_float(pw.x & 0xffff0000u); v0[2] += __uint_as_float(pw.y << 16); v0[3] += __uint_as_float(pw.y & 0xffff0000u);
                        v1[0] += __uint_as_float(pw.z << 16); v1[1] += __uint_as_float(pw.z & 0xffff0000u); v1[2] += __uint_as_float(pw.w << 16); v1[3] += __uint_as_float(pw.w & 0xffff0000u); }
                    { u32x4 w; w.x = pk2(v0[0], v0[1]); w.y = pk2(v0[2], v0[3]); w.z = pk2(v1[0], v1[1]); w.w = pk2(v1[2], v1[3]); *(u32x4*)mp = w; } }
                asm volatile("" ::: "memory"); }
    }
};
struct EpiRes {
    static constexpr bool PERM = true, AFTER_DRAIN = false;
    const float* xin; float* xout; const float* gate; int row_off;
    __device__ __forceinline__ void operator()(const f32x4 (&acc)[2][2][4][2], const Unit& u, int wr, int wc, int fr, int fq) const {
        const int row0 = row_off + u.pm * BM + wr * 64 + fr, col0 = u.pn * BM + wc * 32 + 8 * fq;
        const float* gp = gate + (size_t)((row_off + u.pm * BM) / SEQ) * 6144 + col0;
        f32x4 g[2][2];
#pragma unroll
        for (int bj = 0; bj < 2; ++bj) { g[bj][0] = *(const f32x4*)(gp + bj * HALF); g[bj][1] = *(const f32x4*)(gp + bj * HALF + 4); }
#pragma unroll
        for (int ai = 0; ai < 2; ++ai)
#pragma unroll
            for (int m = 0; m < 4; ++m) { const size_t o = (size_t)(row0 + ai * HALF + m * 16) * 1024 + col0;
#pragma unroll
                for (int bj = 0; bj < 2; ++bj) {
                    const f32x4 a0 = *(const f32x4*)(xin + o + bj * HALF), a1 = *(const f32x4*)(xin + o + bj * HALF + 4);
                    *(f32x4*)(xout + o + bj * HALF) = a0 + g[bj][0] * acc[ai][bj][m][0];
                    *(f32x4*)(xout + o + bj * HALF + 4) = a1 + g[bj][1] * acc[ai][bj][m][1]; }
                asm volatile("" ::: "memory"); }
    }
};
struct EpiSwiGLU {
    static constexpr bool PERM = true, AFTER_DRAIN = false;
    bf16_t* act;
    __device__ __forceinline__ void operator()(const f32x4 (&acc)[2][2][4][2], const Unit& u, int wr, int wc, int fr, int fq) const {
        const int row0 = u.pm * BM + wr * 64 + fr, col0 = u.pn * HALF + wc * 32 + 8 * fq;
#pragma unroll
        for (int ai = 0; ai < 2; ++ai)
#pragma unroll
            for (int m = 0; m < 4; ++m) { bf16_t* rowp = act + (size_t)(row0 + ai * HALF + m * 16) * DFF + col0;
                f32x4 v0, v1;
#pragma unroll
                for (int i = 0; i < 4; ++i) { const float g0 = acc[ai][0][m][0][i], g1 = acc[ai][0][m][1][i];
                    v0[i] = g0 * sigmoidf_(g0) * acc[ai][1][m][0][i]; v1[i] = g1 * sigmoidf_(g1) * acc[ai][1][m][1][i]; }
                u32x4 w; w.x = pk2(v0[0], v0[1]); w.y = pk2(v0[2], v0[3]); w.z = pk2(v1[0], v1[1]); w.w = pk2(v1[2], v1[3]);
                *(u32x4*)rowp = w; }
    }
};
}

#define XB_TMO      128
#define XB_XCNT(j)  (256  + 64 * (j))
#define XB_XSUB(j)  (1280 + 64 * (j))
#define XB_XGEN(j)  (2304 + 64 * (j))
#define XB_TOP      3328
#define XB_TOPGEN   3392
#define XCD_BAR_WORDS 3456
#define XB_SPIN_CAP (1u << 24)

__device__ __forceinline__ unsigned xb_ld(unsigned* p)              { return __hip_atomic_load(p, __ATOMIC_RELAXED, __HIP_MEMORY_SCOPE_AGENT); }
__device__ __forceinline__ unsigned xb_add(unsigned* p, unsigned v) { return __hip_atomic_fetch_add(p, v, __ATOMIC_RELAXED, __HIP_MEMORY_SCOPE_AGENT); }
__device__ __forceinline__ unsigned xb_xcc_id() { return (unsigned)__builtin_amdgcn_s_getreg((3 << 11) | 20) & 0xFu; }
#define XB_SPIN(cond, bar) do { unsigned _sp = 0; while (cond) { __builtin_amdgcn_s_sleep(1); \
    if ((++_sp & 255u) == 0u) { if (xb_ld(&(bar)[XB_TMO])) break; if (_sp > XB_SPIN_CAP) { atomicAdd(&(bar)[XB_TMO], 1u); break; } } } } while (0)

struct XcdBarrier { unsigned* bar; unsigned x; volatile LAS unsigned* st; };

__device__ __forceinline__ XcdBarrier xcd_barrier_post(unsigned* bar, volatile LAS unsigned* st) {
    XcdBarrier b; b.bar = bar; b.x = (unsigned)__builtin_amdgcn_readfirstlane((int)xb_xcc_id()); b.st = st;
    if (threadIdx.x == 0) (void)xb_add(&bar[XB_XCNT(b.x)], 1u);
    return b;
}
__device__ __forceinline__ void xcd_barrier_complete(unsigned* bar, unsigned x, unsigned& nloc, unsigned& nx) {
    const unsigned G = gridDim.x * gridDim.y * gridDim.z;
    unsigned sum, cnt, mine, sp = 0u;
    for (;;) {
        sum = 0u; cnt = 0u; mine = 0u;
#pragma unroll
        for (unsigned j = 0; j < 16; ++j) { const unsigned c = xb_ld(&bar[XB_XCNT(j)]); sum += c; cnt += (c > 0u) ? 1u : 0u; mine = (j == x) ? c : mine; }
        if (sum == G) break;
        __builtin_amdgcn_s_sleep(1);
        if ((++sp & 255u) == 0u) { if (xb_ld(&bar[XB_TMO])) break; if (sp > XB_SPIN_CAP) { atomicAdd(&bar[XB_TMO], 1u); break; } }
    }
    nloc = mine > 0u ? mine : 1u; nx = cnt > 0u ? cnt : 1u;
}
__device__ __forceinline__ void xcd_barrier(const XcdBarrier& b) {
    asm volatile("s_waitcnt vmcnt(0)" ::: "memory");
    __syncthreads();
    if (threadIdx.x == 0) {
        unsigned* bar = b.bar; unsigned bx = b.x; asm volatile("" : "+s"(bar), "+s"(bx));
        __builtin_amdgcn_s_waitcnt(0);
        unsigned nloc = b.st[0], nx = b.st[1];
        if (nloc == 0u) { xcd_barrier_complete(bar, bx, nloc, nx); b.st[0] = nloc; b.st[1] = nx; }
        const unsigned old = xb_add(&bar[XB_XSUB(bx)], 1u);
        const unsigned gen = old / nloc;
        if (old + 1u == (gen + 1u) * nloc) {
            __builtin_amdgcn_fence(__ATOMIC_RELEASE, "agent");
            asm volatile("s_waitcnt vmcnt(0)" ::: "memory");
            const unsigned og = xb_add(&bar[XB_TOP], 1u);
            const unsigned tg = og / nx;
            if (og + 1u == (tg + 1u) * nx) xb_add(&bar[XB_TOPGEN], 1u);
            else XB_SPIN(xb_ld(&bar[XB_TOPGEN]) == tg, bar);
            __builtin_amdgcn_fence(__ATOMIC_ACQUIRE, "agent");
            xb_add(&bar[XB_XGEN(bx)], 1u);
            asm volatile("s_waitcnt vmcnt(0)" ::: "memory");
        } else {
            XB_SPIN(xb_ld(&bar[XB_XGEN(bx)]) == gen, bar);
            __builtin_amdgcn_fence(__ATOMIC_ACQUIRE, "agent");
            asm volatile("s_waitcnt vmcnt(0)" ::: "memory");
        }
    }
    __syncthreads();
}

constexpr int RING_BYTES = 131072;
constexpr int LDSCTL_OFF = 155648;
constexpr int LDS_BYTES = 156672;

struct Args {
    const float* in[23]; float* out; unsigned char* ws; int pad0, pad1;
};
__device__ __forceinline__ const void* ld_karg(unsigned off) {
    asm volatile("" : "+s"(off));
    return *(const void* const __attribute__((address_space(4)))*)((const __attribute__((address_space(4))) char*)__builtin_amdgcn_kernarg_segment_ptr() + off);
}
#define ARG(k) ((const float*)ld_karg(8u * (k)))
#define OUTP() ((float*)ld_karg(184u))
#define WSP() ((unsigned char*)ld_karg(192u))

__device__ __forceinline__ int rel_bucket(int d) {
    if (d < 16) return d;
    int b = 16;
    b += (d >= 22); b += (d >= 30); b += (d >= 40); b += (d >= 54); b += (d >= 73); b += (d >= 99); b += (d >= 134); b += (d >= 182);
    b += (d >= 246); b += (d >= 332); b += (d >= 450); b += (d >= 609); b += (d >= 825); b += (d >= 1117); b += (d >= 1513);
    return b;
}
__device__ __forceinline__ int win_src_col(int n) {
    if (n < 1152) return 512 + (n - 1024);
    if (n < 1224) return n;
    if (n < 1280) return -1;
    if (n < 1792) return 640 + (n - 1280);
    return n - 568;
}
__device__ __forceinline__ void transpose_item(const float* W, int ldw, int K, bf16* WT, int kind, int kb, int nb, LAS float* scr, int lane) {
    const int k0 = 64 * kb, n0 = 32 * nb, nl = n0 + (lane & 31);
    int sc;
    if (kind == 0) sc = win_src_col(nl + 1024);
    else if (kind == 2) { const int j = nl >> 8, r = nl & 255; sc = (r < 128) ? (j * 128 + r) : (DFF + j * 128 + r - 128); }
    else sc = nl;
#pragma unroll 8
    for (int i = 0; i < 32; ++i) { const int kk = 2 * i + (lane >> 5); scr[kk * 33 + (lane & 31)] = (sc >= 0) ? W[(size_t)(k0 + kk) * ldw + sc] : 0.f; }
    asm volatile("s_waitcnt lgkmcnt(0)" ::: "memory");
    const int c = lane & 7;
    const int nrow0 = (kind == 0) ? 1024 : 0;
#pragma unroll
    for (int j = 0; j < 4; ++j) { const int n = (lane >> 3) + 8 * j; const LAS float* s = scr + (8 * c) * 33 + n;
        v4u o; o.x = pk2(s[0 * 33], s[1 * 33]); o.y = pk2(s[2 * 33], s[3 * 33]); o.z = pk2(s[4 * 33], s[5 * 33]); o.w = pk2(s[6 * 33], s[7 * 33]);
        *(v4u*)(WT + (size_t)(nrow0 + n0 + n) * K + k0 + 8 * c) = o; }
    asm volatile("s_waitcnt lgkmcnt(0)" ::: "memory");
}

__device__ __forceinline__ void p0a_prologue(unsigned char* ws, LAS unsigned char* lds, int tid, int lane, int wave, int G) {
    asm volatile("" : "+v"(lane), "+v"(tid));
    const float* c = ARG(1); const float* w_ada = ARG(2); const float* b_ada = ARG(3);
    float* mod = (float*)(ws + WS_MOD);
    if (blockIdx.x < 192) {
        LAS float* cs = (LAS float*)lds;
        LAS float* red = (LAS float*)(lds + 32768);
        for (int i = tid; i < 8192; i += NTHREADS) { const float v = c[i]; cs[i] = v / (1.f + __expf(-v)); }
        __syncthreads();
        for (int it = blockIdx.x; it < 192; it += G) {
            const int l = it / 96, cg = it % 96, n = cg * 64 + lane;
            float acc[8];
#pragma unroll
            for (int b = 0; b < 8; ++b) acc[b] = 0.f;
            const float* wp = w_ada + ((size_t)l * 1024 + wave * 128) * 6144 + n;
#pragma unroll 8
            for (int k = 0; k < 128; ++k) { const float wv = wp[(size_t)k * 6144];
#pragma unroll
                for (int b = 0; b < 8; ++b) acc[b] += cs[b * 1024 + wave * 128 + k] * wv; }
#pragma unroll
            for (int b = 0; b < 8; ++b) red[(wave * 8 + b) * 64 + lane] = acc[b];
            __syncthreads();
            { const int b = tid >> 6; float s = 0.f;
#pragma unroll
              for (int w = 0; w < 8; ++w) s += red[(w * 8 + b) * 64 + lane];
              mod[((size_t)l * 8 + b) * 6144 + n] = s + b_ada[l * 6144 + n]; }
            __syncthreads();
        }
    }
    { const float* rb = ARG(21); float* T = (float*)(ws + WS_TAB);
      for (int d = blockIdx.x * NTHREADS + tid; d < 4096; d += G * NTHREADS) { const int bk = rel_bucket(d);
          for (int j = 0; j < 24; ++j) T[d * 24 + j] = rb[bk * 24 + j]; } }
    if (blockIdx.x == G - 1 && wave == 0) {
        float* lam = (float*)(ws + WS_LAM);
        for (int l = 0; l < NL; ++l) {
            const float s1 = wave_sum(ARG(9)[l * 64 + lane] * ARG(10)[l * 64 + lane]);
            const float s2 = wave_sum(ARG(11)[l * 64 + lane] * ARG(12)[l * 64 + lane]);
            const float lam_init = (l == 0) ? 0.2f : 0.35550907f;
            if (lane == 0) lam[l] = expf(s1) - expf(s2) + lam_init;
        }
    }
    {
        LAS float* scr = (LAS float*)(lds + 65536 + wave * 8448);
        const int gw = blockIdx.x * NWAVES + wave, NGW = G * NWAVES;
        constexpr int I_WIN = 16 * 240, I_B = 8 * 32, I_C = 4 * 32, I_OUT = 16 * 32, I_GU = 16 * 176, I_D = 44 * 32, I_FQ = 2048, I_FA = 2048;
        constexpr int I_LAYER = I_WIN + I_B + I_C + I_OUT + I_GU + I_D + I_FQ + I_FA;
        for (int it = gw; it < NL * I_LAYER; it += NGW) {
            const int l = it / I_LAYER; int r = it % I_LAYER;
            unsigned char* wl = ws + WS_W + (size_t)l * W_LAYER;
            const float* w_in = ARG(5) + (size_t)l * 1024 * WIN_SRC;
            if (r < I_WIN) { transpose_item(w_in, WIN_SRC, 1024, (bf16*)(wl + W_IN), 0, r / 240, r % 240, scr, lane); continue; } r -= I_WIN;
            if (r < I_B)   { transpose_item(ARG(15) + (size_t)l * 512 * 1024, 1024, 512, (bf16*)(wl + W_B), 1, r / 32, r % 32, scr, lane); continue; } r -= I_B;
            if (r < I_C)   { transpose_item(ARG(16) + (size_t)l * 256 * 1024, 1024, 256, (bf16*)(wl + W_C), 1, r / 32, r % 32, scr, lane); continue; } r -= I_C;
            if (r < I_OUT) { transpose_item(ARG(17) + (size_t)l * 1024 * 1024, 1024, 1024, (bf16*)(wl + W_OUT), 1, r / 32, r % 32, scr, lane); continue; } r -= I_OUT;
            if (r < I_GU)  { transpose_item(ARG(19) + (size_t)l * 1024 * NGU, NGU, 1024, (bf16*)(wl + W_GU), 2, r / 176, r % 176, scr, lane); continue; } r -= I_GU;
            if (r < I_D)   { transpose_item(ARG(20) + (size_t)l * DFF * 1024, 1024, DFF, (bf16*)(wl + W_D), 1, r / 32, r % 32, scr, lane); continue; } r -= I_D;
            if (r < I_FQ) {
                const int h = r >> 8, rem = r & 255, cc = (rem >> 7) * 64 + lane, k0 = (rem & 127) * 8;
                const float* uk = ARG(6) + ((size_t)(l * 8 + h) * 64) * 128 + cc;
                const float* wi = w_in + (size_t)k0 * WIN_SRC + h * 64;
                float acc[8];
#pragma unroll
                for (int j = 0; j < 8; ++j) acc[j] = 0.f;
#pragma unroll 8
                for (int d = 0; d < 64; ++d) { const float u = uk[d * 128];
#pragma unroll
                    for (int j = 0; j < 8; ++j) acc[j] += wi[(size_t)j * WIN_SRC + d] * u; }
                v4u o; o.x = pk2(acc[0], acc[1]); o.y = pk2(acc[2], acc[3]); o.z = pk2(acc[4], acc[5]); o.w = pk2(acc[6], acc[7]);
                *(v4u*)((bf16*)(wl + W_IN) + (size_t)(h * 128 + cc) * 1024 + k0) = o;
                continue; }
            r -= I_FQ;
            {
                const int ng = r >> 7, kg = r & 127, h = kg >> 4, c0 = (kg & 15) * 8, n = ng * 64 + lane;
                const float* uv = ARG(7) + ((size_t)(l * 8 + h) * 128 + c0) * 64;
                const float* wa = ARG(14) + ((size_t)l * 512 + h * 64) * 1024 + n;
                float acc[8];
#pragma unroll
                for (int j = 0; j < 8; ++j) acc[j] = 0.f;
#pragma unroll 8
                for (int e = 0; e < 64; ++e) { const float wv = wa[(size_t)e * 1024];
#pragma unroll
                    for (int j = 0; j < 8; ++j) acc[j] += uv[j * 64 + e] * wv; }
                v4u o; o.x = pk2(acc[0], acc[1]); o.y = pk2(acc[2], acc[3]); o.z = pk2(acc[4], acc[5]); o.w = pk2(acc[6], acc[7]);
                *(v4u*)((bf16*)(wl + W_A) + (size_t)n * 1024 + kg * 8) = o;
            }
        }
    }
}

__device__ __forceinline__ void norm_rows(const float* x, bf16* out, const float* g, const float* sh, const float* sc, int gw, int NGW, int lane) {
    asm volatile("" : "+v"(lane));
    for (int row = gw; row < MT; row += NGW) {
        const int b = row / SEQ;
        const f32x4* xr = (const f32x4*)(x + (size_t)row * 1024) + lane;
        f32x4 v[4]; float s = 0.f;
#pragma unroll
        for (int j = 0; j < 4; ++j) { v[j] = xr[64 * j]; s += (v[j].x * v[j].x + v[j].y * v[j].y) + (v[j].z * v[j].z + v[j].w * v[j].w); }
        const float rstd = 1.0f / sqrtf(wave_sum(s) * (1.f / 1024.f) + EPS);
        v2u* o8 = (v2u*)(out + (size_t)row * 1024) + lane;
#pragma unroll
        for (int j = 0; j < 4; ++j) { const int col = 256 * j + 4 * lane;
            const f32x4 gg = *(const f32x4*)(g + col), s1 = *(const f32x4*)(sc + (size_t)b * 6144 + col), s0 = *(const f32x4*)(sh + (size_t)b * 6144 + col);
            const f32x4 y = v[j] * rstd * gg * (s1 + 1.0f) + s0;
            v2u w; w.x = pk2(y.x, y.y); w.y = pk2(y.z, y.w); o8[64 * j] = w; }
    }
}
__device__ __forceinline__ void final_rows(float* x, const float* g, int gw, int NGW, int lane) {
    asm volatile("" : "+v"(lane));
    for (int row = gw; row < MT; row += NGW) {
        f32x4* xr = (f32x4*)(x + (size_t)row * 1024) + lane;
        f32x4 v[4]; float s = 0.f;
#pragma unroll
        for (int j = 0; j < 4; ++j) { v[j] = xr[64 * j]; s += (v[j].x * v[j].x + v[j].y * v[j].y) + (v[j].z * v[j].z + v[j].w * v[j].w); }
        const float rstd = 1.0f / sqrtf(wave_sum(s) * (1.f / 1024.f) + EPS);
#pragma unroll
        for (int j = 0; j < 4; ++j) { const f32x4 gg = *(const f32x4*)(g + 256 * j + 4 * lane); xr[64 * j] = v[j] * rstd * gg; }
    }
}

__device__ __forceinline__ float dot8(const LAS float* q, v4u w) {
    return q[0] * bflo(w.x) + q[1] * bfhi(w.x) + q[2] * bflo(w.y) + q[3] * bfhi(w.y) + q[4] * bflo(w.z) + q[5] * bfhi(w.z) + q[6] * bflo(w.w) + q[7] * bfhi(w.w);
}
__device__ __forceinline__ void kvn_rows(unsigned char* y, bf16* kvn, const float* gkv, unsigned* kmaxw, int gw, int NGW, int lane) {
    asm volatile("" : "+v"(lane));
    const bf16* misc = (const bf16*)(y + Y_MISC);
    float km0 = 0.f, km1 = 0.f, km2 = 0.f, km3 = 0.f;
    for (int r = gw; r < CHR; r += NGW) {
        const unsigned w = *(const unsigned*)(misc + (size_t)r * 256 + 2 * lane);
        const float a0 = bflo(w), a1 = bfhi(w);
        const float rstd = 1.0f / sqrtf(wave_sum(a0 * a0 + a1 * a1) * (1.f / 128.f) + EPS);
        *(unsigned*)(kvn + (size_t)r * 128 + 2 * lane) = pk2(a0 * rstd * gkv[2 * lane], a1 * rstd * gkv[2 * lane + 1]);
        const float kk = bf2f(misc[(size_t)r * 256 + 128 + lane]); const float ks = wave_sum(kk * kk); const int b = r / SEQ;
        km0 = (b == 0) ? fmaxf(km0, ks) : km0; km1 = (b == 1) ? fmaxf(km1, ks) : km1; km2 = (b == 2) ? fmaxf(km2, ks) : km2; km3 = (b == 3) ? fmaxf(km3, ks) : km3;
    }
    if (lane == 0) {
        __hip_atomic_fetch_max(kmaxw + 0, __float_as_uint(km0), __ATOMIC_RELAXED, __HIP_MEMORY_SCOPE_AGENT); __hip_atomic_fetch_max(kmaxw + 1, __float_as_uint(km1), __ATOMIC_RELAXED, __HIP_MEMORY_SCOPE_AGENT);
        __hip_atomic_fetch_max(kmaxw + 2, __float_as_uint(km2), __ATOMIC_RELAXED, __HIP_MEMORY_SCOPE_AGENT); __hip_atomic_fetch_max(kmaxw + 3, __float_as_uint(km3), __ATOMIC_RELAXED, __HIP_MEMORY_SCOPE_AGENT);
    }
}
__device__ __forceinline__ void mixC_v1(unsigned char* y, const float* T, LAS unsigned char* lds, int gw, int NGW, int lane, int wave) {
    asm volatile("" : "+v"(lane));
    const bf16* CQ = (const bf16*)(y + Y_CQ); const bf16* CK = (const bf16*)(y + Y_CK); const bf16* CV = (const bf16*)(y + Y_CV); bf16* OC = (bf16*)(y + Y_OC);
    LAS float* qs = (LAS float*)(lds + wave * 2048);
    LAS float* ps = qs + 64;
    for (int task = gw; task < CHR * 4; task += NGW) {
        const int r = task >> 2, hp = task & 3, t = r & (SEQ - 1), rb = r - t;
        float og[3], lse[3];
#pragma unroll
        for (int g = 0; g < 3; ++g) {
            const int dil = (g == 0) ? 1 : (g == 1) ? 4 : 16, hh = 4 * g + hp;
            qs[lane] = bf2f(CQ[(size_t)r * 768 + hh * 64 + lane]);
            asm volatile("s_waitcnt lgkmcnt(0)" ::: "memory");
            const int tq = t / dil, nv = (tq < 128 ? tq : 128) + 1;
            float lg[3];
#pragma unroll
            for (int rd = 0; rd < 3; ++rd) {
                const int j = lane + 64 * rd; float v = -INFINITY;
                if (j < nv) { const int s = t - j * dil; const bf16* kp = CK + (size_t)(rb + s) * 768 + hh * 64; float dot = 0.f;
#pragma unroll
                    for (int c8 = 0; c8 < 8; ++c8) dot += dot8(qs + 8 * c8, *(const v4u*)(kp + 8 * c8));
                    v = dot * 0.125f + T[(j * dil) * 24 + 12 + hh]; }
                lg[rd] = v;
            }
            const float m = wave_max(fmaxf(fmaxf(lg[0], lg[1]), lg[2]));
            float p[3], ls = 0.f;
#pragma unroll
            for (int rd = 0; rd < 3; ++rd) { p[rd] = (lane + 64 * rd < nv) ? __expf(lg[rd] - m) : 0.f; ls += p[rd]; ps[64 * rd + lane] = p[rd]; }
            const float l = wave_sum(ls);
            asm volatile("s_waitcnt lgkmcnt(0)" ::: "memory");
            float o = 0.f;
            for (int j = 0; j < nv; ++j) { const int s = t - j * dil; o += ps[j] * bf2f(CV[(size_t)(rb + s) * 768 + hh * 64 + lane]); }
            og[g] = o / l; lse[g] = m + __logf(l);
            asm volatile("s_waitcnt lgkmcnt(0)" ::: "memory");
        }
        const float M = fmaxf(fmaxf(lse[0], lse[1]), lse[2]);
        const float a0 = __expf(lse[0] - M), a1 = __expf(lse[1] - M), a2 = __expf(lse[2] - M);
        OC[(size_t)r * 256 + hp * 64 + lane] = (bf16)f2bf((a0 * og[0] + a1 * og[1] + a2 * og[2]) / (a0 + a1 + a2));
    }
}
__device__ __forceinline__ void mixB_v1(unsigned char* y, const float* T, const float* gsub, float lam, float one_m_li, LAS unsigned char* lds, int gw, int NGW, int lane, int wave) {
    asm volatile("" : "+v"(lane));
    bf16* BQ = (bf16*)(y + Y_BQ); const bf16* BK = (const bf16*)(y + Y_BK); const bf16* BV = (const bf16*)(y + Y_BV);
    LAS float* qs = (LAS float*)(lds + wave * 2048);
    LAS float* ps = qs + 128;
    for (int task = gw; task < CHR * 4; task += NGW) {
        const int r = task >> 2, h = task & 3, t = r & (SEQ - 1), rb = r - t;
        qs[lane] = bf2f(BQ[(size_t)r * 512 + h * 128 + lane]); qs[64 + lane] = bf2f(BQ[(size_t)r * 512 + h * 128 + 64 + lane]);
        asm volatile("s_waitcnt lgkmcnt(0)" ::: "memory");
        float m0 = -INFINITY, m1 = -INFINITY, l0 = 0.f, l1 = 0.f, o00 = 0.f, o01 = 0.f, o10 = 0.f, o11 = 0.f;
        for (int s0 = 0; s0 <= t; s0 += 64) {
            const int s = s0 + lane; float lg0 = -INFINITY, lg1 = -INFINITY;
            if (s <= t) { const bf16* kp = BK + (size_t)(rb + s) * 512 + h * 128; float d0 = 0.f, d1 = 0.f;
#pragma unroll
                for (int c8 = 0; c8 < 8; ++c8) { d0 += dot8(qs + 8 * c8, *(const v4u*)(kp + 8 * c8)); d1 += dot8(qs + 64 + 8 * c8, *(const v4u*)(kp + 64 + 8 * c8)); }
                const float bias = T[(t - s) * 24 + 8 + h]; lg0 = d0 * 0.125f + bias; lg1 = d1 * 0.125f + bias; }
            const float nm0 = fmaxf(m0, wave_max(lg0)), nm1 = fmaxf(m1, wave_max(lg1));
            const float f0 = __expf(m0 - nm0), f1 = __expf(m1 - nm1);
            const float p0 = (s <= t) ? __expf(lg0 - nm0) : 0.f, p1 = (s <= t) ? __expf(lg1 - nm1) : 0.f;
            l0 = l0 * f0 + wave_sum(p0); l1 = l1 * f1 + wave_sum(p1); o00 *= f0; o01 *= f0; o10 *= f1; o11 *= f1; m0 = nm0; m1 = nm1;
            ps[lane] = p0; ps[64 + lane] = p1;
            asm volatile("s_waitcnt lgkmcnt(0)" ::: "memory");
            const int nk = (t - s0 + 1 < 64) ? (t - s0 + 1) : 64;
            const bf16* vp = BV + (size_t)(rb + s0) * 512 + h * 128 + lane;
            for (int j = 0; j < nk; ++j) { const float v0 = bf2f(vp[(size_t)j * 512]), v1 = bf2f(vp[(size_t)j * 512 + 64]); const float pa = ps[j], pb = ps[64 + j];
                o00 += pa * v0; o01 += pa * v1; o10 += pb * v0; o11 += pb * v1; }
            asm volatile("s_waitcnt lgkmcnt(0)" ::: "memory");
        }
        const float oa = o00 / l0 - lam * (o10 / l1), ob = o01 / l0 - lam * (o11 / l1);
        const float rstd = 1.0f / sqrtf(wave_sum(oa * oa + ob * ob) * (1.f / 128.f) + EPS);
        BQ[(size_t)r * 512 + h * 128 + lane] = (bf16)f2bf(oa * rstd * gsub[lane] * one_m_li);
        BQ[(size_t)r * 512 + h * 128 + 64 + lane] = (bf16)f2bf(ob * rstd * gsub[64 + lane] * one_m_li);
    }
}
__device__ __forceinline__ unsigned mono_key(float f) { const unsigned u = __float_as_uint(f); return (u & 0x80000000u) ? ~u : (u | 0x80000000u); }
__device__ __forceinline__ void mixA_v1(unsigned char* y, const bf16* KVN, const float* T, LAS unsigned char* lds, int gw, int NGW, int lane, int wave) {
    asm volatile("" : "+v"(lane));
    bf16* QLAT = (bf16*)(y + Y_QLAT); const bf16* MISC = (const bf16*)(y + Y_MISC); const bf16* IQ = (const bf16*)(y + Y_IQ);
    LAS unsigned char* wb = lds + wave * 19456;
    LAS unsigned* scb = (LAS unsigned*)wb;
    LAS float* qi = (LAS float*)(wb + 16384);
    LAS unsigned* sel = (LAS unsigned*)(wb + 18432);
    LAS float* ql = (LAS float*)wb;
    LAS float* pb = (LAS float*)(wb + 4096);
    const unsigned long long lt_mask = (1ull << lane) - 1ull;
    for (int r = gw; r < CHR; r += NGW) {
        const int t = r & (SEQ - 1), rb = r - t, N = t + 1;
#pragma unroll
        for (int i = 0; i < 8; ++i) qi[i * 64 + lane] = bf2f(IQ[(size_t)r * 512 + i * 64 + lane]);
        const float wv = (lane < 8) ? bf2f(MISC[(size_t)r * 256 + 192 + lane]) * 0.044194173824159216f : 0.f;
        float wh[8];
#pragma unroll
        for (int h = 0; h < 8; ++h) wh[h] = __shfl(wv, h);
        asm volatile("s_waitcnt lgkmcnt(0)" ::: "memory");
        for (int s0 = 0; s0 < N; s0 += 64) {
            const int s = s0 + lane;
            if (s < N) { const bf16* kp = MISC + (size_t)(rb + s) * 256 + 128; v4u kw[8];
#pragma unroll
                for (int c8 = 0; c8 < 8; ++c8) kw[c8] = *(const v4u*)(kp + 8 * c8);
                float sc = 0.f;
#pragma unroll
                for (int h = 0; h < 8; ++h) { float d = 0.f;
#pragma unroll
                    for (int c8 = 0; c8 < 8; ++c8) d += dot8(qi + h * 64 + 8 * c8, kw[c8]);
                    sc += wh[h] * fmaxf(d, 0.f); }
                sc += 0.f;
                scb[s] = mono_key(sc); }
        }
        asm volatile("s_waitcnt lgkmcnt(0)" ::: "memory");
        int nsel;
        if (N <= TOPK) { for (int i = lane; i < N; i += 64) sel[i] = (unsigned)i; nsel = N; }
        else {
            unsigned tau = 0u;
            for (int bit = 31; bit >= 0; --bit) { const unsigned cand = tau | (1u << bit); int cnt = 0;
                for (int i = lane; i < N; i += 64) cnt += (scb[i] >= cand) ? 1 : 0;
#pragma unroll
                for (int o = 1; o < 64; o <<= 1) cnt += __shfl_xor(cnt, o);
                if (cnt >= TOPK) tau = cand; }
            int cgt = 0;
            for (int i = lane; i < N; i += 64) cgt += (scb[i] > tau) ? 1 : 0;
#pragma unroll
            for (int o = 1; o < 64; o <<= 1) cgt += __shfl_xor(cgt, o);
            const int need = TOPK - cgt; int pos = 0, eqt = 0;
            for (int s0 = 0; s0 < N; s0 += 64) { const int s = s0 + lane; const unsigned key = (s < N) ? scb[s] : 0u;
                const bool gt = (s < N) && key > tau, eq = (s < N) && key == tau;
                const unsigned long long beq = __ballot(eq);
                const bool take = gt || (eq && (eqt + __popcll(beq & lt_mask)) < need);
                const unsigned long long bt = __ballot(take);
                if (take) sel[pos + __popcll(bt & lt_mask)] = (unsigned)s;
                pos += __popcll(bt); eqt += __popcll(beq); }
            nsel = TOPK;
        }
        asm volatile("s_waitcnt lgkmcnt(0)" ::: "memory");
#pragma unroll
        for (int i = 0; i < 16; ++i) ql[i * 64 + lane] = bf2f(QLAT[(size_t)r * 1024 + i * 64 + lane]);
        asm volatile("s_waitcnt lgkmcnt(0)" ::: "memory");
        for (int rd = 0; rd < 4; ++rd) { const int jj = rd * 64 + lane;
            float acc[8];
#pragma unroll
            for (int h = 0; h < 8; ++h) acc[h] = -INFINITY;
            if (jj < nsel) { const int s = (int)sel[jj]; const bf16* kp = KVN + (size_t)(rb + s) * 128;
#pragma unroll
                for (int h = 0; h < 8; ++h) acc[h] = 0.f;
#pragma unroll 4
                for (int c8 = 0; c8 < 16; ++c8) { const v4u w = *(const v4u*)(kp + 8 * c8);
#pragma unroll
                    for (int h = 0; h < 8; ++h) acc[h] += dot8(ql + h * 128 + 8 * c8, w); }
                const float* tb = T + (t - s) * 24;
#pragma unroll
                for (int h = 0; h < 8; ++h) acc[h] = acc[h] * 0.125f + tb[h]; }
#pragma unroll
            for (int h = 0; h < 8; ++h) pb[h * 256 + jj] = acc[h];
        }
        asm volatile("s_waitcnt lgkmcnt(0)" ::: "memory");
#pragma unroll
        for (int h = 0; h < 8; ++h) { float v[4];
#pragma unroll
            for (int i = 0; i < 4; ++i) v[i] = pb[h * 256 + 64 * i + lane];
            const float m = wave_max(fmaxf(fmaxf(v[0], v[1]), fmaxf(v[2], v[3])));
#pragma unroll
            for (int i = 0; i < 4; ++i) v[i] = __expf(v[i] - m);
            const float inv = 1.0f / wave_sum((v[0] + v[1]) + (v[2] + v[3]));
#pragma unroll
            for (int i = 0; i < 4; ++i) pb[h * 256 + 64 * i + lane] = v[i] * inv; }
        asm volatile("s_waitcnt lgkmcnt(0)" ::: "memory");
        float o0[8], o1[8];
#pragma unroll
        for (int h = 0; h < 8; ++h) { o0[h] = 0.f; o1[h] = 0.f; }
        for (int jj = 0; jj < nsel; ++jj) { const int s = (int)sel[jj]; const bf16* vp = KVN + (size_t)(rb + s) * 128 + lane;
            const float v0 = bf2f(vp[0]), v1 = bf2f(vp[64]);
#pragma unroll
            for (int h = 0; h < 8; ++h) { const float p = pb[h * 256 + jj]; o0[h] += p * v0; o1[h] += p * v1; } }
#pragma unroll
        for (int h = 0; h < 8; ++h) { QLAT[(size_t)r * 1024 + h * 128 + lane] = (bf16)f2bf(o0[h]); QLAT[(size_t)r * 1024 + h * 128 + 64 + lane] = (bf16)f2bf(o1[h]); }
        asm volatile("s_waitcnt lgkmcnt(0)" ::: "memory");
    }
}

typedef short bf16x8 __attribute__((ext_vector_type(8)));
typedef short s16x4 __attribute__((ext_vector_type(4)));
typedef float f32x16 __attribute__((ext_vector_type(16)));
#define LOG2E 1.4426950408889634f
__device__ __forceinline__ int crow(int r, int hi) { return (r & 3) + 8 * (r >> 2) + 4 * hi; }
__device__ __forceinline__ void glds16(const void* g, LAS void* l) { __builtin_amdgcn_global_load_lds((const unsigned*)g, (LAS unsigned*)l, 16, 0, 0); }
__device__ __forceinline__ s16x4 tr16(const LAS unsigned char* p) { return __builtin_bit_cast(s16x4, __builtin_amdgcn_ds_read_tr16_b64_v4i16((LAS s16x4*)p)); }
__device__ __forceinline__ float swap_max(float v) { auto rr = __builtin_amdgcn_permlane32_swap(__float_as_uint(v), __float_as_uint(v), false, false); return fmaxf(__uint_as_float(rr[0]), __uint_as_float(rr[1])); }
__device__ __forceinline__ float swap_add(float v) { auto rr = __builtin_amdgcn_permlane32_swap(__float_as_uint(v), __float_as_uint(v), false, false); return __uint_as_float(rr[0]) + __uint_as_float(rr[1]); }
typedef float f32x2_t __attribute__((ext_vector_type(2))); typedef __bf16 bf16x2_t __attribute__((ext_vector_type(2)));
__device__ __forceinline__ unsigned cvtpk(float lo, float hi) { const f32x2_t v = {lo, hi}; const bf16x2_t b = __builtin_convertvector(v, bf16x2_t); return __builtin_bit_cast(unsigned, b); }
__device__ __forceinline__ void lds_add_u32_asm(LAS void* p, unsigned v) { asm volatile("ds_add_u32 %0, %1" :: "v"((unsigned)(uintptr_t)p), "v"(v) : "memory"); }
__device__ __forceinline__ void lds_st_b16_asm(LAS void* p, unsigned v) { asm volatile("ds_write_b16 %0, %1" :: "v"((unsigned)(uintptr_t)p), "v"(v) : "memory"); }
__device__ __forceinline__ void lds_st_b32_asm(LAS void* p, unsigned v) { asm volatile("ds_write_b32 %0, %1" :: "v"((unsigned)(uintptr_t)p), "v"(v) : "memory"); }
__device__ __forceinline__ s16x4 tr16_asm(const LAS unsigned char* p) { s16x4 v; asm volatile("ds_read_b64_tr_b16 %0, %1" : "=v"(v) : "v"((unsigned)(uintptr_t)p) : "memory"); return v; }
#define TRV(dst, base, off) asm volatile("ds_read_b64_tr_b16 %0, %1 offset:%c2" : "=&v"(dst) : "v"(base), "i"(off) : "memory")
#define LGKM_WAIT8(n, f) asm volatile("s_waitcnt lgkmcnt(" #n ")" : "+v"(f[0]), "+v"(f[1]), "+v"(f[2]), "+v"(f[3]), "+v"(f[4]), "+v"(f[5]), "+v"(f[6]), "+v"(f[7]) :: "memory")
#define VFRAG(f, i) ((bf16x8){f[2 * (i)][0], f[2 * (i)][1], f[2 * (i)][2], f[2 * (i)][3], f[2 * (i) + 1][0], f[2 * (i) + 1][1], f[2 * (i) + 1][2], f[2 * (i) + 1][3]})
#define RAW_BARRIER() do { asm volatile("s_waitcnt lgkmcnt(0)" ::: "memory"); __builtin_amdgcn_s_barrier(); asm volatile("" ::: "memory"); } while (0)

template <int MODE> __device__ __forceinline__ void mixB_fast(unsigned char* y, bf16* OUTB, const float* T, const float* gsub, float lam, float one_m_li, LAS unsigned char* lds, int tid, int lane, int wave, int G) {
    asm volatile("" : "+v"(lane), "+v"(tid));
    bf16* BQ = (bf16*)(y + Y_BQ); const bf16* BK = (const bf16*)(y + Y_BK); const bf16* BV = (const bf16*)(y + Y_BV);
    const int r32 = lane & 31, hi = lane >> 5, m = wave >> 2, qs = wave & 3;
    LAS float* bt = (LAS float*)(lds + 131072);
    constexpr float C2 = 0.125f * LOG2E, THR = 8.0f;
    for (int item = blockIdx.x; item < CHB * 4 * 16; item += G) {
        const int bh = (G == 256) ? (2 * (item & 7) + (item >> 7)) : (item >> 4), pr = (G == 256) ? ((item >> 3) & 15) : (item & 15), bb = bh >> 2, h = bh & 3, rb = bb * SEQ;
        RAW_BARRIER();
        for (int i = tid; i < 64 + 4096; i += NTHREADS) bt[i] = (i < 64) ? 0.f : T[(i - 64) * 24 + 8 + h] * LOG2E;
        if (tid < 128) bt[64 + 4096 + tid] = gsub[tid];
        for (int uu = 0; uu < 2; ++uu) {
            const int qb = (uu == 0) ? (31 - pr) : pr;
            const int q0w = qb * 128 + qs * 32, qpos = q0w + r32;
            bf16x8 qf[4];
#pragma unroll
            for (int ks = 0; ks < 4; ++ks) qf[ks] = *(const bf16x8*)(BQ + (size_t)(rb + qpos) * 512 + h * 128 + m * 64 + 16 * ks + 8 * hi);
            const int NT = 2 * (qb + 1);
            f32x16 O[4];
#pragma unroll
            for (int dq = 0; dq < 4; ++dq)
#pragma unroll
                for (int r = 0; r < 16; ++r) O[dq][r] = 0.f;
            float mref = -INFINITY, lsum = 0.f;
#define MB_STAGE(t_, buf_) do { const int kv0_ = (t_) * 64; LAS unsigned char* sb_ = lds + (buf_) * 32768; \
                _Pragma("unroll") for (int i_ = 0; i_ < 2; ++i_) { const int p_ = 2 * wave + i_, mk_ = p_ >> 3, rg_ = p_ & 7;     \
                    glds16(BK + (size_t)(rb + kv0_ + 8 * rg_ + (lane >> 3)) * 512 + h * 128 + mk_ * 64 + ((lane & 7) ^ (lane >> 3)) * 8, sb_ + mk_ * 8192 + rg_ * 1024); } \
                _Pragma("unroll") for (int i_ = 0; i_ < 2; ++i_) { const int p_ = 2 * wave + i_, dq_ = p_ >> 2, rg_ = p_ & 3; \
                    glds16(BV + (size_t)(rb + kv0_ + 16 * rg_ + (lane >> 2)) * 512 + h * 128 + dq_ * 32 + (lane & 3) * 8, sb_ + 16384 + p_ * 1024); } } while (0)
            MB_STAGE(0, 0); MB_STAGE(1, 1);
            if (NT > 2) MB_STAGE(2, 2);
            for (int t = 0; t < NT; ++t) {
                if (t + 2 < NT) asm volatile("s_waitcnt vmcnt(8)" ::: "memory");
                else if (t + 1 < NT) asm volatile("s_waitcnt vmcnt(4)" ::: "memory");
                else asm volatile("s_waitcnt vmcnt(0)" ::: "memory");
                RAW_BARRIER();
                if (t + 3 < NT) MB_STAGE(t + 3, (t + 3) & 3);
                const int kv0 = t * 64;
                if (MODE != 2 && kv0 <= q0w + 31) {
                    const LAS unsigned char* sb = lds + (t & 3) * 32768;
                    const LAS unsigned char* kb = sb + m * 8192 + r32 * 128;
                    f32x16 s0, s1;
#pragma unroll
                    for (int r = 0; r < 16; ++r) { s0[r] = 0.f; s1[r] = 0.f; }
                    if (MODE != 3)
#pragma unroll
                    for (int ks = 0; ks < 4; ++ks) {
                        const int ko = ((2 * ks + hi) ^ (r32 & 7)) * 16;
                        const bf16x8 k0 = *(const LAS bf16x8*)(kb + ko), k1 = *(const LAS bf16x8*)(kb + ko + 4096);
                        s0 = __builtin_amdgcn_mfma_f32_32x32x16_bf16(k0, qf[ks], s0, 0, 0, 0);
                        s1 = __builtin_amdgcn_mfma_f32_32x32x16_bf16(k1, qf[ks], s1, 0, 0, 0); }
                    const int dmin = q0w - (kv0 + 63), dmax = q0w + 31 - kv0;
                    if (MODE != 3) {
                    if (dmin >= 0 && rel_bucket(dmin) == rel_bucket(dmax)) {
                        const float cb = bt[64 + dmin];
#pragma unroll
                        for (int r = 0; r < 16; ++r) { s0[r] = fmaf(s0[r], C2, cb); s1[r] = fmaf(s1[r], C2, cb); }
                    } else {
                        const LAS float* bp = bt + 64 + (qpos - kv0) - 4 * hi;
#pragma unroll
                        for (int r = 0; r < 16; ++r) { s0[r] = fmaf(s0[r], C2, bp[-((r & 3) + 8 * (r >> 2))]); s1[r] = fmaf(s1[r], C2, bp[-(32 + (r & 3) + 8 * (r >> 2))]); }
                    }
                    if (kv0 + 63 > q0w) {
#pragma unroll
                        for (int r = 0; r < 16; ++r) { const int kv = kv0 + crow(r, hi); if (kv > qpos) s0[r] = -INFINITY; if (kv + 32 > qpos) s1[r] = -INFINITY; }
                    }
                    float rm = fmaxf(s0[0], s1[0]);
#pragma unroll
                    for (int r = 1; r < 16; ++r) rm = fmaxf(rm, fmaxf(s0[r], s1[r]));
                    rm = swap_max(rm);
                    if (__any(rm > mref + THR)) {
                        const float mn = fmaxf(mref, rm), f = __builtin_amdgcn_exp2f(mref - mn);
                        lsum *= f; mref = mn;
#pragma unroll
                        for (int dq = 0; dq < 4; ++dq)
#pragma unroll
                            for (int r = 0; r < 16; ++r) O[dq][r] *= f;
                    }
                    float ps = 0.f;
#pragma unroll
                    for (int r = 0; r < 16; ++r) { s0[r] = __builtin_amdgcn_exp2f(s0[r] - mref); s1[r] = __builtin_amdgcn_exp2f(s1[r] - mref); ps += s0[r] + s1[r]; }
                    lsum += ps;
                    }
                    bf16x8 pf[4];
                    { v4u w;
                      w.x = cvtpk(s0[0], s0[1]); w.y = cvtpk(s0[2], s0[3]); w.z = cvtpk(s0[4], s0[5]); w.w = cvtpk(s0[6], s0[7]); pf[0] = __builtin_bit_cast(bf16x8, w);
                      w.x = cvtpk(s0[8], s0[9]); w.y = cvtpk(s0[10], s0[11]); w.z = cvtpk(s0[12], s0[13]); w.w = cvtpk(s0[14], s0[15]); pf[1] = __builtin_bit_cast(bf16x8, w);
                      w.x = cvtpk(s1[0], s1[1]); w.y = cvtpk(s1[2], s1[3]); w.z = cvtpk(s1[4], s1[5]); w.w = cvtpk(s1[6], s1[7]); pf[2] = __builtin_bit_cast(bf16x8, w);
                      w.x = cvtpk(s1[8], s1[9]); w.y = cvtpk(s1[10], s1[11]); w.z = cvtpk(s1[12], s1[13]); w.w = cvtpk(s1[14], s1[15]); pf[3] = __builtin_bit_cast(bf16x8, w); }
                    const unsigned vb = (unsigned)(uintptr_t)(sb + 16384 + ((lane >> 4) & 1) * 32 + (lane & 3) * 8 + (4 * hi + ((lane & 15) >> 2)) * 64);
                    s16x4 fa[8], fb[8];
#define MB_RD(f, dq_) do { _Pragma("unroll") for (int sp_ = 0; sp_ < 4; ++sp_) { TRV(f[2 * sp_], vb, ((dq_) * 4 + sp_) * 1024); TRV(f[2 * sp_ + 1], vb, ((dq_) * 4 + sp_) * 1024 + 512); } } while (0)
#define MB_MM(f, dq_) do { _Pragma("unroll") for (int sp_ = 0; sp_ < 4; ++sp_) O[dq_] = __builtin_amdgcn_mfma_f32_32x32x16_bf16(VFRAG(f, sp_), pf[sp_], O[dq_], 0, 0, 0); } while (0)
                    if (MODE != 1) {
                    MB_RD(fa, 0); MB_RD(fb, 1); LGKM_WAIT8(8, fa); MB_MM(fa, 0);
                    MB_RD(fa, 2); LGKM_WAIT8(8, fb); MB_MM(fb, 1);
                    MB_RD(fb, 3); LGKM_WAIT8(8, fa); MB_MM(fa, 2);
                    LGKM_WAIT8(0, fb); MB_MM(fb, 3); }
#undef MB_RD
#undef MB_MM
                }
            }
            RAW_BARRIER();
#undef MB_STAGE
            const float inv = 1.0f / swap_add(lsum);
            LAS float* xb = (LAS float*)lds + qs * 4096;
            if (m == 1) {
#pragma unroll
                for (int dq = 0; dq < 4; ++dq)
#pragma unroll
                    for (int r = 0; r < 16; ++r) xb[(dq * 16 + r) * 64 + lane] = O[dq][r] * inv;
            }
            RAW_BARRIER();
            if (m == 0) {
                float ss = 0.f;
#pragma unroll
                for (int dq = 0; dq < 4; ++dq)
#pragma unroll
                    for (int r = 0; r < 16; ++r) { const float o = O[dq][r] * inv - lam * xb[(dq * 16 + r) * 64 + lane]; O[dq][r] = o; ss += o * o; }
                const float rstd = 1.0f / sqrtf(swap_add(ss) * (1.f / 128.f) + EPS) * one_m_li;
                bf16* orow = OUTB + (size_t)(rb + qpos) * 512 + h * 128;
#pragma unroll
                for (int dq = 0; dq < 4; ++dq)
#pragma unroll
                    for (int g4 = 0; g4 < 4; ++g4) { const int d0 = dq * 32 + 8 * g4 + 4 * hi; const f32x4 gs = *(const LAS f32x4*)(bt + 64 + 4096 + d0);
                        v2u w; w.x = pk2(O[dq][4 * g4] * rstd * gs.x, O[dq][4 * g4 + 1] * rstd * gs.y); w.y = pk2(O[dq][4 * g4 + 2] * rstd * gs.z, O[dq][4 * g4 + 3] * rstd * gs.w);
                        *(v2u*)(orow + d0) = w; }
            }
            asm volatile("s_waitcnt vmcnt(0)" ::: "memory");
            RAW_BARRIER();
        }
    }
}

constexpr size_t WS_OG = 432 * MiB, WS_LSE = 480 * MiB;
__device__ __forceinline__ void mixC_fast(unsigned char* y, unsigned char* ws, const float* T, LAS unsigned char* lds, int tid, int lane, int wave, int G) {
    asm volatile("" : "+v"(lane), "+v"(tid));
    const bf16* CQ = (const bf16*)(y + Y_CQ); const bf16* CK = (const bf16*)(y + Y_CK); const bf16* CV = (const bf16*)(y + Y_CV);
    float* OG = (float*)(ws + WS_OG); float* LSE = (float*)(ws + WS_LSE);
    const int r32 = lane & 31, hi = lane >> 5;
    LAS unsigned char* Kl = lds;
    LAS unsigned char* Vl = lds + 49152;
    LAS float* bt = (LAS float*)(lds + 98304);
    constexpr float C2 = 0.125f * LOG2E;
    for (int item = blockIdx.x; item < CHB * 192; item += G) {
        const int bb = item / 192, u = item % 192, g = u >> 6, v = u & 63;
        const int hp = v >> 4, w16 = v & 15;
        const int dil = (g == 0) ? 1 : (g == 1) ? 4 : 16;
        const int rc = (g == 0) ? 0 : (g == 1) ? (w16 >> 2) : w16;
        const int seg = (g == 0) ? w16 : (g == 1) ? (w16 & 3) : 0;
        const int hh = 4 * g + hp, M0 = seg * 256, rb = bb * SEQ;
        RAW_BARRIER();
        if (tid < 192) { int rel = tid - 32; rel = rel < 0 ? 0 : (rel > 128 ? 128 : rel); bt[tid] = T[(rel * dil) * 24 + 12 + hh] * LOG2E; }
#pragma unroll
        for (int i = 0; i < 6; ++i) { const int p = wave * 6 + i, c = p / 6, rbk = p % 6;
            int mk = M0 - 128 + 64 * rbk + lane; mk = mk < 0 ? 0 : mk;
            glds16(CK + (size_t)(rb + mk * dil + rc) * 768 + hh * 64 + c * 8, Kl + c * 6144 + rbk * 1024); }
#pragma unroll
        for (int i = 0; i < 6; ++i) { const int p = wave * 6 + i, dq = p / 24, rg = p % 24;
            int mk = M0 - 128 + 16 * rg + (lane >> 2); mk = mk < 0 ? 0 : mk;
            glds16(CV + (size_t)(rb + mk * dil + rc) * 768 + hh * 64 + dq * 32 + (lane & 3) * 8, Vl + p * 1024); }
        const int mq = M0 + 32 * wave + r32, rowq = rb + mq * dil + rc;
        bf16x8 qf[4];
#pragma unroll
        for (int ks = 0; ks < 4; ++ks) qf[ks] = *(const bf16x8*)(CQ + (size_t)rowq * 768 + hh * 64 + 16 * ks + 8 * hi);
        asm volatile("s_waitcnt vmcnt(0)" ::: "memory");
        RAW_BARRIER();
        f32x16 O[2];
#pragma unroll
        for (int dq = 0; dq < 2; ++dq)
#pragma unroll
            for (int r = 0; r < 16; ++r) O[dq][r] = 0.f;
        float mref = -INFINITY, lsum = 0.f;
#pragma unroll 1
        for (int j = 0; j < 5; ++j) {
            const int lrow = 32 * wave + 32 * j;
            if (M0 - 128 + lrow + 31 < 0) continue;
            const LAS unsigned char* kb = Kl + hi * 6144 + (lrow + r32) * 16;
            f32x16 s0;
#pragma unroll
            for (int r = 0; r < 16; ++r) s0[r] = 0.f;
#pragma unroll
            for (int ks = 0; ks < 4; ++ks) { const bf16x8 k0 = *(const LAS bf16x8*)(kb + ks * 12288); s0 = __builtin_amdgcn_mfma_f32_32x32x16_bf16(k0, qf[ks], s0, 0, 0, 0); }
            const int relb = 128 - 32 * j + r32;
            const LAS float* bp = bt + 32 + relb - 4 * hi;
            const int mkb = M0 - 128 + lrow + 4 * hi;
#pragma unroll
            for (int r = 0; r < 16; ++r) { const int cr = (r & 3) + 8 * (r >> 2), rel = relb - 4 * hi - cr;
                const float vv = fmaf(s0[r], C2, bp[-cr]);
                s0[r] = (rel >= 0 && rel <= 128 && mkb + cr >= 0) ? vv : -INFINITY; }
            float rm = s0[0];
#pragma unroll
            for (int r = 1; r < 16; ++r) rm = fmaxf(rm, s0[r]);
            rm = swap_max(rm);
            const float mn = fmaxf(mref, rm);
            const float f = (mn == -INFINITY) ? 1.f : __builtin_amdgcn_exp2f(mref - mn);
            const float msub = (mn == -INFINITY) ? 0.f : mn;
            lsum *= f; mref = mn;
#pragma unroll
            for (int dq = 0; dq < 2; ++dq)
#pragma unroll
                for (int r = 0; r < 16; ++r) O[dq][r] *= f;
            float ps = 0.f;
#pragma unroll
            for (int r = 0; r < 16; ++r) { s0[r] = __builtin_amdgcn_exp2f(s0[r] - msub); ps += s0[r]; }
            lsum += ps;
            bf16x8 pf[2];
            { v4u w;
              w.x = cvtpk(s0[0], s0[1]); w.y = cvtpk(s0[2], s0[3]); w.z = cvtpk(s0[4], s0[5]); w.w = cvtpk(s0[6], s0[7]); pf[0] = __builtin_bit_cast(bf16x8, w);
              w.x = cvtpk(s0[8], s0[9]); w.y = cvtpk(s0[10], s0[11]); w.z = cvtpk(s0[12], s0[13]); w.w = cvtpk(s0[14], s0[15]); pf[1] = __builtin_bit_cast(bf16x8, w); }
            const unsigned vb = (unsigned)(uintptr_t)(Vl + ((lane >> 4) & 1) * 32 + (lane & 3) * 8 + (4 * hi + ((lane & 15) >> 2)) * 64 + (lrow >> 4) * 1024);
            s16x4 fa[8];
#pragma unroll
            for (int dq = 0; dq < 2; ++dq)
#pragma unroll
                for (int sp = 0; sp < 2; ++sp) { TRV(fa[4 * dq + 2 * sp], vb, (dq * 24 + sp) * 1024); TRV(fa[4 * dq + 2 * sp + 1], vb, (dq * 24 + sp) * 1024 + 512); }
            LGKM_WAIT8(0, fa);
#pragma unroll
            for (int dq = 0; dq < 2; ++dq)
#pragma unroll
                for (int sp = 0; sp < 2; ++sp) O[dq] = __builtin_amdgcn_mfma_f32_32x32x16_bf16(VFRAG(fa, 2 * dq + sp), pf[sp], O[dq], 0, 0, 0);
        }
        const float ltot = swap_add(lsum), inv = 1.0f / ltot;
        float* og = OG + ((size_t)g * CHR + rowq) * 256 + hp * 64;
#pragma unroll
        for (int dq = 0; dq < 2; ++dq)
#pragma unroll
            for (int g4 = 0; g4 < 4; ++g4) { const int d0 = dq * 32 + 8 * g4 + 4 * hi;
                *(f32x4*)(og + d0) = (f32x4){O[dq][4 * g4] * inv, O[dq][4 * g4 + 1] * inv, O[dq][4 * g4 + 2] * inv, O[dq][4 * g4 + 3] * inv}; }
        if (hi == 0) LSE[((size_t)g * CHR + rowq) * 4 + hp] = (mref + __log2f(ltot)) * 0.6931471805599453f;
    }
}
__device__ __forceinline__ void mergeC(unsigned char* y, unsigned char* ws, int gw, int NGW, int lane) {
    asm volatile("" : "+v"(lane));
    const float* OG = (const float*)(ws + WS_OG); const float* LSE = (const float*)(ws + WS_LSE); bf16* OC = (bf16*)(y + Y_OC);
    for (int r = gw; r < CHR; r += NGW) {
        const int hp = lane >> 4, d4 = (lane & 15) * 4;
        float l0 = LSE[((size_t)0 * CHR + r) * 4 + hp], l1 = LSE[((size_t)1 * CHR + r) * 4 + hp], l2 = LSE[((size_t)2 * CHR + r) * 4 + hp];
        const float M = fmaxf(fmaxf(l0, l1), l2);
        const float a0 = __expf(l0 - M), a1 = __expf(l1 - M), a2 = __expf(l2 - M), ia = 1.0f / (a0 + a1 + a2);
        const f32x4 o0 = *(const f32x4*)(OG + ((size_t)0 * CHR + r) * 256 + hp * 64 + d4), o1 = *(const f32x4*)(OG + ((size_t)1 * CHR + r) * 256 + hp * 64 + d4), o2 = *(const f32x4*)(OG + ((size_t)2 * CHR + r) * 256 + hp * 64 + d4);
        const f32x4 o = (o0 * a0 + o1 * a1 + o2 * a2) * ia;
        v2u w; w.x = pk2(o.x, o.y); w.y = pk2(o.z, o.w);
        *(v2u*)(OC + (size_t)r * 256 + hp * 64 + d4) = w;
    }
}

constexpr int CW_KMAX = 8192;
constexpr int A_KST = 0, A_HIST = 32768, A_CAND = 98304, A_SEL = 131072, A_BKT = 147456, A_BIAS = 151552;
__device__ __forceinline__ int a_bin(float s, int kb) {
    int k = (int)(__float_as_uint(fabsf(s)) >> 18) - kb; k = k < 0 ? 0 : (k > 511 ? 511 : k);
    return (s < 0.f) ? (511 - k) : (512 + k);
}
__device__ __forceinline__ unsigned a_edge(int b, int kb) {
    if (b <= 0) return 0u;
    if (b >= 1024) return 0xffffffffu;
    if (b == 512) return 0x80000000u;
    if (b > 512) { const int k = b - 512 + kb; return 0x80000000u | ((unsigned)(k > 0 ? k : 0) << 18); }
    const int k = 512 - b + kb; return 0x80000000u - ((unsigned)(k > 0 ? k : 0) << 18);
}
__device__ __forceinline__ void mixA_fast(unsigned char* y, bf16* OUTA, bf16* OUTA2, const bf16* KVN, const float* T, const float* rel_bias, const unsigned* kmaxw, LAS unsigned char* lds, int tid, int lane, int wave, int G) {
    asm volatile("" : "+v"(lane), "+v"(tid));
    bf16* QLAT = (bf16*)(y + Y_QLAT); const bf16* MISC = (const bf16*)(y + Y_MISC); const bf16* IQ = (const bf16*)(y + Y_IQ);
    const int kl = lane & 31, hi = lane >> 5;
    constexpr float C2 = 0.125f * LOG2E, THR = 8.0f;
    LAS float* biasl = (LAS float*)(lds + A_BIAS);
    const unsigned lt32 = (1u << kl) - 1u;
    for (int item = blockIdx.x; item < CHB * 64; item += G) {
        const int bb = (G == 256) ? (item & 3) : (item >> 6), pr = (G == 256) ? (((item >> 2) & 1) * 32 + (item >> 3)) : (item & 63), rb = bb * SEQ;
        const float kmax = sqrtf(__uint_as_float(kmaxw[bb]));
        for (int uu = 0; uu < 2; ++uu) {
            const int qb = (uu == 0) ? (127 - pr) : pr, t0 = qb * 32, tw = t0 + 4 * wave;
            RAW_BARRIER();
            if (tid < 256) biasl[tid] = rel_bias[(tid >> 3) * 24 + (tid & 7)] * LOG2E;
            bf16x8 aq[4];
            { const int rowq = kl >> 3, hr = kl & 7;
#pragma unroll
              for (int ks = 0; ks < 4; ++ks) aq[ks] = *(const bf16x8*)(IQ + (size_t)(rb + tw + rowq) * 512 + hr * 64 + 16 * ks + 8 * hi); }
            float wr[16];
#pragma unroll
            for (int r = 0; r < 16; ++r) wr[r] = bf2f(MISC[(size_t)(rb + tw + (r >> 2)) * 256 + 192 + (r & 3) + 4 * hi]) * 0.044194173824159216f;
            int kbX, kbY;
            { float ss = 0.f;
#pragma unroll
              for (int ks = 0; ks < 4; ++ks)
#pragma unroll
                  for (int j = 0; j < 8; ++j) { const float v = bf2f((bf16)aq[ks][j]); ss += v * v; }
              ss = swap_add(ss);
              const float wa = fabsf(bf2f(MISC[(size_t)(rb + tw + (kl >> 3)) * 256 + 192 + (kl & 7)])) * 0.044194173824159216f;
              float u = wa * sqrtf(ss) * kmax;
              u += __shfl_xor(u, 1); u += __shfl_xor(u, 2); u += __shfl_xor(u, 4);
              const float uX = __shfl(u, (2 * hi) * 8), uY = __shfl(u, (2 * hi + 1) * 8);
              kbX = (int)(__float_as_uint(uX) >> 18) - 511; kbY = (int)(__float_as_uint(uY) >> 18) - 511; }
            const int tX = tw + 2 * hi, tY = tw + 2 * hi + 1;
            const int qX = wave * 4 + 2 * hi, qY = qX + 1;
            LAS unsigned* histX = (LAS unsigned*)(lds + A_HIST + qX * 2048); LAS unsigned* histY = (LAS unsigned*)(lds + A_HIST + qY * 2048);
            int thrX = -1, thrY = -1; unsigned cntX = 0, cntY = 0, ccX = 0, ccY = 0;
            unsigned eSX = 0u, eCX = 0u, eSY = 0u, eCY = 0u;
#pragma unroll 1
            for (int rep8 = 0; rep8 < ((PROBE == 8 || PROBE == 15) ? 2 : 1); ++rep8) {
            thrX = -1; thrY = -1; cntX = 0; cntY = 0; ccX = 0; ccY = 0;
            { LAS v4u* hz = (LAS v4u*)(lds + A_HIST + wave * 8192);
#pragma unroll
              for (int i = 0; i < 8; ++i) hz[i * 64 + lane] = (v4u){0u, 0u, 0u, 0u}; }
            const int NTK = qb + 1, NCK = (NTK + 3) >> 2;
#define MA_STAGE(ck_, buf_) do { _Pragma("unroll") for (int i_ = 0; i_ < 2; ++i_) { const int p_ = 2 * wave + i_, tl_ = p_ >> 2, ks_ = p_ & 3; \
                glds16(MISC + (size_t)(rb + 128 * (ck_) + 32 * tl_ + kl) * 256 + 128 + (2 * ks_ + hi) * 8, lds + A_KST + (buf_) * 16384 + tl_ * 4096 + ks_ * 1024); } } while (0)
#pragma unroll 1
            for (int pass = 0; pass < 2; ++pass) {
                MA_STAGE(0, 0);
#pragma unroll 1
                for (int ck = 0; ck < NCK; ++ck) {
                    if (ck + 1 < NCK) { MA_STAGE(ck + 1, (ck + 1) & 1); asm volatile("s_waitcnt vmcnt(2)" ::: "memory"); }
                    else asm volatile("s_waitcnt vmcnt(0)" ::: "memory");
                    RAW_BARRIER();
#define RELU(x_) __int_as_float(max(__float_as_int(x_), 0))
#define MA_LOADK(kf_, tl_) do { const LAS unsigned char* kbp_ = lds + A_KST + (ck & 1) * 16384 + (tl_) * 4096 + hi * 512 + kl * 16; \
                        _Pragma("unroll") for (int ks = 0; ks < 4; ++ks) kf_[ks] = *(const LAS bf16x8*)(kbp_ + ks * 1024); } while (0)
#define MA_MMA(c_, kf_) do { _Pragma("unroll") for (int r = 0; r < 16; ++r) c_[r] = 0.f; \
                        _Pragma("unroll") for (int ks = 0; ks < 4; ++ks) c_ = __builtin_amdgcn_mfma_f32_32x32x16_bf16(aq[ks], kf_[ks], c_, 0, 0, 0); } while (0)
#define MA_RED(sX_, sY_, c_) do { float p0_ = 0.f, p1_ = 0.f, p2_ = 0.f, p3_ = 0.f; \
                        _Pragma("unroll") for (int i = 0; i < 4; ++i) { p0_ += wr[i] * RELU(c_[i]); p1_ += wr[4 + i] * RELU(c_[4 + i]); p2_ += wr[8 + i] * RELU(c_[8 + i]); p3_ += wr[12 + i] * RELU(c_[12 + i]); } \
                        { auto rr = __builtin_amdgcn_permlane32_swap(__float_as_uint(p0_), __float_as_uint(p2_), false, false); sX_ = __uint_as_float(rr[0]) + __uint_as_float(rr[1]) + 0.f; } \
                        { auto rr = __builtin_amdgcn_permlane32_swap(__float_as_uint(p1_), __float_as_uint(p3_), false, false); sY_ = __uint_as_float(rr[0]) + __uint_as_float(rr[1]) + 0.f; } } while (0)
#define MA_APPEND(sv_, val_, q_, cnt_, cc_, eS_, eC_, s_) do { const unsigned mk_ = __float_as_uint(sv_) ^ ((unsigned)((int)__float_as_uint(sv_) >> 31) | 0x80000000u); \
                        const bool sel_ = (val_) && mk_ >= (eS_), cd_ = (val_) && mk_ >= (eC_) && mk_ < (eS_); \
                        const unsigned long long bs_ = __ballot(sel_), bc_ = __ballot(cd_); \
                        const unsigned ms_ = hi ? (unsigned)(bs_ >> 32) : (unsigned)bs_, mc_ = hi ? (unsigned)(bc_ >> 32) : (unsigned)bc_; \
                        if (sel_) lds_st_b16_asm((LAS bf16*)(lds + A_SEL + (q_) * 512) + cnt_ + __popc(ms_ & lt32), (unsigned)(s_)); \
                        if (cd_) { const unsigned cp_ = cc_ + __popc(mc_ & lt32); if (cp_ < 128u) { lds_st_b32_asm((LAS float*)(lds + A_CAND + (q_) * 768) + cp_, __float_as_uint(sv_)); lds_st_b16_asm((LAS bf16*)(lds + A_CAND + (q_) * 768 + 512) + cp_, (unsigned)(s_)); } } \
                        cnt_ += __popc(ms_); cc_ += __popc(mc_); } while (0)
#pragma unroll 1
                    for (int tl = 0; tl < 4; tl += 2) {
                        const int kt = 4 * ck + tl; if (kt >= NTK) break;
                        if (PROBE == 15 && rep8 == 0) continue;
                        float sXa, sYa, sXb, sYb;
                        {
                            bf16x8 kfa[4], kfb[4]; f32x16 ca, cb;
                            MA_LOADK(kfa, tl); MA_LOADK(kfb, tl + 1);
                            asm volatile("" : "+v"(kfa[0]), "+v"(kfa[1]), "+v"(kfa[2]), "+v"(kfa[3]), "+v"(kfb[0]), "+v"(kfb[1]), "+v"(kfb[2]), "+v"(kfb[3]));
                            MA_MMA(ca, kfa); MA_MMA(cb, kfb);
                            asm volatile("" : "+v"(ca), "+v"(cb));
                            MA_RED(sXa, sYa, ca); MA_RED(sXb, sYb, cb); }
                        const int sa = kt * 32 + kl, sb2 = sa + 32;
                        const bool vXa = sa <= tX, vYa = sa <= tY, vXb = sb2 <= tX, vYb = sb2 <= tY;
                        if (pass == 0) {
                            const int bXa = a_bin(sXa, kbX), bYa = a_bin(sYa, kbY), bXb = a_bin(sXb, kbX), bYb = a_bin(sYb, kbY);
                            if (vXa) lds_add_u32_asm(histX + (bXa >> 1), 1u << ((bXa & 1) * 16));
                            if (vYa) lds_add_u32_asm(histY + (bYa >> 1), 1u << ((bYa & 1) * 16));
                            if (vXb) lds_add_u32_asm(histX + (bXb >> 1), 1u << ((bXb & 1) * 16));
                            if (vYb) lds_add_u32_asm(histY + (bYb >> 1), 1u << ((bYb & 1) * 16));
                        } else {
                            MA_APPEND(sXa, vXa, qX, cntX, ccX, eSX, eCX, sa); MA_APPEND(sYa, vYa, qY, cntY, ccY, eSY, eCY, sa);
                            MA_APPEND(sXb, vXb, qX, cntX, ccX, eSX, eCX, sb2); MA_APPEND(sYb, vYb, qY, cntY, ccY, eSY, eCY, sb2);
                        }
                    }
#undef MA_LOADK
#undef MA_MMA
#undef MA_RED
#undef MA_APPEND
                    RAW_BARRIER();
                }
                if (pass == 0) {
#pragma unroll 1
                    for (int q4 = 0; q4 < 4; ++q4) {
                        const LAS unsigned* hq = (const LAS unsigned*)(lds + A_HIST + (wave * 4 + q4) * 2048) + 504 - 8 * lane;
                        unsigned w8[8];
                        { const v4u a0 = *(const LAS v4u*)hq, a1 = *(const LAS v4u*)(hq + 4); w8[0] = a0.x; w8[1] = a0.y; w8[2] = a0.z; w8[3] = a0.w; w8[4] = a1.x; w8[5] = a1.y; w8[6] = a1.z; w8[7] = a1.w; }
                        unsigned loc = 0;
#pragma unroll
                        for (int j = 0; j < 8; ++j) loc += (w8[j] & 0xffffu) + (w8[j] >> 16);
                        unsigned inc = loc;
#pragma unroll
                        for (int o = 1; o < 64; o <<= 1) { const unsigned v = __shfl_up(inc, o); if (lane >= o) inc += v; }
                        unsigned run = inc - loc; int thr = -1; unsigned cab = 0;
#pragma unroll
                        for (int j = 7; j >= 0; --j)
#pragma unroll
                            for (int hh = 1; hh >= 0; --hh) { const unsigned cn = (w8[j] >> (16 * hh)) & 0xffffu;
                                if (thr < 0 && run + cn >= (unsigned)TOPK) { thr = 2 * (504 - 8 * lane + j) + hh; cab = run; }
                                run += cn; }
                        const unsigned long long bl = __ballot(inc >= (unsigned)TOPK);
                        int thq = -1; unsigned cbq = 0;
                        if (bl) { const int L = __ffsll((long long)bl) - 1; thq = __shfl(thr, L); cbq = __shfl(cab, L); }
                        (void)cbq;
                        if (q4 == 2 * hi) thrX = thq; if (q4 == 2 * hi + 1) thrY = thq;
                    }
                    eCX = a_edge(thrX, kbX); eSX = a_edge(thrX + 1, kbX); eCY = a_edge(thrY, kbY); eSY = a_edge(thrY + 1, kbY);
                }
            }
            }
#undef MA_STAGE
            {
                const unsigned c0 = (unsigned)__shfl((int)cntX, 0), c2 = (unsigned)__shfl((int)cntX, 32), c1 = (unsigned)__shfl((int)cntY, 0), c3 = (unsigned)__shfl((int)cntY, 32);
                const unsigned k0 = (unsigned)__shfl((int)ccX, 0), k2 = (unsigned)__shfl((int)ccX, 32), k1 = (unsigned)__shfl((int)ccY, 0), k3 = (unsigned)__shfl((int)ccY, 32);
#pragma unroll 1
                for (int q4 = 0; q4 < 4; ++q4) {
                    const unsigned cnt = (q4 == 0) ? c0 : (q4 == 1) ? c1 : (q4 == 2) ? c2 : c3; unsigned cc = (q4 == 0) ? k0 : (q4 == 1) ? k1 : (q4 == 2) ? k2 : k3;
                    if (cc > 128u) cc = 128u;
                    LAS unsigned* nfp = (LAS unsigned*)(lds + A_BIAS + 1024) + wave * 4 + q4;
                    if (lane == 0) *nfp = cnt;
                    if (cnt >= (unsigned)TOPK || cc == 0u) continue;
                    const unsigned need = (unsigned)TOPK - cnt;
                    const LAS float* cs = (const LAS float*)(lds + A_CAND + (wave * 4 + q4) * 768); const LAS bf16* ci = (const LAS bf16*)(lds + A_CAND + (wave * 4 + q4) * 768 + 512);
                    LAS bf16* so = (LAS bf16*)(lds + A_SEL + (wave * 4 + q4) * 512);
                    unsigned base = cnt;
#pragma unroll 1
                    for (unsigned r0 = 0; r0 < cc; r0 += 64) { const unsigned i = r0 + lane; const bool act = i < cc;
                        const float si = act ? cs[i] : 0.f; const unsigned ii = act ? ci[i] : 0u; unsigned rank = 0;
                        for (unsigned j = 0; j < cc; ++j) { const float sj = cs[j]; const unsigned ij = ci[j]; rank += (sj > si || (sj == si && ij < ii)) ? 1u : 0u; }
                        const bool take = act && rank < need;
                        const unsigned long long bt = __ballot(take);
                        if (take) so[base + __popcll(bt & ((1ull << lane) - 1ull))] = (bf16)ii;
                        base += __popcll(bt); }
                    if (lane == 0) *nfp = base;
                }
            }
            RAW_BARRIER();
#pragma unroll 1
            for (int rep9 = 0; rep9 < ((PROBE == 9 || PROBE == 10 || PROBE == 11) ? 2 : 1); ++rep9) {
                bf16* OUTP_ = ((PROBE == 9 || PROBE == 10 || PROBE == 11) && rep9 == 0) ? OUTA2 : OUTA;
                LAS unsigned char* gb = lds + wave * 16384;
                LAS bf16* bkt = (LAS bf16*)(lds + A_BKT + wave * 512);
#pragma unroll 1
                for (int q4 = 0; q4 < 4; ++q4) { int ns = (int)((const LAS unsigned*)(lds + A_BIAS + 1024))[wave * 4 + q4]; ns = ns < TOPK ? ns : TOPK; LAS bf16* so = (LAS bf16*)(lds + A_SEL + (wave * 4 + q4) * 512);
                    for (int i = lane; i < TOPK; i += 64) if (i >= ns) so[i] = 0; }
                asm volatile("s_waitcnt lgkmcnt(0)" ::: "memory");
                const int c15 = lane & 15, g = lane >> 4, q_ = c15 >> 2, p_ = c15 & 3, hc = c15 < 8 ? c15 : 7;
                const int Xr = ((c15 & 3) << 2) | ((c15 >> 2) & 3), Xt = (q_ << 2) | g;
                unsigned ra[4], ta[8];
#pragma unroll
                for (int ks = 0; ks < 4; ++ks) ra[ks] = (unsigned)(256 * c15 + 16 * ((4 * ks + g) ^ Xr));
#pragma unroll
                for (int dt = 0; dt < 8; ++dt) ta[dt] = (unsigned)(256 * (4 * g + q_) + 16 * ((2 * dt + (p_ >> 1)) ^ Xt) + 8 * (p_ & 1));
                bf16x8 bbf;
                { v4u w; const LAS float* bl = biasl + (8 * g) * 8 + hc;
                  constexpr float BS = 8.0f / LOG2E;
                  w.x = pk2(bl[0] * BS, bl[8] * BS); w.y = pk2(bl[16] * BS, bl[24] * BS); w.z = pk2(bl[32] * BS, bl[40] * BS); w.w = pk2(bl[48] * BS, bl[56] * BS); bbf = __builtin_bit_cast(bf16x8, w); }
#define MA_GATHER(q4_, c8_, buf_) do { const LAS bf16* so_ = (const LAS bf16*)(lds + A_SEL + (wave * 4 + (q4_)) * 512) + (c8_) * 32; \
                    int idx_[8]; _Pragma("unroll") for (int i_ = 0; i_ < 8; ++i_) idx_[i_] = (PROBE == 10 && rep9 == 0) ? (4 * i_ + (lane >> 4)) : (int)so_[4 * i_ + (lane >> 4)]; \
                    asm volatile("s_waitcnt lgkmcnt(0)" : "+v"(idx_[0]), "+v"(idx_[1]), "+v"(idx_[2]), "+v"(idx_[3]), "+v"(idx_[4]), "+v"(idx_[5]), "+v"(idx_[6]), "+v"(idx_[7]) :: "memory"); \
                    _Pragma("unroll") for (int i_ = 0; i_ < 8; ++i_) { const int row_ = 4 * i_ + (lane >> 4); \
                        const int ch_ = (lane & 15) ^ (((row_ & 3) << 2) | ((row_ >> 2) & 3)); \
                        glds16(KVN + (size_t)(rb + idx_[i_]) * 128 + ch_ * 8, gb + (buf_) * 8192 + i_ * 1024); } } while (0)
                MA_GATHER(0, 0, 0);
#pragma unroll 1
                for (int q4 = 0; q4 < 4; ++q4) {
                    const int t = tw + q4; int ns = (int)((const LAS unsigned*)(lds + A_BIAS + 1024))[wave * 4 + q4]; ns = ns < TOPK ? ns : TOPK;
                    const LAS bf16* so = (const LAS bf16*)(lds + A_SEL + (wave * 4 + q4) * 512);
                    for (int i = lane; i < TOPK; i += 64) { const int d = t - (int)so[i]; lds_st_b16_asm(bkt + i, (unsigned)rel_bucket(d < 0 ? 0 : d)); }
                    bf16x8 bq[4];
#pragma unroll
                    for (int ks = 0; ks < 4; ++ks) { bq[ks] = (bf16x8){0, 0, 0, 0, 0, 0, 0, 0}; if (c15 < 8) bq[ks] = *(const bf16x8*)(QLAT + (size_t)(rb + t) * 1024 + c15 * 128 + 32 * ks + 8 * g); }
                    f32x4 O[8];
#pragma unroll
                    for (int dt = 0; dt < 8; ++dt) O[dt] = (f32x4){0.f, 0.f, 0.f, 0.f};
                    float mref = -INFINITY, lsum = 0.f;
#pragma unroll 1
                    for (int c8 = 0; c8 < 8; ++c8) {
                        const int step = q4 * 8 + c8, buf = step & 1;
                        asm volatile("s_waitcnt lgkmcnt(0)" ::: "memory");
                        if (step + 1 < 32) { MA_GATHER((step + 1) >> 3, (step + 1) & 7, buf ^ 1); asm volatile("s_waitcnt vmcnt(8)" ::: "memory"); }
                        else asm volatile("s_waitcnt vmcnt(0)" ::: "memory");
                        const LAS unsigned char* cb = gb + buf * 8192;
                        if (PROBE == 11 && rep9 == 0) continue;
                        f32x4 sv[2];
#pragma unroll
                        for (int tau = 0; tau < 2; ++tau) {
                            f32x4 sa = (f32x4){0.f, 0.f, 0.f, 0.f};
#pragma unroll
                            for (int ks = 0; ks < 4; ++ks) { const bf16x8 kf = *(const LAS bf16x8*)(cb + ra[ks] + 4096 * tau); sa = __builtin_amdgcn_mfma_f32_16x16x32_bf16(kf, bq[ks], sa, 0, 0, 0); }
                            const int b = (int)bkt[c8 * 32 + 16 * tau + c15];
                            const unsigned val = ((b >> 3) == g) ? (0x3F80u << ((b & 1) * 16)) : 0u; const int di = (b >> 1) & 3;
                            v4u oh; oh.x = (di == 0) ? val : 0u; oh.y = (di == 1) ? val : 0u; oh.z = (di == 2) ? val : 0u; oh.w = (di == 3) ? val : 0u;
                            sa = __builtin_amdgcn_mfma_f32_16x16x32_bf16(__builtin_bit_cast(bf16x8, oh), bbf, sa, 0, 0, 0);
                            sv[tau] = sa * C2;
                        }
                        if (ns < TOPK) {
#pragma unroll
                            for (int tau = 0; tau < 2; ++tau)
#pragma unroll
                                for (int r = 0; r < 4; ++r) if (c8 * 32 + 16 * tau + 4 * g + r >= ns) sv[tau][r] = -INFINITY;
                        }
                        float rm = fmaxf(fmaxf(fmaxf(sv[0][0], sv[0][1]), fmaxf(sv[0][2], sv[0][3])), fmaxf(fmaxf(sv[1][0], sv[1][1]), fmaxf(sv[1][2], sv[1][3])));
                        rm = fmaxf(rm, __shfl_xor(rm, 16)); rm = fmaxf(rm, __shfl_xor(rm, 32));
                        if (__any(rm > mref + THR)) {
                            const float mn = fmaxf(mref, rm), f = (mn == -INFINITY) ? 1.f : __builtin_amdgcn_exp2f(mref - mn);
                            lsum *= f; mref = mn;
#pragma unroll
                            for (int dt = 0; dt < 8; ++dt) O[dt] = O[dt] * f;
                        }
                        const float msub = (mref == -INFINITY) ? 0.f : mref;
                        float ps = 0.f;
#pragma unroll
                        for (int tau = 0; tau < 2; ++tau)
#pragma unroll
                            for (int r = 0; r < 4; ++r) { sv[tau][r] = __builtin_amdgcn_exp2f(sv[tau][r] - msub); ps += sv[tau][r]; }
                        lsum += ps;
                        bf16x8 pf;
                        { v4u w; w.x = cvtpk(sv[0][0], sv[0][1]); w.y = cvtpk(sv[0][2], sv[0][3]); w.z = cvtpk(sv[1][0], sv[1][1]); w.w = cvtpk(sv[1][2], sv[1][3]); pf = __builtin_bit_cast(bf16x8, w); }
                        {
                            const unsigned cbu = (unsigned)(uintptr_t)cb;
                            s16x4 fa[8], fb[8];
#pragma unroll
                            for (int dt = 0; dt < 4; ++dt) { TRV(fa[2 * dt], cbu + ta[dt], 0); TRV(fa[2 * dt + 1], cbu + ta[dt], 4096); }
#pragma unroll
                            for (int dt = 0; dt < 4; ++dt) { TRV(fb[2 * dt], cbu + ta[4 + dt], 0); TRV(fb[2 * dt + 1], cbu + ta[4 + dt], 4096); }
                            LGKM_WAIT8(8, fa);
#pragma unroll
                            for (int dt = 0; dt < 4; ++dt) O[dt] = __builtin_amdgcn_mfma_f32_16x16x32_bf16(VFRAG(fa, dt), pf, O[dt], 0, 0, 0);
                            LGKM_WAIT8(0, fb);
#pragma unroll
                            for (int dt = 0; dt < 4; ++dt) O[4 + dt] = __builtin_amdgcn_mfma_f32_16x16x32_bf16(VFRAG(fb, dt), pf, O[4 + dt], 0, 0, 0);
                        }
                    }
                    float lt = lsum; lt += __shfl_xor(lt, 16); lt += __shfl_xor(lt, 32);
                    const float inv = 1.0f / lt;
                    if (c15 < 8) { bf16* orow = OUTP_ + (size_t)(rb + t) * 1024 + c15 * 128 + 4 * g;
#pragma unroll
                        for (int dt = 0; dt < 8; ++dt) { v2u w; w.x = pk2(O[dt][0] * inv, O[dt][1] * inv); w.y = pk2(O[dt][2] * inv, O[dt][3] * inv); *(v2u*)(orow + 16 * dt) = w; } }
                }
#undef MA_GATHER
                asm volatile("s_waitcnt vmcnt(0)" ::: "memory");
            }
        }
    }
}
#define Y_() (WSP() + WS_Y)
#define WL_(l) (WSP() + WS_W + (size_t)(l) * W_LAYER)
#define MOD_(l) ((const float*)(WSP() + WS_MOD) + (size_t)(l) * 8 * 6144)
#define T_() ((const float*)(WSP() + WS_TAB))
#define H_() ((bf16*)(WSP() + WS_H))
#define KVN_() ((bf16*)(WSP() + WS_KVN))
#define KMAXW_(l, ch) ((unsigned*)(WSP() + WS_CTL) + 8192 + ((l) * NCH + (ch)) * 64)
#define LAMI_(l) (((l) == 0) ? 0.8f : 0.64449093f)
__device__ __forceinline__ int tidx() { int t = (int)threadIdx.x; asm volatile("" : "+v"(t)); return t; }
#define TID_ tidx()
#define LANE_ (tidx() & 63)
__global__ void __launch_bounds__(NTHREADS, 2) fwd(Args a) {
    extern __shared__ __attribute__((aligned(16))) unsigned char lds_raw[];
    LAS unsigned char* lds = (LAS unsigned char*)lds_raw;
    const int wave = __builtin_amdgcn_readfirstlane((int)threadIdx.x >> 6);
    const int G = gridDim.x, gw = blockIdx.x * NWAVES + wave, NGW = G * NWAVES;
    for (int u = (int)threadIdx.x; u < (LDS_BYTES - LDSCTL_OFF) / 4; u += NTHREADS) ((LAS unsigned*)(lds + LDSCTL_OFF))[u] = 0u;
    __syncthreads();
    XcdBarrier bar = xcd_barrier_post((unsigned*)(WSP() + WS_CTL) + CW_BAR, (volatile LAS unsigned*)(lds + LDSCTL_OFF));

#pragma unroll 1
    for (int rep = 0; rep < (PROBE == 5 ? 2 : 1); ++rep) {
    p0a_prologue(WSP(), lds, TID_, LANE_, wave, G);
    xcd_barrier(bar); }
    norm_rows(ARG(0), H_(), ARG(4), MOD_(0) + 0 * 1024, MOD_(0) + 1 * 1024, gw, NGW, LANE_);
    xcd_barrier(bar);

#pragma unroll 1
    for (int l = 0; l < NL; ++l) {
#pragma unroll 1
        for (int ch = 0; ch < NCH; ++ch) {
            { pg8::Gemm g{H_() + (size_t)ch * CHR * 1024, (const bf16*)(WL_(l) + W_IN), CHR, NIN, 1024}; pg8::StaticOrder S; S.init(CHR, NIN, G, (int)blockIdx.x);
              pg8::EpiIn E{Y_()};
#pragma unroll 1
              for (int rep = 0; rep < (PROBE == 1 ? 2 : 1); ++rep)
              pg8::gemm_phase<pg8::EpiIn, pg8::StaticOrder, true, true>(lds, g, S, E);
            }
            xcd_barrier(bar);
            kvn_rows(Y_(), KVN_(), ARG(8) + l * 128, KMAXW_(l, ch), gw, NGW, LANE_);
#if PROBE == 4
            mixC_fast(Y_(), WSP(), T_(), lds, TID_, LANE_, wave, G);
#endif
            mixC_fast(Y_(), WSP(), T_(), lds, TID_, LANE_, wave, G);
#if PROBE == 2 || (PROBE >= 12 && PROBE <= 14)
            mixB_fast<(PROBE == 2 ? 0 : PROBE - 11)>(Y_(), (bf16*)(WSP() + 484 * MiB), T_(), ARG(13) + l * 128, ((const float*)(WSP() + WS_LAM))[l], LAMI_(l), lds, TID_, LANE_, wave, G);
#endif
            mixB_fast<0>(Y_(), (bf16*)(Y_() + Y_BQ), T_(), ARG(13) + l * 128, ((const float*)(WSP() + WS_LAM))[l], LAMI_(l), lds, TID_, LANE_, wave, G);
            xcd_barrier(bar);
            mergeC(Y_(), WSP(), gw, NGW, LANE_);
#if PROBE == 3 || PROBE == 9 || PROBE == 10 || PROBE == 11
            xcd_barrier(bar);
#endif
#if PROBE == 3
            mixA_fast(Y_(), (bf16*)(WSP() + WS_OG), (bf16*)(WSP() + WS_OG), KVN_(), T_(), ARG(21), KMAXW_(l, ch), lds, TID_, LANE_, wave, G);
#endif
            mixA_fast(Y_(), (bf16*)(Y_() + Y_QLAT), (bf16*)(WSP() + WS_OG), KVN_(), T_(), ARG(21), KMAXW_(l, ch), lds, TID_, LANE_, wave, G);
            xcd_barrier(bar);
#pragma unroll 1
            for (int rep = 0; rep < (PROBE == 7 ? 2 : 1); ++rep)
            { pg8::StaticOrder S; S.init(CHR, 1024, G, (int)blockIdx.x);
              { unsigned char* y = Y_(); pg8::Gemm g{(const bf16*)(y + Y_QLAT), (const bf16*)(WL_(l) + W_A), CHR, 1024, 1024}; pg8::EpiGate<0> E{(const bf16*)(y + Y_Z), 0, (float*)(y + Y_MF32), (bf16*)(y + Y_MBF)};
                pg8::gemm_phase<pg8::EpiGate<0>, pg8::StaticOrder, true, true>(lds, g, S, E); }
              { unsigned char* y = Y_(); pg8::Gemm g{(const bf16*)(y + Y_BQ), (const bf16*)(WL_(l) + W_B), CHR, 1024, 512}; pg8::EpiGate<1> E{(const bf16*)(y + Y_Z), 1024, (float*)(y + Y_MF32), (bf16*)(y + Y_MBF)};
                pg8::gemm_phase<pg8::EpiGate<1>, pg8::StaticOrder, true, true>(lds, g, S, E); }
              { unsigned char* y = Y_(); pg8::Gemm g{(const bf16*)(y + Y_OC), (const bf16*)(WL_(l) + W_C), CHR, 1024, 256}; pg8::EpiGate<2> E{(const bf16*)(y + Y_Z), 2048, (float*)(y + Y_MF32), (bf16*)(y + Y_MBF)};
                pg8::gemm_phase<pg8::EpiGate<2>, pg8::StaticOrder, true, true>(lds, g, S, E); } }
            xcd_barrier(bar);
            { pg8::Gemm g{(const bf16*)(Y_() + Y_MBF), (const bf16*)(WL_(l) + W_OUT), CHR, 1024, 1024}; pg8::StaticOrder S; S.init(CHR, 1024, G, (int)blockIdx.x);
              pg8::EpiRes E{(l == 0) ? ARG(0) : (const float*)OUTP(), OUTP(), MOD_(l) + 2 * 1024, ch * CHR};
              pg8::gemm_phase<pg8::EpiRes, pg8::StaticOrder, true, true>(lds, g, S, E); }
            xcd_barrier(bar);
        }
#pragma unroll 1
        for (int rep = 0; rep < (PROBE == 6 ? 2 : 1); ++rep) {
        norm_rows(OUTP(), H_(), ARG(18) + l * 1024, MOD_(l) + 3 * 1024, MOD_(l) + 4 * 1024, gw, NGW, LANE_);
        xcd_barrier(bar); }
        { pg8::Gemm g{H_(), (const bf16*)(WL_(l) + W_GU), MT, NGU, 1024}; pg8::StaticOrder S; S.init(MT, NGU, G, (int)blockIdx.x);
          pg8::EpiSwiGLU E{(bf16*)(WSP() + WS_ACT)};
#pragma unroll 1
          for (int rep = 0; rep < (PROBE == 1 ? 2 : 1); ++rep)
          pg8::gemm_phase<pg8::EpiSwiGLU, pg8::StaticOrder, true, true>(lds, g, S, E);
        }
        xcd_barrier(bar);
        { pg8::Gemm g{(const bf16*)(WSP() + WS_ACT), (const bf16*)(WL_(l) + W_D), MT, 1024, DFF}; pg8::StaticOrder S; S.init(MT, 1024, G, (int)blockIdx.x);
          pg8::EpiRes E{OUTP(), OUTP(), MOD_(l) + 5 * 1024, 0};
          pg8::gemm_phase<pg8::EpiRes, pg8::StaticOrder, true, true>(lds, g, S, E); }
        xcd_barrier(bar);
        if (l + 1 < NL) { norm_rows(OUTP(), H_(), ARG(4) + (l + 1) * 1024, MOD_(l + 1) + 0 * 1024, MOD_(l + 1) + 1 * 1024, gw, NGW, LANE_); xcd_barrier(bar); }
        else final_rows(OUTP(), ARG(22), gw, NGW, LANE_);
    }
}

extern "C" void kernel_launch(void* const* d_in, const int* in_sizes, int n_in, void* d_out, int out_size, void* d_ws, size_t ws_size, hipStream_t stream) {
    static int grid = 0;
    if (grid == 0) {
        if (n_in != 23 || out_size != MT * DM || ws_size < WS_END) { fprintf(stderr, "kernel_launch: unexpected shapes (n_in %d out %d ws %zu)\n", n_in, out_size, ws_size); grid = -1; return; }
        int dev = 0, cus = 0, per_cu = 0;
        if (hipGetDevice(&dev) != hipSuccess || hipDeviceGetAttribute(&cus, hipDeviceAttributeMultiprocessorCount, dev) != hipSuccess) { grid = -1; return; }
        if (hipFuncSetAttribute((const void*)fwd, hipFuncAttributeMaxDynamicSharedMemorySize, LDS_BYTES) != hipSuccess) { fprintf(stderr, "kernel_launch: hipFuncSetAttribute failed\n"); grid = -1; return; }
        if (hipOccupancyMaxActiveBlocksPerMultiprocessor(&per_cu, (const void*)fwd, NTHREADS, LDS_BYTES) != hipSuccess || per_cu < 1) { fprintf(stderr, "kernel_launch: occupancy query says %d\n", per_cu); }
        (void)hipGetLastError();
        grid = cus;
    }
    if (grid < 0) return;
    (void)hipMemsetAsync((char*)d_ws + WS_CTL, 0, CTL_ZERO_BYTES, stream);
    Args a{};
    for (int i = 0; i < 23; ++i) a.in[i] = (const float*)d_in[i];
    a.out = (float*)d_out; a.ws = (unsigned char*)d_ws; a.pad0 = 0; a.pad1 = 0;
    hipLaunchKernelGGL(fwd, dim3(grid), dim3(NTHREADS), LDS_BYTES, stream, a);
}
```

```cpp
#include <hip/hip_runtime.h>
#include <cstdio>
#include <cstdint>
#ifndef PROBE
#define PROBE 0
#endif
#ifndef DIAG_OFS
#define DIAG_OFS 0.5f
#endif
#ifndef BSTAGE_POS
#define BSTAGE_POS 2
#endif
#ifndef AGATHER_POS
#define AGATHER_POS 1
#endif
namespace pg8 {
#define PG8_LAS __attribute__((address_space(3)))
typedef unsigned short bf16_t;
typedef short bf16x8 __attribute__((ext_vector_type(8)));
typedef float f32x4 __attribute__((ext_vector_type(4)));
typedef unsigned u32x4 __attribute__((ext_vector_type(4)));
constexpr int BM = 256, BK = 64, HALF = 128, HTB = HALF * BK * 2  , STAGE_BYTES = 8 * HTB, NXCD = 8, WGM = 8;

__host__ __device__ __forceinline__ int lds_byte(int r, int c) { const int st = (r >> 4) * 2 + (c >> 5), rr = r & 15, cc = c & 31, ob = rr * 64 + cc * 2; return st * 1024 + (ob ^ (((ob >> 9) & 1) << 5)); }
__host__ __device__ __forceinline__ void stage_rc(int b, int& R, int& C) { const int st = b / 1024, sb = b % 1024, swz = sb ^ (((sb >> 9) & 1) << 5); R = (st >> 1) * 16 + swz / 64; C = (st & 1) * 32 + (swz % 64) / 2; }
__host__ __device__ __forceinline__ int perm32(int rho) { const int n = rho >> 4, i = rho & 15; return 8 * (i >> 2) + 4 * n + (i & 3); }

struct Unit { int pm, pn; };
struct Gemm { const bf16_t* A; const bf16_t* Bt; int M, N, K; };

struct StaticOrder {
    int nM, nN, nwg, G, c;
    __host__ __device__ void init(int M, int N, int G_, int c_) { nM = M / BM; nN = N / BM; nwg = nM * nN; G = G_; c = c_; }
    __host__ __device__ bool next(int i, Unit& u) const {
        const long L = (long)i * G + c; if (L >= nwg) return false;
        int wgid = (int)L; { const int q = nwg / NXCD, r = nwg % NXCD, xcd = wgid % NXCD, off = wgid / NXCD; wgid = (xcd < r ? xcd * (q + 1) : r * (q + 1) + (xcd - r) * q) + off; }
        const int nig = WGM * nN, gid = wgid / nig, fm = gid * WGM, gsz = (nM - fm) < WGM ? (nM - fm) : WGM;
        u.pm = fm + ((wgid % nig) % gsz); u.pn = (wgid % nig) / gsz; return true;
    }
    __device__ __forceinline__ void a_ready(const Unit&) const {}
    __device__ __forceinline__ void done(const Unit&) const {}
};

template <class Epi, class Sched, bool ALIGN_EPI = false, bool SP2 = false>
__device__ __forceinline__ void gemm_phase(PG8_LAS unsigned char* lds, const Gemm g, const Sched& S, const Epi& E, int wv) {
    int tid_l = threadIdx.x; (void)wv; asm volatile("" : "+v"(tid_l));
    const int tid = tid_l, wid = __builtin_amdgcn_readfirstlane(tid >> 6), lane = tid & 63, wr = wid >> 2, wc = wid & 3, fr = lane & 15, fq = lane >> 4;
    int K_l = g.K; asm volatile("" : "+s"(K_l));
    const int K = K_l, nt = K / BK;
    unsigned voffA[2], voffB[2];
#pragma unroll
    for (int i = 0; i < 2; ++i) { int R, C; stage_rc(tid * 16 + i * 8192, R, C); const int Rb = Epi::PERM ? ((R & ~31) + perm32(R & 31)) : R;
        voffA[i] = (unsigned)(R * K + C) * 2u; voffB[i] = (unsigned)(Rb * K + C) * 2u; }
    const size_t kstep = (size_t)(BK * 2);
    const size_t hstep = (size_t)HALF * K * 2;
    const size_t tstep = 2 * hstep;
    const unsigned ldsw = (unsigned)wid * 1024u;
    const int aoff = lds_byte(wr * 64 + fr, fq * 8), boff = lds_byte(wc * 32 + fr, fq * 8);
#define PG8_SA(b, h) (((b) * 2 + (h)) * HTB)
#define PG8_SB(b, h) ((4 + (b) * 2 + (h)) * HTB)
#define PG8_STAGE(bufoff, gbase, voff) do { _Pragma("unroll") for (int _i = 0; _i < 2; ++_i) \
        __builtin_amdgcn_global_load_lds((const unsigned*)((const char*)(gbase) + (voff)[_i]), (PG8_LAS unsigned*)(lds + (bufoff) + ldsw + _i * 8192), 16, 0, 0); } while (0)
#define PG8_LDA(dst, b, h) do { _Pragma("unroll") for (int m = 0; m < 4; ++m) _Pragma("unroll") for (int k = 0; k < 2; ++k) dst[m][k] = *(const PG8_LAS bf16x8*)(lds + PG8_SA(b, h) + aoff + m * 2048 + k * 1024); } while (0)
#define PG8_LDB(dst, b, h) do { _Pragma("unroll") for (int n = 0; n < 2; ++n) _Pragma("unroll") for (int k = 0; k < 2; ++k) dst[n][k] = *(const PG8_LAS bf16x8*)(lds + PG8_SB(b, h) + boff + n * 2048 + k * 1024); } while (0)
#define PG8_MMA(ai, bj, At, Bt) do { __builtin_amdgcn_s_setprio(1); _Pragma("unroll") for (int m = 0; m < 4; ++m) _Pragma("unroll") for (int n = 0; n < 2; ++n) _Pragma("unroll") for (int k = 0; k < 2; ++k) \
        acc[ai][bj][m][n] = __builtin_amdgcn_mfma_f32_16x16x32_bf16(Bt[n][k], At[m][k], acc[ai][bj][m][n], 0, 0, 0); __builtin_amdgcn_s_setprio(0); } while (0)
#define PG8_WAIT_V(n) asm volatile("s_waitcnt vmcnt(" #n ")" ::: "memory")
#define PG8_WAIT_L(n) asm volatile("s_waitcnt lgkmcnt(" #n ")" ::: "memory")
#define PG8_BAR __builtin_amdgcn_s_barrier()
#define PG8_SCHED __builtin_amdgcn_sched_barrier(0)
    Unit cur, nxt; int ui = 0;
    if (!S.next(0, cur)) return;
    f32x4 acc[2][2][4][2];
#pragma unroll
    for (int a = 0; a < 2; ++a)
#pragma unroll
        for (int b = 0; b < 2; ++b)
#pragma unroll
            for (int m = 0; m < 4; ++m)
#pragma unroll
                for (int n = 0; n < 2; ++n) acc[a][b][m][n] = (f32x4){0.f, 0.f, 0.f, 0.f};
    bf16x8 At[4][2], B0[2][2], B1[2][2];
    const char* cA = (const char*)g.A + (size_t)cur.pm * tstep; const char* cB = (const char*)g.Bt + (size_t)cur.pn * tstep;
    S.a_ready(cur);
    if constexpr (SP2) {
        PG8_STAGE(PG8_SB(0, 0), cB, voffB); PG8_STAGE(PG8_SB(0, 1), cB + hstep, voffB); PG8_STAGE(PG8_SA(0, 0), cA, voffA); PG8_STAGE(PG8_SA(0, 1), cA + hstep, voffA);
        if (wr == 1) PG8_BAR;
        PG8_WAIT_V(2); PG8_BAR;
        PG8_STAGE(PG8_SB(1, 0), cB + kstep, voffB); PG8_STAGE(PG8_SA(1, 0), cA + kstep, voffA); PG8_STAGE(PG8_SB(1, 1), cB + hstep + kstep, voffB);
        PG8_WAIT_V(6); PG8_BAR;
    } else {
        PG8_STAGE(PG8_SB(0, 0), cB, voffB); PG8_STAGE(PG8_SA(0, 0), cA, voffA); PG8_STAGE(PG8_SB(0, 1), cB + hstep, voffB); PG8_STAGE(PG8_SA(0, 1), cA + hstep, voffA);
        if (wr == 1) PG8_BAR;
        PG8_WAIT_V(4); PG8_BAR;
        PG8_STAGE(PG8_SB(1, 0), cB + kstep, voffB); PG8_STAGE(PG8_SA(1, 0), cA + kstep, voffA); PG8_STAGE(PG8_SB(1, 1), cB + hstep + kstep, voffB);
        PG8_WAIT_V(6); PG8_BAR;
    }
    for (;;) {
        const bool has_next = S.next(ui + 1, nxt);
        const char* nA = has_next ? (const char*)g.A + (size_t)nxt.pm * tstep : cA; const char* nB = has_next ? (const char*)g.Bt + (size_t)nxt.pn * tstep : cB;
        for (int t = 0; t < nt; t += 2) {
            const bool last = (t == nt - 2);
            const char* a1 = cA + (size_t)(t + 1) * kstep;
            const char* a2 = last ? nA : cA + (size_t)(t + 2) * kstep; const char* b2 = last ? nB : cB + (size_t)(t + 2) * kstep;
            const char* a3 = a2 + kstep; const char* b3 = b2 + kstep;
            if (last && has_next) S.a_ready(nxt);
            if constexpr (SP2) {
            PG8_LDB(B0, 0, 0); PG8_LDB(B1, 0, 1); PG8_SCHED; PG8_LDA(At, 0, 0); PG8_STAGE(PG8_SA(1, 1), a1 + hstep, voffA);
            PG8_WAIT_V(8); PG8_WAIT_L(0); PG8_BAR; PG8_MMA(0, 0, At, B0); PG8_MMA(0, 1, At, B1); PG8_BAR; PG8_SCHED;
            PG8_LDA(At, 0, 1); PG8_STAGE(PG8_SB(0, 0), b2, voffB); PG8_STAGE(PG8_SB(0, 1), b2 + hstep, voffB); PG8_STAGE(PG8_SA(0, 0), a2, voffA);
            PG8_WAIT_V(8); PG8_WAIT_L(0); PG8_BAR; PG8_MMA(1, 0, At, B0); PG8_MMA(1, 1, At, B1); PG8_BAR; PG8_SCHED;
            PG8_LDB(B0, 1, 0); PG8_LDB(B1, 1, 1); PG8_SCHED; PG8_LDA(At, 1, 0); PG8_STAGE(PG8_SA(0, 1), a2 + hstep, voffA);
            PG8_WAIT_V(8); PG8_WAIT_L(0); PG8_BAR; PG8_MMA(0, 0, At, B0); PG8_MMA(0, 1, At, B1); PG8_BAR; PG8_SCHED;
            PG8_LDA(At, 1, 1); PG8_STAGE(PG8_SB(1, 0), b3, voffB); PG8_STAGE(PG8_SB(1, 1), b3 + hstep, voffB); PG8_STAGE(PG8_SA(1, 0), a3, voffA);
            PG8_WAIT_V(8); PG8_WAIT_L(0); PG8_BAR; PG8_MMA(1, 0, At, B0); PG8_MMA(1, 1, At, B1); PG8_BAR; PG8_SCHED;
            } else {
            PG8_LDB(B0, 0, 0); PG8_SCHED; PG8_LDA(At, 0, 0); PG8_STAGE(PG8_SA(1, 1), a1 + hstep, voffA);
            PG8_WAIT_L(8); PG8_BAR; PG8_WAIT_L(0); PG8_MMA(0, 0, At, B0); PG8_BAR; PG8_SCHED;
            PG8_LDB(B1, 0, 1); PG8_STAGE(PG8_SB(0, 0), b2, voffB);
            PG8_BAR; PG8_WAIT_L(0); PG8_MMA(0, 1, At, B1); PG8_BAR;
            PG8_LDA(At, 0, 1); PG8_STAGE(PG8_SA(0, 0), a2, voffA);
            PG8_BAR; PG8_WAIT_L(0); PG8_MMA(1, 0, At, B0); PG8_BAR; PG8_SCHED;
            PG8_STAGE(PG8_SB(0, 1), b2 + hstep, voffB);
            PG8_WAIT_V(6); PG8_BAR; PG8_MMA(1, 1, At, B1); PG8_BAR;
            PG8_LDB(B0, 1, 0); PG8_SCHED; PG8_LDA(At, 1, 0); PG8_STAGE(PG8_SA(0, 1), a2 + hstep, voffA);
            PG8_WAIT_L(8); PG8_BAR; PG8_WAIT_L(0); PG8_MMA(0, 0, At, B0); PG8_BAR; PG8_SCHED;
            PG8_LDB(B1, 1, 1); PG8_STAGE(PG8_SB(1, 0), b3, voffB);
            PG8_BAR; PG8_WAIT_L(0); PG8_MMA(0, 1, At, B1); PG8_BAR;
            PG8_LDA(At, 1, 1); PG8_STAGE(PG8_SA(1, 0), a3, voffA);
            PG8_BAR; PG8_WAIT_L(0); PG8_MMA(1, 0, At, B0); PG8_BAR; PG8_SCHED;
            PG8_STAGE(PG8_SB(1, 1), b3 + hstep, voffB);
            PG8_WAIT_V(6); PG8_BAR; PG8_MMA(1, 1, At, B1); PG8_BAR;
            }
        }
        if constexpr (ALIGN_EPI) { if (wr == 0) PG8_BAR; }
        if constexpr (!Epi::AFTER_DRAIN) { E(acc, cur, wr, wc, fr, fq); S.done(cur); }
        if (!has_next) break;
#pragma unroll
        for (int a = 0; a < 2; ++a)
#pragma unroll
            for (int b = 0; b < 2; ++b)
#pragma unroll
                for (int m = 0; m < 4; ++m)
#pragma unroll
                    for (int n = 0; n < 2; ++n) acc[a][b][m][n] = (f32x4){0.f, 0.f, 0.f, 0.f};
        cur = nxt; cA = nA; cB = nB; ++ui;
        if constexpr (ALIGN_EPI) { if (wr == 1) PG8_BAR; }
    }
    PG8_WAIT_V(0);
    if constexpr (!ALIGN_EPI) { if (wr == 0) PG8_BAR; }
    PG8_BAR;
    if constexpr (Epi::AFTER_DRAIN) { E.fused(acc, cur, wr, wc, fr, fq, lds, wid, lane); S.done(cur); }
#undef PG8_SA
#undef PG8_SB
#undef PG8_STAGE
#undef PG8_LDA
#undef PG8_LDB
#undef PG8_MMA
#undef PG8_WAIT_V
#undef PG8_WAIT_L
#undef PG8_BAR
#undef PG8_SCHED
}
}

constexpr int NB = 8, SEQ = 4096, DM = 1024, MT = NB * SEQ, NL = 2;
constexpr int CHB = 4, CHR = CHB * SEQ, NCH = NB / CHB;
constexpr int NIN = 8192, DFF = 2816, NGU = 2 * DFF, WIN_SRC = 8136;
constexpr int TOPK = 256;
constexpr float EPS = 1e-6f;
constexpr int NWAVES = 8, NTHREADS = 512;

constexpr size_t MiB = 1u << 20;
constexpr size_t WS_CTL = 0, CTL_ZERO_BYTES = 1 * MiB;
constexpr size_t WS_MOD = 1 * MiB;
constexpr size_t WS_TAB = WS_MOD + 393216;
constexpr size_t WS_LAM = WS_TAB + 393216;
constexpr size_t WS_W = 2 * MiB, W_LAYER = 39 * MiB;
constexpr size_t W_IN = 0, W_UKT = 16 * MiB  , W_A = 17 * MiB, W_B = 19 * MiB, W_C = 20 * MiB, W_OUT = 20 * MiB + 512 * 1024, W_GU = 22 * MiB + 512 * 1024, W_D = 33 * MiB + 512 * 1024;
constexpr size_t WS_H = 80 * MiB;
constexpr size_t WS_Y = 144 * MiB;
constexpr size_t Y_QLAT = 0, Y_MISC = 32 * MiB, Y_IQ = 40 * MiB, Y_BQ = 56 * MiB, Y_BK = 72 * MiB, Y_BV = 88 * MiB, Y_CQ = 104 * MiB, Y_CK = 128 * MiB, Y_CV = 152 * MiB, Y_Z = 176 * MiB, Y_OC = 272 * MiB;
constexpr size_t Y_AQ = Y_QLAT, Y_QLS = Y_QLAT + 16 * MiB, Y_OLAT = Y_CQ;
constexpr size_t Y_MF32 = Y_CQ, Y_MBF = Y_BK;
constexpr size_t WS_ACT = WS_Y;
constexpr size_t WS_KVN = 424 * MiB;
constexpr size_t WS_END = 500 * MiB;
constexpr int CW_BAR = 4096;

#define GAS __attribute__((address_space(1)))
#define LAS __attribute__((address_space(3)))
typedef unsigned short bf16;
typedef unsigned v4u __attribute__((ext_vector_type(4)));
typedef unsigned v2u __attribute__((ext_vector_type(2)));
typedef float f32x4 __attribute__((ext_vector_type(4)));

__device__ __forceinline__ unsigned f2bf(float f) { unsigned u = __builtin_bit_cast(unsigned, f); return (u + 0x7fffu + ((u >> 16) & 1u)) >> 16; }
typedef float f32x2_c __attribute__((ext_vector_type(2))); typedef __bf16 bf16x2_c __attribute__((ext_vector_type(2)));
__device__ __forceinline__ unsigned pk2(float lo, float hi) { const f32x2_c v = {lo, hi}; const bf16x2_c b = __builtin_convertvector(v, bf16x2_c); return __builtin_bit_cast(unsigned, b); }
__device__ __forceinline__ float bflo(unsigned w) { return __uint_as_float(w << 16); }
__device__ __forceinline__ float bfhi(unsigned w) { return __uint_as_float(w & 0xffff0000u); }
__device__ __forceinline__ float bf2f(bf16 h) { return __uint_as_float((unsigned)h << 16); }
__device__ __forceinline__ float wave_sum(float v) {
#pragma unroll
    for (int o = 1; o < 64; o <<= 1) v += __shfl_xor(v, o);
    return v;
}
__device__ __forceinline__ float wave_max(float v) {
#pragma unroll
    for (int o = 1; o < 64; o <<= 1) v = fmaxf(v, __shfl_xor(v, o));
    return v;
}
__device__ __forceinline__ float sigmoidf_(float v) { return __builtin_amdgcn_rcpf(1.f + __expf(-v)); }

namespace pg8 {
struct EpiIn {
    static constexpr bool PERM = true, AFTER_DRAIN = false;
    unsigned char* y; int skip;
    __device__ __forceinline__ void operator()(const f32x4 (&acc)[2][2][4][2], const Unit& u, int wr, int wc, int fr, int fq) const {
        if (skip) return;
        const int pn = u.pn; size_t off; int ld, c0; bool sig = false;
        if (pn < 2)        { off = Y_AQ;   ld = 512;  c0 = pn * 256; }
        else if (pn == 2)  { off = Y_MISC; ld = 256;  c0 = 0; }
        else if (pn < 5)   { off = Y_IQ;   ld = 512;  c0 = (pn - 3) * 256; }
        else if (pn < 7)   { off = Y_BQ;   ld = 512;  c0 = (pn - 5) * 256; }
        else if (pn < 9)   { off = Y_BK;   ld = 512;  c0 = (pn - 7) * 256; }
        else if (pn < 11)  { off = Y_BV;   ld = 512;  c0 = (pn - 9) * 256; }
        else if (pn < 14)  { off = Y_CQ;   ld = 768;  c0 = (pn - 11) * 256; }
        else if (pn < 17)  { off = Y_CK;   ld = 768;  c0 = (pn - 14) * 256; }
        else if (pn < 20)  { off = Y_CV;   ld = 768;  c0 = (pn - 17) * 256; }
        else               { off = Y_Z;    ld = 3072; c0 = (pn - 20) * 256; sig = true; }
        bf16_t* base = (bf16_t*)(y + off); const bool qsc = (pn == 5 || pn == 6 || (pn >= 11 && pn < 14));
        const int row0 = u.pm * BM + wr * 64 + fr, col0 = c0 + wc * 32 + 8 * fq;
#pragma unroll
        for (int ai = 0; ai < 2; ++ai)
#pragma unroll
            for (int m = 0; m < 4; ++m) { bf16_t* rowp = base + (size_t)(row0 + ai * HALF + m * 16) * ld + col0;
#pragma unroll
                for (int bj = 0; bj < 2; ++bj) { f32x4 v0 = acc[ai][bj][m][0], v1 = acc[ai][bj][m][1];
                    if (sig) {
#pragma unroll
                        for (int i = 0; i < 4; ++i) { v0[i] = sigmoidf_(v0[i]); v1[i] = sigmoidf_(v1[i]); } }
                    else if (qsc) {
#pragma unroll
                        for (int i = 0; i < 4; ++i) { v0[i] *= 0.125f * 1.4426950408889634f; v1[i] *= 0.125f * 1.4426950408889634f; } }
                    u32x4 w; w.x = pk2(v0[0], v0[1]); w.y = pk2(v0[2], v0[3]); w.z = pk2(v1[0], v1[1]); w.w = pk2(v1[2], v1[3]);
                    __builtin_nontemporal_store(w, (u32x4*)(rowp + bj * HALF)); } }
    }
};
template <int MODE> struct EpiGate {
    static constexpr bool PERM = true, AFTER_DRAIN = false;
    const bf16_t* z; int zc0; float* mf; bf16_t* mb;
    __device__ __forceinline__ void operator()(const f32x4 (&acc)[2][2][4][2], const Unit& u, int wr, int wc, int fr, int fq) const {
        const int row0 = u.pm * BM + wr * 64 + fr, col0 = u.pn * BM + wc * 32 + 8 * fq;
#pragma unroll
        for (int ai = 0; ai < 2; ++ai)
#pragma unroll
            for (int m = 0; m < 4; ++m) { const size_t row = (size_t)(row0 + ai * HALF + m * 16);
#pragma unroll
                for (int bj = 0; bj < 2; ++bj) { const int col = col0 + bj * HALF;
                    const u32x4 zw = *(const u32x4*)(z + row * 3072 + zc0 + col);
                    f32x4 v0 = acc[ai][bj][m][0], v1 = acc[ai][bj][m][1];
                    v0[0] *= __uint_as_float(zw.x << 16); v0[1] *= __uint_as_float(zw.x & 0xffff0000u); v0[2] *= __uint_as_float(zw.y << 16); v0[3] *= __uint_as_float(zw.y & 0xffff0000u);
                    v1[0] *= __uint_as_float(zw.z << 16); v1[1] *= __uint_as_float(zw.z & 0xffff0000u); v1[2] *= __uint_as_float(zw.w << 16); v1[3] *= __uint_as_float(zw.w & 0xffff0000u);
                    bf16_t* mp = mb + row * 1024 + col;
                    if (MODE >= 1) { const u32x4 pw = *(const u32x4*)mp;
                        v0[0] += __uint_as_float(pw.x << 16); v0[1] += __uint_as_float(pw.x & 0xffff0000u); v0[2] += __uint_as_float(pw.y << 16); v0[3] += __uint_as_float(pw.y & 0xffff0000u);
                        v1[0] += __uint_as_float(pw.z << 16); v1[1] += __uint_as_float(pw.z & 0xffff0000u); v1[2] += __uint_as_float(pw.w << 16); v1[3] += __uint_as_float(pw.w & 0xffff0000u); }
                    { u32x4 w; w.x = pk2(v0[0], v0[1]); w.y = pk2(v0[2], v0[3]); w.z = pk2(v1[0], v1[1]); w.w = pk2(v1[2], v1[3]); *(u32x4*)mp = w; } }
                asm volatile("" ::: "memory"); }
    }
};
struct EpiRes {
    static constexpr bool PERM = true, AFTER_DRAIN = false;
    const float* xin; float* xout; const float* gate; int row_off;
    __device__ __forceinline__ void operator()(const f32x4 (&acc)[2][2][4][2], const Unit& u, int wr, int wc, int fr, int fq) const {
        const int row0 = row_off + u.pm * BM + wr * 64 + fr, col0 = u.pn * BM + wc * 32 + 8 * fq;
        const float* gp = gate + (size_t)((row_off + u.pm * BM) / SEQ) * 6144 + col0;
        f32x4 g[2][2];
#pragma unroll
        for (int bj = 0; bj < 2; ++bj) { g[bj][0] = *(const f32x4*)(gp + bj * HALF); g[bj][1] = *(const f32x4*)(gp + bj * HALF + 4); }
#pragma unroll
        for (int ai = 0; ai < 2; ++ai)
#pragma unroll
            for (int m = 0; m < 4; ++m) { const size_t o = (size_t)(row0 + ai * HALF + m * 16) * 1024 + col0;
#pragma unroll
                for (int bj = 0; bj < 2; ++bj) {
                    const f32x4 a0 = *(const f32x4*)(xin + o + bj * HALF), a1 = *(const f32x4*)(xin + o + bj * HALF + 4);
                    *(f32x4*)(xout + o + bj * HALF) = a0 + g[bj][0] * acc[ai][bj][m][0];
                    *(f32x4*)(xout + o + bj * HALF + 4) = a1 + g[bj][1] * acc[ai][bj][m][1]; }
                asm volatile("" ::: "memory"); }
    }
};
struct EpiSwiGLU {
    static constexpr bool PERM = true, AFTER_DRAIN = false;
    bf16_t* act;
    __device__ __forceinline__ void operator()(const f32x4 (&acc)[2][2][4][2], const Unit& u, int wr, int wc, int fr, int fq) const {
        const int row0 = u.pm * BM + wr * 64 + fr, col0 = u.pn * HALF + wc * 32 + 8 * fq;
#pragma unroll
        for (int ai = 0; ai < 2; ++ai)
#pragma unroll
            for (int m = 0; m < 4; ++m) { bf16_t* rowp = act + (size_t)(row0 + ai * HALF + m * 16) * DFF + col0;
                f32x4 v0, v1;
#pragma unroll
                for (int i = 0; i < 4; ++i) { const float g0 = acc[ai][0][m][0][i], g1 = acc[ai][0][m][1][i];
                    v0[i] = g0 * sigmoidf_(g0) * acc[ai][1][m][0][i]; v1[i] = g1 * sigmoidf_(g1) * acc[ai][1][m][1][i]; }
                u32x4 w; w.x = pk2(v0[0], v0[1]); w.y = pk2(v0[2], v0[3]); w.z = pk2(v1[0], v1[1]); w.w = pk2(v1[2], v1[3]);
                __builtin_nontemporal_store(w, (u32x4*)rowp); }
    }
};
}

#define XB_TMO      128
#define XB_XCNT(j)  (256  + 64 * (j))
#define XB_XSUB(j)  (1280 + 64 * (j))
#define XB_XGEN(j)  (2304 + 64 * (j))
#define XB_TOP      3328
#define XB_TOPGEN   3392
#define XCD_BAR_WORDS 3456
#define XB_SPIN_CAP (1u << 24)

__device__ __forceinline__ unsigned xb_ld(unsigned* p)              { return __hip_atomic_load(p, __ATOMIC_RELAXED, __HIP_MEMORY_SCOPE_AGENT); }
__device__ __forceinline__ unsigned xb_add(unsigned* p, unsigned v) { return __hip_atomic_fetch_add(p, v, __ATOMIC_RELAXED, __HIP_MEMORY_SCOPE_AGENT); }
__device__ __forceinline__ unsigned xb_xcc_id() { return (unsigned)__builtin_amdgcn_s_getreg((3 << 11) | 20) & 0xFu; }
#define XB_SPIN(cond, bar) do { unsigned _sp = 0; while (cond) { __builtin_amdgcn_s_sleep(1); \
    if ((++_sp & 255u) == 0u) { if (xb_ld(&(bar)[XB_TMO])) break; if (_sp > XB_SPIN_CAP) { atomicAdd(&(bar)[XB_TMO], 1u); break; } } } } while (0)

__device__ __forceinline__ int lane_id_() { return (int)__builtin_amdgcn_mbcnt_hi(~0u, __builtin_amdgcn_mbcnt_lo(~0u, 0u)); }
struct XcdBarrier { unsigned* bar; unsigned x; volatile LAS unsigned* st; int w; };

__device__ __forceinline__ XcdBarrier xcd_barrier_post(unsigned* bar, volatile LAS unsigned* st, int w) {
    XcdBarrier b; b.bar = bar; b.x = (unsigned)__builtin_amdgcn_readfirstlane((int)xb_xcc_id()); b.st = st; b.w = w;
    if (threadIdx.x == 0) (void)xb_add(&bar[XB_XCNT(b.x)], 1u);
    return b;
}
__device__ __forceinline__ void xcd_barrier_complete(unsigned* bar, unsigned x, unsigned& nloc, unsigned& nx) {
    const unsigned G = gridDim.x * gridDim.y * gridDim.z;
    unsigned sum, cnt, mine, sp = 0u;
    for (;;) {
        sum = 0u; cnt = 0u; mine = 0u;
#pragma unroll
        for (unsigned j = 0; j < 16; ++j) { const unsigned c = xb_ld(&bar[XB_XCNT(j)]); sum += c; cnt += (c > 0u) ? 1u : 0u; mine = (j == x) ? c : mine; }
        if (sum == G) break;
        __builtin_amdgcn_s_sleep(1);
        if ((++sp & 255u) == 0u) { if (xb_ld(&bar[XB_TMO])) break; if (sp > XB_SPIN_CAP) { atomicAdd(&bar[XB_TMO], 1u); break; } }
    }
    nloc = mine > 0u ? mine : 1u; nx = cnt > 0u ? cnt : 1u;
}
__device__ __forceinline__ void xcd_barrier(const XcdBarrier& b) {
    asm volatile("s_waitcnt vmcnt(0)" ::: "memory");
    __syncthreads();
    if (threadIdx.x == 0) {
        unsigned* bar = b.bar; unsigned bx = b.x; asm volatile("" : "+s"(bar), "+s"(bx));
        __builtin_amdgcn_s_waitcnt(0);
        unsigned nloc = b.st[0], nx = b.st[1];
        if (nloc == 0u) { xcd_barrier_complete(bar, bx, nloc, nx); b.st[0] = nloc; b.st[1] = nx; }
        const unsigned old = xb_add(&bar[XB_XSUB(bx)], 1u);
        const unsigned gen = old / nloc;
        if (old + 1u == (gen + 1u) * nloc) {
            __builtin_amdgcn_fence(__ATOMIC_RELEASE, "agent");
            asm volatile("s_waitcnt vmcnt(0)" ::: "memory");
            const unsigned og = xb_add(&bar[XB_TOP], 1u);
            const unsigned tg = og / nx;
            if (og + 1u == (tg + 1u) * nx) xb_add(&bar[XB_TOPGEN], 1u);
            else XB_SPIN(xb_ld(&bar[XB_TOPGEN]) == tg, bar);
            __builtin_amdgcn_fence(__ATOMIC_ACQUIRE, "agent");
            xb_add(&bar[XB_XGEN(bx)], 1u);
            asm volatile("s_waitcnt vmcnt(0)" ::: "memory");
        } else {
            XB_SPIN(xb_ld(&bar[XB_XGEN(bx)]) == gen, bar);
            __builtin_amdgcn_fence(__ATOMIC_ACQUIRE, "agent");
            asm volatile("s_waitcnt vmcnt(0)" ::: "memory");
        }
    }
    __syncthreads();
}

constexpr int RING_BYTES = 131072;
constexpr int LDSCTL_OFF = 160256;
constexpr int LDS_BYTES = 161280;

struct Args {
    const float* in[23]; float* out; unsigned char* ws; int pad0, pad1;
};
__device__ __forceinline__ const void* ld_karg(unsigned off) {
    asm volatile("" : "+s"(off));
    return *(const void* const __attribute__((address_space(4)))*)((const __attribute__((address_space(4))) char*)__builtin_amdgcn_kernarg_segment_ptr() + off);
}
#define ARG(k) ((const float*)ld_karg(8u * (k)))
#define OUTP() ((float*)ld_karg(184u))
#define WSP() ((unsigned char*)ld_karg(192u))

__device__ __forceinline__ int rel_bucket(int d) {
    if (d < 16) return d;
    int b = 16;
    b += (d >= 22); b += (d >= 30); b += (d >= 40); b += (d >= 54); b += (d >= 73); b += (d >= 99); b += (d >= 134); b += (d >= 182);
    b += (d >= 246); b += (d >= 332); b += (d >= 450); b += (d >= 609); b += (d >= 825); b += (d >= 1117); b += (d >= 1513);
    return b;
}
__device__ __forceinline__ int win_src_col(int n) {
    if (n < 640) return n;
    if (n < 712) return n + 512;
    if (n < 768) return -1;
    if (n < 1280) return n - 128;
    return n - 56;
}
__device__ __forceinline__ void transpose_item(const float* W, int ldw, int K, bf16* WT, int kind, int kb, int nb, LAS float* scr, int lane) {
    const int k0 = 64 * kb, n0 = 32 * nb, nl = n0 + (lane & 31);
    int sc;
    if (kind == 0) sc = win_src_col(nl);
    else if (kind == 2) { const int j = nl >> 8, r = nl & 255; sc = (r < 128) ? (j * 128 + r) : (DFF + j * 128 + r - 128); }
    else sc = nl;
    float wv[32];
    const float* wsrc = W + (size_t)(k0 + (lane >> 5)) * ldw + (sc >= 0 ? sc : 0);
#pragma unroll
    for (int i = 0; i < 32; ++i) wv[i] = wsrc[(size_t)(2 * i) * ldw];
#pragma unroll
    for (int i = 0; i < 32; ++i) scr[(2 * i + (lane >> 5)) * 33 + (lane & 31)] = (sc >= 0) ? wv[i] : 0.f;
    asm volatile("s_waitcnt lgkmcnt(0)" ::: "memory");
    const int c = lane & 7;
    const int nrow0 = 0;
#pragma unroll
    for (int j = 0; j < 4; ++j) { const int n = (lane >> 3) + 8 * j; const LAS float* s = scr + (8 * c) * 33 + n;
        v4u o; o.x = pk2(s[0 * 33], s[1 * 33]); o.y = pk2(s[2 * 33], s[3 * 33]); o.z = pk2(s[4 * 33], s[5 * 33]); o.w = pk2(s[6 * 33], s[7 * 33]);
        *(v4u*)(WT + (size_t)(nrow0 + n0 + n) * K + k0 + 8 * c) = o; }
    asm volatile("s_waitcnt lgkmcnt(0)" ::: "memory");
}

__device__ __forceinline__ void p0a_prologue(unsigned char* ws, LAS unsigned char* lds, int tid, int lane, int wave, int G) {
    asm volatile("" : "+v"(lane), "+v"(tid));
    const float* c = ARG(1); const float* w_ada = ARG(2); const float* b_ada = ARG(3);
    float* mod = (float*)(ws + WS_MOD);
    if (blockIdx.x < 192) {
        LAS float* cs = (LAS float*)lds;
        LAS float* red = (LAS float*)(lds + 32768);
        for (int i = tid; i < 8192; i += NTHREADS) { const float v = c[i]; cs[i] = v / (1.f + __expf(-v)); }
        __syncthreads();
        for (int it = blockIdx.x; it < 192; it += G) {
            const int l = it / 96, cg = it % 96, n = cg * 64 + lane;
            float acc[8];
#pragma unroll
            for (int b = 0; b < 8; ++b) acc[b] = 0.f;
            const float* wp = w_ada + ((size_t)l * 1024 + wave * 128) * 6144 + n;
#pragma unroll 32
            for (int k = 0; k < 128; ++k) { const float wv = wp[(size_t)k * 6144];
#pragma unroll
                for (int b = 0; b < 8; ++b) acc[b] += cs[b * 1024 + wave * 128 + k] * wv; }
#pragma unroll
            for (int b = 0; b < 8; ++b) red[(wave * 8 + b) * 64 + lane] = acc[b];
            __syncthreads();
            { const int b = tid >> 6; float s = 0.f;
#pragma unroll
              for (int w = 0; w < 8; ++w) s += red[(w * 8 + b) * 64 + lane];
              mod[((size_t)l * 8 + b) * 6144 + n] = s + b_ada[l * 6144 + n]; }
            __syncthreads();
        }
    }
    { const float* rb = ARG(21); float* T = (float*)(ws + WS_TAB);
      for (int d = blockIdx.x * NTHREADS + tid; d < 4096; d += G * NTHREADS) { const int bk = rel_bucket(d);
          for (int j = 0; j < 24; ++j) T[d * 24 + j] = rb[bk * 24 + j]; } }
    if (blockIdx.x == G - 1 && wave == 0) {
        float* lam = (float*)(ws + WS_LAM);
        for (int l = 0; l < NL; ++l) {
            const float s1 = wave_sum(ARG(9)[l * 64 + lane] * ARG(10)[l * 64 + lane]);
            const float s2 = wave_sum(ARG(11)[l * 64 + lane] * ARG(12)[l * 64 + lane]);
            const float lam_init = (l == 0) ? 0.2f : 0.35550907f;
            if (lane == 0) lam[l] = expf(s1) - expf(s2) + lam_init;
        }
    }
    {
        LAS float* scr = (LAS float*)(lds + 65536 + wave * 8448);
        const int gw = blockIdx.x * NWAVES + wave, NGW = G * NWAVES;
        constexpr int I_WIN = 16 * 256, I_B = 8 * 32, I_C = 4 * 32, I_OUT = 16 * 32, I_GU = 16 * 176, I_D = 44 * 32, I_FQ = 128, I_FA = 2048;
        constexpr int I_LAYER = I_WIN + I_B + I_C + I_OUT + I_GU + I_D + I_FQ + I_FA;
        for (int it = gw; it < NL * I_LAYER; it += NGW) {
            const int l = it / I_LAYER; int r = it % I_LAYER;
            unsigned char* wl = ws + WS_W + (size_t)l * W_LAYER;
            const float* w_in = ARG(5) + (size_t)l * 1024 * WIN_SRC;
            if (r < I_WIN) { transpose_item(w_in, WIN_SRC, 1024, (bf16*)(wl + W_IN), 0, r / 256, r % 256, scr, lane); continue; } r -= I_WIN;
            if (r < I_B)   { transpose_item(ARG(15) + (size_t)l * 512 * 1024, 1024, 512, (bf16*)(wl + W_B), 1, r / 32, r % 32, scr, lane); continue; } r -= I_B;
            if (r < I_C)   { transpose_item(ARG(16) + (size_t)l * 256 * 1024, 1024, 256, (bf16*)(wl + W_C), 1, r / 32, r % 32, scr, lane); continue; } r -= I_C;
            if (r < I_OUT) { transpose_item(ARG(17) + (size_t)l * 1024 * 1024, 1024, 1024, (bf16*)(wl + W_OUT), 1, r / 32, r % 32, scr, lane); continue; } r -= I_OUT;
            if (r < I_GU)  { transpose_item(ARG(19) + (size_t)l * 1024 * NGU, NGU, 1024, (bf16*)(wl + W_GU), 2, r / 176, r % 176, scr, lane); continue; } r -= I_GU;
            if (r < I_D)   { transpose_item(ARG(20) + (size_t)l * DFF * 1024, 1024, DFF, (bf16*)(wl + W_D), 1, r / 32, r % 32, scr, lane); continue; } r -= I_D;
            if (r < I_FQ) {
                const int h = r >> 4, chalf = (r >> 3) & 1, d0 = (r & 7) * 8, cc = chalf * 64 + lane;
                const float* uk = ARG(6) + ((size_t)(l * 8 + h) * 64 + d0) * 128 + cc;
                v4u o; o.x = pk2(uk[0], uk[128]); o.y = pk2(uk[256], uk[384]); o.z = pk2(uk[512], uk[640]); o.w = pk2(uk[768], uk[896]);
                *(v4u*)((bf16*)(wl + W_UKT) + ((size_t)h * 128 + cc) * 64 + d0) = o;
                continue; }
            r -= I_FQ;
            {
                const int ng = r >> 7, kg = r & 127, h = kg >> 4, c0 = (kg & 15) * 8, n = ng * 64 + lane;
                const float* uv = ARG(7) + ((size_t)(l * 8 + h) * 128 + c0) * 64;
                const float* wa = ARG(14) + ((size_t)l * 512 + h * 64) * 1024 + n;
                float acc[8];
#pragma unroll
                for (int j = 0; j < 8; ++j) acc[j] = 0.f;
#pragma unroll 32
                for (int e = 0; e < 64; ++e) { const float wv = wa[(size_t)e * 1024];
#pragma unroll
                    for (int j = 0; j < 8; ++j) acc[j] += uv[j * 64 + e] * wv; }
                v4u o; o.x = pk2(acc[0], acc[1]); o.y = pk2(acc[2], acc[3]); o.z = pk2(acc[4], acc[5]); o.w = pk2(acc[6], acc[7]);
                *(v4u*)((bf16*)(wl + W_A) + (size_t)n * 1024 + kg * 8) = o;
            }
        }
    }
}

__device__ __forceinline__ void norm_rows(const float* x, bf16* out, const float* g, const float* sh, const float* sc, int gw, int NGW, int lane) {
    asm volatile("" : "+v"(lane));
    for (int row = gw; row < MT; row += 2 * NGW) {
        const int row2 = (row + NGW < MT) ? row + NGW : row;
        const f32x4* xr = (const f32x4*)(x + (size_t)row * 1024) + lane; const f32x4* xr2 = (const f32x4*)(x + (size_t)row2 * 1024) + lane;
        f32x4 v[4], u[4]; float s = 0.f, s2 = 0.f;
#pragma unroll
        for (int j = 0; j < 4; ++j) { v[j] = xr[64 * j]; u[j] = xr2[64 * j]; }
#pragma unroll
        for (int j = 0; j < 4; ++j) { s += (v[j].x * v[j].x + v[j].y * v[j].y) + (v[j].z * v[j].z + v[j].w * v[j].w); s2 += (u[j].x * u[j].x + u[j].y * u[j].y) + (u[j].z * u[j].z + u[j].w * u[j].w); }
        const float rstd = 1.0f / sqrtf(wave_sum(s) * (1.f / 1024.f) + EPS), rstd2 = 1.0f / sqrtf(wave_sum(s2) * (1.f / 1024.f) + EPS);
        const int b = row / SEQ, b2 = row2 / SEQ;
        v2u* o8 = (v2u*)(out + (size_t)row * 1024) + lane; v2u* o82 = (v2u*)(out + (size_t)row2 * 1024) + lane;
#pragma unroll
        for (int j = 0; j < 4; ++j) { const int col = 256 * j + 4 * lane;
            const f32x4 gg = *(const f32x4*)(g + col);
            { const f32x4 s1 = *(const f32x4*)(sc + (size_t)b * 6144 + col), s0 = *(const f32x4*)(sh + (size_t)b * 6144 + col);
              const f32x4 y = v[j] * rstd * gg * (s1 + 1.0f) + s0; v2u w; w.x = pk2(y.x, y.y); w.y = pk2(y.z, y.w); o8[64 * j] = w; }
            if (row2 != row) { const f32x4 s1 = *(const f32x4*)(sc + (size_t)b2 * 6144 + col), s0 = *(const f32x4*)(sh + (size_t)b2 * 6144 + col);
              const f32x4 y = u[j] * rstd2 * gg * (s1 + 1.0f) + s0; v2u w; w.x = pk2(y.x, y.y); w.y = pk2(y.z, y.w); o82[64 * j] = w; } }
    }
}
__device__ __forceinline__ void final_rows(float* x, const float* g, int gw, int NGW, int lane) {
    asm volatile("" : "+v"(lane));
    for (int row = gw; row < MT; row += 2 * NGW) {
        const int row2 = (row + NGW < MT) ? row + NGW : row;
        f32x4* xr = (f32x4*)(x + (size_t)row * 1024) + lane; f32x4* xr2 = (f32x4*)(x + (size_t)row2 * 1024) + lane;
        f32x4 v[4], u[4]; float s = 0.f, s2 = 0.f;
#pragma unroll
        for (int j = 0; j < 4; ++j) { v[j] = xr[64 * j]; u[j] = xr2[64 * j]; }
#pragma unroll
        for (int j = 0; j < 4; ++j) { s += (v[j].x * v[j].x + v[j].y * v[j].y) + (v[j].z * v[j].z + v[j].w * v[j].w); s2 += (u[j].x * u[j].x + u[j].y * u[j].y) + (u[j].z * u[j].z + u[j].w * u[j].w); }
        const float rstd = 1.0f / sqrtf(wave_sum(s) * (1.f / 1024.f) + EPS), rstd2 = 1.0f / sqrtf(wave_sum(s2) * (1.f / 1024.f) + EPS);
#pragma unroll
        for (int j = 0; j < 4; ++j) { const f32x4 gg = *(const f32x4*)(g + 256 * j + 4 * lane); xr[64 * j] = v[j] * rstd * gg; if (row2 != row) xr2[64 * j] = u[j] * rstd2 * gg; }
    }
}
__device__ __forceinline__ void kvn_rows(unsigned char* y, bf16* kvn, const float* gkv, unsigned* kmaxw, int gw, int NGW, int lane) {
    asm volatile("" : "+v"(lane));
    const bf16* misc = (const bf16*)(y + Y_MISC);
    float km0 = 0.f, km1 = 0.f, km2 = 0.f, km3 = 0.f;
    const float g0 = gkv[2 * lane], g1 = gkv[2 * lane + 1];
    for (int r0 = gw; r0 < CHR; r0 += 4 * NGW) {
        unsigned w[4]; bf16 kq[4];
#pragma unroll
        for (int i = 0; i < 4; ++i) { const int r = (r0 + i * NGW < CHR) ? r0 + i * NGW : r0; w[i] = *(const unsigned*)(misc + (size_t)r * 256 + 2 * lane); kq[i] = misc[(size_t)r * 256 + 128 + lane]; }
#pragma unroll
        for (int i = 0; i < 4; ++i) { const int r = r0 + i * NGW; if (r >= CHR) break;
            const float a0 = bflo(w[i]), a1 = bfhi(w[i]);
            const float rstd = 1.0f / sqrtf(wave_sum(a0 * a0 + a1 * a1) * (1.f / 128.f) + EPS);
            *(unsigned*)(kvn + (size_t)r * 128 + 2 * lane) = pk2(a0 * rstd * g0, a1 * rstd * g1);
            const float kk = bf2f(kq[i]); const float ks = wave_sum(kk * kk); const int b = r / SEQ;
            km0 = (b == 0) ? fmaxf(km0, ks) : km0; km1 = (b == 1) ? fmaxf(km1, ks) : km1; km2 = (b == 2) ? fmaxf(km2, ks) : km2; km3 = (b == 3) ? fmaxf(km3, ks) : km3; }
    }
    if (lane == 0) {
        __hip_atomic_fetch_max(kmaxw + 0, __float_as_uint(km0), __ATOMIC_RELAXED, __HIP_MEMORY_SCOPE_AGENT); __hip_atomic_fetch_max(kmaxw + 1, __float_as_uint(km1), __ATOMIC_RELAXED, __HIP_MEMORY_SCOPE_AGENT);
        __hip_atomic_fetch_max(kmaxw + 2, __float_as_uint(km2), __ATOMIC_RELAXED, __HIP_MEMORY_SCOPE_AGENT); __hip_atomic_fetch_max(kmaxw + 3, __float_as_uint(km3), __ATOMIC_RELAXED, __HIP_MEMORY_SCOPE_AGENT);
    }
}
typedef short bf16x8 __attribute__((ext_vector_type(8)));
typedef short s16x4 __attribute__((ext_vector_type(4)));
typedef float f32x16 __attribute__((ext_vector_type(16)));
#define LOG2E 1.4426950408889634f
__device__ __forceinline__ int crow(int r, int hi) { return (r & 3) + 8 * (r >> 2) + 4 * hi; }
__device__ __forceinline__ void glds16(const void* g, LAS void* l) { __builtin_amdgcn_global_load_lds((const unsigned*)g, (LAS unsigned*)l, 16, 0, 0); }
__device__ __forceinline__ s16x4 tr16(const LAS unsigned char* p) { return __builtin_bit_cast(s16x4, __builtin_amdgcn_ds_read_tr16_b64_v4i16((LAS s16x4*)p)); }
__device__ __forceinline__ float swap_max(float v) { auto rr = __builtin_amdgcn_permlane32_swap(__float_as_uint(v), __float_as_uint(v), false, false); return fmaxf(__uint_as_float(rr[0]), __uint_as_float(rr[1])); }
__device__ __forceinline__ float swap16_max(float v) { auto rr = __builtin_amdgcn_permlane16_swap(__float_as_uint(v), __float_as_uint(v), false, false); return fmaxf(__uint_as_float(rr[0]), __uint_as_float(rr[1])); }
__device__ __forceinline__ float swap16_add(float v) { auto rr = __builtin_amdgcn_permlane16_swap(__float_as_uint(v), __float_as_uint(v), false, false); return __uint_as_float(rr[0]) + __uint_as_float(rr[1]); }
__device__ __forceinline__ float swap_add(float v) { auto rr = __builtin_amdgcn_permlane32_swap(__float_as_uint(v), __float_as_uint(v), false, false); return __uint_as_float(rr[0]) + __uint_as_float(rr[1]); }
typedef float f32x2_t __attribute__((ext_vector_type(2))); typedef __bf16 bf16x2_t __attribute__((ext_vector_type(2)));
__device__ __forceinline__ unsigned cvtpk(float lo, float hi) { const f32x2_t v = {lo, hi}; const bf16x2_t b = __builtin_convertvector(v, bf16x2_t); return __builtin_bit_cast(unsigned, b); }
__device__ __forceinline__ void lds_add_u32_asm(LAS void* p, unsigned v) { asm volatile("ds_add_u32 %0, %1" :: "v"((unsigned)(uintptr_t)p), "v"(v) : "memory"); }
__device__ __forceinline__ void lds_st_b16_asm(LAS void* p, unsigned v) { asm volatile("ds_write_b16 %0, %1" :: "v"((unsigned)(uintptr_t)p), "v"(v) : "memory"); }
__device__ __forceinline__ void lds_st_b32_asm(LAS void* p, unsigned v) { asm volatile("ds_write_b32 %0, %1" :: "v"((unsigned)(uintptr_t)p), "v"(v) : "memory"); }
__device__ __forceinline__ s16x4 tr16_asm(const LAS unsigned char* p) { s16x4 v; asm volatile("ds_read_b64_tr_b16 %0, %1" : "=v"(v) : "v"((unsigned)(uintptr_t)p) : "memory"); return v; }
#define TRV(dst, base, off) asm volatile("ds_read_b64_tr_b16 %0, %1 offset:%c2" : "=&v"(dst) : "v"(base), "i"(off) : "memory")
#define LGKM_WAIT8(n, f) asm volatile("s_waitcnt lgkmcnt(" #n ")" : "+v"(f[0]), "+v"(f[1]), "+v"(f[2]), "+v"(f[3]), "+v"(f[4]), "+v"(f[5]), "+v"(f[6]), "+v"(f[7]) :: "memory")
#define VFRAG(f, i) ((bf16x8){f[2 * (i)][0], f[2 * (i)][1], f[2 * (i)][2], f[2 * (i)][3], f[2 * (i) + 1][0], f[2 * (i) + 1][1], f[2 * (i) + 1][2], f[2 * (i) + 1][3]})
#define RAW_BARRIER() do { asm volatile("s_waitcnt lgkmcnt(0)" ::: "memory"); __builtin_amdgcn_s_barrier(); asm volatile("" ::: "memory"); } while (0)

template <int MODE> __device__ __forceinline__ void mixB_fast(unsigned char* y, bf16* OUTB, const float* T, const float* gsub, float lam, float one_m_li, LAS unsigned char* lds, int tid, int lane, int wave, int G) {
    asm volatile("" : "+v"(lane), "+v"(tid));
    bf16* BQ = (bf16*)(y + Y_BQ); const bf16* BK = (const bf16*)(y + Y_BK); const bf16* BV = (const bf16*)(y + Y_BV);
    const int r32 = lane & 31, hi = lane >> 5, m = wave >> 2, qs = wave & 3;
    LAS float* gs_l = (LAS float*)(lds + 131072); LAS float* ctab = gs_l + 128; LAS float* btab = gs_l + 272;
    constexpr int BDM = 1599, BNX = 1728, BCS = 1744, SENTI = 0x7f000000;
    constexpr float THR = 8.0f;
    for (int item = blockIdx.x; item < CHB * 4 * 16; item += G) {
        const int bh = (G == 256) ? (2 * (item & 7) + (item >> 7)) : (item >> 4), pr = (G == 256) ? ((item >> 3) & 15) : (item & 15), bb = bh >> 2, h = bh & 3, rb = bb * SEQ;
        RAW_BARRIER();
        int tq = tid; asm volatile("" : "+v"(tq));
#pragma unroll
        for (int k = 0; k < 4; ++k) { const int x = tq + k * NTHREADS, d = BDM - x;
            const float v = (d >= 0 && x < BNX + 3) ? T[d * 24 + 8 + h] * LOG2E : -INFINITY;
#pragma unroll
            for (int sc = 0; sc < 4; ++sc) { const int i = x - sc; if (i >= 0 && i < BNX) btab[sc * BCS + i] = v; } }
        if (tid < 128) gs_l[tid] = gsub[tid];
        else if (tid < 128 + 136) { const int n = tid - 128 - 4, dmin = 32 * n + 1;
            ctab[tid - 128] = (n >= 0 && rel_bucket(dmin) == rel_bucket(dmin + 62)) ? T[dmin * 24 + 8 + h] * LOG2E : __int_as_float(SENTI); }
        for (int uu = 0; uu < 2; ++uu) {
            const int qb = (uu == 0) ? (31 - pr) : pr;
            const int q0w = qb * 128 + qs * 32, qpos = q0w + r32;
            bf16x8 qf[4];
#pragma unroll
            for (int ks = 0; ks < 4; ++ks) qf[ks] = *(const bf16x8*)(BQ + (size_t)(rb + qpos) * 512 + h * 128 + m * 64 + 16 * ks + 8 * hi);
            const int NT = 2 * (qb + 1);
            const int xl0 = BDM - qpos + 4 * hi;
            const LAS unsigned char* bta = (const LAS unsigned char*)(btab + (xl0 & 3) * (BCS - 1) + xl0);
            f32x16 O[4];
#pragma unroll
            for (int dq = 0; dq < 4; ++dq)
#pragma unroll
                for (int r = 0; r < 16; ++r) O[dq][r] = 0.f;
            float mref = -INFINITY, lsum = 0.f;
#define MB_STAGE(t_, buf_) do { const int kv0_ = (t_) * 64; LAS unsigned char* sb_ = lds + (buf_) * 32768; \
                _Pragma("unroll") for (int i_ = 0; i_ < 2; ++i_) { const int p_ = 2 * wave + i_, mk_ = p_ >> 3, rg_ = p_ & 7;     \
                    glds16(BK + (size_t)(rb + kv0_ + 8 * rg_ + (lane >> 3)) * 512 + h * 128 + mk_ * 64 + ((lane & 7) ^ ((4 * rg_ + (lane >> 4)) & 7)) * 8, sb_ + mk_ * 8192 + rg_ * 1024); } \
                _Pragma("unroll") for (int i_ = 0; i_ < 2; ++i_) { const int p_ = 2 * wave + i_, dq_ = p_ >> 2, rg_ = p_ & 3; \
                    glds16(BV + (size_t)(rb + kv0_ + 16 * rg_ + (lane >> 2)) * 512 + h * 128 + dq_ * 32 + (lane & 3) * 8, sb_ + 16384 + p_ * 1024); } } while (0)
            MB_STAGE(0, 0); MB_STAGE(1, 1);
#pragma unroll 1
            for (int u2 = 0; u2 < NT / 2; ++u2) {
                asm volatile("s_waitcnt vmcnt(0)" ::: "memory");
                RAW_BARRIER();
#if BSTAGE_POS == 0
                if (2 * u2 + 2 < NT && MODE != 3) { MB_STAGE(2 * u2 + 2, (2 * u2 + 2) & 3); MB_STAGE(2 * u2 + 3, (2 * u2 + 3) & 3); }
#endif
                const int kva = u2 * 128;
                if (MODE != 2 && kva <= q0w + 31) {
                    const LAS unsigned char* sba = lds + ((2 * u2) & 3) * 32768; const LAS unsigned char* sbb = lds + ((2 * u2 + 1) & 3) * 32768;
                    f32x16 sa0, sa1, sb0, sb1; float ct0, ct1, ct2, ct3;
#define KRD(dst_, a_, off_) asm volatile("ds_read_b128 %0, %1 offset:%c2" : "=&v"(dst_) : "v"(a_), "i"(off_) : "memory")
#define KRD4(f_, o_, a_) do { KRD(f_[o_], a_, 0); KRD(f_[(o_) + 1], a_, 4096); KRD(f_[(o_) + 2], a_, 32768); KRD(f_[(o_) + 3], a_, 36864); } while (0)
#define KWAIT4(n_, f_, o_) asm volatile("s_waitcnt lgkmcnt(" #n_ ")" : "+v"(f_[o_]), "+v"(f_[(o_) + 1]), "+v"(f_[(o_) + 2]), "+v"(f_[(o_) + 3]) :: "memory")
#define KMM4(f_, o_, ks_) do { sa0 = __builtin_amdgcn_mfma_f32_32x32x16_bf16(f_[o_], qf[ks_], sa0, 0, 0, 0); sa1 = __builtin_amdgcn_mfma_f32_32x32x16_bf16(f_[(o_) + 1], qf[ks_], sa1, 0, 0, 0); \
                        sb0 = __builtin_amdgcn_mfma_f32_32x32x16_bf16(f_[(o_) + 2], qf[ks_], sb0, 0, 0, 0); sb1 = __builtin_amdgcn_mfma_f32_32x32x16_bf16(f_[(o_) + 3], qf[ks_], sb1, 0, 0, 0); } while (0)
                    bf16x8 kf[8];
                    {   const int ci0 = (q0w - kva) >> 5;
                        const LAS unsigned char* bp = bta + kva * 4;
                        const unsigned cta = (unsigned)(uintptr_t)(ctab + ci0);
                        unsigned cw0, cw1, cw2, cw3;
                        asm volatile("ds_read_b32 %0, %4 offset:12\n\tds_read_b32 %1, %4 offset:8\n\tds_read_b32 %2, %4 offset:4\n\tds_read_b32 %3, %4" : "=&v"(cw0), "=&v"(cw1), "=&v"(cw2), "=&v"(cw3) : "v"(cta) : "memory");
                        const unsigned kbase = (unsigned)(uintptr_t)(sba + m * 8192 + r32 * 128); const int sw = (r32 >> 1) & 7;
                        const unsigned ka0 = kbase + ((hi ^ sw) << 4), ka1 = kbase + (((2 + hi) ^ sw) << 4), ka2 = kbase + (((4 + hi) ^ sw) << 4), ka3 = kbase + (((6 + hi) ^ sw) << 4);
                        KRD4(kf, 0, ka0); KRD4(kf, 4, ka1);
                        asm volatile("s_waitcnt lgkmcnt(8)" : "+v"(cw0), "+v"(cw1), "+v"(cw2), "+v"(cw3) :: "memory");
#define MB_INIT(s_, c_, t_, w_) do { const int cw_ = __builtin_amdgcn_readfirstlane((int)(w_)); \
                            if (cw_ != SENTI) { c_ = __int_as_float(cw_); _Pragma("unroll") for (int r = 0; r < 16; ++r) s_[r] = 0.f; } \
                            else { c_ = 0.f; _Pragma("unroll") for (int j_ = 0; j_ < 4; ++j_) { const f32x4 b_ = *(const LAS f32x4*)(bp + (t_) * 128 + j_ * 32); \
                                s_[4 * j_] = b_.x; s_[4 * j_ + 1] = b_.y; s_[4 * j_ + 2] = b_.z; s_[4 * j_ + 3] = b_.w; } } } while (0)
                        MB_INIT(sa0, ct0, 0, cw0); MB_INIT(sa1, ct1, 1, cw1); MB_INIT(sb0, ct2, 2, cw2); MB_INIT(sb1, ct3, 3, cw3);
#undef MB_INIT
                        KWAIT4(4, kf, 0); KMM4(kf, 0, 0);
                        KRD4(kf, 0, ka2); KWAIT4(4, kf, 4); KMM4(kf, 4, 1);
                        KRD4(kf, 4, ka3); KWAIT4(4, kf, 0); KMM4(kf, 0, 2);
                        KWAIT4(0, kf, 4); KMM4(kf, 4, 3);
                    }
#undef KRD
#undef KRD4
#undef KWAIT4
#undef KMM4
#if BSTAGE_POS == 1
                    if (2 * u2 + 2 < NT && MODE != 3) { MB_STAGE(2 * u2 + 2, (2 * u2 + 2) & 3); MB_STAGE(2 * u2 + 3, (2 * u2 + 3) & 3); }
#elif BSTAGE_POS == 2
                    if (2 * u2 + 2 < NT && MODE != 3) { MB_STAGE(2 * u2 + 2, (2 * u2 + 2) & 3); }
#endif
                    if (MODE == 4) { lsum += sa0[0] + sa1[0] + sb0[0] + sb1[0] + sa0[9] + sa1[9] + sb0[9] + sb1[9]; continue; }
                    float rm;
                    {   float m0 = fmaxf(sa0[0], sa0[1]), m1 = fmaxf(sa1[0], sa1[1]), m2 = fmaxf(sb0[0], sb0[1]), m3 = fmaxf(sb1[0], sb1[1]);
#pragma unroll
                        for (int r = 2; r < 16; ++r) { m0 = fmaxf(m0, sa0[r]); m1 = fmaxf(m1, sa1[r]); m2 = fmaxf(m2, sb0[r]); m3 = fmaxf(m3, sb1[r]); }
                        rm = fmaxf(fmaxf(m0 + ct0, m1 + ct1), fmaxf(m2 + ct2, m3 + ct3)); }
                    rm = swap_max(rm);
                    if (__any(rm > mref + THR)) {
                        const float mn = fmaxf(mref, rm), f = __builtin_amdgcn_exp2f(mref - mn);
                        lsum *= f; mref = mn;
#pragma unroll
                        for (int dq = 0; dq < 4; ++dq)
#pragma unroll
                            for (int r = 0; r < 16; ++r) O[dq][r] *= f;
                    }
                    float ps = 0.f; const float rf0 = mref - ct0, rf1 = mref - ct1, rf2 = mref - ct2, rf3 = mref - ct3;
#pragma unroll
                    for (int r = 0; r < 16; ++r) { sa0[r] = __builtin_amdgcn_exp2f(sa0[r] - rf0); sa1[r] = __builtin_amdgcn_exp2f(sa1[r] - rf1); ps += sa0[r] + sa1[r]; }
                    bf16x8 pf[8];
#define MB_PACK(dst_, s_, o_) do { v4u w_; w_.x = cvtpk(s_[o_], s_[o_ + 1]); w_.y = cvtpk(s_[o_ + 2], s_[o_ + 3]); w_.z = cvtpk(s_[o_ + 4], s_[o_ + 5]); w_.w = cvtpk(s_[o_ + 6], s_[o_ + 7]); dst_ = __builtin_bit_cast(bf16x8, w_); } while (0)
#define MB_EXPB(i0_) do { asm volatile("" : "+v"(sb0), "+v"(sb1)); \
                        _Pragma("unroll") for (int r = (i0_); r < (i0_) + 4; ++r) { sb0[r] = __builtin_amdgcn_exp2f(sb0[r] - rf2); sb1[r] = __builtin_amdgcn_exp2f(sb1[r] - rf3); ps += sb0[r] + sb1[r]; } } while (0)
                    MB_PACK(pf[0], sa0, 0); MB_PACK(pf[1], sa0, 8); MB_PACK(pf[2], sa1, 0); MB_PACK(pf[3], sa1, 8);
#if BSTAGE_POS == 2
                    if (2 * u2 + 2 < NT && MODE != 3) { MB_STAGE(2 * u2 + 3, (2 * u2 + 3) & 3); }
#endif
                    const unsigned vlo = (unsigned)(((lane >> 4) & 1) * 32 + (lane & 3) * 8 + (4 * hi + ((lane & 15) >> 2)) * 64);
                    const unsigned vba = (unsigned)(uintptr_t)(sba + 16384) + vlo, vbb = (unsigned)(uintptr_t)(sbb + 16384) + vlo;
                    s16x4 fa[8], fb[8];
#define MB_RD(f, vb_, dq_) do { if (MODE != 1) _Pragma("unroll") for (int sp_ = 0; sp_ < 4; ++sp_) { TRV(f[2 * sp_], vb_, ((dq_) * 4 + sp_) * 1024); TRV(f[2 * sp_ + 1], vb_, ((dq_) * 4 + sp_) * 1024 + 512); } } while (0)
#define MB_MM(f, dq_, po_) do { if (MODE == 1) { asm volatile("" :: "v"(pf[(po_)]), "v"(pf[(po_) + 1]), "v"(pf[(po_) + 2]), "v"(pf[(po_) + 3])); } else _Pragma("unroll") for (int sp_ = 0; sp_ < 4; ++sp_) O[dq_] = __builtin_amdgcn_mfma_f32_32x32x16_bf16(VFRAG(f, sp_), pf[(po_) + sp_], O[dq_], 0, 0, 0); } while (0)
                    MB_RD(fa, vba, 0); MB_RD(fb, vba, 1); LGKM_WAIT8(8, fa); MB_MM(fa, 0, 0); MB_EXPB(0);
                    MB_RD(fa, vba, 2); LGKM_WAIT8(8, fb); MB_MM(fb, 1, 0); MB_EXPB(4);
                    MB_RD(fb, vba, 3); LGKM_WAIT8(8, fa); MB_MM(fa, 2, 0); MB_EXPB(8);
                    MB_RD(fa, vbb, 0); LGKM_WAIT8(8, fb); MB_MM(fb, 3, 0); MB_EXPB(12);
                    lsum += ps;
                    MB_PACK(pf[4], sb0, 0); MB_PACK(pf[5], sb0, 8); MB_PACK(pf[6], sb1, 0); MB_PACK(pf[7], sb1, 8);
                    MB_RD(fb, vbb, 1); LGKM_WAIT8(8, fa); MB_MM(fa, 0, 4);
                    MB_RD(fa, vbb, 2); LGKM_WAIT8(8, fb); MB_MM(fb, 1, 4);
                    MB_RD(fb, vbb, 3); LGKM_WAIT8(8, fa); MB_MM(fa, 2, 4);
                    LGKM_WAIT8(0, fb); MB_MM(fb, 3, 4);
#undef MB_PACK
#undef MB_EXPB
#undef MB_RD
#undef MB_MM
                }
            }
            RAW_BARRIER();
#undef MB_STAGE
            const float inv = 1.0f / swap_add(lsum);
            LAS float* xb = (LAS float*)lds + qs * 4096;
            if (m == 1) {
#pragma unroll
                for (int dq = 0; dq < 4; ++dq)
#pragma unroll
                    for (int r = 0; r < 16; ++r) xb[(dq * 16 + r) * 64 + lane] = O[dq][r] * inv;
            }
            RAW_BARRIER();
            if (m == 0) {
                float ss = 0.f;
#pragma unroll
                for (int dq = 0; dq < 4; ++dq)
#pragma unroll
                    for (int r = 0; r < 16; ++r) { const float o = O[dq][r] * inv - lam * xb[(dq * 16 + r) * 64 + lane]; O[dq][r] = o; ss += o * o; }
                const float rstd = 1.0f / sqrtf(swap_add(ss) * (1.f / 128.f) + EPS) * one_m_li;
                bf16* orow = OUTB + (size_t)(rb + qpos) * 512 + h * 128;
#pragma unroll
                for (int dq = 0; dq < 4; ++dq)
#pragma unroll
                    for (int g4 = 0; g4 < 4; ++g4) { const int d0 = dq * 32 + 8 * g4 + 4 * hi; const f32x4 gs = *(const LAS f32x4*)(gs_l + d0);
                        v2u w; w.x = pk2(O[dq][4 * g4] * rstd * gs.x, O[dq][4 * g4 + 1] * rstd * gs.y); w.y = pk2(O[dq][4 * g4 + 2] * rstd * gs.z, O[dq][4 * g4 + 3] * rstd * gs.w);
                        *(v2u*)(orow + d0) = w; }
            }
            asm volatile("s_waitcnt vmcnt(0)" ::: "memory");
            RAW_BARRIER();
        }
    }
}

constexpr size_t WS_OG = 432 * MiB, WS_LSE = 480 * MiB;
__device__ __forceinline__ void mixC_fast(unsigned char* y, unsigned char* ws, const float* T, LAS unsigned char* lds, int tid, int lane, int wave, int G) {
    asm volatile("" : "+v"(lane), "+v"(tid));
    const bf16* CQ = (const bf16*)(y + Y_CQ); const bf16* CK = (const bf16*)(y + Y_CK); const bf16* CV = (const bf16*)(y + Y_CV);
    float* OG = (float*)(ws + WS_OG); float* LSE = (float*)(ws + WS_LSE);
    const int r32 = lane & 31, hi = lane >> 5;
    LAS unsigned char* Kl = lds;
    LAS unsigned char* Vl = lds + 49152;
    LAS float* bt = (LAS float*)(lds + 98304);
    constexpr int CBS = 208;
    for (int item = blockIdx.x; item < CHB * 192; item += G) {
        const int bb = item / 192, u = item % 192, g = u >> 6, v = u & 63;
        const int hp = v >> 4, w16 = v & 15;
        const int dil = (g == 0) ? 1 : (g == 1) ? 4 : 16;
        const int rc = (g == 0) ? 0 : (g == 1) ? (w16 >> 2) : w16;
        const int seg = (g == 0) ? w16 : (g == 1) ? (w16 & 3) : 0;
        const int hh = 4 * g + hp, M0 = seg * 256, rb = bb * SEQ;
        RAW_BARRIER();
        if (tid < 196) { const int rel = 159 - tid; const float v = (rel >= 0 && rel <= 128) ? T[(rel * dil) * 24 + 12 + hh] * LOG2E : -INFINITY;
#pragma unroll
            for (int sc = 0; sc < 4; ++sc) { const int i = tid - sc; if (i >= 0 && i < 192) bt[sc * CBS + i] = v; } }
#pragma unroll
        for (int i = 0; i < 6; ++i) { const int p = wave * 6 + i;
            int mk = M0 - 128 + 8 * p + (lane >> 3); mk = mk < 0 ? 0 : mk;
            glds16(CK + (size_t)(rb + mk * dil + rc) * 768 + hh * 64 + ((lane & 7) ^ ((4 * p + (lane >> 4)) & 7)) * 8, Kl + p * 1024); }
#pragma unroll
        for (int i = 0; i < 6; ++i) { const int p = wave * 6 + i, dq = p / 24, rg = p % 24;
            int mk = M0 - 128 + 16 * rg + (lane >> 2); mk = mk < 0 ? 0 : mk;
            glds16(CV + (size_t)(rb + mk * dil + rc) * 768 + hh * 64 + dq * 32 + (lane & 3) * 8, Vl + p * 1024); }
        const int mq = M0 + 32 * wave + r32, rowq = rb + mq * dil + rc;
        bf16x8 qf[4];
#pragma unroll
        for (int ks = 0; ks < 4; ++ks) qf[ks] = *(const bf16x8*)(CQ + (size_t)rowq * 768 + hh * 64 + 16 * ks + 8 * hi);
        asm volatile("s_waitcnt vmcnt(0)" ::: "memory");
        RAW_BARRIER();
        f32x16 O[2];
#pragma unroll
        for (int dq = 0; dq < 2; ++dq)
#pragma unroll
            for (int r = 0; r < 16; ++r) O[dq][r] = 0.f;
        float mref = -INFINITY, lsum = 0.f;
#pragma unroll 1
        for (int j = 0; j < 5; ++j) {
            const int lrow = 32 * wave + 32 * j;
            if (M0 - 128 + lrow + 31 < 0) continue;
            const LAS unsigned char* kb = Kl + (lrow + r32) * 128;
            f32x16 s0;
            {   const int xl = 31 + 32 * j - r32 + 4 * hi;
                const LAS float* bp = bt + (xl & 3) * (CBS - 1) + xl;
#pragma unroll
                for (int j4 = 0; j4 < 4; ++j4) { const f32x4 b = *(const LAS f32x4*)(bp + 8 * j4); s0[4 * j4] = b.x; s0[4 * j4 + 1] = b.y; s0[4 * j4 + 2] = b.z; s0[4 * j4 + 3] = b.w; } }
#pragma unroll
            for (int ks = 0; ks < 4; ++ks) { const bf16x8 k0 = *(const LAS bf16x8*)(kb + (((2 * ks + hi) ^ (((lrow + r32) >> 1) & 7)) << 4)); s0 = __builtin_amdgcn_mfma_f32_32x32x16_bf16(k0, qf[ks], s0, 0, 0, 0); }
            if (M0 - 128 + lrow < 0) {
                const int mkb = M0 - 128 + lrow + 4 * hi;
#pragma unroll
                for (int r = 0; r < 16; ++r) { const int cr = (r & 3) + 8 * (r >> 2); if (mkb + cr < 0) s0[r] = -INFINITY; } }
            float rm = s0[0];
#pragma unroll
            for (int r = 1; r < 16; ++r) rm = fmaxf(rm, s0[r]);
            rm = swap_max(rm);
            const float mn = fmaxf(mref, rm);
            const float f = (mn == -INFINITY) ? 1.f : __builtin_amdgcn_exp2f(mref - mn);
            const float msub = (mn == -INFINITY) ? 0.f : mn;
            lsum *= f; mref = mn;
#pragma unroll
            for (int dq = 0; dq < 2; ++dq)
#pragma unroll
                for (int r = 0; r < 16; ++r) O[dq][r] *= f;
            float ps = 0.f;
#pragma unroll
            for (int r = 0; r < 16; ++r) { s0[r] = __builtin_amdgcn_exp2f(s0[r] - msub); ps += s0[r]; }
            lsum += ps;
            bf16x8 pf[2];
            { v4u w;
              w.x = cvtpk(s0[0], s0[1]); w.y = cvtpk(s0[2], s0[3]); w.z = cvtpk(s0[4], s0[5]); w.w = cvtpk(s0[6], s0[7]); pf[0] = __builtin_bit_cast(bf16x8, w);
              w.x = cvtpk(s0[8], s0[9]); w.y = cvtpk(s0[10], s0[11]); w.z = cvtpk(s0[12], s0[13]); w.w = cvtpk(s0[14], s0[15]); pf[1] = __builtin_bit_cast(bf16x8, w); }
            const unsigned vb = (unsigned)(uintptr_t)(Vl + ((lane >> 4) & 1) * 32 + (lane & 3) * 8 + (4 * hi + ((lane & 15) >> 2)) * 64 + (lrow >> 4) * 1024);
            s16x4 fa[8];
#pragma unroll
            for (int dq = 0; dq < 2; ++dq)
#pragma unroll
                for (int sp = 0; sp < 2; ++sp) { TRV(fa[4 * dq + 2 * sp], vb, (dq * 24 + sp) * 1024); TRV(fa[4 * dq + 2 * sp + 1], vb, (dq * 24 + sp) * 1024 + 512); }
            LGKM_WAIT8(0, fa);
#pragma unroll
            for (int dq = 0; dq < 2; ++dq)
#pragma unroll
                for (int sp = 0; sp < 2; ++sp) O[dq] = __builtin_amdgcn_mfma_f32_32x32x16_bf16(VFRAG(fa, 2 * dq + sp), pf[sp], O[dq], 0, 0, 0);
        }
        const float ltot = swap_add(lsum), inv = 1.0f / ltot;
        float* og = OG + ((size_t)g * CHR + rowq) * 256 + hp * 64;
#pragma unroll
        for (int dq = 0; dq < 2; ++dq)
#pragma unroll
            for (int g4 = 0; g4 < 4; ++g4) { const int d0 = dq * 32 + 8 * g4 + 4 * hi;
                *(f32x4*)(og + d0) = (f32x4){O[dq][4 * g4] * inv, O[dq][4 * g4 + 1] * inv, O[dq][4 * g4 + 2] * inv, O[dq][4 * g4 + 3] * inv}; }
        if (hi == 0) LSE[((size_t)g * CHR + rowq) * 4 + hp] = (mref + __log2f(ltot)) * 0.6931471805599453f;
    }
}
__device__ __forceinline__ void mergeC(unsigned char* y, unsigned char* ws, int gw, int NGW, int lane) {
    asm volatile("" : "+v"(lane));
    const float* OG = (const float*)(ws + WS_OG); const float* LSE = (const float*)(ws + WS_LSE); bf16* OC = (bf16*)(y + Y_OC);
    const int hp = lane >> 4, d4 = (lane & 15) * 4;
    for (int r0 = gw; r0 < CHR; r0 += 2 * NGW) {
        const int r1 = (r0 + NGW < CHR) ? r0 + NGW : r0;
        float l[2][3]; f32x4 o[2][3];
#pragma unroll
        for (int i = 0; i < 2; ++i) { const int r = i ? r1 : r0;
#pragma unroll
            for (int g = 0; g < 3; ++g) { l[i][g] = LSE[((size_t)g * CHR + r) * 4 + hp]; o[i][g] = *(const f32x4*)(OG + ((size_t)g * CHR + r) * 256 + hp * 64 + d4); } }
#pragma unroll
        for (int i = 0; i < 2; ++i) { const int r = i ? r1 : r0; if (i == 1 && r1 == r0) break;
            const float M = fmaxf(fmaxf(l[i][0], l[i][1]), l[i][2]);
            const float a0 = __expf(l[i][0] - M), a1 = __expf(l[i][1] - M), a2 = __expf(l[i][2] - M), ia = 1.0f / (a0 + a1 + a2);
            const f32x4 ov = (o[i][0] * a0 + o[i][1] * a1 + o[i][2] * a2) * ia;
            v2u w; w.x = pk2(ov.x, ov.y); w.y = pk2(ov.z, ov.w);
            *(v2u*)(OC + (size_t)r * 256 + hp * 64 + d4) = w; }
    }
}

constexpr int CW_KMAX = 8192;
constexpr int A_KST = 0, A_HIST = 32768, A_CAND = 98304, A_SEL = 131072, A_BKT = 147456, A_BIAS = 151552;
__device__ __forceinline__ int a_bin(float s, int kb) {
    int k = (int)(__float_as_uint(fabsf(s)) >> 18) - kb; k = k < 0 ? 0 : (k > 511 ? 511 : k);
    return (s < 0.f) ? (511 - k) : (512 + k);
}
__device__ __forceinline__ unsigned a_edge(int b, int kb) {
    if (b <= 0) return 0u;
    if (b >= 1024) return 0xffffffffu;
    if (b == 512) return 0x80000000u;
    if (b > 512) { const int k = b - 512 + kb; return 0x80000000u | ((unsigned)(k > 0 ? k : 0) << 18); }
    const int k = 512 - b + kb; return 0x80000000u - ((unsigned)(k > 0 ? k : 0) << 18);
}
__device__ __forceinline__ void mixA_fast(unsigned char* y, bf16* OUTA, bf16* OUTA2, const bf16* KVN, const bf16* UKT, const float* T, const float* rel_bias, const unsigned* kmaxw, LAS unsigned char* lds, int tid, int lane, int wave, int G) {
    asm volatile("" : "+v"(lane), "+v"(tid));
    const bf16* AQ = (const bf16*)(y + Y_AQ); bf16* QLS = (bf16*)(y + Y_QLS) + (size_t)blockIdx.x * 32 * 1024; const bf16* MISC = (const bf16*)(y + Y_MISC); const bf16* IQ = (const bf16*)(y + Y_IQ);
    const int kl = lane & 31, hi = lane >> 5;
    constexpr float C2 = 0.125f * LOG2E, THR = 8.0f;
    unsigned short* KEYS = (unsigned short*)(y + ((blockIdx.x < 160) ? (Y_CK + 8 * MiB + (size_t)blockIdx.x * 262144) : (Y_BK + (size_t)(blockIdx.x - 160) * 262144)));
    LAS float* biasl = (LAS float*)(lds + A_BIAS);
    const unsigned lt32 = (1u << kl) - 1u;
    for (int item = blockIdx.x; item < CHB * 64; item += G) {
        const int bb = (G == 256) ? (item & 3) : (item >> 6), pr = (G == 256) ? (((item >> 2) & 1) * 32 + (item >> 3)) : (item & 63), rb = bb * SEQ;
        const float kmax = sqrtf(__uint_as_float(kmaxw[bb]));
        for (int uu = 0; uu < 2; ++uu) {
            const int qb = (uu == 0) ? (127 - pr) : pr, t0 = qb * 32, tw = t0 + 4 * wave;
            RAW_BARRIER();
            { int tq = tid; asm volatile("" : "+v"(tq)); if (tq < 256) biasl[tq] = rel_bias[(tq >> 3) * 24 + (tq & 7)] * LOG2E; }
            bf16x8 aq[4];
            int klq = kl, hiq = hi; asm volatile("" : "+v"(klq), "+v"(hiq));
            { const int rowq = klq >> 3, hr = klq & 7;
#pragma unroll
              for (int ks = 0; ks < 4; ++ks) aq[ks] = *(const bf16x8*)(IQ + (size_t)(rb + tw + rowq) * 512 + hr * 64 + 16 * ks + 8 * hiq); }
            float wr[16];
#pragma unroll
            for (int r = 0; r < 16; ++r) wr[r] = bf2f(MISC[(size_t)(rb + tw + (r >> 2)) * 256 + 192 + (r & 3) + 4 * hiq]) * 0.044194173824159216f;
            int kbX, kbY;
            { float ss = 0.f;
#pragma unroll
              for (int ks = 0; ks < 4; ++ks)
#pragma unroll
                  for (int j = 0; j < 8; ++j) { const float v = bf2f((bf16)aq[ks][j]); ss += v * v; }
              ss = swap_add(ss);
              const float wa = fabsf(bf2f(MISC[(size_t)(rb + tw + (klq >> 3)) * 256 + 192 + (klq & 7)])) * 0.044194173824159216f;
              float u = wa * sqrtf(ss) * kmax;
              u += __shfl_xor(u, 1); u += __shfl_xor(u, 2); u += __shfl_xor(u, 4);
              const float uX = __shfl(u, (2 * hi) * 8), uY = __shfl(u, (2 * hi + 1) * 8);
              kbX = (int)(__float_as_uint(uX) >> 18) - 511; kbY = (int)(__float_as_uint(uY) >> 18) - 511; }
            const int tX = tw + 2 * hi, tY = tw + 2 * hi + 1;
            const int qX = wave * 4 + 2 * hi, qY = qX + 1;
            LAS unsigned* histX = (LAS unsigned*)(lds + A_HIST + qX * 2048); LAS unsigned* histY = (LAS unsigned*)(lds + A_HIST + qY * 2048);
            int thrX = -1, thrY = -1; unsigned cntX = 0, cntY = 0, ccX = 0, ccY = 0;
            unsigned eSX = 0u, eCX = 0u, eSY = 0u, eCY = 0u;
#pragma unroll 1
            for (int rep8 = 0; rep8 < ((PROBE == 8 || PROBE == 15) ? 2 : 1); ++rep8) {
            thrX = -1; thrY = -1; cntX = 0; cntY = 0; ccX = 0; ccY = 0;
            { LAS v4u* hz = (LAS v4u*)(lds + A_HIST + wave * 8192);
              unsigned z0 = 0u; asm volatile("" : "+v"(z0));
#pragma unroll
              for (int i = 0; i < 8; ++i) hz[i * 64 + lane] = (v4u){z0, z0, z0, z0}; }
            const int NTK = qb + 1, NCK = (NTK + 3) >> 2;
#define MA_STAGE(ck_, buf_) do { _Pragma("unroll") for (int i_ = 0; i_ < 2; ++i_) { const int p_ = 2 * wave + i_, tl_ = p_ >> 2, ks_ = p_ & 3; \
                glds16(MISC + (size_t)(rb + 128 * (ck_) + 32 * tl_ + kl) * 256 + 128 + (2 * ks_ + hi) * 8, lds + A_KST + (buf_) * 16384 + tl_ * 4096 + ks_ * 1024); } } while (0)
#pragma unroll 1
            for (int pass = 0; pass < 1; ++pass) {
                const int NTR = (NTK + 1) >> 1;
                RAW_BARRIER();
                MA_STAGE(0, 0);
                asm volatile("s_waitcnt vmcnt(0)" ::: "memory");
                RAW_BARRIER();
                if (NCK > 1) MA_STAGE(1, 1);
#define RELU(x_) __int_as_float(max(__float_as_int(x_), 0))
#define MA_LOADK(kf_, bf_, tl_) do { const LAS unsigned char* kbp_ = lds + A_KST + (bf_) * 16384 + (tl_) * 4096 + hi * 512 + kl * 16; \
                        _Pragma("unroll") for (int ks = 0; ks < 4; ++ks) kf_[ks] = *(const LAS bf16x8*)(kbp_ + ks * 1024); } while (0)
#define MA_MMA(c_, kf_) do { _Pragma("unroll") for (int r = 0; r < 16; ++r) c_[r] = 0.f; \
                        _Pragma("unroll") for (int ks = 0; ks < 4; ++ks) c_ = __builtin_amdgcn_mfma_f32_32x32x16_bf16(aq[ks], kf_[ks], c_, 0, 0, 0); } while (0)
#define MA_RED(sX_, sY_, c_) do { float p0_ = 0.f, p1_ = 0.f, p2_ = 0.f, p3_ = 0.f; \
                        _Pragma("unroll") for (int i = 0; i < 4; ++i) { p0_ += wr[i] * RELU(c_[i]); p1_ += wr[4 + i] * RELU(c_[4 + i]); p2_ += wr[8 + i] * RELU(c_[8 + i]); p3_ += wr[12 + i] * RELU(c_[12 + i]); } \
                        { auto rr = __builtin_amdgcn_permlane32_swap(__float_as_uint(p0_), __float_as_uint(p2_), false, false); sX_ = __uint_as_float(rr[0]) + __uint_as_float(rr[1]) + 0.f; } \
                        { auto rr = __builtin_amdgcn_permlane32_swap(__float_as_uint(p1_), __float_as_uint(p3_), false, false); sY_ = __uint_as_float(rr[0]) + __uint_as_float(rr[1]) + 0.f; } } while (0)
#define MA_APPEND(sv_, val_, q_, cnt_, cc_, eS_, eC_, s_) do { const unsigned mk_ = __float_as_uint(sv_) ^ ((unsigned)((int)__float_as_uint(sv_) >> 31) | 0x80000000u); \
                        const bool sel_ = (val_) && mk_ >= (eS_), cd_ = (val_) && mk_ >= (eC_) && mk_ < (eS_); \
                        const unsigned long long bs_ = __ballot(sel_), bc_ = __ballot(cd_); \
                        const unsigned ms_ = hi ? (unsigned)(bs_ >> 32) : (unsigned)bs_, mc_ = hi ? (unsigned)(bc_ >> 32) : (unsigned)bc_; \
                        if (sel_) lds_st_b16_asm((LAS bf16*)(lds + A_SEL + (q_) * 512) + cnt_ + __popc(ms_ & lt32), (unsigned)(s_)); \
                        if (cd_) { const unsigned cp_ = cc_ + __popc(mc_ & lt32); if (cp_ < 128u) { lds_st_b32_asm((LAS float*)(lds + A_CAND + (q_) * 768) + cp_, __float_as_uint(sv_)); lds_st_b16_asm((LAS bf16*)(lds + A_CAND + (q_) * 768 + 512) + cp_, (unsigned)(s_)); } } \
                        cnt_ += __popc(ms_); cc_ += __popc(mc_); } while (0)
                f32x16 ca, cb;
                {   bf16x8 kfa[4], kfb[4];
                    MA_LOADK(kfa, 0, 0); MA_LOADK(kfb, 0, 1);
                    MA_MMA(ca, kfa); MA_MMA(cb, kfb); }
#pragma unroll 1
                for (int t = 0; t < NTR; ++t) {
                    bf16x8 kfa[4], kfb[4];
                    if (t + 1 < NTR && ((t + 1) & 1) == 0) {
                        const int c = (t + 1) >> 1;
                        asm volatile("s_waitcnt vmcnt(0)" ::: "memory");
                        RAW_BARRIER();
                        if (c + 1 < NCK) MA_STAGE(c + 1, (c + 1) & 1);
                    }
                    const int bf = ((t + 1) >> 1) & 1, tl = 2 * ((t + 1) & 1);
#define MA_KRD(kf_, a_) asm volatile("ds_read_b128 %0, %4\n\tds_read_b128 %1, %4 offset:1024\n\tds_read_b128 %2, %4 offset:2048\n\tds_read_b128 %3, %4 offset:3072" : "=&v"(kf_[0]), "=&v"(kf_[1]), "=&v"(kf_[2]), "=&v"(kf_[3]) : "v"(a_) : "memory")
#define MA_KWAIT(kf_) asm volatile("s_waitcnt lgkmcnt(0)" : "+v"(kf_[0]), "+v"(kf_[1]), "+v"(kf_[2]), "+v"(kf_[3]) :: "memory")
                    const unsigned kad = (unsigned)(uintptr_t)(lds + A_KST + bf * 16384 + tl * 4096 + hi * 512 + kl * 16);
                    MA_KRD(kfa, kad);
                    float sXa, sYa, sXb, sYb;
                    MA_RED(sXa, sYa, ca);
                    asm volatile("" : "+v"(sXa), "+v"(sYa));
                    MA_KWAIT(kfa); MA_MMA(ca, kfa);
                    MA_KRD(kfb, kad + 4096u);
                    MA_RED(sXb, sYb, cb);
                    asm volatile("" : "+v"(sXb), "+v"(sYb));
                    MA_KWAIT(kfb); MA_MMA(cb, kfb);
#undef MA_KRD
#undef MA_KWAIT
                    const int sa = t * 64 + kl, sb2 = sa + 32;
                    const bool vXa = sa <= tX, vYa = sa <= tY, vXb = sb2 <= tX, vYb = sb2 <= tY;
                    if (pass == 0) {
                        const int bXa = a_bin(sXa, kbX), bYa = a_bin(sYa, kbY), bXb = a_bin(sXb, kbX), bYb = a_bin(sYb, kbY);
                        lds_add_u32_asm(histX + (bXa >> 1), vXa ? (1u << ((bXa & 1) * 16)) : 0u);
                        lds_add_u32_asm(histY + (bYa >> 1), vYa ? (1u << ((bYa & 1) * 16)) : 0u);
                        lds_add_u32_asm(histX + (bXb >> 1), vXb ? (1u << ((bXb & 1) * 16)) : 0u);
                        lds_add_u32_asm(histY + (bYb >> 1), vYb ? (1u << ((bYb & 1) * 16)) : 0u);
#define A_KEY16(s_) ((unsigned short)((__float_as_uint(s_) ^ ((unsigned)((int)__float_as_uint(s_) >> 31) | 0x80000000u)) >> 16))
                        {   unsigned short* kw = KEYS + (size_t)qX * 4096 + sa;
                            kw[0] = A_KEY16(sXa); kw[4096] = A_KEY16(sYa); kw[32] = A_KEY16(sXb); kw[4096 + 32] = A_KEY16(sYb); }
#undef A_KEY16
                    } else {
                        MA_APPEND(sXa, vXa, qX, cntX, ccX, eSX, eCX, sa); MA_APPEND(sYa, vYa, qY, cntY, ccY, eSY, eCY, sa);
                        MA_APPEND(sXb, vXb, qX, cntX, ccX, eSX, eCX, sb2); MA_APPEND(sYb, vYb, qY, cntY, ccY, eSY, eCY, sb2);
                    }
                    asm volatile("" : "+v"(ca), "+v"(cb));
                }
#undef MA_LOADK
#undef MA_MMA
#undef MA_RED
#undef MA_APPEND
                RAW_BARRIER();
                if (pass == 0) {
#pragma unroll 1
                    for (int q4 = 0; q4 < 4; ++q4) {
                        const LAS unsigned* hq = (const LAS unsigned*)(lds + A_HIST + (wave * 4 + q4) * 2048) + 504 - 8 * lane;
                        unsigned w8[8];
                        { const v4u a0 = *(const LAS v4u*)hq, a1 = *(const LAS v4u*)(hq + 4); w8[0] = a0.x; w8[1] = a0.y; w8[2] = a0.z; w8[3] = a0.w; w8[4] = a1.x; w8[5] = a1.y; w8[6] = a1.z; w8[7] = a1.w; }
                        unsigned loc = 0;
#pragma unroll
                        for (int j = 0; j < 8; ++j) loc += (w8[j] & 0xffffu) + (w8[j] >> 16);
                        unsigned inc = loc;
#pragma unroll
                        for (int o = 1; o < 64; o <<= 1) { const unsigned v = __shfl_up(inc, o); if (lane >= o) inc += v; }
                        unsigned run = inc - loc; int thr = -1; unsigned cab = 0;
#pragma unroll
                        for (int j = 7; j >= 0; --j)
#pragma unroll
                            for (int hh = 1; hh >= 0; --hh) { const unsigned cn = (w8[j] >> (16 * hh)) & 0xffffu;
                                if (thr < 0 && run + cn >= (unsigned)TOPK) { thr = 2 * (504 - 8 * lane + j) + hh; cab = run; }
                                run += cn; }
                        const unsigned long long bl = __ballot(inc >= (unsigned)TOPK);
                        int thq = -1; unsigned cbq = 0;
                        if (bl) { const int L = __ffsll((long long)bl) - 1; thq = __shfl(thr, L); cbq = __shfl(cab, L); }
                        (void)cbq;
                        if (q4 == 2 * hi) thrX = thq; if (q4 == 2 * hi + 1) thrY = thq;
                    }
                    eCX = a_edge(thrX, kbX); eSX = a_edge(thrX + 1, kbX); eCY = a_edge(thrY, kbY); eSY = a_edge(thrY + 1, kbY);
                }
            }
            {
                asm volatile("s_waitcnt vmcnt(0)" ::: "memory");
                __builtin_amdgcn_fence(__ATOMIC_RELEASE, "workgroup"); __builtin_amdgcn_fence(__ATOMIC_ACQUIRE, "workgroup");
                unsigned cq0 = 0, cq1 = 0, cq2 = 0, cq3 = 0, kq0 = 0, kq1 = 0, kq2 = 0, kq3 = 0;
#define MA_SCANQ(q4_, cntv_, ccv_) do { \
                    const unsigned eS_ = (unsigned)__builtin_amdgcn_readlane((int)(((q4_) & 1) ? eSY : eSX), ((q4_) >> 1) * 32) >> 16, eC_ = (unsigned)__builtin_amdgcn_readlane((int)(((q4_) & 1) ? eCY : eCX), ((q4_) >> 1) * 32) >> 16; \
                    const int tq_ = tw + (q4_), nch_ = (tq_ + 512) >> 9; \
                    const unsigned short* row_ = KEYS + (size_t)(wave * 4 + (q4_)) * 4096 + lane;     \
                    LAS bf16* so_ = (LAS bf16*)(lds + A_SEL + (wave * 4 + (q4_)) * 512); LAS bf16* co_ = (LAS bf16*)(lds + A_CAND + (wave * 4 + (q4_)) * 768 + 512); \
                    unsigned cnt_ = 0, cc_ = 0; unsigned nx_[8]; \
                    _Pragma("unroll") for (int j_ = 0; j_ < 8; ++j_) nx_[j_] = row_[64 * j_]; \
                    _Pragma("unroll 1") for (int c_ = 0; c_ < nch_; ++c_) { \
                        unsigned w_[8]; _Pragma("unroll") for (int j_ = 0; j_ < 8; ++j_) w_[j_] = nx_[j_]; \
                        if (c_ + 1 < nch_) { _Pragma("unroll") for (int j_ = 0; j_ < 8; ++j_) nx_[j_] = row_[512 * (c_ + 1) + 64 * j_]; } \
                        _Pragma("unroll") for (int j_ = 0; j_ < 8; ++j_) { \
                            const unsigned k_ = w_[j_]; const int ki_ = 512 * c_ + 64 * j_ + lane; \
                            const bool val_ = ki_ <= tq_, sel_ = val_ && k_ >= eS_, cd_ = val_ && k_ >= eC_ && k_ < eS_; \
                            const unsigned long long bs_ = __ballot(sel_), bc_ = __ballot(cd_); \
                            if (sel_) lds_st_b16_asm(so_ + cnt_ + __builtin_amdgcn_mbcnt_hi((unsigned)(bs_ >> 32), __builtin_amdgcn_mbcnt_lo((unsigned)bs_, 0u)), (unsigned)ki_); \
                            if (cd_) { const unsigned cp_ = cc_ + __builtin_amdgcn_mbcnt_hi((unsigned)(bc_ >> 32), __builtin_amdgcn_mbcnt_lo((unsigned)bc_, 0u)); if (cp_ < 128u) lds_st_b16_asm(co_ + cp_, (unsigned)ki_); } \
                            cnt_ += (unsigned)__popcll(bs_); cc_ += (unsigned)__popcll(bc_); } } \
                    cntv_ = cnt_; ccv_ = cc_; } while (0)
                MA_SCANQ(0, cq0, kq0); MA_SCANQ(1, cq1, kq1); MA_SCANQ(2, cq2, kq2); MA_SCANQ(3, cq3, kq3);
#undef MA_SCANQ
                cntX = hi ? cq2 : cq0; cntY = hi ? cq3 : cq1; ccX = hi ? kq2 : kq0; ccY = hi ? kq3 : kq1;
                asm volatile("s_waitcnt lgkmcnt(0)" ::: "memory");
                const int n0 = min(__builtin_amdgcn_readlane((int)ccX, 0), 128), n2 = min(__builtin_amdgcn_readlane((int)ccX, 32), 128), n1 = min(__builtin_amdgcn_readlane((int)ccY, 0), 128), n3 = min(__builtin_amdgcn_readlane((int)ccY, 32), 128);
#pragma unroll 1
                for (int qp = 0; qp < 2; ++qp) {
                    const int na = qp ? n2 : n0, nb2 = qp ? n3 : n1, nmax = na > nb2 ? na : nb2;
                    LAS float* csa = (LAS float*)(lds + A_CAND + (wave * 4 + 2 * qp) * 768); LAS float* csb = (LAS float*)(lds + A_CAND + (wave * 4 + 2 * qp + 1) * 768);
                    const LAS bf16* cia = (const LAS bf16*)(lds + A_CAND + (wave * 4 + 2 * qp) * 768 + 512); const LAS bf16* cib = (const LAS bf16*)(lds + A_CAND + (wave * 4 + 2 * qp + 1) * 768 + 512);
#pragma unroll 1
                    for (int tb = 0; tb < nmax; tb += 32) {
                        const int ia = (tb + kl < na) ? (int)cia[tb + kl] : 0, ib = (tb + kl < nb2) ? (int)cib[tb + kl] : 0;
                        bf16x8 kfa[4], kfb[4];
#pragma unroll
                        for (int ks = 0; ks < 4; ++ks) { kfa[ks] = *(const bf16x8*)(MISC + (size_t)(rb + ia) * 256 + 128 + (2 * ks + hi) * 8); kfb[ks] = *(const bf16x8*)(MISC + (size_t)(rb + ib) * 256 + 128 + (2 * ks + hi) * 8); }
                        f32x16 ca, cb;
#pragma unroll
                        for (int r = 0; r < 16; ++r) { ca[r] = 0.f; cb[r] = 0.f; }
#pragma unroll
                        for (int ks = 0; ks < 4; ++ks) { ca = __builtin_amdgcn_mfma_f32_32x32x16_bf16(aq[ks], kfa[ks], ca, 0, 0, 0); cb = __builtin_amdgcn_mfma_f32_32x32x16_bf16(aq[ks], kfb[ks], cb, 0, 0, 0); }
#define RELU2(x_) __int_as_float(max(__float_as_int(x_), 0))
#define MA_RED2(sX_, sY_, c_) do { float p0_ = 0.f, p1_ = 0.f, p2_ = 0.f, p3_ = 0.f; \
                        _Pragma("unroll") for (int i = 0; i < 4; ++i) { p0_ += wr[i] * RELU2(c_[i]); p1_ += wr[4 + i] * RELU2(c_[4 + i]); p2_ += wr[8 + i] * RELU2(c_[8 + i]); p3_ += wr[12 + i] * RELU2(c_[12 + i]); } \
                        { auto rr = __builtin_amdgcn_permlane32_swap(__float_as_uint(p0_), __float_as_uint(p2_), false, false); sX_ = __uint_as_float(rr[0]) + __uint_as_float(rr[1]) + 0.f; } \
                        { auto rr = __builtin_amdgcn_permlane32_swap(__float_as_uint(p1_), __float_as_uint(p3_), false, false); sY_ = __uint_as_float(rr[0]) + __uint_as_float(rr[1]) + 0.f; } } while (0)
                        float aX, aY, bX, bY;
                        MA_RED2(aX, aY, ca); MA_RED2(bX, bY, cb);
#undef MA_RED2
#undef RELU2
                        if (hi == qp && tb + kl < na) csa[tb + kl] = aX;
                        if (hi == qp && tb + kl < nb2) csb[tb + kl] = bY;
                    }
                }
                asm volatile("s_waitcnt lgkmcnt(0)" ::: "memory");
            }
            }
#undef MA_STAGE
            {
                const unsigned c0 = (unsigned)__shfl((int)cntX, 0), c2 = (unsigned)__shfl((int)cntX, 32), c1 = (unsigned)__shfl((int)cntY, 0), c3 = (unsigned)__shfl((int)cntY, 32);
                const unsigned k0 = (unsigned)__shfl((int)ccX, 0), k2 = (unsigned)__shfl((int)ccX, 32), k1 = (unsigned)__shfl((int)ccY, 0), k3 = (unsigned)__shfl((int)ccY, 32);
#pragma unroll 1
                for (int q4 = 0; q4 < 4; ++q4) {
                    const unsigned cnt = (q4 == 0) ? c0 : (q4 == 1) ? c1 : (q4 == 2) ? c2 : c3; unsigned cc = (q4 == 0) ? k0 : (q4 == 1) ? k1 : (q4 == 2) ? k2 : k3;
                    if (cc > 128u) cc = 128u;
                    LAS unsigned* nfp = (LAS unsigned*)(lds + A_BIAS + 1024) + wave * 4 + q4;
                    if (lane == 0) *nfp = cnt;
                    if (cnt >= (unsigned)TOPK || cc == 0u) continue;
                    const unsigned need = (unsigned)TOPK - cnt;
                    const LAS float* cs = (const LAS float*)(lds + A_CAND + (wave * 4 + q4) * 768); const LAS bf16* ci = (const LAS bf16*)(lds + A_CAND + (wave * 4 + q4) * 768 + 512);
                    LAS bf16* so = (LAS bf16*)(lds + A_SEL + (wave * 4 + q4) * 512);
                    unsigned base = cnt;
#pragma unroll 1
                    for (unsigned r0 = 0; r0 < cc; r0 += 64) { const unsigned i = r0 + lane; const bool act = i < cc;
                        const float si = act ? cs[i] : 0.f; const unsigned ii = act ? ci[i] : 0u; unsigned rank = 0;
                        for (unsigned j = 0; j < cc; ++j) { const float sj = cs[j]; const unsigned ij = ci[j]; rank += (sj > si || (sj == si && ij < ii)) ? 1u : 0u; }
                        const bool take = act && rank < need;
                        const unsigned long long bt = __ballot(take);
                        if (take) so[base + __popcll(bt & ((1ull << lane) - 1ull))] = (bf16)ii;
                        base += __popcll(bt); }
                    if (lane == 0) *nfp = base;
                }
            }
            RAW_BARRIER();
            {
                bf16x8 bqa[4];
#pragma unroll
                for (int ks = 0; ks < 4; ++ks) bqa[ks] = *(const bf16x8*)(AQ + (size_t)(rb + t0 + kl) * 512 + wave * 64 + 16 * ks + 8 * hi);
#pragma unroll
                for (int nt = 0; nt < 4; ++nt) {
                    f32x16 cq;
#pragma unroll
                    for (int r = 0; r < 16; ++r) cq[r] = 0.f;
#pragma unroll
                    for (int ks = 0; ks < 4; ++ks) { const bf16x8 ua = *(const bf16x8*)(UKT + ((size_t)wave * 128 + 32 * nt + kl) * 64 + 16 * ks + 8 * hi); cq = __builtin_amdgcn_mfma_f32_32x32x16_bf16(ua, bqa[ks], cq, 0, 0, 0); }
                    bf16* qrow = QLS + (size_t)kl * 1024 + wave * 128 + 32 * nt + 4 * hi;
#pragma unroll
                    for (int g4 = 0; g4 < 4; ++g4) { v2u w; w.x = pk2(cq[4 * g4], cq[4 * g4 + 1]); w.y = pk2(cq[4 * g4 + 2], cq[4 * g4 + 3]); *(v2u*)(qrow + 8 * g4) = w; }
                }
                asm volatile("s_waitcnt vmcnt(0)" ::: "memory");
                __builtin_amdgcn_fence(__ATOMIC_RELEASE, "workgroup");
                RAW_BARRIER();
                __builtin_amdgcn_fence(__ATOMIC_ACQUIRE, "workgroup");
            }
#pragma unroll 1
            for (int rep9 = 0; rep9 < ((PROBE == 9 || PROBE == 10 || PROBE == 11) ? 2 : 1); ++rep9) {
                bf16* OUTP_ = ((PROBE == 9 || PROBE == 10 || PROBE == 11) && rep9 == 0) ? OUTA2 : OUTA;
                LAS unsigned char* gb = lds + wave * 16384;
                LAS bf16* bkt = (LAS bf16*)(lds + A_BKT + wave * 512);
#pragma unroll 1
                for (int q4 = 0; q4 < 4; ++q4) { int ns = (int)((const LAS unsigned*)(lds + A_BIAS + 1024))[wave * 4 + q4]; ns = ns < TOPK ? ns : TOPK; LAS bf16* so = (LAS bf16*)(lds + A_SEL + (wave * 4 + q4) * 512);
                    for (int i = lane; i < TOPK; i += 64) if (i >= ns) so[i] = 0; }
                asm volatile("s_waitcnt lgkmcnt(0)" ::: "memory");
                const int c15 = lane & 15, g = lane >> 4, q_ = c15 >> 2, p_ = c15 & 3, hc = c15 < 8 ? c15 : 7;
                const int Xr = ((c15 & 3) << 2) | ((c15 >> 2) & 3), Xt = (q_ << 2) | g;
                unsigned ra[4], ta[8];
#pragma unroll
                for (int ks = 0; ks < 4; ++ks) ra[ks] = (unsigned)(256 * c15 + 16 * ((4 * ks + g) ^ Xr));
#pragma unroll
                for (int dt = 0; dt < 8; ++dt) ta[dt] = (unsigned)(256 * (4 * g + q_) + 16 * ((2 * dt + (p_ >> 1)) ^ Xt) + 8 * (p_ & 1));
                bf16x8 bbf;
                { v4u w; const LAS float* bl = biasl + (8 * g) * 8 + hc;
                  constexpr float BS = 8.0f / LOG2E;
                  w.x = pk2(bl[0] * BS, bl[8] * BS); w.y = pk2(bl[16] * BS, bl[24] * BS); w.z = pk2(bl[32] * BS, bl[40] * BS); w.w = pk2(bl[48] * BS, bl[56] * BS); bbf = __builtin_bit_cast(bf16x8, w); }
#define MA_GATHER(q4_, c8_, buf_) do { const LAS bf16* so_ = (const LAS bf16*)(lds + A_SEL + (wave * 4 + (q4_)) * 512) + (c8_) * 32; \
                    int idx_[8]; _Pragma("unroll") for (int i_ = 0; i_ < 8; ++i_) idx_[i_] = (PROBE == 10 && rep9 == 0) ? (4 * i_ + (lane >> 4)) : (int)so_[4 * i_ + (lane >> 4)]; \
                    asm volatile("s_waitcnt lgkmcnt(0)" : "+v"(idx_[0]), "+v"(idx_[1]), "+v"(idx_[2]), "+v"(idx_[3]), "+v"(idx_[4]), "+v"(idx_[5]), "+v"(idx_[6]), "+v"(idx_[7]) :: "memory"); \
                    _Pragma("unroll") for (int i_ = 0; i_ < 8; ++i_) { const int row_ = 4 * i_ + (lane >> 4); \
                        const int ch_ = (lane & 15) ^ (((row_ & 3) << 2) | ((row_ >> 2) & 3)); \
                        glds16(KVN + (size_t)(rb + idx_[i_]) * 128 + ch_ * 8, gb + (buf_) * 8192 + i_ * 1024); } } while (0)
                MA_GATHER(0, 0, 0);
#pragma unroll 1
                for (int q4 = 0; q4 < 4; ++q4) {
                    const int t = tw + q4; int ns = (int)((const LAS unsigned*)(lds + A_BIAS + 1024))[wave * 4 + q4]; ns = ns < TOPK ? ns : TOPK;
                    const LAS bf16* so = (const LAS bf16*)(lds + A_SEL + (wave * 4 + q4) * 512);
                    for (int i = lane; i < TOPK; i += 64) { const int d = t - (int)so[i]; lds_st_b16_asm(bkt + i, (unsigned)rel_bucket(d < 0 ? 0 : d)); }
                    bf16x8 bq[4];
#pragma unroll
                    for (int ks = 0; ks < 4; ++ks) { bq[ks] = (bf16x8){0, 0, 0, 0, 0, 0, 0, 0}; if (c15 < 8) bq[ks] = *(const bf16x8*)(QLS + (size_t)(4 * wave + q4) * 1024 + c15 * 128 + 32 * ks + 8 * g); }
                    f32x4 O[8];
#pragma unroll
                    for (int dt = 0; dt < 8; ++dt) O[dt] = (f32x4){0.f, 0.f, 0.f, 0.f};
                    float mref = -INFINITY, lsum = 0.f;
#pragma unroll 1
                    for (int c8 = 0; c8 < 8; ++c8) {
                        const int step = q4 * 8 + c8, buf = step & 1;
#if AGATHER_POS == 0
                        asm volatile("s_waitcnt lgkmcnt(0)" ::: "memory");
                        if (step + 1 < 32) { MA_GATHER((step + 1) >> 3, (step + 1) & 7, buf ^ 1); asm volatile("s_waitcnt vmcnt(8)" ::: "memory"); }
                        else asm volatile("s_waitcnt vmcnt(0)" ::: "memory");
#else
                        asm volatile("s_waitcnt vmcnt(0) lgkmcnt(0)" ::: "memory");
#endif
                        const LAS unsigned char* cb = gb + buf * 8192;
                        if (PROBE == 11 && rep9 == 0) continue;
                        f32x4 sv[2];
#pragma unroll
                        for (int tau = 0; tau < 2; ++tau) {
                            f32x4 sa = (f32x4){0.f, 0.f, 0.f, 0.f};
#pragma unroll
                            for (int ks = 0; ks < 4; ++ks) { const bf16x8 kf = *(const LAS bf16x8*)(cb + ra[ks] + 4096 * tau); sa = __builtin_amdgcn_mfma_f32_16x16x32_bf16(kf, bq[ks], sa, 0, 0, 0); }
                            const int b = (int)bkt[c8 * 32 + 16 * tau + c15];
                            const unsigned val = ((b >> 3) == g) ? (0x3F80u << ((b & 1) * 16)) : 0u; const int di = (b >> 1) & 3;
                            v4u oh; oh.x = (di == 0) ? val : 0u; oh.y = (di == 1) ? val : 0u; oh.z = (di == 2) ? val : 0u; oh.w = (di == 3) ? val : 0u;
                            sa = __builtin_amdgcn_mfma_f32_16x16x32_bf16(__builtin_bit_cast(bf16x8, oh), bbf, sa, 0, 0, 0);
                            sv[tau] = sa * C2;
                        }
                        if (ns < TOPK) {
#pragma unroll
                            for (int tau = 0; tau < 2; ++tau)
#pragma unroll
                                for (int r = 0; r < 4; ++r) if (c8 * 32 + 16 * tau + 4 * g + r >= ns) sv[tau][r] = -INFINITY;
                        }
                        float rm = fmaxf(fmaxf(fmaxf(sv[0][0], sv[0][1]), fmaxf(sv[0][2], sv[0][3])), fmaxf(fmaxf(sv[1][0], sv[1][1]), fmaxf(sv[1][2], sv[1][3])));
                        rm = swap_max(swap16_max(rm));
                        if (__any(rm > mref + THR)) {
                            const float mn = fmaxf(mref, rm), f = (mn == -INFINITY) ? 1.f : __builtin_amdgcn_exp2f(mref - mn);
                            lsum *= f; mref = mn;
#pragma unroll
                            for (int dt = 0; dt < 8; ++dt) O[dt] = O[dt] * f;
                        }
                        const float msub = (mref == -INFINITY) ? 0.f : mref;
                        float ps = 0.f;
#pragma unroll
                        for (int tau = 0; tau < 2; ++tau)
#pragma unroll
                            for (int r = 0; r < 4; ++r) { sv[tau][r] = __builtin_amdgcn_exp2f(sv[tau][r] - msub); ps += sv[tau][r]; }
                        lsum += ps;
#if AGATHER_POS == 1
                        if (step + 1 < 32 && !(PROBE == 11 && rep9 == 0)) { MA_GATHER((step + 1) >> 3, (step + 1) & 7, buf ^ 1); }
#endif
                        bf16x8 pf;
                        { v4u w; w.x = cvtpk(sv[0][0], sv[0][1]); w.y = cvtpk(sv[0][2], sv[0][3]); w.z = cvtpk(sv[1][0], sv[1][1]); w.w = cvtpk(sv[1][2], sv[1][3]); pf = __builtin_bit_cast(bf16x8, w); }
                        {
                            const unsigned cbu = (unsigned)(uintptr_t)cb;
                            s16x4 fa[8], fb[8];
#pragma unroll
                            for (int dt = 0; dt < 4; ++dt) { TRV(fa[2 * dt], cbu + ta[dt], 0); TRV(fa[2 * dt + 1], cbu + ta[dt], 4096); }
#pragma unroll
                            for (int dt = 0; dt < 4; ++dt) { TRV(fb[2 * dt], cbu + ta[4 + dt], 0); TRV(fb[2 * dt + 1], cbu + ta[4 + dt], 4096); }
                            LGKM_WAIT8(8, fa);
#pragma unroll
                            for (int dt = 0; dt < 4; ++dt) O[dt] = __builtin_amdgcn_mfma_f32_16x16x32_bf16(VFRAG(fa, dt), pf, O[dt], 0, 0, 0);
                            LGKM_WAIT8(0, fb);
#pragma unroll
                            for (int dt = 0; dt < 4; ++dt) O[4 + dt] = __builtin_amdgcn_mfma_f32_16x16x32_bf16(VFRAG(fb, dt), pf, O[4 + dt], 0, 0, 0);
                        }
                    }
                    const float lt = swap_add(swap16_add(lsum));
                    const float inv = 1.0f / lt;
                    if (c15 < 8) { bf16* orow = OUTP_ + (size_t)(rb + t) * 1024 + c15 * 128 + 4 * g;
#pragma unroll
                        for (int dt = 0; dt < 8; ++dt) { v2u w; w.x = pk2(O[dt][0] * inv, O[dt][1] * inv); w.y = pk2(O[dt][2] * inv, O[dt][3] * inv); *(v2u*)(orow + 16 * dt) = w; } }
                }
#undef MA_GATHER
                asm volatile("s_waitcnt vmcnt(0)" ::: "memory");
            }
        }
    }
}
#define Y_() (WSP() + WS_Y)
#define WL_(l) (WSP() + WS_W + (size_t)(l) * W_LAYER)
#define MOD_(l) ((const float*)(WSP() + WS_MOD) + (size_t)(l) * 8 * 6144)
#define T_() ((const float*)(WSP() + WS_TAB))
#define H_() ((bf16*)(WSP() + WS_H))
#define KVN_() ((bf16*)(WSP() + WS_KVN))
#define KMAXW_(l, ch) ((unsigned*)(WSP() + WS_CTL) + 8192 + ((l) * NCH + (ch)) * 64)
#define LAMI_(l) (((l) == 0) ? 0.8f : 0.64449093f)
__device__ __forceinline__ int tidx(int w) { int t = (int)threadIdx.x; (void)w; asm volatile("" : "+v"(t)); return t; }
#define TID_ tidx(wave)
#define LANE_ (tidx(wave) & 63)
#ifndef STAGGER_TICKS
#define STAGGER_TICKS 0
#endif
#ifndef P1_ALIGN
#define P1_ALIGN true
#endif
#define GBAR() do { xcd_barrier(bar); if (PROBE == 16) xcd_barrier(bar); } while (0)
__global__ void __launch_bounds__(NTHREADS, 2) fwd(Args a) {
    extern __shared__ __attribute__((aligned(16))) unsigned char lds_raw[];
    LAS unsigned char* lds = (LAS unsigned char*)lds_raw;
    const int wave = __builtin_amdgcn_readfirstlane((int)threadIdx.x >> 6);
    const int G = gridDim.x, gw = blockIdx.x * NWAVES + wave, NGW = G * NWAVES;
    for (int u = (int)threadIdx.x; u < (LDS_BYTES - LDSCTL_OFF) / 4; u += NTHREADS) ((LAS unsigned*)(lds + LDSCTL_OFF))[u] = 0u;
    __syncthreads();
    XcdBarrier bar = xcd_barrier_post((unsigned*)(WSP() + WS_CTL) + CW_BAR, (volatile LAS unsigned*)(lds + LDSCTL_OFF), wave);

#pragma unroll 1
    for (int rep = 0; rep < (PROBE == 5 ? 2 : 1); ++rep) {
    p0a_prologue(WSP(), lds, TID_, LANE_, wave, G);
    GBAR(); }
    norm_rows(ARG(0), H_(), ARG(4), MOD_(0) + 0 * 1024, MOD_(0) + 1 * 1024, gw, NGW, LANE_);
    GBAR();

#pragma unroll 1
    for (int l = 0; l < NL; ++l) {
#pragma unroll 1
        for (int ch = 0; ch < NCH; ++ch) {
            { pg8::Gemm g{H_() + (size_t)ch * CHR * 1024, (const bf16*)(WL_(l) + W_IN), CHR, NIN, 1024}; pg8::StaticOrder S; S.init(CHR, NIN, G, (int)blockIdx.x);
              pg8::EpiIn E{Y_(), 0};
#if STAGGER_TICKS > 0
              { const unsigned long long t0 = __builtin_amdgcn_s_memrealtime(); const unsigned long long dl = (unsigned long long)((blockIdx.x >> 3) & 3u) * STAGGER_TICKS;
                while (__builtin_amdgcn_s_memrealtime() - t0 < dl) __builtin_amdgcn_s_sleep(8); }
#endif
#pragma unroll 1
              for (int rep = 0; rep < ((PROBE == 1 || PROBE == 17 || PROBE == 19) ? 2 : 1); ++rep) {
              E.skip = (PROBE == 19 && rep == 0) ? 1 : 0;
              pg8::gemm_phase<pg8::EpiIn, pg8::StaticOrder, P1_ALIGN, true>(lds, g, S, E, wave); }
            }
            GBAR();
            kvn_rows(Y_(), KVN_(), ARG(8) + l * 128, KMAXW_(l, ch), gw, NGW, LANE_);
#if PROBE == 4
            mixC_fast(Y_(), WSP(), T_(), lds, TID_, LANE_, wave, G);
#endif
            mixC_fast(Y_(), WSP(), T_(), lds, TID_, LANE_, wave, G);
#if PROBE == 2 || (PROBE >= 12 && PROBE <= 15)
            mixB_fast<(PROBE == 2 ? 0 : PROBE - 11)>(Y_(), (bf16*)(WSP() + 484 * MiB), T_(), ARG(13) + l * 128, ((const float*)(WSP() + WS_LAM))[l], LAMI_(l), lds, TID_, LANE_, wave, G);
#endif
            mixB_fast<0>(Y_(), (bf16*)(Y_() + Y_BQ), T_(), ARG(13) + l * 128, ((const float*)(WSP() + WS_LAM))[l], LAMI_(l), lds, TID_, LANE_, wave, G);
            GBAR();
            mergeC(Y_(), WSP(), gw, NGW, LANE_);
#if PROBE == 3 || PROBE == 9 || PROBE == 10 || PROBE == 11
            GBAR();
#endif
#if PROBE == 3
            mixA_fast(Y_(), (bf16*)(WSP() + WS_OG), (bf16*)(WSP() + WS_OG), KVN_(), (const bf16*)(WL_(l) + W_UKT), T_(), ARG(21), KMAXW_(l, ch), lds, TID_, LANE_, wave, G);
#endif
            mixA_fast(Y_(), (bf16*)(Y_() + Y_OLAT), (bf16*)(WSP() + WS_OG), KVN_(), (const bf16*)(WL_(l) + W_UKT), T_(), ARG(21), KMAXW_(l, ch), lds, TID_, LANE_, wave, G);
            GBAR();
#pragma unroll 1
            for (int rep = 0; rep < (PROBE == 7 ? 2 : 1); ++rep)
            { pg8::StaticOrder S; S.init(CHR, 1024, G, (int)blockIdx.x);
              { unsigned char* y = Y_(); pg8::Gemm g{(const bf16*)(y + Y_OLAT), (const bf16*)(WL_(l) + W_A), CHR, 1024, 1024}; pg8::EpiGate<0> E{(const bf16*)(y + Y_Z), 0, (float*)(y + Y_MF32), (bf16*)(y + Y_MBF)};
                pg8::gemm_phase<pg8::EpiGate<0>, pg8::StaticOrder, true, true>(lds, g, S, E, wave); }
              { unsigned char* y = Y_(); pg8::Gemm g{(const bf16*)(y + Y_BQ), (const bf16*)(WL_(l) + W_B), CHR, 1024, 512}; pg8::EpiGate<1> E{(const bf16*)(y + Y_Z), 1024, (float*)(y + Y_MF32), (bf16*)(y + Y_MBF)};
                pg8::gemm_phase<pg8::EpiGate<1>, pg8::StaticOrder, true, true>(lds, g, S, E, wave); }
              { unsigned char* y = Y_(); pg8::Gemm g{(const bf16*)(y + Y_OC), (const bf16*)(WL_(l) + W_C), CHR, 1024, 256}; pg8::EpiGate<2> E{(const bf16*)(y + Y_Z), 2048, (float*)(y + Y_MF32), (bf16*)(y + Y_MBF)};
                pg8::gemm_phase<pg8::EpiGate<2>, pg8::StaticOrder, true, true>(lds, g, S, E, wave); } }
            GBAR();
            { pg8::Gemm g{(const bf16*)(Y_() + Y_MBF), (const bf16*)(WL_(l) + W_OUT), CHR, 1024, 1024}; pg8::StaticOrder S; S.init(CHR, 1024, G, (int)blockIdx.x);
              pg8::EpiRes E{(l == 0) ? ARG(0) : (const float*)OUTP(), OUTP(), MOD_(l) + 2 * 1024, ch * CHR};
              pg8::gemm_phase<pg8::EpiRes, pg8::StaticOrder, true, true>(lds, g, S, E, wave); }
            GBAR();
        }
#pragma unroll 1
        for (int rep = 0; rep < (PROBE == 6 ? 2 : 1); ++rep) {
        norm_rows(OUTP(), H_(), ARG(18) + l * 1024, MOD_(l) + 3 * 1024, MOD_(l) + 4 * 1024, gw, NGW, LANE_);
        GBAR(); }
        { pg8::Gemm g{H_(), (const bf16*)(WL_(l) + W_GU), MT, NGU, 1024}; pg8::StaticOrder S; S.init(MT, NGU, G, (int)blockIdx.x);
          pg8::EpiSwiGLU E{(bf16*)(WSP() + WS_ACT)};
#pragma unroll 1
          for (int rep = 0; rep < ((PROBE == 1 || PROBE == 18) ? 2 : 1); ++rep)
          pg8::gemm_phase<pg8::EpiSwiGLU, pg8::StaticOrder, true, true>(lds, g, S, E, wave);
        }
        GBAR();
        { pg8::Gemm g{(const bf16*)(WSP() + WS_ACT), (const bf16*)(WL_(l) + W_D), MT, 1024, DFF}; pg8::StaticOrder S; S.init(MT, 1024, G, (int)blockIdx.x);
          pg8::EpiRes E{OUTP(), OUTP(), MOD_(l) + 5 * 1024, 0};
          pg8::gemm_phase<pg8::EpiRes, pg8::StaticOrder, true, true>(lds, g, S, E, wave); }
        GBAR();
        if (l + 1 < NL) { norm_rows(OUTP(), H_(), ARG(4) + (l + 1) * 1024, MOD_(l + 1) + 0 * 1024, MOD_(l + 1) + 1 * 1024, gw, NGW, LANE_); GBAR(); }
        else final_rows(OUTP(), ARG(22), gw, NGW, LANE_);
    }
}

extern "C" void kernel_launch(void* const* d_in, const int* in_sizes, int n_in, void* d_out, int out_size, void* d_ws, size_t ws_size, hipStream_t stream) {
    static int grid = 0;
    if (grid == 0) {
        if (n_in != 23 || out_size != MT * DM || ws_size < WS_END) { fprintf(stderr, "kernel_launch: unexpected shapes (n_in %d out %d ws %zu)\n", n_in, out_size, ws_size); grid = -1; return; }
        int dev = 0, cus = 0, per_cu = 0;
        if (hipGetDevice(&dev) != hipSuccess || hipDeviceGetAttribute(&cus, hipDeviceAttributeMultiprocessorCount, dev) != hipSuccess) { grid = -1; return; }
        if (hipFuncSetAttribute((const void*)fwd, hipFuncAttributeMaxDynamicSharedMemorySize, LDS_BYTES) != hipSuccess) { fprintf(stderr, "kernel_launch: hipFuncSetAttribute failed\n"); grid = -1; return; }
        if (hipOccupancyMaxActiveBlocksPerMultiprocessor(&per_cu, (const void*)fwd, NTHREADS, LDS_BYTES) != hipSuccess || per_cu < 1) { fprintf(stderr, "kernel_launch: occupancy query says %d\n", per_cu); }
        (void)hipGetLastError();
        grid = cus;
    }
    if (grid < 0) return;
    (void)hipMemsetAsync((char*)d_ws + WS_CTL, 0, CTL_ZERO_BYTES, stream);
    Args a{};
    for (int i = 0; i < 23; ++i) a.in[i] = (const float*)d_in[i];
    a.out = (float*)d_out; a.ws = (unsigned char*)d_ws; a.pad0 = 0; a.pad1 = 0;
    hipLaunchKernelGGL(fwd, dim3(grid), dim3(NTHREADS), LDS_BYTES, stream, a);
}
```

```cpp
#include <hip/hip_runtime.h>
#include <cstdio>
#include <cstdint>
#ifndef PROBE
#define PROBE 0
#endif
#ifndef DIAG_OFS
#define DIAG_OFS 0.5f
#endif
#ifndef BSTAGE_POS
#define BSTAGE_POS 2
#endif
#ifndef AGATHER_POS
#define AGATHER_POS 1
#endif
namespace pg8 {
#define PG8_LAS __attribute__((address_space(3)))
typedef unsigned short bf16_t;
typedef short bf16x8 __attribute__((ext_vector_type(8)));
typedef float f32x4 __attribute__((ext_vector_type(4)));
typedef unsigned u32x4 __attribute__((ext_vector_type(4)));
constexpr int BM = 256, BK = 64, HALF = 128, HTB = HALF * BK * 2  , STAGE_BYTES = 8 * HTB, NXCD = 8, WGM = 8;

__host__ __device__ __forceinline__ int lds_byte(int r, int c) { const int st = (r >> 4) * 2 + (c >> 5), rr = r & 15, cc = c & 31, ob = rr * 64 + cc * 2; return st * 1024 + (ob ^ (((ob >> 9) & 1) << 5)); }
__host__ __device__ __forceinline__ void stage_rc(int b, int& R, int& C) { const int st = b / 1024, sb = b % 1024, swz = sb ^ (((sb >> 9) & 1) << 5); R = (st >> 1) * 16 + swz / 64; C = (st & 1) * 32 + (swz % 64) / 2; }
__host__ __device__ __forceinline__ int perm32(int rho) { const int n = rho >> 4, i = rho & 15; return 8 * (i >> 2) + 4 * n + (i & 3); }

struct Unit { int pm, pn; };
struct Gemm { const bf16_t* A; const bf16_t* Bt; int M, N, K; };

struct StaticOrder {
    int nM, nN, nwg, G, c;
    __host__ __device__ void init(int M, int N, int G_, int c_) { nM = M / BM; nN = N / BM; nwg = nM * nN; G = G_; c = c_; }
    __host__ __device__ bool next(int i, Unit& u) const {
        const long L = (long)i * G + c; if (L >= nwg) return false;
        int wgid = (int)L; { const int q = nwg / NXCD, r = nwg % NXCD, xcd = wgid % NXCD, off = wgid / NXCD; wgid = (xcd < r ? xcd * (q + 1) : r * (q + 1) + (xcd - r) * q) + off; }
        const int nig = WGM * nN, gid = wgid / nig, fm = gid * WGM, gsz = (nM - fm) < WGM ? (nM - fm) : WGM;
        u.pm = fm + ((wgid % nig) % gsz); u.pn = (wgid % nig) / gsz; return true;
    }
    __device__ __forceinline__ void a_ready(const Unit&) const {}
    __device__ __forceinline__ void done(const Unit&) const {}
};

template <class Epi, class Sched, bool ALIGN_EPI = false, bool SP2 = false>
__device__ __forceinline__ void gemm_phase(PG8_LAS unsigned char* lds, const Gemm g, const Sched& S, const Epi& E, int wv) {
    int tid_l = threadIdx.x; (void)wv; asm volatile("" : "+v"(tid_l));
    const int tid = tid_l, wid = __builtin_amdgcn_readfirstlane(tid >> 6), lane = tid & 63, wr = wid >> 2, wc = wid & 3, fr = lane & 15, fq = lane >> 4;
    int K_l = g.K; asm volatile("" : "+s"(K_l));
    const int K = K_l, nt = K / BK;
    unsigned voffA[2], voffB[2];
#pragma unroll
    for (int i = 0; i < 2; ++i) { int R, C; stage_rc(tid * 16 + i * 8192, R, C); const int Rb = Epi::PERM ? ((R & ~31) + perm32(R & 31)) : R;
        voffA[i] = (unsigned)(R * K + C) * 2u; voffB[i] = (unsigned)(Rb * K + C) * 2u; }
    const size_t kstep = (size_t)(BK * 2);
    const size_t hstep = (size_t)HALF * K * 2;
    const size_t tstep = 2 * hstep;
    const unsigned ldsw = (unsigned)wid * 1024u;
    const int aoff = lds_byte(wr * 64 + fr, fq * 8), boff = lds_byte(wc * 32 + fr, fq * 8);
#define PG8_SA(b, h) (((b) * 2 + (h)) * HTB)
#define PG8_SB(b, h) ((4 + (b) * 2 + (h)) * HTB)
#define PG8_STAGE(bufoff, gbase, voff) do { _Pragma("unroll") for (int _i = 0; _i < 2; ++_i) \
        __builtin_amdgcn_global_load_lds((const unsigned*)((const char*)(gbase) + (voff)[_i]), (PG8_LAS unsigned*)(lds + (bufoff) + ldsw + _i * 8192), 16, 0, 0); } while (0)
#define PG8_LDA(dst, b, h) do { _Pragma("unroll") for (int m = 0; m < 4; ++m) _Pragma("unroll") for (int k = 0; k < 2; ++k) dst[m][k] = *(const PG8_LAS bf16x8*)(lds + PG8_SA(b, h) + aoff + m * 2048 + k * 1024); } while (0)
#define PG8_LDB(dst, b, h) do { _Pragma("unroll") for (int n = 0; n < 2; ++n) _Pragma("unroll") for (int k = 0; k < 2; ++k) dst[n][k] = *(const PG8_LAS bf16x8*)(lds + PG8_SB(b, h) + boff + n * 2048 + k * 1024); } while (0)
#define PG8_MMA(ai, bj, At, Bt) do { __builtin_amdgcn_s_setprio(1); _Pragma("unroll") for (int m = 0; m < 4; ++m) _Pragma("unroll") for (int n = 0; n < 2; ++n) _Pragma("unroll") for (int k = 0; k < 2; ++k) \
        acc[ai][bj][m][n] = __builtin_amdgcn_mfma_f32_16x16x32_bf16(Bt[n][k], At[m][k], acc[ai][bj][m][n], 0, 0, 0); __builtin_amdgcn_s_setprio(0); } while (0)
#define PG8_WAIT_V(n) asm volatile("s_waitcnt vmcnt(" #n ")" ::: "memory")
#define PG8_WAIT_L(n) asm volatile("s_waitcnt lgkmcnt(" #n ")" ::: "memory")
#define PG8_BAR __builtin_amdgcn_s_barrier()
#define PG8_SCHED __builtin_amdgcn_sched_barrier(0)
    Unit cur, nxt; int ui = 0;
    if (!S.next(0, cur)) return;
    f32x4 acc[2][2][4][2];
#pragma unroll
    for (int a = 0; a < 2; ++a)
#pragma unroll
        for (int b = 0; b < 2; ++b)
#pragma unroll
            for (int m = 0; m < 4; ++m)
#pragma unroll
                for (int n = 0; n < 2; ++n) acc[a][b][m][n] = (f32x4){0.f, 0.f, 0.f, 0.f};
    bf16x8 At[4][2], B0[2][2], B1[2][2];
    const char* cA = (const char*)g.A + (size_t)cur.pm * tstep; const char* cB = (const char*)g.Bt + (size_t)cur.pn * tstep;
    S.a_ready(cur);
    if constexpr (SP2) {
        PG8_STAGE(PG8_SB(0, 0), cB, voffB); PG8_STAGE(PG8_SB(0, 1), cB + hstep, voffB); PG8_STAGE(PG8_SA(0, 0), cA, voffA); PG8_STAGE(PG8_SA(0, 1), cA + hstep, voffA);
        if (wr == 1) PG8_BAR;
        PG8_WAIT_V(2); PG8_BAR;
        PG8_STAGE(PG8_SB(1, 0), cB + kstep, voffB); PG8_STAGE(PG8_SA(1, 0), cA + kstep, voffA); PG8_STAGE(PG8_SB(1, 1), cB + hstep + kstep, voffB);
        PG8_WAIT_V(6); PG8_BAR;
    } else {
        PG8_STAGE(PG8_SB(0, 0), cB, voffB); PG8_STAGE(PG8_SA(0, 0), cA, voffA); PG8_STAGE(PG8_SB(0, 1), cB + hstep, voffB); PG8_STAGE(PG8_SA(0, 1), cA + hstep, voffA);
        if (wr == 1) PG8_BAR;
        PG8_WAIT_V(4); PG8_BAR;
        PG8_STAGE(PG8_SB(1, 0), cB + kstep, voffB); PG8_STAGE(PG8_SA(1, 0), cA + kstep, voffA); PG8_STAGE(PG8_SB(1, 1), cB + hstep + kstep, voffB);
        PG8_WAIT_V(6); PG8_BAR;
    }
    for (;;) {
        const bool has_next = S.next(ui + 1, nxt);
        const char* nA = has_next ? (const char*)g.A + (size_t)nxt.pm * tstep : cA; const char* nB = has_next ? (const char*)g.Bt + (size_t)nxt.pn * tstep : cB;
        for (int t = 0; t < nt; t += 2) {
            const bool last = (t == nt - 2);
            const char* a1 = cA + (size_t)(t + 1) * kstep;
            const char* a2 = last ? nA : cA + (size_t)(t + 2) * kstep; const char* b2 = last ? nB : cB + (size_t)(t + 2) * kstep;
            const char* a3 = a2 + kstep; const char* b3 = b2 + kstep;
            if (last && has_next) S.a_ready(nxt);
            if constexpr (SP2) {
            PG8_LDB(B0, 0, 0); PG8_LDB(B1, 0, 1); PG8_SCHED; PG8_LDA(At, 0, 0); PG8_STAGE(PG8_SA(1, 1), a1 + hstep, voffA);
            PG8_WAIT_V(8); PG8_WAIT_L(0); PG8_BAR; PG8_MMA(0, 0, At, B0); PG8_MMA(0, 1, At, B1); PG8_BAR; PG8_SCHED;
            PG8_LDA(At, 0, 1); PG8_STAGE(PG8_SB(0, 0), b2, voffB); PG8_STAGE(PG8_SB(0, 1), b2 + hstep, voffB); PG8_STAGE(PG8_SA(0, 0), a2, voffA);
            PG8_WAIT_V(8); PG8_WAIT_L(0); PG8_BAR; PG8_MMA(1, 0, At, B0); PG8_MMA(1, 1, At, B1); PG8_BAR; PG8_SCHED;
            PG8_LDB(B0, 1, 0); PG8_LDB(B1, 1, 1); PG8_SCHED; PG8_LDA(At, 1, 0); PG8_STAGE(PG8_SA(0, 1), a2 + hstep, voffA);
            PG8_WAIT_V(8); PG8_WAIT_L(0); PG8_BAR; PG8_MMA(0, 0, At, B0); PG8_MMA(0, 1, At, B1); PG8_BAR; PG8_SCHED;
            PG8_LDA(At, 1, 1); PG8_STAGE(PG8_SB(1, 0), b3, voffB); PG8_STAGE(PG8_SB(1, 1), b3 + hstep, voffB); PG8_STAGE(PG8_SA(1, 0), a3, voffA);
            PG8_WAIT_V(8); PG8_WAIT_L(0); PG8_BAR; PG8_MMA(1, 0, At, B0); PG8_MMA(1, 1, At, B1); PG8_BAR; PG8_SCHED;
            } else {
            PG8_LDB(B0, 0, 0); PG8_SCHED; PG8_LDA(At, 0, 0); PG8_STAGE(PG8_SA(1, 1), a1 + hstep, voffA);
            PG8_WAIT_L(8); PG8_BAR; PG8_WAIT_L(0); PG8_MMA(0, 0, At, B0); PG8_BAR; PG8_SCHED;
            PG8_LDB(B1, 0, 1); PG8_STAGE(PG8_SB(0, 0), b2, voffB);
            PG8_BAR; PG8_WAIT_L(0); PG8_MMA(0, 1, At, B1); PG8_BAR;
            PG8_LDA(At, 0, 1); PG8_STAGE(PG8_SA(0, 0), a2, voffA);
            PG8_BAR; PG8_WAIT_L(0); PG8_MMA(1, 0, At, B0); PG8_BAR; PG8_SCHED;
            PG8_STAGE(PG8_SB(0, 1), b2 + hstep, voffB);
            PG8_WAIT_V(6); PG8_BAR; PG8_MMA(1, 1, At, B1); PG8_BAR;
            PG8_LDB(B0, 1, 0); PG8_SCHED; PG8_LDA(At, 1, 0); PG8_STAGE(PG8_SA(0, 1), a2 + hstep, voffA);
            PG8_WAIT_L(8); PG8_BAR; PG8_WAIT_L(0); PG8_MMA(0, 0, At, B0); PG8_BAR; PG8_SCHED;
            PG8_LDB(B1, 1, 1); PG8_STAGE(PG8_SB(1, 0), b3, voffB);
            PG8_BAR; PG8_WAIT_L(0); PG8_MMA(0, 1, At, B1); PG8_BAR;
            PG8_LDA(At, 1, 1); PG8_STAGE(PG8_SA(1, 0), a3, voffA);
            PG8_BAR; PG8_WAIT_L(0); PG8_MMA(1, 0, At, B0); PG8_BAR; PG8_SCHED;
            PG8_STAGE(PG8_SB(1, 1), b3 + hstep, voffB);
            PG8_WAIT_V(6); PG8_BAR; PG8_MMA(1, 1, At, B1); PG8_BAR;
            }
        }
        if constexpr (ALIGN_EPI) { if (wr == 0) PG8_BAR; }
        if constexpr (!Epi::AFTER_DRAIN) { E(acc, cur, wr, wc, fr, fq); S.done(cur); }
        if (!has_next) break;
#pragma unroll
        for (int a = 0; a < 2; ++a)
#pragma unroll
            for (int b = 0; b < 2; ++b)
#pragma unroll
                for (int m = 0; m < 4; ++m)
#pragma unroll
                    for (int n = 0; n < 2; ++n) acc[a][b][m][n] = (f32x4){0.f, 0.f, 0.f, 0.f};
        cur = nxt; cA = nA; cB = nB; ++ui;
        if constexpr (ALIGN_EPI) { if (wr == 1) PG8_BAR; }
    }
    PG8_WAIT_V(0);
    if constexpr (!ALIGN_EPI) { if (wr == 0) PG8_BAR; }
    PG8_BAR;
    if constexpr (Epi::AFTER_DRAIN) { E.fused(acc, cur, wr, wc, fr, fq, lds, wid, lane); S.done(cur); }
#undef PG8_SA
#undef PG8_SB
#undef PG8_STAGE
#undef PG8_LDA
#undef PG8_LDB
#undef PG8_MMA
#undef PG8_WAIT_V
#undef PG8_WAIT_L
#undef PG8_BAR
#undef PG8_SCHED
}
}

constexpr int NB = 8, SEQ = 4096, DM = 1024, MT = NB * SEQ, NL = 2;
constexpr int CHB = 4, CHR = CHB * SEQ, NCH = NB / CHB;
constexpr int NIN = 8192, DFF = 2816, NGU = 2 * DFF, WIN_SRC = 8136;
constexpr int TOPK = 256;
constexpr float EPS = 1e-6f;
constexpr int NWAVES = 8, NTHREADS = 512;

constexpr size_t MiB = 1u << 20;
constexpr size_t WS_CTL = 0, CTL_ZERO_BYTES = 1 * MiB;
constexpr size_t WS_MOD = 1 * MiB;
constexpr size_t WS_TAB = WS_MOD + 393216;
constexpr size_t WS_LAM = WS_TAB + 393216;
constexpr size_t WS_W = 2 * MiB, W_LAYER = 39 * MiB;
constexpr size_t W_IN = 0, W_UKT = 16 * MiB  , W_A = 17 * MiB, W_B = 19 * MiB, W_C = 20 * MiB, W_OUT = 20 * MiB + 512 * 1024, W_GU = 22 * MiB + 512 * 1024, W_D = 33 * MiB + 512 * 1024;
constexpr size_t WS_H = 80 * MiB;
constexpr size_t WS_Y = 144 * MiB;
constexpr size_t Y_QLAT = 0, Y_MISC = 32 * MiB, Y_IQ = 40 * MiB, Y_BQ = 56 * MiB, Y_BK = 72 * MiB, Y_BV = 88 * MiB, Y_CQ = 104 * MiB, Y_CK = 128 * MiB, Y_CV = 152 * MiB, Y_Z = 176 * MiB, Y_OC = 272 * MiB;
constexpr size_t Y_AQ = Y_QLAT, Y_QLS = Y_QLAT + 16 * MiB, Y_OLAT = Y_CQ;
constexpr size_t Y_MF32 = Y_CQ, Y_MBF = Y_BK;
constexpr size_t WS_ACT = WS_Y;
constexpr size_t WS_KVN = 424 * MiB;
constexpr size_t WS_END = 500 * MiB;
constexpr int CW_BAR = 4096;

#define GAS __attribute__((address_space(1)))
#define LAS __attribute__((address_space(3)))
typedef unsigned short bf16;
typedef unsigned v4u __attribute__((ext_vector_type(4)));
typedef unsigned v2u __attribute__((ext_vector_type(2)));
typedef float f32x4 __attribute__((ext_vector_type(4)));

__device__ __forceinline__ unsigned f2bf(float f) { unsigned u = __builtin_bit_cast(unsigned, f); return (u + 0x7fffu + ((u >> 16) & 1u)) >> 16; }
typedef float f32x2_c __attribute__((ext_vector_type(2))); typedef __bf16 bf16x2_c __attribute__((ext_vector_type(2)));
__device__ __forceinline__ unsigned pk2(float lo, float hi) { const f32x2_c v = {lo, hi}; const bf16x2_c b = __builtin_convertvector(v, bf16x2_c); return __builtin_bit_cast(unsigned, b); }
__device__ __forceinline__ float bflo(unsigned w) { return __uint_as_float(w << 16); }
__device__ __forceinline__ float bfhi(unsigned w) { return __uint_as_float(w & 0xffff0000u); }
__device__ __forceinline__ float bf2f(bf16 h) { return __uint_as_float((unsigned)h << 16); }
__device__ __forceinline__ float wave_sum(float v) {
#pragma unroll
    for (int o = 1; o < 64; o <<= 1) v += __shfl_xor(v, o);
    return v;
}
__device__ __forceinline__ float wave_max(float v) {
#pragma unroll
    for (int o = 1; o < 64; o <<= 1) v = fmaxf(v, __shfl_xor(v, o));
    return v;
}
__device__ __forceinline__ float sigmoidf_(float v) { return __builtin_amdgcn_rcpf(1.f + __expf(-v)); }

namespace pg8 {
struct EpiIn {
    static constexpr bool PERM = true, AFTER_DRAIN = false;
    unsigned char* y; int skip;
    __device__ __forceinline__ void operator()(const f32x4 (&acc)[2][2][4][2], const Unit& u, int wr, int wc, int fr, int fq) const {
        if (skip) return;
        const int pn = u.pn; size_t off; int ld, c0; bool sig = false;
        if (pn < 2)        { off = Y_AQ;   ld = 512;  c0 = pn * 256; }
        else if (pn == 2)  { off = Y_MISC; ld = 256;  c0 = 0; }
        else if (pn < 5)   { off = Y_IQ;   ld = 512;  c0 = (pn - 3) * 256; }
        else if (pn < 7)   { off = Y_BQ;   ld = 512;  c0 = (pn - 5) * 256; }
        else if (pn < 9)   { off = Y_BK;   ld = 512;  c0 = (pn - 7) * 256; }
        else if (pn < 11)  { off = Y_BV;   ld = 512;  c0 = (pn - 9) * 256; }
        else if (pn < 14)  { off = Y_CQ;   ld = 768;  c0 = (pn - 11) * 256; }
        else if (pn < 17)  { off = Y_CK;   ld = 768;  c0 = (pn - 14) * 256; }
        else if (pn < 20)  { off = Y_CV;   ld = 768;  c0 = (pn - 17) * 256; }
        else               { off = Y_Z;    ld = 3072; c0 = (pn - 20) * 256; sig = true; }
        bf16_t* base = (bf16_t*)(y + off); const bool qsc = (pn == 5 || pn == 6 || (pn >= 11 && pn < 14));
        const int row0 = u.pm * BM + wr * 64 + fr, col0 = c0 + wc * 32 + 8 * fq;
#pragma unroll
        for (int ai = 0; ai < 2; ++ai)
#pragma unroll
            for (int m = 0; m < 4; ++m) { bf16_t* rowp = base + (size_t)(row0 + ai * HALF + m * 16) * ld + col0;
#pragma unroll
                for (int bj = 0; bj < 2; ++bj) { f32x4 v0 = acc[ai][bj][m][0], v1 = acc[ai][bj][m][1];
                    if (sig) {
#pragma unroll
                        for (int i = 0; i < 4; ++i) { v0[i] = sigmoidf_(v0[i]); v1[i] = sigmoidf_(v1[i]); } }
                    else if (qsc) {
#pragma unroll
                        for (int i = 0; i < 4; ++i) { v0[i] *= 0.125f * 1.4426950408889634f; v1[i] *= 0.125f * 1.4426950408889634f; } }
                    u32x4 w; w.x = pk2(v0[0], v0[1]); w.y = pk2(v0[2], v0[3]); w.z = pk2(v1[0], v1[1]); w.w = pk2(v1[2], v1[3]);
                    *(u32x4*)(rowp + bj * HALF) = w; } }
    }
};
template <int MODE> struct EpiGate {
    static constexpr bool PERM = true, AFTER_DRAIN = false;
    const bf16_t* z; int zc0; float* mf; bf16_t* mb;
    __device__ __forceinline__ void operator()(const f32x4 (&acc)[2][2][4][2], const Unit& u, int wr, int wc, int fr, int fq) const {
        const int row0 = u.pm * BM + wr * 64 + fr, col0 = u.pn * BM + wc * 32 + 8 * fq;
#pragma unroll
        for (int ai = 0; ai < 2; ++ai)
#pragma unroll
            for (int m = 0; m < 4; ++m) { const size_t row = (size_t)(row0 + ai * HALF + m * 16);
#pragma unroll
                for (int bj = 0; bj < 2; ++bj) { const int col = col0 + bj * HALF;
                    const u32x4 zw = *(const u32x4*)(z + row * 3072 + zc0 + col);
                    f32x4 v0 = acc[ai][bj][m][0], v1 = acc[ai][bj][m][1];
                    v0[0] *= __uint_as_float(zw.x << 16); v0[1] *= __uint_as_float(zw.x & 0xffff0000u); v0[2] *= __uint_as_float(zw.y << 16); v0[3] *= __uint_as_float(zw.y & 0xffff0000u);
                    v1[0] *= __uint_as_float(zw.z << 16); v1[1] *= __uint_as_float(zw.z & 0xffff0000u); v1[2] *= __uint_as_float(zw.w << 16); v1[3] *= __uint_as_float(zw.w & 0xffff0000u);
                    bf16_t* mp = mb + row * 1024 + col;
                    if (MODE >= 1) { const u32x4 pw = *(const u32x4*)mp;
                        v0[0] += __uint_as_float(pw.x << 16); v0[1] += __uint_as_float(pw.x & 0xffff0000u); v0[2] += __uint_as_float(pw.y << 16); v0[3] += __uint_as_float(pw.y & 0xffff0000u);
                        v1[0] += __uint_as_float(pw.z << 16); v1[1] += __uint_as_float(pw.z & 0xffff0000u); v1[2] += __uint_as_float(pw.w << 16); v1[3] += __uint_as_float(pw.w & 0xffff0000u); }
                    { u32x4 w; w.x = pk2(v0[0], v0[1]); w.y = pk2(v0[2], v0[3]); w.z = pk2(v1[0], v1[1]); w.w = pk2(v1[2], v1[3]); *(u32x4*)mp = w; } }
                asm volatile("" ::: "memory"); }
    }
};
struct EpiRes {
    static constexpr bool PERM = true, AFTER_DRAIN = false;
    const float* xin; float* xout; const float* gate; int row_off;
    __device__ __forceinline__ void operator()(const f32x4 (&acc)[2][2][4][2], const Unit& u, int wr, int wc, int fr, int fq) const {
        const int row0 = row_off + u.pm * BM + wr * 64 + fr, col0 = u.pn * BM + wc * 32 + 8 * fq;
        const float* gp = gate + (size_t)((row_off + u.pm * BM) / SEQ) * 6144 + col0;
        f32x4 g[2][2];
#pragma unroll
        for (int bj = 0; bj < 2; ++bj) { g[bj][0] = *(const f32x4*)(gp + bj * HALF); g[bj][1] = *(const f32x4*)(gp + bj * HALF + 4); }
#pragma unroll
        for (int ai = 0; ai < 2; ++ai)
#pragma unroll
            for (int m = 0; m < 4; ++m) { const size_t o = (size_t)(row0 + ai * HALF + m * 16) * 1024 + col0;
#pragma unroll
                for (int bj = 0; bj < 2; ++bj) {
                    const f32x4 a0 = *(const f32x4*)(xin + o + bj * HALF), a1 = *(const f32x4*)(xin + o + bj * HALF + 4);
                    *(f32x4*)(xout + o + bj * HALF) = a0 + g[bj][0] * acc[ai][bj][m][0];
                    *(f32x4*)(xout + o + bj * HALF + 4) = a1 + g[bj][1] * acc[ai][bj][m][1]; }
                asm volatile("" ::: "memory"); }
    }
};
struct EpiSwiGLU {
    static constexpr bool PERM = true, AFTER_DRAIN = false;
    bf16_t* act;
    __device__ __forceinline__ void operator()(const f32x4 (&acc)[2][2][4][2], const Unit& u, int wr, int wc, int fr, int fq) const {
        const int row0 = u.pm * BM + wr * 64 + fr, col0 = u.pn * HALF + wc * 32 + 8 * fq;
#pragma unroll
        for (int ai = 0; ai < 2; ++ai)
#pragma unroll
            for (int m = 0; m < 4; ++m) { bf16_t* rowp = act + (size_t)(row0 + ai * HALF + m * 16) * DFF + col0;
                f32x4 v0, v1;
#pragma unroll
                for (int i = 0; i < 4; ++i) { const float g0 = acc[ai][0][m][0][i], g1 = acc[ai][0][m][1][i];
                    v0[i] = g0 * sigmoidf_(g0) * acc[ai][1][m][0][i]; v1[i] = g1 * sigmoidf_(g1) * acc[ai][1][m][1][i]; }
                u32x4 w; w.x = pk2(v0[0], v0[1]); w.y = pk2(v0[2], v0[3]); w.z = pk2(v1[0], v1[1]); w.w = pk2(v1[2], v1[3]);
                *(u32x4*)rowp = w; }
    }
};
}

#define XB_TMO      128
#define XB_XCNT(j)  (256  + 64 * (j))
#define XB_XSUB(j)  (1280 + 64 * (j))
#define XB_XGEN(j)  (2304 + 64 * (j))
#define XB_TOP      3328
#define XB_TOPGEN   3392
#define XCD_BAR_WORDS 3456
#define XB_SPIN_CAP (1u << 24)

__device__ __forceinline__ unsigned xb_ld(unsigned* p)              { return __hip_atomic_load(p, __ATOMIC_RELAXED, __HIP_MEMORY_SCOPE_AGENT); }
__device__ __forceinline__ unsigned xb_add(unsigned* p, unsigned v) { return __hip_atomic_fetch_add(p, v, __ATOMIC_RELAXED, __HIP_MEMORY_SCOPE_AGENT); }
__device__ __forceinline__ unsigned xb_xcc_id() { return (unsigned)__builtin_amdgcn_s_getreg((3 << 11) | 20) & 0xFu; }
#define XB_SPIN(cond, bar) do { unsigned _sp = 0; while (cond) { __builtin_amdgcn_s_sleep(1); \
    if ((++_sp & 255u) == 0u) { if (xb_ld(&(bar)[XB_TMO])) break; if (_sp > XB_SPIN_CAP) { atomicAdd(&(bar)[XB_TMO], 1u); break; } } } } while (0)

__device__ __forceinline__ int lane_id_() { return (int)__builtin_amdgcn_mbcnt_hi(~0u, __builtin_amdgcn_mbcnt_lo(~0u, 0u)); }
struct XcdBarrier { unsigned* bar; unsigned x; volatile LAS unsigned* st; int w; };

__device__ __forceinline__ XcdBarrier xcd_barrier_post(unsigned* bar, volatile LAS unsigned* st, int w) {
    XcdBarrier b; b.bar = bar; b.x = (unsigned)__builtin_amdgcn_readfirstlane((int)xb_xcc_id()); b.st = st; b.w = w;
    if (threadIdx.x == 0) (void)xb_add(&bar[XB_XCNT(b.x)], 1u);
    return b;
}
__device__ __forceinline__ void xcd_barrier_complete(unsigned* bar, unsigned x, unsigned& nloc, unsigned& nx) {
    const unsigned G = gridDim.x * gridDim.y * gridDim.z;
    unsigned sum, cnt, mine, sp = 0u;
    for (;;) {
        sum = 0u; cnt = 0u; mine = 0u;
#pragma unroll
        for (unsigned j = 0; j < 16; ++j) { const unsigned c = xb_ld(&bar[XB_XCNT(j)]); sum += c; cnt += (c > 0u) ? 1u : 0u; mine = (j == x) ? c : mine; }
        if (sum == G) break;
        __builtin_amdgcn_s_sleep(1);
        if ((++sp & 255u) == 0u) { if (xb_ld(&bar[XB_TMO])) break; if (sp > XB_SPIN_CAP) { atomicAdd(&bar[XB_TMO], 1u); break; } }
    }
    nloc = mine > 0u ? mine : 1u; nx = cnt > 0u ? cnt : 1u;
}
__device__ __forceinline__ void xcd_barrier(const XcdBarrier& b) {
    asm volatile("s_waitcnt vmcnt(0)" ::: "memory");
    __syncthreads();
    if (threadIdx.x == 0) {
        unsigned* bar = b.bar; unsigned bx = b.x; asm volatile("" : "+s"(bar), "+s"(bx));
        __builtin_amdgcn_s_waitcnt(0);
        unsigned nloc = b.st[0], nx = b.st[1];
        if (nloc == 0u) { xcd_barrier_complete(bar, bx, nloc, nx); b.st[0] = nloc; b.st[1] = nx; }
        const unsigned old = xb_add(&bar[XB_XSUB(bx)], 1u);
        const unsigned gen = old / nloc;
        if (old + 1u == (gen + 1u) * nloc) {
            __builtin_amdgcn_fence(__ATOMIC_RELEASE, "agent");
            asm volatile("s_waitcnt vmcnt(0)" ::: "memory");
            const unsigned og = xb_add(&bar[XB_TOP], 1u);
            const unsigned tg = og / nx;
            if (og + 1u == (tg + 1u) * nx) xb_add(&bar[XB_TOPGEN], 1u);
            else XB_SPIN(xb_ld(&bar[XB_TOPGEN]) == tg, bar);
            __builtin_amdgcn_fence(__ATOMIC_ACQUIRE, "agent");
            xb_add(&bar[XB_XGEN(bx)], 1u);
            asm volatile("s_waitcnt vmcnt(0)" ::: "memory");
        } else {
            XB_SPIN(xb_ld(&bar[XB_XGEN(bx)]) == gen, bar);
            asm volatile("buffer_inv sc0" ::: "memory");
            __builtin_amdgcn_fence(__ATOMIC_ACQUIRE, "workgroup");
            asm volatile("s_waitcnt vmcnt(0)" ::: "memory");
        }
    }
    __syncthreads();
}

constexpr int RING_BYTES = 131072;
constexpr int LDSCTL_OFF = 160256;
constexpr int LDS_BYTES = 161280;

struct Args {
    const float* in[23]; float* out; unsigned char* ws; int pad0, pad1;
};
__device__ __forceinline__ const void* ld_karg(unsigned off) {
    asm volatile("" : "+s"(off));
    return *(const void* const __attribute__((address_space(4)))*)((const __attribute__((address_space(4))) char*)__builtin_amdgcn_kernarg_segment_ptr() + off);
}
#define ARG(k) ((const float*)ld_karg(8u * (k)))
#define OUTP() ((float*)ld_karg(184u))
#define WSP() ((unsigned char*)ld_karg(192u))

__device__ __forceinline__ int rel_bucket(int d) {
    if (d < 16) return d;
    int b = 16;
    b += (d >= 22); b += (d >= 30); b += (d >= 40); b += (d >= 54); b += (d >= 73); b += (d >= 99); b += (d >= 134); b += (d >= 182);
    b += (d >= 246); b += (d >= 332); b += (d >= 450); b += (d >= 609); b += (d >= 825); b += (d >= 1117); b += (d >= 1513);
    return b;
}
__device__ __forceinline__ int win_src_col(int n) {
    if (n < 640) return n;
    if (n < 712) return n + 512;
    if (n < 768) return -1;
    if (n < 1280) return n - 128;
    return n - 56;
}
__device__ __forceinline__ void transpose_item(const float* W, int ldw, int K, bf16* WT, int kind, int kb, int nb, LAS float* scr, int lane) {
    const int k0 = 64 * kb, n0 = 32 * nb, nl = n0 + (lane & 31);
    int sc;
    if (kind == 0) sc = win_src_col(nl);
    else if (kind == 2) { const int j = nl >> 8, r = nl & 255; sc = (r < 128) ? (j * 128 + r) : (DFF + j * 128 + r - 128); }
    else sc = nl;
    float wv[32];
    const float* wsrc = W + (size_t)(k0 + (lane >> 5)) * ldw + (sc >= 0 ? sc : 0);
#pragma unroll
    for (int i = 0; i < 32; ++i) wv[i] = wsrc[(size_t)(2 * i) * ldw];
#pragma unroll
    for (int i = 0; i < 32; ++i) scr[(2 * i + (lane >> 5)) * 33 + (lane & 31)] = (sc >= 0) ? wv[i] : 0.f;
    asm volatile("s_waitcnt lgkmcnt(0)" ::: "memory");
    const int c = lane & 7;
    const int nrow0 = 0;
#pragma unroll
    for (int j = 0; j < 4; ++j) { const int n = (lane >> 3) + 8 * j; const LAS float* s = scr + (8 * c) * 33 + n;
        v4u o; o.x = pk2(s[0 * 33], s[1 * 33]); o.y = pk2(s[2 * 33], s[3 * 33]); o.z = pk2(s[4 * 33], s[5 * 33]); o.w = pk2(s[6 * 33], s[7 * 33]);
        *(v4u*)(WT + (size_t)(nrow0 + n0 + n) * K + k0 + 8 * c) = o; }
    asm volatile("s_waitcnt lgkmcnt(0)" ::: "memory");
}

__device__ __forceinline__ void p0a_prologue(unsigned char* ws, LAS unsigned char* lds, int tid, int lane, int wave, int G) {
    asm volatile("" : "+v"(lane), "+v"(tid));
    const float* c = ARG(1); const float* w_ada = ARG(2); const float* b_ada = ARG(3);
    float* mod = (float*)(ws + WS_MOD);
    if (blockIdx.x < 192) {
        LAS float* cs = (LAS float*)lds;
        LAS float* red = (LAS float*)(lds + 32768);
        for (int i = tid; i < 8192; i += NTHREADS) { const float v = c[i]; cs[i] = v / (1.f + __expf(-v)); }
        __syncthreads();
        for (int it = blockIdx.x; it < 192; it += G) {
            const int l = it / 96, cg = it % 96, n = cg * 64 + lane;
            float acc[8];
#pragma unroll
            for (int b = 0; b < 8; ++b) acc[b] = 0.f;
            const float* wp = w_ada + ((size_t)l * 1024 + wave * 128) * 6144 + n;
#pragma unroll 32
            for (int k = 0; k < 128; ++k) { const float wv = wp[(size_t)k * 6144];
#pragma unroll
                for (int b = 0; b < 8; ++b) acc[b] += cs[b * 1024 + wave * 128 + k] * wv; }
#pragma unroll
            for (int b = 0; b < 8; ++b) red[(wave * 8 + b) * 64 + lane] = acc[b];
            __syncthreads();
            { const int b = tid >> 6; float s = 0.f;
#pragma unroll
              for (int w = 0; w < 8; ++w) s += red[(w * 8 + b) * 64 + lane];
              mod[((size_t)l * 8 + b) * 6144 + n] = s + b_ada[l * 6144 + n]; }
            __syncthreads();
        }
    }
    { const float* rb = ARG(21); float* T = (float*)(ws + WS_TAB);
      for (int d = blockIdx.x * NTHREADS + tid; d < 4096; d += G * NTHREADS) { const int bk = rel_bucket(d);
          for (int j = 0; j < 24; ++j) T[d * 24 + j] = rb[bk * 24 + j]; } }
    if (blockIdx.x == G - 1 && wave == 0) {
        float* lam = (float*)(ws + WS_LAM);
        for (int l = 0; l < NL; ++l) {
            const float s1 = wave_sum(ARG(9)[l * 64 + lane] * ARG(10)[l * 64 + lane]);
            const float s2 = wave_sum(ARG(11)[l * 64 + lane] * ARG(12)[l * 64 + lane]);
            const float lam_init = (l == 0) ? 0.2f : 0.35550907f;
            if (lane == 0) lam[l] = expf(s1) - expf(s2) + lam_init;
        }
    }
    {
        LAS float* scr = (LAS float*)(lds + 65536 + wave * 8448);
        const int gw = blockIdx.x * NWAVES + wave, NGW = G * NWAVES;
        constexpr int I_WIN = 16 * 256, I_B = 8 * 32, I_C = 4 * 32, I_OUT = 16 * 32, I_GU = 16 * 176, I_D = 44 * 32, I_FQ = 128, I_FA = 2048;
        constexpr int I_LAYER = I_WIN + I_B + I_C + I_OUT + I_GU + I_D + I_FQ + I_FA;
        for (int it = gw; it < NL * I_LAYER; it += NGW) {
            const int l = it / I_LAYER; int r = it % I_LAYER;
            unsigned char* wl = ws + WS_W + (size_t)l * W_LAYER;
            const float* w_in = ARG(5) + (size_t)l * 1024 * WIN_SRC;
            if (r < I_WIN) { transpose_item(w_in, WIN_SRC, 1024, (bf16*)(wl + W_IN), 0, r / 256, r % 256, scr, lane); continue; } r -= I_WIN;
            if (r < I_B)   { transpose_item(ARG(15) + (size_t)l * 512 * 1024, 1024, 512, (bf16*)(wl + W_B), 1, r / 32, r % 32, scr, lane); continue; } r -= I_B;
            if (r < I_C)   { transpose_item(ARG(16) + (size_t)l * 256 * 1024, 1024, 256, (bf16*)(wl + W_C), 1, r / 32, r % 32, scr, lane); continue; } r -= I_C;
            if (r < I_OUT) { transpose_item(ARG(17) + (size_t)l * 1024 * 1024, 1024, 1024, (bf16*)(wl + W_OUT), 1, r / 32, r % 32, scr, lane); continue; } r -= I_OUT;
            if (r < I_GU)  { transpose_item(ARG(19) + (size_t)l * 1024 * NGU, NGU, 1024, (bf16*)(wl + W_GU), 2, r / 176, r % 176, scr, lane); continue; } r -= I_GU;
            if (r < I_D)   { transpose_item(ARG(20) + (size_t)l * DFF * 1024, 1024, DFF, (bf16*)(wl + W_D), 1, r / 32, r % 32, scr, lane); continue; } r -= I_D;
            if (r < I_FQ) {
                const int h = r >> 4, chalf = (r >> 3) & 1, d0 = (r & 7) * 8, cc = chalf * 64 + lane;
                const float* uk = ARG(6) + ((size_t)(l * 8 + h) * 64 + d0) * 128 + cc;
                v4u o; o.x = pk2(uk[0], uk[128]); o.y = pk2(uk[256], uk[384]); o.z = pk2(uk[512], uk[640]); o.w = pk2(uk[768], uk[896]);
                *(v4u*)((bf16*)(wl + W_UKT) + ((size_t)h * 128 + cc) * 64 + d0) = o;
                continue; }
            r -= I_FQ;
            {
                const int ng = r >> 7, kg = r & 127, h = kg >> 4, c0 = (kg & 15) * 8, n = ng * 64 + lane;
                const float* uv = ARG(7) + ((size_t)(l * 8 + h) * 128 + c0) * 64;
                const float* wa = ARG(14) + ((size_t)l * 512 + h * 64) * 1024 + n;
                float acc[8];
#pragma unroll
                for (int j = 0; j < 8; ++j) acc[j] = 0.f;
#pragma unroll 32
                for (int e = 0; e < 64; ++e) { const float wv = wa[(size_t)e * 1024];
#pragma unroll
                    for (int j = 0; j < 8; ++j) acc[j] += uv[j * 64 + e] * wv; }
                v4u o; o.x = pk2(acc[0], acc[1]); o.y = pk2(acc[2], acc[3]); o.z = pk2(acc[4], acc[5]); o.w = pk2(acc[6], acc[7]);
                *(v4u*)((bf16*)(wl + W_A) + (size_t)n * 1024 + kg * 8) = o;
            }
        }
    }
}

__device__ __forceinline__ void norm_rows(const float* x, bf16* out, const float* g, const float* sh, const float* sc, int gw, int NGW, int lane) {
    asm volatile("" : "+v"(lane));
    for (int row = gw; row < MT; row += 2 * NGW) {
        const int row2 = (row + NGW < MT) ? row + NGW : row;
        const f32x4* xr = (const f32x4*)(x + (size_t)row * 1024) + lane; const f32x4* xr2 = (const f32x4*)(x + (size_t)row2 * 1024) + lane;
        f32x4 v[4], u[4]; float s = 0.f, s2 = 0.f;
#pragma unroll
        for (int j = 0; j < 4; ++j) { v[j] = xr[64 * j]; u[j] = xr2[64 * j]; }
#pragma unroll
        for (int j = 0; j < 4; ++j) { s += (v[j].x * v[j].x + v[j].y * v[j].y) + (v[j].z * v[j].z + v[j].w * v[j].w); s2 += (u[j].x * u[j].x + u[j].y * u[j].y) + (u[j].z * u[j].z + u[j].w * u[j].w); }
        const float rstd = 1.0f / sqrtf(wave_sum(s) * (1.f / 1024.f) + EPS), rstd2 = 1.0f / sqrtf(wave_sum(s2) * (1.f / 1024.f) + EPS);
        const int b = row / SEQ, b2 = row2 / SEQ;
        v2u* o8 = (v2u*)(out + (size_t)row * 1024) + lane; v2u* o82 = (v2u*)(out + (size_t)row2 * 1024) + lane;
#pragma unroll
        for (int j = 0; j < 4; ++j) { const int col = 256 * j + 4 * lane;
            const f32x4 gg = *(const f32x4*)(g + col);
            { const f32x4 s1 = *(const f32x4*)(sc + (size_t)b * 6144 + col), s0 = *(const f32x4*)(sh + (size_t)b * 6144 + col);
              const f32x4 y = v[j] * rstd * gg * (s1 + 1.0f) + s0; v2u w; w.x = pk2(y.x, y.y); w.y = pk2(y.z, y.w); o8[64 * j] = w; }
            if (row2 != row) { const f32x4 s1 = *(const f32x4*)(sc + (size_t)b2 * 6144 + col), s0 = *(const f32x4*)(sh + (size_t)b2 * 6144 + col);
              const f32x4 y = u[j] * rstd2 * gg * (s1 + 1.0f) + s0; v2u w; w.x = pk2(y.x, y.y); w.y = pk2(y.z, y.w); o82[64 * j] = w; } }
    }
}
__device__ __forceinline__ void final_rows(float* x, const float* g, int gw, int NGW, int lane) {
    asm volatile("" : "+v"(lane));
    for (int row = gw; row < MT; row += 2 * NGW) {
        const int row2 = (row + NGW < MT) ? row + NGW : row;
        f32x4* xr = (f32x4*)(x + (size_t)row * 1024) + lane; f32x4* xr2 = (f32x4*)(x + (size_t)row2 * 1024) + lane;
        f32x4 v[4], u[4]; float s = 0.f, s2 = 0.f;
#pragma unroll
        for (int j = 0; j < 4; ++j) { v[j] = xr[64 * j]; u[j] = xr2[64 * j]; }
#pragma unroll
        for (int j = 0; j < 4; ++j) { s += (v[j].x * v[j].x + v[j].y * v[j].y) + (v[j].z * v[j].z + v[j].w * v[j].w); s2 += (u[j].x * u[j].x + u[j].y * u[j].y) + (u[j].z * u[j].z + u[j].w * u[j].w); }
        const float rstd = 1.0f / sqrtf(wave_sum(s) * (1.f / 1024.f) + EPS), rstd2 = 1.0f / sqrtf(wave_sum(s2) * (1.f / 1024.f) + EPS);
#pragma unroll
        for (int j = 0; j < 4; ++j) { const f32x4 gg = *(const f32x4*)(g + 256 * j + 4 * lane); xr[64 * j] = v[j] * rstd * gg; if (row2 != row) xr2[64 * j] = u[j] * rstd2 * gg; }
    }
}
__device__ __forceinline__ void kvn_rows(unsigned char* y, bf16* kvn, const float* gkv, unsigned* kmaxw, int gw, int NGW, int lane) {
    asm volatile("" : "+v"(lane));
    const bf16* misc = (const bf16*)(y + Y_MISC);
    float km0 = 0.f, km1 = 0.f, km2 = 0.f, km3 = 0.f;
    const float g0 = gkv[2 * lane], g1 = gkv[2 * lane + 1];
    for (int r0 = gw; r0 < CHR; r0 += 4 * NGW) {
        unsigned w[4]; bf16 kq[4];
#pragma unroll
        for (int i = 0; i < 4; ++i) { const int r = (r0 + i * NGW < CHR) ? r0 + i * NGW : r0; w[i] = *(const unsigned*)(misc + (size_t)r * 256 + 2 * lane); kq[i] = misc[(size_t)r * 256 + 128 + lane]; }
#pragma unroll
        for (int i = 0; i < 4; ++i) { const int r = r0 + i * NGW; if (r >= CHR) break;
            const float a0 = bflo(w[i]), a1 = bfhi(w[i]);
            const float rstd = 1.0f / sqrtf(wave_sum(a0 * a0 + a1 * a1) * (1.f / 128.f) + EPS);
            *(unsigned*)(kvn + (size_t)r * 128 + 2 * lane) = pk2(a0 * rstd * g0, a1 * rstd * g1);
            const float kk = bf2f(kq[i]); const float ks = wave_sum(kk * kk); const int b = r / SEQ;
            km0 = (b == 0) ? fmaxf(km0, ks) : km0; km1 = (b == 1) ? fmaxf(km1, ks) : km1; km2 = (b == 2) ? fmaxf(km2, ks) : km2; km3 = (b == 3) ? fmaxf(km3, ks) : km3; }
    }
    if (lane == 0) {
        __hip_atomic_fetch_max(kmaxw + 0, __float_as_uint(km0), __ATOMIC_RELAXED, __HIP_MEMORY_SCOPE_AGENT); __hip_atomic_fetch_max(kmaxw + 1, __float_as_uint(km1), __ATOMIC_RELAXED, __HIP_MEMORY_SCOPE_AGENT);
        __hip_atomic_fetch_max(kmaxw + 2, __float_as_uint(km2), __ATOMIC_RELAXED, __HIP_MEMORY_SCOPE_AGENT); __hip_atomic_fetch_max(kmaxw + 3, __float_as_uint(km3), __ATOMIC_RELAXED, __HIP_MEMORY_SCOPE_AGENT);
    }
}
typedef short bf16x8 __attribute__((ext_vector_type(8)));
typedef short s16x4 __attribute__((ext_vector_type(4)));
typedef float f32x16 __attribute__((ext_vector_type(16)));
#define LOG2E 1.4426950408889634f
__device__ __forceinline__ int crow(int r, int hi) { return (r & 3) + 8 * (r >> 2) + 4 * hi; }
__device__ __forceinline__ void glds16(const void* g, LAS void* l) { __builtin_amdgcn_global_load_lds((const unsigned*)g, (LAS unsigned*)l, 16, 0, 0); }
__device__ __forceinline__ s16x4 tr16(const LAS unsigned char* p) { return __builtin_bit_cast(s16x4, __builtin_amdgcn_ds_read_tr16_b64_v4i16((LAS s16x4*)p)); }
__device__ __forceinline__ float swap_max(float v) { auto rr = __builtin_amdgcn_permlane32_swap(__float_as_uint(v), __float_as_uint(v), false, false); return fmaxf(__uint_as_float(rr[0]), __uint_as_float(rr[1])); }
__device__ __forceinline__ float swap16_max(float v) { auto rr = __builtin_amdgcn_permlane16_swap(__float_as_uint(v), __float_as_uint(v), false, false); return fmaxf(__uint_as_float(rr[0]), __uint_as_float(rr[1])); }
__device__ __forceinline__ float swap16_add(float v) { auto rr = __builtin_amdgcn_permlane16_swap(__float_as_uint(v), __float_as_uint(v), false, false); return __uint_as_float(rr[0]) + __uint_as_float(rr[1]); }
__device__ __forceinline__ float swap_add(float v) { auto rr = __builtin_amdgcn_permlane32_swap(__float_as_uint(v), __float_as_uint(v), false, false); return __uint_as_float(rr[0]) + __uint_as_float(rr[1]); }
typedef float f32x2_t __attribute__((ext_vector_type(2))); typedef __bf16 bf16x2_t __attribute__((ext_vector_type(2)));
__device__ __forceinline__ unsigned cvtpk(float lo, float hi) { const f32x2_t v = {lo, hi}; const bf16x2_t b = __builtin_convertvector(v, bf16x2_t); return __builtin_bit_cast(unsigned, b); }
__device__ __forceinline__ void lds_add_u32_asm(LAS void* p, unsigned v) { asm volatile("ds_add_u32 %0, %1" :: "v"((unsigned)(uintptr_t)p), "v"(v) : "memory"); }
__device__ __forceinline__ void lds_st_b16_asm(LAS void* p, unsigned v) { asm volatile("ds_write_b16 %0, %1" :: "v"((unsigned)(uintptr_t)p), "v"(v) : "memory"); }
__device__ __forceinline__ void lds_st_b32_asm(LAS void* p, unsigned v) { asm volatile("ds_write_b32 %0, %1" :: "v"((unsigned)(uintptr_t)p), "v"(v) : "memory"); }
__device__ __forceinline__ s16x4 tr16_asm(const LAS unsigned char* p) { s16x4 v; asm volatile("ds_read_b64_tr_b16 %0, %1" : "=v"(v) : "v"((unsigned)(uintptr_t)p) : "memory"); return v; }
#define TRV(dst, base, off) asm volatile("ds_read_b64_tr_b16 %0, %1 offset:%c2" : "=&v"(dst) : "v"(base), "i"(off) : "memory")
#define LGKM_WAIT8(n, f) asm volatile("s_waitcnt lgkmcnt(" #n ")" : "+v"(f[0]), "+v"(f[1]), "+v"(f[2]), "+v"(f[3]), "+v"(f[4]), "+v"(f[5]), "+v"(f[6]), "+v"(f[7]) :: "memory")
#define VFRAG(f, i) ((bf16x8){f[2 * (i)][0], f[2 * (i)][1], f[2 * (i)][2], f[2 * (i)][3], f[2 * (i) + 1][0], f[2 * (i) + 1][1], f[2 * (i) + 1][2], f[2 * (i) + 1][3]})
#define RAW_BARRIER() do { asm volatile("s_waitcnt lgkmcnt(0)" ::: "memory"); __builtin_amdgcn_s_barrier(); asm volatile("" ::: "memory"); } while (0)

template <int MODE> __device__ __forceinline__ void mixB_fast(unsigned char* y, bf16* OUTB, const float* T, const float* gsub, float lam, float one_m_li, LAS unsigned char* lds, int tid, int lane, int wave, int G) {
    asm volatile("" : "+v"(lane), "+v"(tid));
    bf16* BQ = (bf16*)(y + Y_BQ); const bf16* BK = (const bf16*)(y + Y_BK); const bf16* BV = (const bf16*)(y + Y_BV);
    const int r32 = lane & 31, hi = lane >> 5, m = wave >> 2, qs = wave & 3;
    LAS float* gs_l = (LAS float*)(lds + 131072); LAS float* ctab = gs_l + 128; LAS float* btab = gs_l + 272;
    constexpr int BDM = 1599, BNX = 1728, BCS = 1744, SENTI = 0x7f000000;
    constexpr float THR = 8.0f;
    for (int item = blockIdx.x; item < CHB * 4 * 16; item += G) {
        const int bh = (G == 256) ? (2 * (item & 7) + (item >> 7)) : (item >> 4), pr = (G == 256) ? ((item >> 3) & 15) : (item & 15), bb = bh >> 2, h = bh & 3, rb = bb * SEQ;
        RAW_BARRIER();
        int tq = tid; asm volatile("" : "+v"(tq));
#pragma unroll
        for (int k = 0; k < 4; ++k) { const int x = tq + k * NTHREADS, d = BDM - x;
            const float v = (d >= 0 && x < BNX + 3) ? T[d * 24 + 8 + h] * LOG2E : -INFINITY;
#pragma unroll
            for (int sc = 0; sc < 4; ++sc) { const int i = x - sc; if (i >= 0 && i < BNX) btab[sc * BCS + i] = v; } }
        if (tid < 128) gs_l[tid] = gsub[tid];
        else if (tid < 128 + 136) { const int n = tid - 128 - 4, dmin = 32 * n + 1;
            ctab[tid - 128] = (n >= 0 && rel_bucket(dmin) == rel_bucket(dmin + 62)) ? T[dmin * 24 + 8 + h] * LOG2E : __int_as_float(SENTI); }
        for (int uu = 0; uu < 2; ++uu) {
            const int qb = (uu == 0) ? (31 - pr) : pr;
            const int q0w = qb * 128 + qs * 32, qpos = q0w + r32;
            bf16x8 qf[4];
#pragma unroll
            for (int ks = 0; ks < 4; ++ks) qf[ks] = *(const bf16x8*)(BQ + (size_t)(rb + qpos) * 512 + h * 128 + m * 64 + 16 * ks + 8 * hi);
            const int NT = 2 * (qb + 1);
            const int xl0 = BDM - qpos + 4 * hi;
            const LAS unsigned char* bta = (const LAS unsigned char*)(btab + (xl0 & 3) * (BCS - 1) + xl0);
            f32x16 O[4];
#pragma unroll
            for (int dq = 0; dq < 4; ++dq)
#pragma unroll
                for (int r = 0; r < 16; ++r) O[dq][r] = 0.f;
            float mref = -INFINITY, lsum = 0.f;
#define MB_STAGE(t_, buf_) do { const int kv0_ = (t_) * 64; LAS unsigned char* sb_ = lds + (buf_) * 32768; \
                _Pragma("unroll") for (int i_ = 0; i_ < 2; ++i_) { const int p_ = 2 * wave + i_, mk_ = p_ >> 3, rg_ = p_ & 7;     \
                    glds16(BK + (size_t)(rb + kv0_ + 8 * rg_ + (lane >> 3)) * 512 + h * 128 + mk_ * 64 + ((lane & 7) ^ ((4 * rg_ + (lane >> 4)) & 7)) * 8, sb_ + mk_ * 8192 + rg_ * 1024); } \
                _Pragma("unroll") for (int i_ = 0; i_ < 2; ++i_) { const int p_ = 2 * wave + i_, dq_ = p_ >> 2, rg_ = p_ & 3; \
                    glds16(BV + (size_t)(rb + kv0_ + 16 * rg_ + (lane >> 2)) * 512 + h * 128 + dq_ * 32 + (lane & 3) * 8, sb_ + 16384 + p_ * 1024); } } while (0)
            MB_STAGE(0, 0); MB_STAGE(1, 1);
#pragma unroll 1
            for (int u2 = 0; u2 < NT / 2; ++u2) {
                asm volatile("s_waitcnt vmcnt(0)" ::: "memory");
                RAW_BARRIER();
#if BSTAGE_POS == 0
                if (2 * u2 + 2 < NT && MODE != 3) { MB_STAGE(2 * u2 + 2, (2 * u2 + 2) & 3); MB_STAGE(2 * u2 + 3, (2 * u2 + 3) & 3); }
#endif
                const int kva = u2 * 128;
                if (MODE != 2 && kva <= q0w + 31) {
                    const LAS unsigned char* sba = lds + ((2 * u2) & 3) * 32768; const LAS unsigned char* sbb = lds + ((2 * u2 + 1) & 3) * 32768;
                    f32x16 sa0, sa1, sb0, sb1; float ct0, ct1, ct2, ct3;
#define KRD(dst_, a_, off_) asm volatile("ds_read_b128 %0, %1 offset:%c2" : "=&v"(dst_) : "v"(a_), "i"(off_) : "memory")
#define KRD4(f_, o_, a_) do { KRD(f_[o_], a_, 0); KRD(f_[(o_) + 1], a_, 4096); KRD(f_[(o_) + 2], a_, 32768); KRD(f_[(o_) + 3], a_, 36864); } while (0)
#define KWAIT4(n_, f_, o_) asm volatile("s_waitcnt lgkmcnt(" #n_ ")" : "+v"(f_[o_]), "+v"(f_[(o_) + 1]), "+v"(f_[(o_) + 2]), "+v"(f_[(o_) + 3]) :: "memory")
#define KMM4(f_, o_, ks_) do { sa0 = __builtin_amdgcn_mfma_f32_32x32x16_bf16(f_[o_], qf[ks_], sa0, 0, 0, 0); sa1 = __builtin_amdgcn_mfma_f32_32x32x16_bf16(f_[(o_) + 1], qf[ks_], sa1, 0, 0, 0); \
                        sb0 = __builtin_amdgcn_mfma_f32_32x32x16_bf16(f_[(o_) + 2], qf[ks_], sb0, 0, 0, 0); sb1 = __builtin_amdgcn_mfma_f32_32x32x16_bf16(f_[(o_) + 3], qf[ks_], sb1, 0, 0, 0); } while (0)
                    bf16x8 kf[8];
                    {   const int ci0 = (q0w - kva) >> 5;
                        const LAS unsigned char* bp = bta + kva * 4;
                        const unsigned cta = (unsigned)(uintptr_t)(ctab + ci0);
                        unsigned cw0, cw1, cw2, cw3;
                        asm volatile("ds_read_b32 %0, %4 offset:12\n\tds_read_b32 %1, %4 offset:8\n\tds_read_b32 %2, %4 offset:4\n\tds_read_b32 %3, %4" : "=&v"(cw0), "=&v"(cw1), "=&v"(cw2), "=&v"(cw3) : "v"(cta) : "memory");
                        const unsigned kbase = (unsigned)(uintptr_t)(sba + m * 8192 + r32 * 128); const int sw = (r32 >> 1) & 7;
                        const unsigned ka0 = kbase + ((hi ^ sw) << 4), ka1 = kbase + (((2 + hi) ^ sw) << 4), ka2 = kbase + (((4 + hi) ^ sw) << 4), ka3 = kbase + (((6 + hi) ^ sw) << 4);
                        KRD4(kf, 0, ka0); KRD4(kf, 4, ka1);
                        asm volatile("s_waitcnt lgkmcnt(8)" : "+v"(cw0), "+v"(cw1), "+v"(cw2), "+v"(cw3) :: "memory");
#define MB_INIT(s_, c_, t_, w_) do { const int cw_ = __builtin_amdgcn_readfirstlane((int)(w_)); \
                            if (cw_ != SENTI) { c_ = __int_as_float(cw_); _Pragma("unroll") for (int r = 0; r < 16; ++r) s_[r] = 0.f; } \
                            else { c_ = 0.f; _Pragma("unroll") for (int j_ = 0; j_ < 4; ++j_) { const f32x4 b_ = *(const LAS f32x4*)(bp + (t_) * 128 + j_ * 32); \
                                s_[4 * j_] = b_.x; s_[4 * j_ + 1] = b_.y; s_[4 * j_ + 2] = b_.z; s_[4 * j_ + 3] = b_.w; } } } while (0)
                        MB_INIT(sa0, ct0, 0, cw0); MB_INIT(sa1, ct1, 1, cw1); MB_INIT(sb0, ct2, 2, cw2); MB_INIT(sb1, ct3, 3, cw3);
#undef MB_INIT
                        KWAIT4(4, kf, 0); KMM4(kf, 0, 0);
                        KRD4(kf, 0, ka2); KWAIT4(4, kf, 4); KMM4(kf, 4, 1);
                        KRD4(kf, 4, ka3); KWAIT4(4, kf, 0); KMM4(kf, 0, 2);
                        KWAIT4(0, kf, 4); KMM4(kf, 4, 3);
                    }
#undef KRD
#undef KRD4
#undef KWAIT4
#undef KMM4
#if BSTAGE_POS == 1
                    if (2 * u2 + 2 < NT && MODE != 3) { MB_STAGE(2 * u2 + 2, (2 * u2 + 2) & 3); MB_STAGE(2 * u2 + 3, (2 * u2 + 3) & 3); }
#elif BSTAGE_POS == 2
                    if (2 * u2 + 2 < NT && MODE != 3) { MB_STAGE(2 * u2 + 2, (2 * u2 + 2) & 3); }
#endif
                    if (MODE == 4) { lsum += sa0[0] + sa1[0] + sb0[0] + sb1[0] + sa0[9] + sa1[9] + sb0[9] + sb1[9]; continue; }
                    float rm;
                    {   float m0 = fmaxf(sa0[0], sa0[1]), m1 = fmaxf(sa1[0], sa1[1]), m2 = fmaxf(sb0[0], sb0[1]), m3 = fmaxf(sb1[0], sb1[1]);
#pragma unroll
                        for (int r = 2; r < 16; ++r) { m0 = fmaxf(m0, sa0[r]); m1 = fmaxf(m1, sa1[r]); m2 = fmaxf(m2, sb0[r]); m3 = fmaxf(m3, sb1[r]); }
                        rm = fmaxf(fmaxf(m0 + ct0, m1 + ct1), fmaxf(m2 + ct2, m3 + ct3)); }
                    rm = swap_max(rm);
                    if (__any(rm > mref + THR)) {
                        const float mn = fmaxf(mref, rm), f = __builtin_amdgcn_exp2f(mref - mn);
                        lsum *= f; mref = mn;
#pragma unroll
                        for (int dq = 0; dq < 4; ++dq)
#pragma unroll
                            for (int r = 0; r < 16; ++r) O[dq][r] *= f;
                    }
                    float ps = 0.f; const float rf0 = mref - ct0, rf1 = mref - ct1, rf2 = mref - ct2, rf3 = mref - ct3;
#pragma unroll
                    for (int r = 0; r < 16; ++r) { sa0[r] = __builtin_amdgcn_exp2f(sa0[r] - rf0); sa1[r] = __builtin_amdgcn_exp2f(sa1[r] - rf1); ps += sa0[r] + sa1[r]; }
                    bf16x8 pf[8];
#define MB_PACK(dst_, s_, o_) do { v4u w_; w_.x = cvtpk(s_[o_], s_[o_ + 1]); w_.y = cvtpk(s_[o_ + 2], s_[o_ + 3]); w_.z = cvtpk(s_[o_ + 4], s_[o_ + 5]); w_.w = cvtpk(s_[o_ + 6], s_[o_ + 7]); dst_ = __builtin_bit_cast(bf16x8, w_); } while (0)
#define MB_EXPB(i0_) do { asm volatile("" : "+v"(sb0), "+v"(sb1)); \
                        _Pragma("unroll") for (int r = (i0_); r < (i0_) + 4; ++r) { sb0[r] = __builtin_amdgcn_exp2f(sb0[r] - rf2); sb1[r] = __builtin_amdgcn_exp2f(sb1[r] - rf3); ps += sb0[r] + sb1[r]; } } while (0)
                    MB_PACK(pf[0], sa0, 0); MB_PACK(pf[1], sa0, 8); MB_PACK(pf[2], sa1, 0); MB_PACK(pf[3], sa1, 8);
#if BSTAGE_POS == 2
                    if (2 * u2 + 2 < NT && MODE != 3) { MB_STAGE(2 * u2 + 3, (2 * u2 + 3) & 3); }
#endif
                    const unsigned vlo = (unsigned)(((lane >> 4) & 1) * 32 + (lane & 3) * 8 + (4 * hi + ((lane & 15) >> 2)) * 64);
                    const unsigned vba = (unsigned)(uintptr_t)(sba + 16384) + vlo, vbb = (unsigned)(uintptr_t)(sbb + 16384) + vlo;
                    s16x4 fa[8], fb[8];
#define MB_RD(f, vb_, dq_) do { if (MODE != 1) _Pragma("unroll") for (int sp_ = 0; sp_ < 4; ++sp_) { TRV(f[2 * sp_], vb_, ((dq_) * 4 + sp_) * 1024); TRV(f[2 * sp_ + 1], vb_, ((dq_) * 4 + sp_) * 1024 + 512); } } while (0)
#define MB_MM(f, dq_, po_) do { if (MODE == 1) { asm volatile("" :: "v"(pf[(po_)]), "v"(pf[(po_) + 1]), "v"(pf[(po_) + 2]), "v"(pf[(po_) + 3])); } else _Pragma("unroll") for (int sp_ = 0; sp_ < 4; ++sp_) O[dq_] = __builtin_amdgcn_mfma_f32_32x32x16_bf16(VFRAG(f, sp_), pf[(po_) + sp_], O[dq_], 0, 0, 0); } while (0)
                    MB_RD(fa, vba, 0); MB_RD(fb, vba, 1); LGKM_WAIT8(8, fa); MB_MM(fa, 0, 0); MB_EXPB(0);
                    MB_RD(fa, vba, 2); LGKM_WAIT8(8, fb); MB_MM(fb, 1, 0); MB_EXPB(4);
                    MB_RD(fb, vba, 3); LGKM_WAIT8(8, fa); MB_MM(fa, 2, 0); MB_EXPB(8);
                    MB_RD(fa, vbb, 0); LGKM_WAIT8(8, fb); MB_MM(fb, 3, 0); MB_EXPB(12);
                    lsum += ps;
                    MB_PACK(pf[4], sb0, 0); MB_PACK(pf[5], sb0, 8); MB_PACK(pf[6], sb1, 0); MB_PACK(pf[7], sb1, 8);
                    MB_RD(fb, vbb, 1); LGKM_WAIT8(8, fa); MB_MM(fa, 0, 4);
                    MB_RD(fa, vbb, 2); LGKM_WAIT8(8, fb); MB_MM(fb, 1, 4);
                    MB_RD(fb, vbb, 3); LGKM_WAIT8(8, fa); MB_MM(fa, 2, 4);
                    LGKM_WAIT8(0, fb); MB_MM(fb, 3, 4);
#undef MB_PACK
#undef MB_EXPB
#undef MB_RD
#undef MB_MM
                }
            }
            RAW_BARRIER();
#undef MB_STAGE
            const float inv = 1.0f / swap_add(lsum);
            LAS float* xb = (LAS float*)lds + qs * 4096;
            if (m == 1) {
#pragma unroll
                for (int dq = 0; dq < 4; ++dq)
#pragma unroll
                    for (int r = 0; r < 16; ++r) xb[(dq * 16 + r) * 64 + lane] = O[dq][r] * inv;
            }
            RAW_BARRIER();
            if (m == 0) {
                float ss = 0.f;
#pragma unroll
                for (int dq = 0; dq < 4; ++dq)
#pragma unroll
                    for (int r = 0; r < 16; ++r) { const float o = O[dq][r] * inv - lam * xb[(dq * 16 + r) * 64 + lane]; O[dq][r] = o; ss += o * o; }
                const float rstd = 1.0f / sqrtf(swap_add(ss) * (1.f / 128.f) + EPS) * one_m_li;
                bf16* orow = OUTB + (size_t)(rb + qpos) * 512 + h * 128;
#pragma unroll
                for (int dq = 0; dq < 4; ++dq)
#pragma unroll
                    for (int g4 = 0; g4 < 4; ++g4) { const int d0 = dq * 32 + 8 * g4 + 4 * hi; const f32x4 gs = *(const LAS f32x4*)(gs_l + d0);
                        v2u w; w.x = pk2(O[dq][4 * g4] * rstd * gs.x, O[dq][4 * g4 + 1] * rstd * gs.y); w.y = pk2(O[dq][4 * g4 + 2] * rstd * gs.z, O[dq][4 * g4 + 3] * rstd * gs.w);
                        *(v2u*)(orow + d0) = w; }
            }
            asm volatile("s_waitcnt vmcnt(0)" ::: "memory");
            RAW_BARRIER();
        }
    }
}

constexpr size_t WS_OG = 432 * MiB, WS_LSE = 480 * MiB;
__device__ __forceinline__ void mixC_fast(unsigned char* y, unsigned char* ws, const float* T, LAS unsigned char* lds, int tid, int lane, int wave, int G) {
    asm volatile("" : "+v"(lane), "+v"(tid));
    const bf16* CQ = (const bf16*)(y + Y_CQ); const bf16* CK = (const bf16*)(y + Y_CK); const bf16* CV = (const bf16*)(y + Y_CV);
    float* OG = (float*)(ws + WS_OG); float* LSE = (float*)(ws + WS_LSE);
    const int r32 = lane & 31, hi = lane >> 5;
    LAS unsigned char* Kl = lds;
    LAS unsigned char* Vl = lds + 49152;
    LAS float* bt = (LAS float*)(lds + 98304);
    constexpr int CBS = 208;
    for (int item = blockIdx.x; item < CHB * 192; item += G) {
        const int bb = item / 192, u = item % 192, g = u >> 6, v = u & 63;
        const int hp = v >> 4, w16 = v & 15;
        const int dil = (g == 0) ? 1 : (g == 1) ? 4 : 16;
        const int rc = (g == 0) ? 0 : (g == 1) ? (w16 >> 2) : w16;
        const int seg = (g == 0) ? w16 : (g == 1) ? (w16 & 3) : 0;
        const int hh = 4 * g + hp, M0 = seg * 256, rb = bb * SEQ;
        RAW_BARRIER();
        if (tid < 196) { const int rel = 159 - tid; const float v = (rel >= 0 && rel <= 128) ? T[(rel * dil) * 24 + 12 + hh] * LOG2E : -INFINITY;
#pragma unroll
            for (int sc = 0; sc < 4; ++sc) { const int i = tid - sc; if (i >= 0 && i < 192) bt[sc * CBS + i] = v; } }
#pragma unroll
        for (int i = 0; i < 6; ++i) { const int p = wave * 6 + i;
            int mk = M0 - 128 + 8 * p + (lane >> 3); mk = mk < 0 ? 0 : mk;
            glds16(CK + (size_t)(rb + mk * dil + rc) * 768 + hh * 64 + ((lane & 7) ^ ((4 * p + (lane >> 4)) & 7)) * 8, Kl + p * 1024); }
#pragma unroll
        for (int i = 0; i < 6; ++i) { const int p = wave * 6 + i, dq = p / 24, rg = p % 24;
            int mk = M0 - 128 + 16 * rg + (lane >> 2); mk = mk < 0 ? 0 : mk;
            glds16(CV + (size_t)(rb + mk * dil + rc) * 768 + hh * 64 + dq * 32 + (lane & 3) * 8, Vl + p * 1024); }
        const int mq = M0 + 32 * wave + r32, rowq = rb + mq * dil + rc;
        bf16x8 qf[4];
#pragma unroll
        for (int ks = 0; ks < 4; ++ks) qf[ks] = *(const bf16x8*)(CQ + (size_t)rowq * 768 + hh * 64 + 16 * ks + 8 * hi);
        asm volatile("s_waitcnt vmcnt(0)" ::: "memory");
        RAW_BARRIER();
        f32x16 O[2];
#pragma unroll
        for (int dq = 0; dq < 2; ++dq)
#pragma unroll
            for (int r = 0; r < 16; ++r) O[dq][r] = 0.f;
        float mref = -INFINITY, lsum = 0.f;
#pragma unroll 1
        for (int j = 0; j < 5; ++j) {
            const int lrow = 32 * wave + 32 * j;
            if (M0 - 128 + lrow + 31 < 0) continue;
            const LAS unsigned char* kb = Kl + (lrow + r32) * 128;
            f32x16 s0;
            {   const int xl = 31 + 32 * j - r32 + 4 * hi;
                const LAS float* bp = bt + (xl & 3) * (CBS - 1) + xl;
#pragma unroll
                for (int j4 = 0; j4 < 4; ++j4) { const f32x4 b = *(const LAS f32x4*)(bp + 8 * j4); s0[4 * j4] = b.x; s0[4 * j4 + 1] = b.y; s0[4 * j4 + 2] = b.z; s0[4 * j4 + 3] = b.w; } }
#pragma unroll
            for (int ks = 0; ks < 4; ++ks) { const bf16x8 k0 = *(const LAS bf16x8*)(kb + (((2 * ks + hi) ^ (((lrow + r32) >> 1) & 7)) << 4)); s0 = __builtin_amdgcn_mfma_f32_32x32x16_bf16(k0, qf[ks], s0, 0, 0, 0); }
            if (M0 - 128 + lrow < 0) {
                const int mkb = M0 - 128 + lrow + 4 * hi;
#pragma unroll
                for (int r = 0; r < 16; ++r) { const int cr = (r & 3) + 8 * (r >> 2); if (mkb + cr < 0) s0[r] = -INFINITY; } }
            float rm = s0[0];
#pragma unroll
            for (int r = 1; r < 16; ++r) rm = fmaxf(rm, s0[r]);
            rm = swap_max(rm);
            const float mn = fmaxf(mref, rm);
            const float f = (mn == -INFINITY) ? 1.f : __builtin_amdgcn_exp2f(mref - mn);
            const float msub = (mn == -INFINITY) ? 0.f : mn;
            lsum *= f; mref = mn;
#pragma unroll
            for (int dq = 0; dq < 2; ++dq)
#pragma unroll
                for (int r = 0; r < 16; ++r) O[dq][r] *= f;
            float ps = 0.f;
#pragma unroll
            for (int r = 0; r < 16; ++r) { s0[r] = __builtin_amdgcn_exp2f(s0[r] - msub); ps += s0[r]; }
            lsum += ps;
            bf16x8 pf[2];
            { v4u w;
              w.x = cvtpk(s0[0], s0[1]); w.y = cvtpk(s0[2], s0[3]); w.z = cvtpk(s0[4], s0[5]); w.w = cvtpk(s0[6], s0[7]); pf[0] = __builtin_bit_cast(bf16x8, w);
              w.x = cvtpk(s0[8], s0[9]); w.y = cvtpk(s0[10], s0[11]); w.z = cvtpk(s0[12], s0[13]); w.w = cvtpk(s0[14], s0[15]); pf[1] = __builtin_bit_cast(bf16x8, w); }
            const unsigned vb = (unsigned)(uintptr_t)(Vl + ((lane >> 4) & 1) * 32 + (lane & 3) * 8 + (4 * hi + ((lane & 15) >> 2)) * 64 + (lrow >> 4) * 1024);
            s16x4 fa[8];
#pragma unroll
            for (int dq = 0; dq < 2; ++dq)
#pragma unroll
                for (int sp = 0; sp < 2; ++sp) { TRV(fa[4 * dq + 2 * sp], vb, (dq * 24 + sp) * 1024); TRV(fa[4 * dq + 2 * sp + 1], vb, (dq * 24 + sp) * 1024 + 512); }
            LGKM_WAIT8(0, fa);
#pragma unroll
            for (int dq = 0; dq < 2; ++dq)
#pragma unroll
                for (int sp = 0; sp < 2; ++sp) O[dq] = __builtin_amdgcn_mfma_f32_32x32x16_bf16(VFRAG(fa, 2 * dq + sp), pf[sp], O[dq], 0, 0, 0);
        }
        const float ltot = swap_add(lsum), inv = 1.0f / ltot;
        float* og = OG + ((size_t)g * CHR + rowq) * 256 + hp * 64;
#pragma unroll
        for (int dq = 0; dq < 2; ++dq)
#pragma unroll
            for (int g4 = 0; g4 < 4; ++g4) { const int d0 = dq * 32 + 8 * g4 + 4 * hi;
                *(f32x4*)(og + d0) = (f32x4){O[dq][4 * g4] * inv, O[dq][4 * g4 + 1] * inv, O[dq][4 * g4 + 2] * inv, O[dq][4 * g4 + 3] * inv}; }
        if (hi == 0) LSE[((size_t)g * CHR + rowq) * 4 + hp] = (mref + __log2f(ltot)) * 0.6931471805599453f;
    }
}
__device__ __forceinline__ void mergeC(unsigned char* y, unsigned char* ws, int gw, int NGW, int lane) {
    asm volatile("" : "+v"(lane));
    const float* OG = (const float*)(ws + WS_OG); const float* LSE = (const float*)(ws + WS_LSE); bf16* OC = (bf16*)(y + Y_OC);
    const int hp = lane >> 4, d4 = (lane & 15) * 4;
    for (int r0 = gw; r0 < CHR; r0 += 2 * NGW) {
        const int r1 = (r0 + NGW < CHR) ? r0 + NGW : r0;
        float l[2][3]; f32x4 o[2][3];
#pragma unroll
        for (int i = 0; i < 2; ++i) { const int r = i ? r1 : r0;
#pragma unroll
            for (int g = 0; g < 3; ++g) { l[i][g] = LSE[((size_t)g * CHR + r) * 4 + hp]; o[i][g] = *(const f32x4*)(OG + ((size_t)g * CHR + r) * 256 + hp * 64 + d4); } }
#pragma unroll
        for (int i = 0; i < 2; ++i) { const int r = i ? r1 : r0; if (i == 1 && r1 == r0) break;
            const float M = fmaxf(fmaxf(l[i][0], l[i][1]), l[i][2]);
            const float a0 = __expf(l[i][0] - M), a1 = __expf(l[i][1] - M), a2 = __expf(l[i][2] - M), ia = 1.0f / (a0 + a1 + a2);
            const f32x4 ov = (o[i][0] * a0 + o[i][1] * a1 + o[i][2] * a2) * ia;
            v2u w; w.x = pk2(ov.x, ov.y); w.y = pk2(ov.z, ov.w);
            *(v2u*)(OC + (size_t)r * 256 + hp * 64 + d4) = w; }
    }
}

constexpr int CW_KMAX = 8192;
constexpr int A_KST = 0, A_HIST = 32768, A_CAND = 98304, A_SEL = 131072, A_BKT = 147456, A_BIAS = 151552;
__device__ __forceinline__ int a_bin(float s, int kb) {
    int k = (int)(__float_as_uint(fabsf(s)) >> 18) - kb; k = k < 0 ? 0 : (k > 511 ? 511 : k);
    return (s < 0.f) ? (511 - k) : (512 + k);
}
__device__ __forceinline__ unsigned a_edge(int b, int kb) {
    if (b <= 0) return 0u;
    if (b >= 1024) return 0xffffffffu;
    if (b == 512) return 0x80000000u;
    if (b > 512) { const int k = b - 512 + kb; return 0x80000000u | ((unsigned)(k > 0 ? k : 0) << 18); }
    const int k = 512 - b + kb; return 0x80000000u - ((unsigned)(k > 0 ? k : 0) << 18);
}
__device__ __forceinline__ void mixA_fast(unsigned char* y, bf16* OUTA, bf16* OUTA2, const bf16* KVN, const bf16* UKT, const float* T, const float* rel_bias, const unsigned* kmaxw, LAS unsigned char* lds, int tid, int lane, int wave, int G) {
    asm volatile("" : "+v"(lane), "+v"(tid));
    const bf16* AQ = (const bf16*)(y + Y_AQ); bf16* QLS = (bf16*)(y + Y_QLS) + (size_t)blockIdx.x * 32 * 1024; const bf16* MISC = (const bf16*)(y + Y_MISC); const bf16* IQ = (const bf16*)(y + Y_IQ);
    const int kl = lane & 31, hi = lane >> 5;
    constexpr float C2 = 0.125f * LOG2E, THR = 8.0f;
    unsigned short* KEYS = (unsigned short*)(y + ((blockIdx.x < 160) ? (Y_CK + 8 * MiB + (size_t)blockIdx.x * 262144) : (Y_BK + (size_t)(blockIdx.x - 160) * 262144)));
    LAS float* biasl = (LAS float*)(lds + A_BIAS);
    const unsigned lt32 = (1u << kl) - 1u;
    for (int item = blockIdx.x; item < CHB * 64; item += G) {
        const int bb = (G == 256) ? (item & 3) : (item >> 6), pr = (G == 256) ? (((item >> 2) & 1) * 32 + (item >> 3)) : (item & 63), rb = bb * SEQ;
        const float kmax = sqrtf(__uint_as_float(kmaxw[bb]));
        for (int uu = 0; uu < 2; ++uu) {
            const int qb = (uu == 0) ? (127 - pr) : pr, t0 = qb * 32, tw = t0 + 4 * wave;
            RAW_BARRIER();
            { int tq = tid; asm volatile("" : "+v"(tq)); if (tq < 256) biasl[tq] = rel_bias[(tq >> 3) * 24 + (tq & 7)] * LOG2E; }
            bf16x8 aq[4];
            int klq = kl, hiq = hi; asm volatile("" : "+v"(klq), "+v"(hiq));
            { const int rowq = klq >> 3, hr = klq & 7;
#pragma unroll
              for (int ks = 0; ks < 4; ++ks) aq[ks] = *(const bf16x8*)(IQ + (size_t)(rb + tw + rowq) * 512 + hr * 64 + 16 * ks + 8 * hiq); }
            float wr[16];
#pragma unroll
            for (int r = 0; r < 16; ++r) wr[r] = bf2f(MISC[(size_t)(rb + tw + (r >> 2)) * 256 + 192 + (r & 3) + 4 * hiq]) * 0.044194173824159216f;
            int kbX, kbY;
            { float ss = 0.f;
#pragma unroll
              for (int ks = 0; ks < 4; ++ks)
#pragma unroll
                  for (int j = 0; j < 8; ++j) { const float v = bf2f((bf16)aq[ks][j]); ss += v * v; }
              ss = swap_add(ss);
              const float wa = fabsf(bf2f(MISC[(size_t)(rb + tw + (klq >> 3)) * 256 + 192 + (klq & 7)])) * 0.044194173824159216f;
              float u = wa * sqrtf(ss) * kmax;
              u += __shfl_xor(u, 1); u += __shfl_xor(u, 2); u += __shfl_xor(u, 4);
              const float uX = __shfl(u, (2 * hi) * 8), uY = __shfl(u, (2 * hi + 1) * 8);
              kbX = (int)(__float_as_uint(uX) >> 18) - 511; kbY = (int)(__float_as_uint(uY) >> 18) - 511; }
            const int tX = tw + 2 * hi, tY = tw + 2 * hi + 1;
            const int qX = wave * 4 + 2 * hi, qY = qX + 1;
            LAS unsigned* histX = (LAS unsigned*)(lds + A_HIST + qX * 2048); LAS unsigned* histY = (LAS unsigned*)(lds + A_HIST + qY * 2048);
            int thrX = -1, thrY = -1; unsigned cntX = 0, cntY = 0, ccX = 0, ccY = 0;
            unsigned eSX = 0u, eCX = 0u, eSY = 0u, eCY = 0u;
#pragma unroll 1
            for (int rep8 = 0; rep8 < ((PROBE == 8 || PROBE == 15) ? 2 : 1); ++rep8) {
            thrX = -1; thrY = -1; cntX = 0; cntY = 0; ccX = 0; ccY = 0;
            { LAS v4u* hz = (LAS v4u*)(lds + A_HIST + wave * 8192);
              unsigned z0 = 0u; asm volatile("" : "+v"(z0));
#pragma unroll
              for (int i = 0; i < 8; ++i) hz[i * 64 + lane] = (v4u){z0, z0, z0, z0}; }
            const int NTK = qb + 1, NCK = (NTK + 3) >> 2;
#define MA_STAGE(ck_, buf_) do { _Pragma("unroll") for (int i_ = 0; i_ < 2; ++i_) { const int p_ = 2 * wave + i_, tl_ = p_ >> 2, ks_ = p_ & 3; \
                glds16(MISC + (size_t)(rb + 128 * (ck_) + 32 * tl_ + kl) * 256 + 128 + (2 * ks_ + hi) * 8, lds + A_KST + (buf_) * 16384 + tl_ * 4096 + ks_ * 1024); } } while (0)
#pragma unroll 1
            for (int pass = 0; pass < 1; ++pass) {
                const int NTR = (NTK + 1) >> 1;
                RAW_BARRIER();
                MA_STAGE(0, 0);
                asm volatile("s_waitcnt vmcnt(0)" ::: "memory");
                RAW_BARRIER();
                if (NCK > 1) MA_STAGE(1, 1);
#define RELU(x_) __int_as_float(max(__float_as_int(x_), 0))
#define MA_LOADK(kf_, bf_, tl_) do { const LAS unsigned char* kbp_ = lds + A_KST + (bf_) * 16384 + (tl_) * 4096 + hi * 512 + kl * 16; \
                        _Pragma("unroll") for (int ks = 0; ks < 4; ++ks) kf_[ks] = *(const LAS bf16x8*)(kbp_ + ks * 1024); } while (0)
#define MA_MMA(c_, kf_) do { _Pragma("unroll") for (int r = 0; r < 16; ++r) c_[r] = 0.f; \
                        _Pragma("unroll") for (int ks = 0; ks < 4; ++ks) c_ = __builtin_amdgcn_mfma_f32_32x32x16_bf16(aq[ks], kf_[ks], c_, 0, 0, 0); } while (0)
#define MA_RED(sX_, sY_, c_) do { float p0_ = 0.f, p1_ = 0.f, p2_ = 0.f, p3_ = 0.f; \
                        _Pragma("unroll") for (int i = 0; i < 4; ++i) { p0_ += wr[i] * RELU(c_[i]); p1_ += wr[4 + i] * RELU(c_[4 + i]); p2_ += wr[8 + i] * RELU(c_[8 + i]); p3_ += wr[12 + i] * RELU(c_[12 + i]); } \
                        { auto rr = __builtin_amdgcn_permlane32_swap(__float_as_uint(p0_), __float_as_uint(p2_), false, false); sX_ = __uint_as_float(rr[0]) + __uint_as_float(rr[1]) + 0.f; } \
                        { auto rr = __builtin_amdgcn_permlane32_swap(__float_as_uint(p1_), __float_as_uint(p3_), false, false); sY_ = __uint_as_float(rr[0]) + __uint_as_float(rr[1]) + 0.f; } } while (0)
#define MA_APPEND(sv_, val_, q_, cnt_, cc_, eS_, eC_, s_) do { const unsigned mk_ = __float_as_uint(sv_) ^ ((unsigned)((int)__float_as_uint(sv_) >> 31) | 0x80000000u); \
                        const bool sel_ = (val_) && mk_ >= (eS_), cd_ = (val_) && mk_ >= (eC_) && mk_ < (eS_); \
                        const unsigned long long bs_ = __ballot(sel_), bc_ = __ballot(cd_); \
                        const unsigned ms_ = hi ? (unsigned)(bs_ >> 32) : (unsigned)bs_, mc_ = hi ? (unsigned)(bc_ >> 32) : (unsigned)bc_; \
                        if (sel_) lds_st_b16_asm((LAS bf16*)(lds + A_SEL + (q_) * 512) + cnt_ + __popc(ms_ & lt32), (unsigned)(s_)); \
                        if (cd_) { const unsigned cp_ = cc_ + __popc(mc_ & lt32); if (cp_ < 128u) { lds_st_b32_asm((LAS float*)(lds + A_CAND + (q_) * 768) + cp_, __float_as_uint(sv_)); lds_st_b16_asm((LAS bf16*)(lds + A_CAND + (q_) * 768 + 512) + cp_, (unsigned)(s_)); } } \
                        cnt_ += __popc(ms_); cc_ += __popc(mc_); } while (0)
                f32x16 ca, cb;
                {   bf16x8 kfa[4], kfb[4];
                    MA_LOADK(kfa, 0, 0); MA_LOADK(kfb, 0, 1);
                    MA_MMA(ca, kfa); MA_MMA(cb, kfb); }
#pragma unroll 1
                for (int t = 0; t < NTR; ++t) {
                    bf16x8 kfa[4], kfb[4];
                    if (t + 1 < NTR && ((t + 1) & 1) == 0) {
                        const int c = (t + 1) >> 1;
                        asm volatile("s_waitcnt vmcnt(0)" ::: "memory");
                        RAW_BARRIER();
                        if (c + 1 < NCK) MA_STAGE(c + 1, (c + 1) & 1);
                    }
                    const int bf = ((t + 1) >> 1) & 1, tl = 2 * ((t + 1) & 1);
#define MA_KRD(kf_, a_) asm volatile("ds_read_b128 %0, %4\n\tds_read_b128 %1, %4 offset:1024\n\tds_read_b128 %2, %4 offset:2048\n\tds_read_b128 %3, %4 offset:3072" : "=&v"(kf_[0]), "=&v"(kf_[1]), "=&v"(kf_[2]), "=&v"(kf_[3]) : "v"(a_) : "memory")
#define MA_KWAIT(kf_) asm volatile("s_waitcnt lgkmcnt(0)" : "+v"(kf_[0]), "+v"(kf_[1]), "+v"(kf_[2]), "+v"(kf_[3]) :: "memory")
                    const unsigned kad = (unsigned)(uintptr_t)(lds + A_KST + bf * 16384 + tl * 4096 + hi * 512 + kl * 16);
                    MA_KRD(kfa, kad);
                    float sXa, sYa, sXb, sYb;
                    MA_RED(sXa, sYa, ca);
                    asm volatile("" : "+v"(sXa), "+v"(sYa));
                    MA_KWAIT(kfa); MA_MMA(ca, kfa);
                    MA_KRD(kfb, kad + 4096u);
                    MA_RED(sXb, sYb, cb);
                    asm volatile("" : "+v"(sXb), "+v"(sYb));
                    MA_KWAIT(kfb); MA_MMA(cb, kfb);
#undef MA_KRD
#undef MA_KWAIT
                    const int sa = t * 64 + kl, sb2 = sa + 32;
                    const bool vXa = sa <= tX, vYa = sa <= tY, vXb = sb2 <= tX, vYb = sb2 <= tY;
                    if (pass == 0) {
                        const int bXa = a_bin(sXa, kbX), bYa = a_bin(sYa, kbY), bXb = a_bin(sXb, kbX), bYb = a_bin(sYb, kbY);
                        lds_add_u32_asm(histX + (bXa >> 1), vXa ? (1u << ((bXa & 1) * 16)) : 0u);
                        lds_add_u32_asm(histY + (bYa >> 1), vYa ? (1u << ((bYa & 1) * 16)) : 0u);
                        lds_add_u32_asm(histX + (bXb >> 1), vXb ? (1u << ((bXb & 1) * 16)) : 0u);
                        lds_add_u32_asm(histY + (bYb >> 1), vYb ? (1u << ((bYb & 1) * 16)) : 0u);
#define A_KEY16(s_) ((unsigned short)((__float_as_uint(s_) ^ ((unsigned)((int)__float_as_uint(s_) >> 31) | 0x80000000u)) >> 16))
                        {   unsigned short* kw = KEYS + (size_t)qX * 4096 + sa;
                            kw[0] = A_KEY16(sXa); kw[4096] = A_KEY16(sYa); kw[32] = A_KEY16(sXb); kw[4096 + 32] = A_KEY16(sYb); }
#undef A_KEY16
                    } else {
                        MA_APPEND(sXa, vXa, qX, cntX, ccX, eSX, eCX, sa); MA_APPEND(sYa, vYa, qY, cntY, ccY, eSY, eCY, sa);
                        MA_APPEND(sXb, vXb, qX, cntX, ccX, eSX, eCX, sb2); MA_APPEND(sYb, vYb, qY, cntY, ccY, eSY, eCY, sb2);
                    }
                    asm volatile("" : "+v"(ca), "+v"(cb));
                }
#undef MA_LOADK
#undef MA_MMA
#undef MA_RED
#undef MA_APPEND
                RAW_BARRIER();
                if (pass == 0) {
#pragma unroll 1
                    for (int q4 = 0; q4 < 4; ++q4) {
                        const LAS unsigned* hq = (const LAS unsigned*)(lds + A_HIST + (wave * 4 + q4) * 2048) + 504 - 8 * lane;
                        unsigned w8[8];
                        { const v4u a0 = *(const LAS v4u*)hq, a1 = *(const LAS v4u*)(hq + 4); w8[0] = a0.x; w8[1] = a0.y; w8[2] = a0.z; w8[3] = a0.w; w8[4] = a1.x; w8[5] = a1.y; w8[6] = a1.z; w8[7] = a1.w; }
                        unsigned loc = 0;
#pragma unroll
                        for (int j = 0; j < 8; ++j) loc += (w8[j] & 0xffffu) + (w8[j] >> 16);
                        unsigned inc = loc;
#pragma unroll
                        for (int o = 1; o < 64; o <<= 1) { const unsigned v = __shfl_up(inc, o); if (lane >= o) inc += v; }
                        unsigned run = inc - loc; int thr = -1; unsigned cab = 0;
#pragma unroll
                        for (int j = 7; j >= 0; --j)
#pragma unroll
                            for (int hh = 1; hh >= 0; --hh) { const unsigned cn = (w8[j] >> (16 * hh)) & 0xffffu;
                                if (thr < 0 && run + cn >= (unsigned)TOPK) { thr = 2 * (504 - 8 * lane + j) + hh; cab = run; }
                                run += cn; }
                        const unsigned long long bl = __ballot(inc >= (unsigned)TOPK);
                        int thq = -1; unsigned cbq = 0;
                        if (bl) { const int L = __ffsll((long long)bl) - 1; thq = __shfl(thr, L); cbq = __shfl(cab, L); }
                        (void)cbq;
                        if (q4 == 2 * hi) thrX = thq; if (q4 == 2 * hi + 1) thrY = thq;
                    }
                    eCX = a_edge(thrX, kbX); eSX = a_edge(thrX + 1, kbX); eCY = a_edge(thrY, kbY); eSY = a_edge(thrY + 1, kbY);
                }
            }
            {
                asm volatile("s_waitcnt vmcnt(0)" ::: "memory");
                __builtin_amdgcn_fence(__ATOMIC_RELEASE, "workgroup"); __builtin_amdgcn_fence(__ATOMIC_ACQUIRE, "workgroup");
                unsigned cq0 = 0, cq1 = 0, cq2 = 0, cq3 = 0, kq0 = 0, kq1 = 0, kq2 = 0, kq3 = 0;
#define MA_SCANQ(q4_, cntv_, ccv_) do { \
                    const unsigned eS_ = (unsigned)__builtin_amdgcn_readlane((int)(((q4_) & 1) ? eSY : eSX), ((q4_) >> 1) * 32) >> 16, eC_ = (unsigned)__builtin_amdgcn_readlane((int)(((q4_) & 1) ? eCY : eCX), ((q4_) >> 1) * 32) >> 16; \
                    const int tq_ = tw + (q4_), nch_ = (tq_ + 512) >> 9; \
                    const unsigned short* row_ = KEYS + (size_t)(wave * 4 + (q4_)) * 4096 + lane;     \
                    LAS bf16* so_ = (LAS bf16*)(lds + A_SEL + (wave * 4 + (q4_)) * 512); LAS bf16* co_ = (LAS bf16*)(lds + A_CAND + (wave * 4 + (q4_)) * 768 + 512); \
                    unsigned cnt_ = 0, cc_ = 0; unsigned nx_[8]; \
                    _Pragma("unroll") for (int j_ = 0; j_ < 8; ++j_) nx_[j_] = row_[64 * j_]; \
                    _Pragma("unroll 1") for (int c_ = 0; c_ < nch_; ++c_) { \
                        unsigned w_[8]; _Pragma("unroll") for (int j_ = 0; j_ < 8; ++j_) w_[j_] = nx_[j_]; \
                        if (c_ + 1 < nch_) { _Pragma("unroll") for (int j_ = 0; j_ < 8; ++j_) nx_[j_] = row_[512 * (c_ + 1) + 64 * j_]; } \
                        _Pragma("unroll") for (int j_ = 0; j_ < 8; ++j_) { \
                            const unsigned k_ = w_[j_]; const int ki_ = 512 * c_ + 64 * j_ + lane; \
                            const bool val_ = ki_ <= tq_, sel_ = val_ && k_ >= eS_, cd_ = val_ && k_ >= eC_ && k_ < eS_; \
                            const unsigned long long bs_ = __ballot(sel_), bc_ = __ballot(cd_); \
                            if (sel_) lds_st_b16_asm(so_ + cnt_ + __builtin_amdgcn_mbcnt_hi((unsigned)(bs_ >> 32), __builtin_amdgcn_mbcnt_lo((unsigned)bs_, 0u)), (unsigned)ki_); \
                            if (cd_) { const unsigned cp_ = cc_ + __builtin_amdgcn_mbcnt_hi((unsigned)(bc_ >> 32), __builtin_amdgcn_mbcnt_lo((unsigned)bc_, 0u)); if (cp_ < 128u) lds_st_b16_asm(co_ + cp_, (unsigned)ki_); } \
                            cnt_ += (unsigned)__popcll(bs_); cc_ += (unsigned)__popcll(bc_); } } \
                    cntv_ = cnt_; ccv_ = cc_; } while (0)
                MA_SCANQ(0, cq0, kq0); MA_SCANQ(1, cq1, kq1); MA_SCANQ(2, cq2, kq2); MA_SCANQ(3, cq3, kq3);
#undef MA_SCANQ
                cntX = hi ? cq2 : cq0; cntY = hi ? cq3 : cq1; ccX = hi ? kq2 : kq0; ccY = hi ? kq3 : kq1;
                asm volatile("s_waitcnt lgkmcnt(0)" ::: "memory");
                const int n0 = min(__builtin_amdgcn_readlane((int)ccX, 0), 128), n2 = min(__builtin_amdgcn_readlane((int)ccX, 32), 128), n1 = min(__builtin_amdgcn_readlane((int)ccY, 0), 128), n3 = min(__builtin_amdgcn_readlane((int)ccY, 32), 128);
#pragma unroll 1
                for (int qp = 0; qp < 2; ++qp) {
                    const int na = qp ? n2 : n0, nb2 = qp ? n3 : n1, nmax = na > nb2 ? na : nb2;
                    LAS float* csa = (LAS float*)(lds + A_CAND + (wave * 4 + 2 * qp) * 768); LAS float* csb = (LAS float*)(lds + A_CAND + (wave * 4 + 2 * qp + 1) * 768);
                    const LAS bf16* cia = (const LAS bf16*)(lds + A_CAND + (wave * 4 + 2 * qp) * 768 + 512); const LAS bf16* cib = (const LAS bf16*)(lds + A_CAND + (wave * 4 + 2 * qp + 1) * 768 + 512);
#pragma unroll 1
                    for (int tb = 0; tb < nmax; tb += 32) {
                        const int ia = (tb + kl < na) ? (int)cia[tb + kl] : 0, ib = (tb + kl < nb2) ? (int)cib[tb + kl] : 0;
                        bf16x8 kfa[4], kfb[4];
#pragma unroll
                        for (int ks = 0; ks < 4; ++ks) { kfa[ks] = *(const bf16x8*)(MISC + (size_t)(rb + ia) * 256 + 128 + (2 * ks + hi) * 8); kfb[ks] = *(const bf16x8*)(MISC + (size_t)(rb + ib) * 256 + 128 + (2 * ks + hi) * 8); }
                        f32x16 ca, cb;
#pragma unroll
                        for (int r = 0; r < 16; ++r) { ca[r] = 0.f; cb[r] = 0.f; }
#pragma unroll
                        for (int ks = 0; ks < 4; ++ks) { ca = __builtin_amdgcn_mfma_f32_32x32x16_bf16(aq[ks], kfa[ks], ca, 0, 0, 0); cb = __builtin_amdgcn_mfma_f32_32x32x16_bf16(aq[ks], kfb[ks], cb, 0, 0, 0); }
#define RELU2(x_) __int_as_float(max(__float_as_int(x_), 0))
#define MA_RED2(sX_, sY_, c_) do { float p0_ = 0.f, p1_ = 0.f, p2_ = 0.f, p3_ = 0.f; \
                        _Pragma("unroll") for (int i = 0; i < 4; ++i) { p0_ += wr[i] * RELU2(c_[i]); p1_ += wr[4 + i] * RELU2(c_[4 + i]); p2_ += wr[8 + i] * RELU2(c_[8 + i]); p3_ += wr[12 + i] * RELU2(c_[12 + i]); } \
                        { auto rr = __builtin_amdgcn_permlane32_swap(__float_as_uint(p0_), __float_as_uint(p2_), false, false); sX_ = __uint_as_float(rr[0]) + __uint_as_float(rr[1]) + 0.f; } \
                        { auto rr = __builtin_amdgcn_permlane32_swap(__float_as_uint(p1_), __float_as_uint(p3_), false, false); sY_ = __uint_as_float(rr[0]) + __uint_as_float(rr[1]) + 0.f; } } while (0)
                        float aX, aY, bX, bY;
                        MA_RED2(aX, aY, ca); MA_RED2(bX, bY, cb);
#undef MA_RED2
#undef RELU2
                        if (hi == qp && tb + kl < na) csa[tb + kl] = aX;
                        if (hi == qp && tb + kl < nb2) csb[tb + kl] = bY;
                    }
                }
                asm volatile("s_waitcnt lgkmcnt(0)" ::: "memory");
            }
            }
#undef MA_STAGE
            {
                const unsigned c0 = (unsigned)__shfl((int)cntX, 0), c2 = (unsigned)__shfl((int)cntX, 32), c1 = (unsigned)__shfl((int)cntY, 0), c3 = (unsigned)__shfl((int)cntY, 32);
                const unsigned k0 = (unsigned)__shfl((int)ccX, 0), k2 = (unsigned)__shfl((int)ccX, 32), k1 = (unsigned)__shfl((int)ccY, 0), k3 = (unsigned)__shfl((int)ccY, 32);
#pragma unroll 1
                for (int q4 = 0; q4 < 4; ++q4) {
                    const unsigned cnt = (q4 == 0) ? c0 : (q4 == 1) ? c1 : (q4 == 2) ? c2 : c3; unsigned cc = (q4 == 0) ? k0 : (q4 == 1) ? k1 : (q4 == 2) ? k2 : k3;
                    if (cc > 128u) cc = 128u;
                    LAS unsigned* nfp = (LAS unsigned*)(lds + A_BIAS + 1024) + wave * 4 + q4;
                    if (lane == 0) *nfp = cnt;
                    if (cnt >= (unsigned)TOPK || cc == 0u) continue;
                    const unsigned need = (unsigned)TOPK - cnt;
                    const LAS float* cs = (const LAS float*)(lds + A_CAND + (wave * 4 + q4) * 768); const LAS bf16* ci = (const LAS bf16*)(lds + A_CAND + (wave * 4 + q4) * 768 + 512);
                    LAS bf16* so = (LAS bf16*)(lds + A_SEL + (wave * 4 + q4) * 512);
                    unsigned base = cnt;
#pragma unroll 1
                    for (unsigned r0 = 0; r0 < cc; r0 += 64) { const unsigned i = r0 + lane; const bool act = i < cc;
                        const float si = act ? cs[i] : 0.f; const unsigned ii = act ? ci[i] : 0u; unsigned rank = 0;
                        for (unsigned j = 0; j < cc; ++j) { const float sj = cs[j]; const unsigned ij = ci[j]; rank += (sj > si || (sj == si && ij < ii)) ? 1u : 0u; }
                        const bool take = act && rank < need;
                        const unsigned long long bt = __ballot(take);
                        if (take) so[base + __popcll(bt & ((1ull << lane) - 1ull))] = (bf16)ii;
                        base += __popcll(bt); }
                    if (lane == 0) *nfp = base;
                }
            }
            RAW_BARRIER();
            {
                bf16x8 bqa[4];
#pragma unroll
                for (int ks = 0; ks < 4; ++ks) bqa[ks] = *(const bf16x8*)(AQ + (size_t)(rb + t0 + kl) * 512 + wave * 64 + 16 * ks + 8 * hi);
#pragma unroll
                for (int nt = 0; nt < 4; ++nt) {
                    f32x16 cq;
#pragma unroll
                    for (int r = 0; r < 16; ++r) cq[r] = 0.f;
#pragma unroll
                    for (int ks = 0; ks < 4; ++ks) { const bf16x8 ua = *(const bf16x8*)(UKT + ((size_t)wave * 128 + 32 * nt + kl) * 64 + 16 * ks + 8 * hi); cq = __builtin_amdgcn_mfma_f32_32x32x16_bf16(ua, bqa[ks], cq, 0, 0, 0); }
                    bf16* qrow = QLS + (size_t)kl * 1024 + wave * 128 + 32 * nt + 4 * hi;
#pragma unroll
                    for (int g4 = 0; g4 < 4; ++g4) { v2u w; w.x = pk2(cq[4 * g4], cq[4 * g4 + 1]); w.y = pk2(cq[4 * g4 + 2], cq[4 * g4 + 3]); *(v2u*)(qrow + 8 * g4) = w; }
                }
                asm volatile("s_waitcnt vmcnt(0)" ::: "memory");
                __builtin_amdgcn_fence(__ATOMIC_RELEASE, "workgroup");
                RAW_BARRIER();
                __builtin_amdgcn_fence(__ATOMIC_ACQUIRE, "workgroup");
            }
#pragma unroll 1
            for (int rep9 = 0; rep9 < ((PROBE == 9 || PROBE == 10 || PROBE == 11) ? 2 : 1); ++rep9) {
                bf16* OUTP_ = ((PROBE == 9 || PROBE == 10 || PROBE == 11) && rep9 == 0) ? OUTA2 : OUTA;
                LAS unsigned char* gb = lds + wave * 16384;
                LAS bf16* bkt = (LAS bf16*)(lds + A_BKT + wave * 512);
#pragma unroll 1
                for (int q4 = 0; q4 < 4; ++q4) { int ns = (int)((const LAS unsigned*)(lds + A_BIAS + 1024))[wave * 4 + q4]; ns = ns < TOPK ? ns : TOPK; LAS bf16* so = (LAS bf16*)(lds + A_SEL + (wave * 4 + q4) * 512);
                    for (int i = lane; i < TOPK; i += 64) if (i >= ns) so[i] = 0; }
                asm volatile("s_waitcnt lgkmcnt(0)" ::: "memory");
                const int c15 = lane & 15, g = lane >> 4, q_ = c15 >> 2, p_ = c15 & 3, hc = c15 < 8 ? c15 : 7;
                const int Xr = ((c15 & 3) << 2) | ((c15 >> 2) & 3), Xt = (q_ << 2) | g;
                unsigned ra[4], ta[8];
#pragma unroll
                for (int ks = 0; ks < 4; ++ks) ra[ks] = (unsigned)(256 * c15 + 16 * ((4 * ks + g) ^ Xr));
#pragma unroll
                for (int dt = 0; dt < 8; ++dt) ta[dt] = (unsigned)(256 * (4 * g + q_) + 16 * ((2 * dt + (p_ >> 1)) ^ Xt) + 8 * (p_ & 1));
                bf16x8 bbf;
                { v4u w; const LAS float* bl = biasl + (8 * g) * 8 + hc;
                  constexpr float BS = 8.0f / LOG2E;
                  w.x = pk2(bl[0] * BS, bl[8] * BS); w.y = pk2(bl[16] * BS, bl[24] * BS); w.z = pk2(bl[32] * BS, bl[40] * BS); w.w = pk2(bl[48] * BS, bl[56] * BS); bbf = __builtin_bit_cast(bf16x8, w); }
#define MA_GATHER(q4_, c8_, buf_) do { const LAS bf16* so_ = (const LAS bf16*)(lds + A_SEL + (wave * 4 + (q4_)) * 512) + (c8_) * 32; \
                    int idx_[8]; _Pragma("unroll") for (int i_ = 0; i_ < 8; ++i_) idx_[i_] = (PROBE == 10 && rep9 == 0) ? (4 * i_ + (lane >> 4)) : (int)so_[4 * i_ + (lane >> 4)]; \
                    asm volatile("s_waitcnt lgkmcnt(0)" : "+v"(idx_[0]), "+v"(idx_[1]), "+v"(idx_[2]), "+v"(idx_[3]), "+v"(idx_[4]), "+v"(idx_[5]), "+v"(idx_[6]), "+v"(idx_[7]) :: "memory"); \
                    _Pragma("unroll") for (int i_ = 0; i_ < 8; ++i_) { const int row_ = 4 * i_ + (lane >> 4); \
                        const int ch_ = (lane & 15) ^ (((row_ & 3) << 2) | ((row_ >> 2) & 3)); \
                        glds16(KVN + (size_t)(rb + idx_[i_]) * 128 + ch_ * 8, gb + (buf_) * 8192 + i_ * 1024); } } while (0)
                MA_GATHER(0, 0, 0);
#pragma unroll 1
                for (int q4 = 0; q4 < 4; ++q4) {
                    const int t = tw + q4; int ns = (int)((const LAS unsigned*)(lds + A_BIAS + 1024))[wave * 4 + q4]; ns = ns < TOPK ? ns : TOPK;
                    const LAS bf16* so = (const LAS bf16*)(lds + A_SEL + (wave * 4 + q4) * 512);
                    for (int i = lane; i < TOPK; i += 64) { const int d = t - (int)so[i]; lds_st_b16_asm(bkt + i, (unsigned)rel_bucket(d < 0 ? 0 : d)); }
                    bf16x8 bq[4];
#pragma unroll
                    for (int ks = 0; ks < 4; ++ks) { bq[ks] = (bf16x8){0, 0, 0, 0, 0, 0, 0, 0}; if (c15 < 8) bq[ks] = *(const bf16x8*)(QLS + (size_t)(4 * wave + q4) * 1024 + c15 * 128 + 32 * ks + 8 * g); }
                    f32x4 O[8];
#pragma unroll
                    for (int dt = 0; dt < 8; ++dt) O[dt] = (f32x4){0.f, 0.f, 0.f, 0.f};
                    float mref = -INFINITY, lsum = 0.f;
#pragma unroll 1
                    for (int c8 = 0; c8 < 8; ++c8) {
                        const int step = q4 * 8 + c8, buf = step & 1;
#if AGATHER_POS == 0
                        asm volatile("s_waitcnt lgkmcnt(0)" ::: "memory");
                        if (step + 1 < 32) { MA_GATHER((step + 1) >> 3, (step + 1) & 7, buf ^ 1); asm volatile("s_waitcnt vmcnt(8)" ::: "memory"); }
                        else asm volatile("s_waitcnt vmcnt(0)" ::: "memory");
#else
                        asm volatile("s_waitcnt vmcnt(0) lgkmcnt(0)" ::: "memory");
#endif
                        const LAS unsigned char* cb = gb + buf * 8192;
                        if (PROBE == 11 && rep9 == 0) continue;
                        f32x4 sv[2];
#pragma unroll
                        for (int tau = 0; tau < 2; ++tau) {
                            f32x4 sa = (f32x4){0.f, 0.f, 0.f, 0.f};
#pragma unroll
                            for (int ks = 0; ks < 4; ++ks) { const bf16x8 kf = *(const LAS bf16x8*)(cb + ra[ks] + 4096 * tau); sa = __builtin_amdgcn_mfma_f32_16x16x32_bf16(kf, bq[ks], sa, 0, 0, 0); }
                            const int b = (int)bkt[c8 * 32 + 16 * tau + c15];
                            const unsigned val = ((b >> 3) == g) ? (0x3F80u << ((b & 1) * 16)) : 0u; const int di = (b >> 1) & 3;
                            v4u oh; oh.x = (di == 0) ? val : 0u; oh.y = (di == 1) ? val : 0u; oh.z = (di == 2) ? val : 0u; oh.w = (di == 3) ? val : 0u;
                            sa = __builtin_amdgcn_mfma_f32_16x16x32_bf16(__builtin_bit_cast(bf16x8, oh), bbf, sa, 0, 0, 0);
                            sv[tau] = sa * C2;
                        }
                        if (ns < TOPK) {
#pragma unroll
                            for (int tau = 0; tau < 2; ++tau)
#pragma unroll
                                for (int r = 0; r < 4; ++r) if (c8 * 32 + 16 * tau + 4 * g + r >= ns) sv[tau][r] = -INFINITY;
                        }
                        float rm = fmaxf(fmaxf(fmaxf(sv[0][0], sv[0][1]), fmaxf(sv[0][2], sv[0][3])), fmaxf(fmaxf(sv[1][0], sv[1][1]), fmaxf(sv[1][2], sv[1][3])));
                        rm = swap_max(swap16_max(rm));
                        if (__any(rm > mref + THR)) {
                            const float mn = fmaxf(mref, rm), f = (mn == -INFINITY) ? 1.f : __builtin_amdgcn_exp2f(mref - mn);
                            lsum *= f; mref = mn;
#pragma unroll
                            for (int dt = 0; dt < 8; ++dt) O[dt] = O[dt] * f;
                        }
                        const float msub = (mref == -INFINITY) ? 0.f : mref;
                        float ps = 0.f;
#pragma unroll
                        for (int tau = 0; tau < 2; ++tau)
#pragma unroll
                            for (int r = 0; r < 4; ++r) { sv[tau][r] = __builtin_amdgcn_exp2f(sv[tau][r] - msub); ps += sv[tau][r]; }
                        lsum += ps;
#if AGATHER_POS == 1
                        if (step + 1 < 32 && !(PROBE == 11 && rep9 == 0)) { MA_GATHER((step + 1) >> 3, (step + 1) & 7, buf ^ 1); }
#endif
                        bf16x8 pf;
                        { v4u w; w.x = cvtpk(sv[0][0], sv[0][1]); w.y = cvtpk(sv[0][2], sv[0][3]); w.z = cvtpk(sv[1][0], sv[1][1]); w.w = cvtpk(sv[1][2], sv[1][3]); pf = __builtin_bit_cast(bf16x8, w); }
                        {
                            const unsigned cbu = (unsigned)(uintptr_t)cb;
                            s16x4 fa[8], fb[8];
#pragma unroll
                            for (int dt = 0; dt < 4; ++dt) { TRV(fa[2 * dt], cbu + ta[dt], 0); TRV(fa[2 * dt + 1], cbu + ta[dt], 4096); }
#pragma unroll
                            for (int dt = 0; dt < 4; ++dt) { TRV(fb[2 * dt], cbu + ta[4 + dt], 0); TRV(fb[2 * dt + 1], cbu + ta[4 + dt], 4096); }
                            LGKM_WAIT8(8, fa);
#pragma unroll
                            for (int dt = 0; dt < 4; ++dt) O[dt] = __builtin_amdgcn_mfma_f32_16x16x32_bf16(VFRAG(fa, dt), pf, O[dt], 0, 0, 0);
                            LGKM_WAIT8(0, fb);
#pragma unroll
                            for (int dt = 0; dt < 4; ++dt) O[4 + dt] = __builtin_amdgcn_mfma_f32_16x16x32_bf16(VFRAG(fb, dt), pf, O[4 + dt], 0, 0, 0);
                        }
                    }
                    const float lt = swap_add(swap16_add(lsum));
                    const float inv = 1.0f / lt;
                    if (c15 < 8) { bf16* orow = OUTP_ + (size_t)(rb + t) * 1024 + c15 * 128 + 4 * g;
#pragma unroll
                        for (int dt = 0; dt < 8; ++dt) { v2u w; w.x = pk2(O[dt][0] * inv, O[dt][1] * inv); w.y = pk2(O[dt][2] * inv, O[dt][3] * inv); *(v2u*)(orow + 16 * dt) = w; } }
                }
#undef MA_GATHER
                asm volatile("s_waitcnt vmcnt(0)" ::: "memory");
            }
        }
    }
}
#define Y_() (WSP() + WS_Y)
#define WL_(l) (WSP() + WS_W + (size_t)(l) * W_LAYER)
#define MOD_(l) ((const float*)(WSP() + WS_MOD) + (size_t)(l) * 8 * 6144)
#define T_() ((const float*)(WSP() + WS_TAB))
#define H_() ((bf16*)(WSP() + WS_H))
#define KVN_() ((bf16*)(WSP() + WS_KVN))
#define KMAXW_(l, ch) ((unsigned*)(WSP() + WS_CTL) + 8192 + ((l) * NCH + (ch)) * 64)
#define LAMI_(l) (((l) == 0) ? 0.8f : 0.64449093f)
__device__ __forceinline__ int tidx(int w) { int t = (int)threadIdx.x; (void)w; asm volatile("" : "+v"(t)); return t; }
#define TID_ tidx(wave)
#define LANE_ (tidx(wave) & 63)
#ifndef STAGGER_TICKS
#define STAGGER_TICKS 0
#endif
#ifndef P1_ALIGN
#define P1_ALIGN true
#endif
#define GBAR() do { xcd_barrier(bar); if (PROBE == 16) xcd_barrier(bar); } while (0)
__global__ void __launch_bounds__(NTHREADS, 2) fwd(Args a) {
    extern __shared__ __attribute__((aligned(16))) unsigned char lds_raw[];
    LAS unsigned char* lds = (LAS unsigned char*)lds_raw;
    const int wave = __builtin_amdgcn_readfirstlane((int)threadIdx.x >> 6);
    const int G = gridDim.x, gw = blockIdx.x * NWAVES + wave, NGW = G * NWAVES;
    for (int u = (int)threadIdx.x; u < (LDS_BYTES - LDSCTL_OFF) / 4; u += NTHREADS) ((LAS unsigned*)(lds + LDSCTL_OFF))[u] = 0u;
    __syncthreads();
    XcdBarrier bar = xcd_barrier_post((unsigned*)(WSP() + WS_CTL) + CW_BAR, (volatile LAS unsigned*)(lds + LDSCTL_OFF), wave);

#pragma unroll 1
    for (int rep = 0; rep < (PROBE == 5 ? 2 : 1); ++rep) {
    p0a_prologue(WSP(), lds, TID_, LANE_, wave, G);
    GBAR(); }
    norm_rows(ARG(0), H_(), ARG(4), MOD_(0) + 0 * 1024, MOD_(0) + 1 * 1024, gw, NGW, LANE_);
    GBAR();

#pragma unroll 1
    for (int l = 0; l < NL; ++l) {
#pragma unroll 1
        for (int ch = 0; ch < NCH; ++ch) {
            { pg8::Gemm g{H_() + (size_t)ch * CHR * 1024, (const bf16*)(WL_(l) + W_IN), CHR, NIN, 1024}; pg8::StaticOrder S; S.init(CHR, NIN, G, (int)blockIdx.x);
              pg8::EpiIn E{Y_(), 0};
#if STAGGER_TICKS > 0
              { const unsigned long long t0 = __builtin_amdgcn_s_memrealtime(); const unsigned long long dl = (unsigned long long)((blockIdx.x >> 3) & 3u) * STAGGER_TICKS;
                while (__builtin_amdgcn_s_memrealtime() - t0 < dl) __builtin_amdgcn_s_sleep(8); }
#endif
#pragma unroll 1
              for (int rep = 0; rep < ((PROBE == 1 || PROBE == 17 || PROBE == 19) ? 2 : 1); ++rep) {
              E.skip = (PROBE == 19 && rep == 0) ? 1 : 0;
              pg8::gemm_phase<pg8::EpiIn, pg8::StaticOrder, P1_ALIGN, true>(lds, g, S, E, wave); }
            }
            GBAR();
            kvn_rows(Y_(), KVN_(), ARG(8) + l * 128, KMAXW_(l, ch), gw, NGW, LANE_);
#if PROBE == 4
            mixC_fast(Y_(), WSP(), T_(), lds, TID_, LANE_, wave, G);
#endif
            mixC_fast(Y_(), WSP(), T_(), lds, TID_, LANE_, wave, G);
#if PROBE == 2 || (PROBE >= 12 && PROBE <= 15)
            mixB_fast<(PROBE == 2 ? 0 : PROBE - 11)>(Y_(), (bf16*)(WSP() + 484 * MiB), T_(), ARG(13) + l * 128, ((const float*)(WSP() + WS_LAM))[l], LAMI_(l), lds, TID_, LANE_, wave, G);
#endif
            mixB_fast<0>(Y_(), (bf16*)(Y_() + Y_BQ), T_(), ARG(13) + l * 128, ((const float*)(WSP() + WS_LAM))[l], LAMI_(l), lds, TID_, LANE_, wave, G);
            GBAR();
            mergeC(Y_(), WSP(), gw, NGW, LANE_);
#if PROBE == 3 || PROBE == 9 || PROBE == 10 || PROBE == 11
            GBAR();
#endif
#if PROBE == 3
            mixA_fast(Y_(), (bf16*)(WSP() + WS_OG), (bf16*)(WSP() + WS_OG), KVN_(), (const bf16*)(WL_(l) + W_UKT), T_(), ARG(21), KMAXW_(l, ch), lds, TID_, LANE_, wave, G);
#endif
            mixA_fast(Y_(), (bf16*)(Y_() + Y_OLAT), (bf16*)(WSP() + WS_OG), KVN_(), (const bf16*)(WL_(l) + W_UKT), T_(), ARG(21), KMAXW_(l, ch), lds, TID_, LANE_, wave, G);
            GBAR();
#pragma unroll 1
            for (int rep = 0; rep < (PROBE == 7 ? 2 : 1); ++rep)
            { pg8::StaticOrder S; S.init(CHR, 1024, G, (int)blockIdx.x);
              { unsigned char* y = Y_(); pg8::Gemm g{(const bf16*)(y + Y_OLAT), (const bf16*)(WL_(l) + W_A), CHR, 1024, 1024}; pg8::EpiGate<0> E{(const bf16*)(y + Y_Z), 0, (float*)(y + Y_MF32), (bf16*)(y + Y_MBF)};
                pg8::gemm_phase<pg8::EpiGate<0>, pg8::StaticOrder, true, true>(lds, g, S, E, wave); }
              { unsigned char* y = Y_(); pg8::Gemm g{(const bf16*)(y + Y_BQ), (const bf16*)(WL_(l) + W_B), CHR, 1024, 512}; pg8::EpiGate<1> E{(const bf16*)(y + Y_Z), 1024, (float*)(y + Y_MF32), (bf16*)(y + Y_MBF)};
                pg8::gemm_phase<pg8::EpiGate<1>, pg8::StaticOrder, true, true>(lds, g, S, E, wave); }
              { unsigned char* y = Y_(); pg8::Gemm g{(const bf16*)(y + Y_OC), (const bf16*)(WL_(l) + W_C), CHR, 1024, 256}; pg8::EpiGate<2> E{(const bf16*)(y + Y_Z), 2048, (float*)(y + Y_MF32), (bf16*)(y + Y_MBF)};
                pg8::gemm_phase<pg8::EpiGate<2>, pg8::StaticOrder, true, true>(lds, g, S, E, wave); } }
            GBAR();
            { pg8::Gemm g{(const bf16*)(Y_() + Y_MBF), (const bf16*)(WL_(l) + W_OUT), CHR, 1024, 1024}; pg8::StaticOrder S; S.init(CHR, 1024, G, (int)blockIdx.x);
              pg8::EpiRes E{(l == 0) ? ARG(0) : (const float*)OUTP(), OUTP(), MOD_(l) + 2 * 1024, ch * CHR};
              pg8::gemm_phase<pg8::EpiRes, pg8::StaticOrder, true, true>(lds, g, S, E, wave); }
            GBAR();
        }
#pragma unroll 1
        for (int rep = 0; rep < (PROBE == 6 ? 2 : 1); ++rep) {
        norm_rows(OUTP(), H_(), ARG(18) + l * 1024, MOD_(l) + 3 * 1024, MOD_(l) + 4 * 1024, gw, NGW, LANE_);
        GBAR(); }
        { pg8::Gemm g{H_(), (const bf16*)(WL_(l) + W_GU), MT, NGU, 1024}; pg8::StaticOrder S; S.init(MT, NGU, G, (int)blockIdx.x);
          pg8::EpiSwiGLU E{(bf16*)(WSP() + WS_ACT)};
#pragma unroll 1
          for (int rep = 0; rep < ((PROBE == 1 || PROBE == 18) ? 2 : 1); ++rep)
          pg8::gemm_phase<pg8::EpiSwiGLU, pg8::StaticOrder, true, true>(lds, g, S, E, wave);
        }
        GBAR();
        { pg8::Gemm g{(const bf16*)(WSP() + WS_ACT), (const bf16*)(WL_(l) + W_D), MT, 1024, DFF}; pg8::StaticOrder S; S.init(MT, 1024, G, (int)blockIdx.x);
          pg8::EpiRes E{OUTP(), OUTP(), MOD_(l) + 5 * 1024, 0};
          pg8::gemm_phase<pg8::EpiRes, pg8::StaticOrder, true, true>(lds, g, S, E, wave); }
        GBAR();
        if (l + 1 < NL) { norm_rows(OUTP(), H_(), ARG(4) + (l + 1) * 1024, MOD_(l + 1) + 0 * 1024, MOD_(l + 1) + 1 * 1024, gw, NGW, LANE_); GBAR(); }
        else final_rows(OUTP(), ARG(22), gw, NGW, LANE_);
    }
}

extern "C" void kernel_launch(void* const* d_in, const int* in_sizes, int n_in, void* d_out, int out_size, void* d_ws, size_t ws_size, hipStream_t stream) {
    static int grid = 0;
    if (grid == 0) {
        if (n_in != 23 || out_size != MT * DM || ws_size < WS_END) { fprintf(stderr, "kernel_launch: unexpected shapes (n_in %d out %d ws %zu)\n", n_in, out_size, ws_size); grid = -1; return; }
        int dev = 0, cus = 0, per_cu = 0;
        if (hipGetDevice(&dev) != hipSuccess || hipDeviceGetAttribute(&cus, hipDeviceAttributeMultiprocessorCount, dev) != hipSuccess) { grid = -1; return; }
        if (hipFuncSetAttribute((const void*)fwd, hipFuncAttributeMaxDynamicSharedMemorySize, LDS_BYTES) != hipSuccess) { fprintf(stderr, "kernel_launch: hipFuncSetAttribute failed\n"); grid = -1; return; }
        if (hipOccupancyMaxActiveBlocksPerMultiprocessor(&per_cu, (const void*)fwd, NTHREADS, LDS_BYTES) != hipSuccess || per_cu < 1) { fprintf(stderr, "kernel_launch: occupancy query says %d\n", per_cu); }
        (void)hipGetLastError();
        grid = cus;
    }
    if (grid < 0) return;
    (void)hipMemsetAsync((char*)d_ws + WS_CTL, 0, CTL_ZERO_BYTES, stream);
    Args a{};
    for (int i = 0; i < 23; ++i) a.in[i] = (const float*)d_in[i];
    a.out = (float*)d_out; a.ws = (unsigned char*)d_ws; a.pad0 = 0; a.pad1 = 0;
    hipLaunchKernelGGL(fwd, dim3(grid), dim3(NTHREADS), LDS_BYTES, stream, a);
}
```

```cpp
#include <hip/hip_runtime.h>
#include <cstdio>
#include <cstdint>
#ifndef PROBE
#define PROBE 0
#endif
#ifndef DIAG_OFS
#define DIAG_OFS 0.5f
#endif
#ifndef BSTAGE_POS
#define BSTAGE_POS 2
#endif
#ifndef AGATHER_POS
#define AGATHER_POS 1
#endif
namespace pg8 {
#define PG8_LAS __attribute__((address_space(3)))
typedef unsigned short bf16_t;
typedef short bf16x8 __attribute__((ext_vector_type(8)));
typedef float f32x4 __attribute__((ext_vector_type(4)));
typedef unsigned u32x4 __attribute__((ext_vector_type(4)));
constexpr int BM = 256, BK = 64, HALF = 128, HTB = HALF * BK * 2  , STAGE_BYTES = 8 * HTB, NXCD = 8, WGM = 8;

__host__ __device__ __forceinline__ int lds_byte(int r, int c) { const int st = (r >> 4) * 2 + (c >> 5), rr = r & 15, cc = c & 31, ob = rr * 64 + cc * 2; return st * 1024 + (ob ^ (((ob >> 9) & 1) << 5)); }
__host__ __device__ __forceinline__ void stage_rc(int b, int& R, int& C) { const int st = b / 1024, sb = b % 1024, swz = sb ^ (((sb >> 9) & 1) << 5); R = (st >> 1) * 16 + swz / 64; C = (st & 1) * 32 + (swz % 64) / 2; }
__host__ __device__ __forceinline__ int perm32(int rho) { const int n = rho >> 4, i = rho & 15; return 8 * (i >> 2) + 4 * n + (i & 3); }

struct Unit { int pm, pn; };
struct Gemm { const bf16_t* A; const bf16_t* Bt; int M, N, K; };

struct StaticOrder {
    int nM, nN, nwg, G, c;
    __host__ __device__ void init(int M, int N, int G_, int c_) { nM = M / BM; nN = N / BM; nwg = nM * nN; G = G_; c = c_; }
    __host__ __device__ bool next(int i, Unit& u) const {
        const long L = (long)i * G + c; if (L >= nwg) return false;
        int wgid = (int)L; { const int q = nwg / NXCD, r = nwg % NXCD, xcd = wgid % NXCD, off = wgid / NXCD; wgid = (xcd < r ? xcd * (q + 1) : r * (q + 1) + (xcd - r) * q) + off; }
        const int nig = WGM * nN, gid = wgid / nig, fm = gid * WGM, gsz = (nM - fm) < WGM ? (nM - fm) : WGM;
        u.pm = fm + ((wgid % nig) % gsz); u.pn = (wgid % nig) / gsz; return true;
    }
    __device__ __forceinline__ void a_ready(const Unit&) const {}
    __device__ __forceinline__ void done(const Unit&) const {}
};

template <class Epi, class Sched, bool ALIGN_EPI = false, bool SP2 = false>
__device__ __forceinline__ void gemm_phase(PG8_LAS unsigned char* lds, const Gemm g, const Sched& S, const Epi& E, int wv) {
    int tid_l = threadIdx.x; (void)wv; asm volatile("" : "+v"(tid_l));
    const int tid = tid_l, wid = __builtin_amdgcn_readfirstlane(tid >> 6), lane = tid & 63, wr = wid >> 2, wc = wid & 3, fr = lane & 15, fq = lane >> 4;
    int K_l = g.K; asm volatile("" : "+s"(K_l));
    const int K = K_l, nt = K / BK;
    unsigned voffA[2], voffB[2];
#pragma unroll
    for (int i = 0; i < 2; ++i) { int R, C; stage_rc(tid * 16 + i * 8192, R, C); const int Rb = Epi::PERM ? ((R & ~31) + perm32(R & 31)) : R;
        voffA[i] = (unsigned)(R * K + C) * 2u; voffB[i] = (unsigned)(Rb * K + C) * 2u; }
    const size_t kstep = (size_t)(BK * 2);
    const size_t hstep = (size_t)HALF * K * 2;
    const size_t tstep = 2 * hstep;
    const unsigned ldsw = (unsigned)wid * 1024u;
    const int aoff = lds_byte(wr * 64 + fr, fq * 8), boff = lds_byte(wc * 32 + fr, fq * 8);
#define PG8_SA(b, h) (((b) * 2 + (h)) * HTB)
#define PG8_SB(b, h) ((4 + (b) * 2 + (h)) * HTB)
#define PG8_STAGE(bufoff, gbase, voff) do { _Pragma("unroll") for (int _i = 0; _i < 2; ++_i) \
        __builtin_amdgcn_global_load_lds((const unsigned*)((const char*)(gbase) + (voff)[_i]), (PG8_LAS unsigned*)(lds + (bufoff) + ldsw + _i * 8192), 16, 0, 0); } while (0)
#define PG8_LDA(dst, b, h) do { _Pragma("unroll") for (int m = 0; m < 4; ++m) _Pragma("unroll") for (int k = 0; k < 2; ++k) dst[m][k] = *(const PG8_LAS bf16x8*)(lds + PG8_SA(b, h) + aoff + m * 2048 + k * 1024); } while (0)
#define PG8_LDB(dst, b, h) do { _Pragma("unroll") for (int n = 0; n < 2; ++n) _Pragma("unroll") for (int k = 0; k < 2; ++k) dst[n][k] = *(const PG8_LAS bf16x8*)(lds + PG8_SB(b, h) + boff + n * 2048 + k * 1024); } while (0)
#define PG8_MMA(ai, bj, At, Bt) do { __builtin_amdgcn_s_setprio(1); _Pragma("unroll") for (int m = 0; m < 4; ++m) _Pragma("unroll") for (int n = 0; n < 2; ++n) _Pragma("unroll") for (int k = 0; k < 2; ++k) \
        acc[ai][bj][m][n] = __builtin_amdgcn_mfma_f32_16x16x32_bf16(Bt[n][k], At[m][k], acc[ai][bj][m][n], 0, 0, 0); __builtin_amdgcn_s_setprio(0); } while (0)
#define PG8_WAIT_V(n) asm volatile("s_waitcnt vmcnt(" #n ")" ::: "memory")
#define PG8_WAIT_L(n) asm volatile("s_waitcnt lgkmcnt(" #n ")" ::: "memory")
#define PG8_BAR __builtin_amdgcn_s_barrier()
#define PG8_SCHED __builtin_amdgcn_sched_barrier(0)
    Unit cur, nxt; int ui = 0;
    if (!S.next(0, cur)) return;
    f32x4 acc[2][2][4][2];
#pragma unroll
    for (int a = 0; a < 2; ++a)
#pragma unroll
        for (int b = 0; b < 2; ++b)
#pragma unroll
            for (int m = 0; m < 4; ++m)
#pragma unroll
                for (int n = 0; n < 2; ++n) acc[a][b][m][n] = (f32x4){0.f, 0.f, 0.f, 0.f};
    bf16x8 At[4][2], B0[2][2], B1[2][2];
    const char* cA = (const char*)g.A + (size_t)cur.pm * tstep; const char* cB = (const char*)g.Bt + (size_t)cur.pn * tstep;
    S.a_ready(cur);
    if constexpr (SP2) {
        PG8_STAGE(PG8_SB(0, 0), cB, voffB); PG8_STAGE(PG8_SB(0, 1), cB + hstep, voffB); PG8_STAGE(PG8_SA(0, 0), cA, voffA); PG8_STAGE(PG8_SA(0, 1), cA + hstep, voffA);
        if (wr == 1) PG8_BAR;
        PG8_WAIT_V(2); PG8_BAR;
        PG8_STAGE(PG8_SB(1, 0), cB + kstep, voffB); PG8_STAGE(PG8_SA(1, 0), cA + kstep, voffA); PG8_STAGE(PG8_SB(1, 1), cB + hstep + kstep, voffB);
        PG8_WAIT_V(6); PG8_BAR;
    } else {
        PG8_STAGE(PG8_SB(0, 0), cB, voffB); PG8_STAGE(PG8_SA(0, 0), cA, voffA); PG8_STAGE(PG8_SB(0, 1), cB + hstep, voffB); PG8_STAGE(PG8_SA(0, 1), cA + hstep, voffA);
        if (wr == 1) PG8_BAR;
        PG8_WAIT_V(4); PG8_BAR;
        PG8_STAGE(PG8_SB(1, 0), cB + kstep, voffB); PG8_STAGE(PG8_SA(1, 0), cA + kstep, voffA); PG8_STAGE(PG8_SB(1, 1), cB + hstep + kstep, voffB);
        PG8_WAIT_V(6); PG8_BAR;
    }
    for (;;) {
        const bool has_next = S.next(ui + 1, nxt);
        const char* nA = has_next ? (const char*)g.A + (size_t)nxt.pm * tstep : cA; const char* nB = has_next ? (const char*)g.Bt + (size_t)nxt.pn * tstep : cB;
        for (int t = 0; t < nt; t += 2) {
            const bool last = (t == nt - 2);
            const char* a1 = cA + (size_t)(t + 1) * kstep;
            const char* a2 = last ? nA : cA + (size_t)(t + 2) * kstep; const char* b2 = last ? nB : cB + (size_t)(t + 2) * kstep;
            const char* a3 = a2 + kstep; const char* b3 = b2 + kstep;
            if (last && has_next) S.a_ready(nxt);
            if constexpr (SP2) {
            PG8_LDB(B0, 0, 0); PG8_LDB(B1, 0, 1); PG8_SCHED; PG8_LDA(At, 0, 0); PG8_STAGE(PG8_SA(1, 1), a1 + hstep, voffA);
            PG8_WAIT_V(8); PG8_WAIT_L(0); PG8_BAR; PG8_MMA(0, 0, At, B0); PG8_MMA(0, 1, At, B1); PG8_BAR; PG8_SCHED;
            PG8_LDA(At, 0, 1); PG8_STAGE(PG8_SB(0, 0), b2, voffB); PG8_STAGE(PG8_SB(0, 1), b2 + hstep, voffB); PG8_STAGE(PG8_SA(0, 0), a2, voffA);
            PG8_WAIT_V(8); PG8_WAIT_L(0); PG8_BAR; PG8_MMA(1, 0, At, B0); PG8_MMA(1, 1, At, B1); PG8_BAR; PG8_SCHED;
            PG8_LDB(B0, 1, 0); PG8_LDB(B1, 1, 1); PG8_SCHED; PG8_LDA(At, 1, 0); PG8_STAGE(PG8_SA(0, 1), a2 + hstep, voffA);
            PG8_WAIT_V(8); PG8_WAIT_L(0); PG8_BAR; PG8_MMA(0, 0, At, B0); PG8_MMA(0, 1, At, B1); PG8_BAR; PG8_SCHED;
            PG8_LDA(At, 1, 1); PG8_STAGE(PG8_SB(1, 0), b3, voffB); PG8_STAGE(PG8_SB(1, 1), b3 + hstep, voffB); PG8_STAGE(PG8_SA(1, 0), a3, voffA);
            PG8_WAIT_V(8); PG8_WAIT_L(0); PG8_BAR; PG8_MMA(1, 0, At, B0); PG8_MMA(1, 1, At, B1); PG8_BAR; PG8_SCHED;
            } else {
            PG8_LDB(B0, 0, 0); PG8_SCHED; PG8_LDA(At, 0, 0); PG8_STAGE(PG8_SA(1, 1), a1 + hstep, voffA);
            PG8_WAIT_L(8); PG8_BAR; PG8_WAIT_L(0); PG8_MMA(0, 0, At, B0); PG8_BAR; PG8_SCHED;
            PG8_LDB(B1, 0, 1); PG8_STAGE(PG8_SB(0, 0), b2, voffB);
            PG8_BAR; PG8_WAIT_L(0); PG8_MMA(0, 1, At, B1); PG8_BAR;
            PG8_LDA(At, 0, 1); PG8_STAGE(PG8_SA(0, 0), a2, voffA);
            PG8_BAR; PG8_WAIT_L(0); PG8_MMA(1, 0, At, B0); PG8_BAR; PG8_SCHED;
            PG8_STAGE(PG8_SB(0, 1), b2 + hstep, voffB);
            PG8_WAIT_V(6); PG8_BAR; PG8_MMA(1, 1, At, B1); PG8_BAR;
            PG8_LDB(B0, 1, 0); PG8_SCHED; PG8_LDA(At, 1, 0); PG8_STAGE(PG8_SA(0, 1), a2 + hstep, voffA);
            PG8_WAIT_L(8); PG8_BAR; PG8_WAIT_L(0); PG8_MMA(0, 0, At, B0); PG8_BAR; PG8_SCHED;
            PG8_LDB(B1, 1, 1); PG8_STAGE(PG8_SB(1, 0), b3, voffB);
            PG8_BAR; PG8_WAIT_L(0); PG8_MMA(0, 1, At, B1); PG8_BAR;
            PG8_LDA(At, 1, 1); PG8_STAGE(PG8_SA(1, 0), a3, voffA);
            PG8_BAR; PG8_WAIT_L(0); PG8_MMA(1, 0, At, B0); PG8_BAR; PG8_SCHED;
            PG8_STAGE(PG8_SB(1, 1), b3 + hstep, voffB);
            PG8_WAIT_V(6); PG8_BAR; PG8_MMA(1, 1, At, B1); PG8_BAR;
            }
        }
        if constexpr (ALIGN_EPI) { if (wr == 0) PG8_BAR; }
        if constexpr (!Epi::AFTER_DRAIN) { E(acc, cur, wr, wc, fr, fq); S.done(cur); }
        if (!has_next) break;
#pragma unroll
        for (int a = 0; a < 2; ++a)
#pragma unroll
            for (int b = 0; b < 2; ++b)
#pragma unroll
                for (int m = 0; m < 4; ++m)
#pragma unroll
                    for (int n = 0; n < 2; ++n) acc[a][b][m][n] = (f32x4){0.f, 0.f, 0.f, 0.f};
        cur = nxt; cA = nA; cB = nB; ++ui;
        if constexpr (ALIGN_EPI) { if (wr == 1) PG8_BAR; }
    }
    PG8_WAIT_V(0);
    if constexpr (!ALIGN_EPI) { if (wr == 0) PG8_BAR; }
    PG8_BAR;
    if constexpr (Epi::AFTER_DRAIN) { E.fused(acc, cur, wr, wc, fr, fq, lds, wid, lane); S.done(cur); }
#undef PG8_SA
#undef PG8_SB
#undef PG8_STAGE
#undef PG8_LDA
#undef PG8_LDB
#undef PG8_MMA
#undef PG8_WAIT_V
#undef PG8_WAIT_L
#undef PG8_BAR
#undef PG8_SCHED
}
}

constexpr int NB = 8, SEQ = 4096, DM = 1024, MT = NB * SEQ, NL = 2;
constexpr int CHB = 4, CHR = CHB * SEQ, NCH = NB / CHB;
constexpr int NIN = 8192, DFF = 2816, NGU = 2 * DFF, WIN_SRC = 8136;
constexpr int TOPK = 256;
constexpr float EPS = 1e-6f;
constexpr int NWAVES = 8, NTHREADS = 512;

constexpr size_t MiB = 1u << 20;
constexpr size_t WS_CTL = 0, CTL_ZERO_BYTES = 1 * MiB;
constexpr size_t WS_MOD = 1 * MiB;
constexpr size_t WS_TAB = WS_MOD + 393216;
constexpr size_t WS_LAM = WS_TAB + 393216;
constexpr size_t WS_W = 2 * MiB, W_LAYER = 39 * MiB;
constexpr size_t W_IN = 0, W_UKT = 16 * MiB  , W_A = 17 * MiB, W_B = 19 * MiB, W_C = 20 * MiB, W_OUT = 20 * MiB + 512 * 1024, W_GU = 22 * MiB + 512 * 1024, W_D = 33 * MiB + 512 * 1024;
constexpr size_t WS_H = 80 * MiB;
constexpr size_t WS_Y = 144 * MiB;
constexpr size_t Y_QLAT = 0, Y_MISC = 32 * MiB, Y_IQ = 40 * MiB, Y_BQ = 56 * MiB, Y_BK = 72 * MiB, Y_BV = 88 * MiB, Y_CQ = 104 * MiB, Y_CK = 128 * MiB, Y_CV = 152 * MiB, Y_Z = 176 * MiB, Y_OC = 272 * MiB;
constexpr size_t Y_AQ = Y_QLAT, Y_QLS = Y_QLAT + 16 * MiB, Y_OLAT = Y_CQ;
constexpr size_t Y_MF32 = Y_CQ, Y_MBF = Y_BK;
constexpr size_t WS_ACT = WS_Y;
constexpr size_t WS_KVN = 424 * MiB;
constexpr size_t WS_END = 500 * MiB;
constexpr int CW_BAR = 4096;

#define GAS __attribute__((address_space(1)))
#define LAS __attribute__((address_space(3)))
typedef unsigned short bf16;
typedef unsigned v4u __attribute__((ext_vector_type(4)));
typedef unsigned v2u __attribute__((ext_vector_type(2)));
typedef float f32x4 __attribute__((ext_vector_type(4)));

__device__ __forceinline__ unsigned f2bf(float f) { unsigned u = __builtin_bit_cast(unsigned, f); return (u + 0x7fffu + ((u >> 16) & 1u)) >> 16; }
typedef float f32x2_c __attribute__((ext_vector_type(2))); typedef __bf16 bf16x2_c __attribute__((ext_vector_type(2)));
__device__ __forceinline__ unsigned pk2(float lo, float hi) { const f32x2_c v = {lo, hi}; const bf16x2_c b = __builtin_convertvector(v, bf16x2_c); return __builtin_bit_cast(unsigned, b); }
__device__ __forceinline__ float bflo(unsigned w) { return __uint_as_float(w << 16); }
__device__ __forceinline__ float bfhi(unsigned w) { return __uint_as_float(w & 0xffff0000u); }
__device__ __forceinline__ float bf2f(bf16 h) { return __uint_as_float((unsigned)h << 16); }
__device__ __forceinline__ float wave_sum(float v) {
#pragma unroll
    for (int o = 1; o < 64; o <<= 1) v += __shfl_xor(v, o);
    return v;
}
__device__ __forceinline__ float wave_max(float v) {
#pragma unroll
    for (int o = 1; o < 64; o <<= 1) v = fmaxf(v, __shfl_xor(v, o));
    return v;
}
__device__ __forceinline__ float sigmoidf_(float v) { return __builtin_amdgcn_rcpf(1.f + __expf(-v)); }

namespace pg8 {
struct EpiIn {
    static constexpr bool PERM = true, AFTER_DRAIN = false;
    unsigned char* y; int skip;
    __device__ __forceinline__ void operator()(const f32x4 (&acc)[2][2][4][2], const Unit& u, int wr, int wc, int fr, int fq) const {
        if (skip) return;
        const int pn = u.pn; size_t off; int ld, c0; bool sig = false;
        if (pn < 2)        { off = Y_AQ;   ld = 512;  c0 = pn * 256; }
        else if (pn == 2)  { off = Y_MISC; ld = 256;  c0 = 0; }
        else if (pn < 5)   { off = Y_IQ;   ld = 512;  c0 = (pn - 3) * 256; }
        else if (pn < 7)   { off = Y_BQ;   ld = 512;  c0 = (pn - 5) * 256; }
        else if (pn < 9)   { off = Y_BK;   ld = 512;  c0 = (pn - 7) * 256; }
        else if (pn < 11)  { off = Y_BV;   ld = 512;  c0 = (pn - 9) * 256; }
        else if (pn < 14)  { off = Y_CQ;   ld = 768;  c0 = (pn - 11) * 256; }
        else if (pn < 17)  { off = Y_CK;   ld = 768;  c0 = (pn - 14) * 256; }
        else if (pn < 20)  { off = Y_CV;   ld = 768;  c0 = (pn - 17) * 256; }
        else               { off = Y_Z;    ld = 3072; c0 = (pn - 20) * 256; sig = true; }
        bf16_t* base = (bf16_t*)(y + off); const bool qsc = (pn == 5 || pn == 6 || (pn >= 11 && pn < 14));
        const int row0 = u.pm * BM + wr * 64 + fr, col0 = c0 + wc * 32 + 8 * fq;
#pragma unroll
        for (int ai = 0; ai < 2; ++ai)
#pragma unroll
            for (int m = 0; m < 4; ++m) { bf16_t* rowp = base + (size_t)(row0 + ai * HALF + m * 16) * ld + col0;
#pragma unroll
                for (int bj = 0; bj < 2; ++bj) { f32x4 v0 = acc[ai][bj][m][0], v1 = acc[ai][bj][m][1];
                    if (sig) {
#pragma unroll
                        for (int i = 0; i < 4; ++i) { v0[i] = sigmoidf_(v0[i]); v1[i] = sigmoidf_(v1[i]); } }
                    else if (qsc) {
#pragma unroll
                        for (int i = 0; i < 4; ++i) { v0[i] *= 0.125f * 1.4426950408889634f; v1[i] *= 0.125f * 1.4426950408889634f; } }
                    if (sig) {
                        unsigned lo = 0u, hi = 0u;
                        lo = __builtin_amdgcn_cvt_pk_u8_f32(fmaf(v0[0], 255.f, 0.5f), 0, lo); lo = __builtin_amdgcn_cvt_pk_u8_f32(fmaf(v0[1], 255.f, 0.5f), 1, lo);
                        lo = __builtin_amdgcn_cvt_pk_u8_f32(fmaf(v0[2], 255.f, 0.5f), 2, lo); lo = __builtin_amdgcn_cvt_pk_u8_f32(fmaf(v0[3], 255.f, 0.5f), 3, lo);
                        hi = __builtin_amdgcn_cvt_pk_u8_f32(fmaf(v1[0], 255.f, 0.5f), 0, hi); hi = __builtin_amdgcn_cvt_pk_u8_f32(fmaf(v1[1], 255.f, 0.5f), 1, hi);
                        hi = __builtin_amdgcn_cvt_pk_u8_f32(fmaf(v1[2], 255.f, 0.5f), 2, hi); hi = __builtin_amdgcn_cvt_pk_u8_f32(fmaf(v1[3], 255.f, 0.5f), 3, hi);
                        v2u w8; w8.x = lo; w8.y = hi;
                        *(v2u*)((unsigned char*)(y + Y_Z) + (size_t)(row0 + ai * HALF + m * 16) * 3072 + col0 + bj * HALF) = w8;
                    } else {
                    u32x4 w; w.x = pk2(v0[0], v0[1]); w.y = pk2(v0[2], v0[3]); w.z = pk2(v1[0], v1[1]); w.w = pk2(v1[2], v1[3]);
                    *(u32x4*)(rowp + bj * HALF) = w; } } }
    }
};
template <int MODE> struct EpiGate {
    static constexpr bool PERM = true, AFTER_DRAIN = false;
    const unsigned char* z; int zc0; float* mf; bf16_t* mb;
    __device__ __forceinline__ void operator()(const f32x4 (&acc)[2][2][4][2], const Unit& u, int wr, int wc, int fr, int fq) const {
        const int row0 = u.pm * BM + wr * 64 + fr, col0 = u.pn * BM + wc * 32 + 8 * fq;
#pragma unroll
        for (int ai = 0; ai < 2; ++ai)
#pragma unroll
            for (int m = 0; m < 4; ++m) { const size_t row = (size_t)(row0 + ai * HALF + m * 16);
#pragma unroll
                for (int bj = 0; bj < 2; ++bj) { const int col = col0 + bj * HALF;
                    const v2u zw = *(const v2u*)(z + row * 3072 + zc0 + col);
                    f32x4 v0 = acc[ai][bj][m][0], v1 = acc[ai][bj][m][1];
                    constexpr float I255 = 1.f / 255.f;
                    v0[0] *= (float)((zw.x >> 0) & 0xffu) * I255; v0[1] *= (float)((zw.x >> 8) & 0xffu) * I255; v0[2] *= (float)((zw.x >> 16) & 0xffu) * I255; v0[3] *= (float)((zw.x >> 24) & 0xffu) * I255;
                    v1[0] *= (float)((zw.y >> 0) & 0xffu) * I255; v1[1] *= (float)((zw.y >> 8) & 0xffu) * I255; v1[2] *= (float)((zw.y >> 16) & 0xffu) * I255; v1[3] *= (float)((zw.y >> 24) & 0xffu) * I255;
                    bf16_t* mp = mb + row * 1024 + col;
                    if (MODE >= 1) { const u32x4 pw = *(const u32x4*)mp;
                        v0[0] += __uint_as_float(pw.x << 16); v0[1] += __uint_as_float(pw.x & 0xffff0000u); v0[2] += __uint_as_float(pw.y << 16); v0[3] += __uint_as_float(pw.y & 0xffff0000u);
                        v1[0] += __uint_as_float(pw.z << 16); v1[1] += __uint_as_float(pw.z & 0xffff0000u); v1[2] += __uint_as_float(pw.w << 16); v1[3] += __uint_as_float(pw.w & 0xffff0000u); }
                    { u32x4 w; w.x = pk2(v0[0], v0[1]); w.y = pk2(v0[2], v0[3]); w.z = pk2(v1[0], v1[1]); w.w = pk2(v1[2], v1[3]); *(u32x4*)mp = w; } }
                asm volatile("" ::: "memory"); }
    }
};
struct EpiRes {
    static constexpr bool PERM = true, AFTER_DRAIN = false;
    const float* xin; float* xout; const float* gate; int row_off;
    __device__ __forceinline__ void operator()(const f32x4 (&acc)[2][2][4][2], const Unit& u, int wr, int wc, int fr, int fq) const {
        const int row0 = row_off + u.pm * BM + wr * 64 + fr, col0 = u.pn * BM + wc * 32 + 8 * fq;
        const float* gp = gate + (size_t)((row_off + u.pm * BM) / SEQ) * 6144 + col0;
        f32x4 g[2][2];
#pragma unroll
        for (int bj = 0; bj < 2; ++bj) { g[bj][0] = *(const f32x4*)(gp + bj * HALF); g[bj][1] = *(const f32x4*)(gp + bj * HALF + 4); }
#pragma unroll
        for (int ai = 0; ai < 2; ++ai)
#pragma unroll
            for (int m = 0; m < 4; ++m) { const size_t o = (size_t)(row0 + ai * HALF + m * 16) * 1024 + col0;
#pragma unroll
                for (int bj = 0; bj < 2; ++bj) {
                    const f32x4 a0 = *(const f32x4*)(xin + o + bj * HALF), a1 = *(const f32x4*)(xin + o + bj * HALF + 4);
                    *(f32x4*)(xout + o + bj * HALF) = a0 + g[bj][0] * acc[ai][bj][m][0];
                    *(f32x4*)(xout + o + bj * HALF + 4) = a1 + g[bj][1] * acc[ai][bj][m][1]; }
                asm volatile("" ::: "memory"); }
    }
};
struct EpiSwiGLU {
    static constexpr bool PERM = true, AFTER_DRAIN = false;
    bf16_t* act;
    __device__ __forceinline__ void operator()(const f32x4 (&acc)[2][2][4][2], const Unit& u, int wr, int wc, int fr, int fq) const {
        const int row0 = u.pm * BM + wr * 64 + fr, col0 = u.pn * HALF + wc * 32 + 8 * fq;
#pragma unroll
        for (int ai = 0; ai < 2; ++ai)
#pragma unroll
            for (int m = 0; m < 4; ++m) { bf16_t* rowp = act + (size_t)(row0 + ai * HALF + m * 16) * DFF + col0;
                f32x4 v0, v1;
#pragma unroll
                for (int i = 0; i < 4; ++i) { const float g0 = acc[ai][0][m][0][i], g1 = acc[ai][0][m][1][i];
                    v0[i] = g0 * sigmoidf_(g0) * acc[ai][1][m][0][i]; v1[i] = g1 * sigmoidf_(g1) * acc[ai][1][m][1][i]; }
                u32x4 w; w.x = pk2(v0[0], v0[1]); w.y = pk2(v0[2], v0[3]); w.z = pk2(v1[0], v1[1]); w.w = pk2(v1[2], v1[3]);
                *(u32x4*)rowp = w; }
    }
};
}

#define XB_TMO      128
#define XB_XCNT(j)  (256  + 64 * (j))
#define XB_XSUB(j)  (1280 + 64 * (j))
#define XB_XGEN(j)  (2304 + 64 * (j))
#define XB_TOP      3328
#define XB_TOPGEN   3392
#define XCD_BAR_WORDS 3456
#define XB_SPIN_CAP (1u << 24)

__device__ __forceinline__ unsigned xb_ld(unsigned* p)              { return __hip_atomic_load(p, __ATOMIC_RELAXED, __HIP_MEMORY_SCOPE_AGENT); }
__device__ __forceinline__ unsigned xb_add(unsigned* p, unsigned v) { return __hip_atomic_fetch_add(p, v, __ATOMIC_RELAXED, __HIP_MEMORY_SCOPE_AGENT); }
__device__ __forceinline__ unsigned xb_xcc_id() { return (unsigned)__builtin_amdgcn_s_getreg((3 << 11) | 20) & 0xFu; }
#define XB_SPIN(cond, bar) do { unsigned _sp = 0; while (cond) { __builtin_amdgcn_s_sleep(1); \
    if ((++_sp & 255u) == 0u) { if (xb_ld(&(bar)[XB_TMO])) break; if (_sp > XB_SPIN_CAP) { atomicAdd(&(bar)[XB_TMO], 1u); break; } } } } while (0)

__device__ __forceinline__ int lane_id_() { return (int)__builtin_amdgcn_mbcnt_hi(~0u, __builtin_amdgcn_mbcnt_lo(~0u, 0u)); }
struct XcdBarrier { unsigned* bar; unsigned x; volatile LAS unsigned* st; int w; };

__device__ __forceinline__ XcdBarrier xcd_barrier_post(unsigned* bar, volatile LAS unsigned* st, int w) {
    XcdBarrier b; b.bar = bar; b.x = (unsigned)__builtin_amdgcn_readfirstlane((int)xb_xcc_id()); b.st = st; b.w = w;
    if (threadIdx.x == 0) (void)xb_add(&bar[XB_XCNT(b.x)], 1u);
    return b;
}
__device__ __forceinline__ void xcd_barrier_complete(unsigned* bar, unsigned x, unsigned& nloc, unsigned& nx) {
    const unsigned G = gridDim.x * gridDim.y * gridDim.z;
    unsigned sum, cnt, mine, sp = 0u;
    for (;;) {
        sum = 0u; cnt = 0u; mine = 0u;
#pragma unroll
        for (unsigned j = 0; j < 16; ++j) { const unsigned c = xb_ld(&bar[XB_XCNT(j)]); sum += c; cnt += (c > 0u) ? 1u : 0u; mine = (j == x) ? c : mine; }
        if (sum == G) break;
        __builtin_amdgcn_s_sleep(1);
        if ((++sp & 255u) == 0u) { if (xb_ld(&bar[XB_TMO])) break; if (sp > XB_SPIN_CAP) { atomicAdd(&bar[XB_TMO], 1u); break; } }
    }
    nloc = mine > 0u ? mine : 1u; nx = cnt > 0u ? cnt : 1u;
}
__device__ __forceinline__ void xcd_barrier(const XcdBarrier& b) {
    asm volatile("s_waitcnt vmcnt(0)" ::: "memory");
    __syncthreads();
    if (threadIdx.x == 0) {
        unsigned* bar = b.bar; unsigned bx = b.x; asm volatile("" : "+s"(bar), "+s"(bx));
        __builtin_amdgcn_s_waitcnt(0);
        unsigned nloc = b.st[0], nx = b.st[1];
        if (nloc == 0u) { xcd_barrier_complete(bar, bx, nloc, nx); b.st[0] = nloc; b.st[1] = nx; }
        const unsigned old = xb_add(&bar[XB_XSUB(bx)], 1u);
        const unsigned gen = old / nloc;
        if (old + 1u == (gen + 1u) * nloc) {
            __builtin_amdgcn_fence(__ATOMIC_RELEASE, "agent");
            asm volatile("s_waitcnt vmcnt(0)" ::: "memory");
            const unsigned og = xb_add(&bar[XB_TOP], 1u);
            const unsigned tg = og / nx;
            if (og + 1u == (tg + 1u) * nx) xb_add(&bar[XB_TOPGEN], 1u);
            else XB_SPIN(xb_ld(&bar[XB_TOPGEN]) == tg, bar);
            __builtin_amdgcn_fence(__ATOMIC_ACQUIRE, "agent");
            xb_add(&bar[XB_XGEN(bx)], 1u);
            asm volatile("s_waitcnt vmcnt(0)" ::: "memory");
        } else {
            XB_SPIN(xb_ld(&bar[XB_XGEN(bx)]) == gen, bar);
            __builtin_amdgcn_fence(__ATOMIC_ACQUIRE, "agent");
            asm volatile("s_waitcnt vmcnt(0)" ::: "memory");
        }
    }
    __syncthreads();
}

constexpr int RING_BYTES = 131072;
constexpr int LDSCTL_OFF = 160256;
constexpr int LDS_BYTES = 161280;

struct Args {
    const float* in[23]; float* out; unsigned char* ws; int pad0, pad1;
};
__device__ __forceinline__ const void* ld_karg(unsigned off) {
    asm volatile("" : "+s"(off));
    return *(const void* const __attribute__((address_space(4)))*)((const __attribute__((address_space(4))) char*)__builtin_amdgcn_kernarg_segment_ptr() + off);
}
#define ARG(k) ((const float*)ld_karg(8u * (k)))
#define OUTP() ((float*)ld_karg(184u))
#define WSP() ((unsigned char*)ld_karg(192u))

__device__ __forceinline__ int rel_bucket(int d) {
    if (d < 16) return d;
    int b = 16;
    b += (d >= 22); b += (d >= 30); b += (d >= 40); b += (d >= 54); b += (d >= 73); b += (d >= 99); b += (d >= 134); b += (d >= 182);
    b += (d >= 246); b += (d >= 332); b += (d >= 450); b += (d >= 609); b += (d >= 825); b += (d >= 1117); b += (d >= 1513);
    return b;
}
__device__ __forceinline__ int win_src_col(int n) {
    if (n < 640) return n;
    if (n < 712) return n + 512;
    if (n < 768) return -1;
    if (n < 1280) return n - 128;
    return n - 56;
}
__device__ __forceinline__ void transpose_item(const float* W, int ldw, int K, bf16* WT, int kind, int kb, int nb, LAS float* scr, int lane) {
    const int k0 = 64 * kb, n0 = 32 * nb, nl = n0 + (lane & 31);
    int sc;
    if (kind == 0) sc = win_src_col(nl);
    else if (kind == 2) { const int j = nl >> 8, r = nl & 255; sc = (r < 128) ? (j * 128 + r) : (DFF + j * 128 + r - 128); }
    else sc = nl;
    float wv[32];
    const float* wsrc = W + (size_t)(k0 + (lane >> 5)) * ldw + (sc >= 0 ? sc : 0);
#pragma unroll
    for (int i = 0; i < 32; ++i) wv[i] = wsrc[(size_t)(2 * i) * ldw];
#pragma unroll
    for (int i = 0; i < 32; ++i) scr[(2 * i + (lane >> 5)) * 33 + (lane & 31)] = (sc >= 0) ? wv[i] : 0.f;
    asm volatile("s_waitcnt lgkmcnt(0)" ::: "memory");
    const int c = lane & 7;
    const int nrow0 = 0;
#pragma unroll
    for (int j = 0; j < 4; ++j) { const int n = (lane >> 3) + 8 * j; const LAS float* s = scr + (8 * c) * 33 + n;
        v4u o; o.x = pk2(s[0 * 33], s[1 * 33]); o.y = pk2(s[2 * 33], s[3 * 33]); o.z = pk2(s[4 * 33], s[5 * 33]); o.w = pk2(s[6 * 33], s[7 * 33]);
        *(v4u*)(WT + (size_t)(nrow0 + n0 + n) * K + k0 + 8 * c) = o; }
    asm volatile("s_waitcnt lgkmcnt(0)" ::: "memory");
}

__device__ __forceinline__ void p0a_prologue(unsigned char* ws, LAS unsigned char* lds, int tid, int lane, int wave, int G) {
    asm volatile("" : "+v"(lane), "+v"(tid));
    const float* c = ARG(1); const float* w_ada = ARG(2); const float* b_ada = ARG(3);
    float* mod = (float*)(ws + WS_MOD);
    if (blockIdx.x < 192) {
        LAS float* cs = (LAS float*)lds;
        LAS float* red = (LAS float*)(lds + 32768);
        for (int i = tid; i < 8192; i += NTHREADS) { const float v = c[i]; cs[i] = v / (1.f + __expf(-v)); }
        __syncthreads();
        for (int it = blockIdx.x; it < 192; it += G) {
            const int l = it / 96, cg = it % 96, n = cg * 64 + lane;
            float acc[8];
#pragma unroll
            for (int b = 0; b < 8; ++b) acc[b] = 0.f;
            const float* wp = w_ada + ((size_t)l * 1024 + wave * 128) * 6144 + n;
#pragma unroll 32
            for (int k = 0; k < 128; ++k) { const float wv = wp[(size_t)k * 6144];
#pragma unroll
                for (int b = 0; b < 8; ++b) acc[b] += cs[b * 1024 + wave * 128 + k] * wv; }
#pragma unroll
            for (int b = 0; b < 8; ++b) red[(wave * 8 + b) * 64 + lane] = acc[b];
            __syncthreads();
            { const int b = tid >> 6; float s = 0.f;
#pragma unroll
              for (int w = 0; w < 8; ++w) s += red[(w * 8 + b) * 64 + lane];
              mod[((size_t)l * 8 + b) * 6144 + n] = s + b_ada[l * 6144 + n]; }
            __syncthreads();
        }
    }
    { const float* rb = ARG(21); float* T = (float*)(ws + WS_TAB);
      for (int d = blockIdx.x * NTHREADS + tid; d < 4096; d += G * NTHREADS) { const int bk = rel_bucket(d);
          for (int j = 0; j < 24; ++j) T[d * 24 + j] = rb[bk * 24 + j]; } }
    if (blockIdx.x == G - 1 && wave == 0) {
        float* lam = (float*)(ws + WS_LAM);
        for (int l = 0; l < NL; ++l) {
            const float s1 = wave_sum(ARG(9)[l * 64 + lane] * ARG(10)[l * 64 + lane]);
            const float s2 = wave_sum(ARG(11)[l * 64 + lane] * ARG(12)[l * 64 + lane]);
            const float lam_init = (l == 0) ? 0.2f : 0.35550907f;
            if (lane == 0) lam[l] = expf(s1) - expf(s2) + lam_init;
        }
    }
    {
        LAS float* scr = (LAS float*)(lds + 65536 + wave * 8448);
        const int gw = blockIdx.x * NWAVES + wave, NGW = G * NWAVES;
        constexpr int I_WIN = 16 * 256, I_B = 8 * 32, I_C = 4 * 32, I_OUT = 16 * 32, I_GU = 16 * 176, I_D = 44 * 32, I_FQ = 128, I_FA = 2048;
        constexpr int I_LAYER = I_WIN + I_B + I_C + I_OUT + I_GU + I_D + I_FQ + I_FA;
        for (int it = gw; it < NL * I_LAYER; it += NGW) {
            const int l = it / I_LAYER; int r = it % I_LAYER;
            unsigned char* wl = ws + WS_W + (size_t)l * W_LAYER;
            const float* w_in = ARG(5) + (size_t)l * 1024 * WIN_SRC;
            if (r < I_WIN) { transpose_item(w_in, WIN_SRC, 1024, (bf16*)(wl + W_IN), 0, r / 256, r % 256, scr, lane); continue; } r -= I_WIN;
            if (r < I_B)   { transpose_item(ARG(15) + (size_t)l * 512 * 1024, 1024, 512, (bf16*)(wl + W_B), 1, r / 32, r % 32, scr, lane); continue; } r -= I_B;
            if (r < I_C)   { transpose_item(ARG(16) + (size_t)l * 256 * 1024, 1024, 256, (bf16*)(wl + W_C), 1, r / 32, r % 32, scr, lane); continue; } r -= I_C;
            if (r < I_OUT) { transpose_item(ARG(17) + (size_t)l * 1024 * 1024, 1024, 1024, (bf16*)(wl + W_OUT), 1, r / 32, r % 32, scr, lane); continue; } r -= I_OUT;
            if (r < I_GU)  { transpose_item(ARG(19) + (size_t)l * 1024 * NGU, NGU, 1024, (bf16*)(wl + W_GU), 2, r / 176, r % 176, scr, lane); continue; } r -= I_GU;
            if (r < I_D)   { transpose_item(ARG(20) + (size_t)l * DFF * 1024, 1024, DFF, (bf16*)(wl + W_D), 1, r / 32, r % 32, scr, lane); continue; } r -= I_D;
            if (r < I_FQ) {
                const int h = r >> 4, chalf = (r >> 3) & 1, d0 = (r & 7) * 8, cc = chalf * 64 + lane;
                const float* uk = ARG(6) + ((size_t)(l * 8 + h) * 64 + d0) * 128 + cc;
                v4u o; o.x = pk2(uk[0], uk[128]); o.y = pk2(uk[256], uk[384]); o.z = pk2(uk[512], uk[640]); o.w = pk2(uk[768], uk[896]);
                *(v4u*)((bf16*)(wl + W_UKT) + ((size_t)h * 128 + cc) * 64 + d0) = o;
                continue; }
            r -= I_FQ;
            {
                const int ng = r >> 7, kg = r & 127, h = kg >> 4, c0 = (kg & 15) * 8, n = ng * 64 + lane;
                const float* uv = ARG(7) + ((size_t)(l * 8 + h) * 128 + c0) * 64;
                const float* wa = ARG(14) + ((size_t)l * 512 + h * 64) * 1024 + n;
                float acc[8];
#pragma unroll
                for (int j = 0; j < 8; ++j) acc[j] = 0.f;
#pragma unroll 32
                for (int e = 0; e < 64; ++e) { const float wv = wa[(size_t)e * 1024];
#pragma unroll
                    for (int j = 0; j < 8; ++j) acc[j] += uv[j * 64 + e] * wv; }
                v4u o; o.x = pk2(acc[0], acc[1]); o.y = pk2(acc[2], acc[3]); o.z = pk2(acc[4], acc[5]); o.w = pk2(acc[6], acc[7]);
                *(v4u*)((bf16*)(wl + W_A) + (size_t)n * 1024 + kg * 8) = o;
            }
        }
    }
}

__device__ __forceinline__ void norm_rows(const float* x, bf16* out, const float* g, const float* sh, const float* sc, int gw, int NGW, int lane) {
    asm volatile("" : "+v"(lane));
    for (int row = gw; row < MT; row += 2 * NGW) {
        const int row2 = (row + NGW < MT) ? row + NGW : row;
        const f32x4* xr = (const f32x4*)(x + (size_t)row * 1024) + lane; const f32x4* xr2 = (const f32x4*)(x + (size_t)row2 * 1024) + lane;
        f32x4 v[4], u[4]; float s = 0.f, s2 = 0.f;
#pragma unroll
        for (int j = 0; j < 4; ++j) { v[j] = xr[64 * j]; u[j] = xr2[64 * j]; }
#pragma unroll
        for (int j = 0; j < 4; ++j) { s += (v[j].x * v[j].x + v[j].y * v[j].y) + (v[j].z * v[j].z + v[j].w * v[j].w); s2 += (u[j].x * u[j].x + u[j].y * u[j].y) + (u[j].z * u[j].z + u[j].w * u[j].w); }
        const float rstd = 1.0f / sqrtf(wave_sum(s) * (1.f / 1024.f) + EPS), rstd2 = 1.0f / sqrtf(wave_sum(s2) * (1.f / 1024.f) + EPS);
        const int b = row / SEQ, b2 = row2 / SEQ;
        v2u* o8 = (v2u*)(out + (size_t)row * 1024) + lane; v2u* o82 = (v2u*)(out + (size_t)row2 * 1024) + lane;
#pragma unroll
        for (int j = 0; j < 4; ++j) { const int col = 256 * j + 4 * lane;
            const f32x4 gg = *(const f32x4*)(g + col);
            { const f32x4 s1 = *(const f32x4*)(sc + (size_t)b * 6144 + col), s0 = *(const f32x4*)(sh + (size_t)b * 6144 + col);
              const f32x4 y = v[j] * rstd * gg * (s1 + 1.0f) + s0; v2u w; w.x = pk2(y.x, y.y); w.y = pk2(y.z, y.w); o8[64 * j] = w; }
            if (row2 != row) { const f32x4 s1 = *(const f32x4*)(sc + (size_t)b2 * 6144 + col), s0 = *(const f32x4*)(sh + (size_t)b2 * 6144 + col);
              const f32x4 y = u[j] * rstd2 * gg * (s1 + 1.0f) + s0; v2u w; w.x = pk2(y.x, y.y); w.y = pk2(y.z, y.w); o82[64 * j] = w; } }
    }
}
__device__ __forceinline__ void final_rows(float* x, const float* g, int gw, int NGW, int lane) {
    asm volatile("" : "+v"(lane));
    for (int row = gw; row < MT; row += 2 * NGW) {
        const int row2 = (row + NGW < MT) ? row + NGW : row;
        f32x4* xr = (f32x4*)(x + (size_t)row * 1024) + lane; f32x4* xr2 = (f32x4*)(x + (size_t)row2 * 1024) + lane;
        f32x4 v[4], u[4]; float s = 0.f, s2 = 0.f;
#pragma unroll
        for (int j = 0; j < 4; ++j) { v[j] = xr[64 * j]; u[j] = xr2[64 * j]; }
#pragma unroll
        for (int j = 0; j < 4; ++j) { s += (v[j].x * v[j].x + v[j].y * v[j].y) + (v[j].z * v[j].z + v[j].w * v[j].w); s2 += (u[j].x * u[j].x + u[j].y * u[j].y) + (u[j].z * u[j].z + u[j].w * u[j].w); }
        const float rstd = 1.0f / sqrtf(wave_sum(s) * (1.f / 1024.f) + EPS), rstd2 = 1.0f / sqrtf(wave_sum(s2) * (1.f / 1024.f) + EPS);
#pragma unroll
        for (int j = 0; j < 4; ++j) { const f32x4 gg = *(const f32x4*)(g + 256 * j + 4 * lane); xr[64 * j] = v[j] * rstd * gg; if (row2 != row) xr2[64 * j] = u[j] * rstd2 * gg; }
    }
}
__device__ __forceinline__ void kvn_rows(unsigned char* y, bf16* kvn, const float* gkv, unsigned* kmaxw, int gw, int NGW, int lane) {
    asm volatile("" : "+v"(lane));
    const bf16* misc = (const bf16*)(y + Y_MISC);
    float km0 = 0.f, km1 = 0.f, km2 = 0.f, km3 = 0.f;
    const float g0 = gkv[2 * lane], g1 = gkv[2 * lane + 1];
    for (int r0 = gw; r0 < CHR; r0 += 4 * NGW) {
        unsigned w[4]; bf16 kq[4];
#pragma unroll
        for (int i = 0; i < 4; ++i) { const int r = (r0 + i * NGW < CHR) ? r0 + i * NGW : r0; w[i] = *(const unsigned*)(misc + (size_t)r * 256 + 2 * lane); kq[i] = misc[(size_t)r * 256 + 128 + lane]; }
#pragma unroll
        for (int i = 0; i < 4; ++i) { const int r = r0 + i * NGW; if (r >= CHR) break;
            const float a0 = bflo(w[i]), a1 = bfhi(w[i]);
            const float rstd = 1.0f / sqrtf(wave_sum(a0 * a0 + a1 * a1) * (1.f / 128.f) + EPS);
            *(unsigned*)(kvn + (size_t)r * 128 + 2 * lane) = pk2(a0 * rstd * g0, a1 * rstd * g1);
            const float kk = bf2f(kq[i]); const float ks = wave_sum(kk * kk); const int b = r / SEQ;
            km0 = (b == 0) ? fmaxf(km0, ks) : km0; km1 = (b == 1) ? fmaxf(km1, ks) : km1; km2 = (b == 2) ? fmaxf(km2, ks) : km2; km3 = (b == 3) ? fmaxf(km3, ks) : km3; }
    }
    if (lane == 0) {
        __hip_atomic_fetch_max(kmaxw + 0, __float_as_uint(km0), __ATOMIC_RELAXED, __HIP_MEMORY_SCOPE_AGENT); __hip_atomic_fetch_max(kmaxw + 1, __float_as_uint(km1), __ATOMIC_RELAXED, __HIP_MEMORY_SCOPE_AGENT);
        __hip_atomic_fetch_max(kmaxw + 2, __float_as_uint(km2), __ATOMIC_RELAXED, __HIP_MEMORY_SCOPE_AGENT); __hip_atomic_fetch_max(kmaxw + 3, __float_as_uint(km3), __ATOMIC_RELAXED, __HIP_MEMORY_SCOPE_AGENT);
    }
}
typedef short bf16x8 __attribute__((ext_vector_type(8)));
typedef short s16x4 __attribute__((ext_vector_type(4)));
typedef float f32x16 __attribute__((ext_vector_type(16)));
#define LOG2E 1.4426950408889634f
__device__ __forceinline__ int crow(int r, int hi) { return (r & 3) + 8 * (r >> 2) + 4 * hi; }
__device__ __forceinline__ void glds16(const void* g, LAS void* l) { __builtin_amdgcn_global_load_lds((const unsigned*)g, (LAS unsigned*)l, 16, 0, 0); }
__device__ __forceinline__ s16x4 tr16(const LAS unsigned char* p) { return __builtin_bit_cast(s16x4, __builtin_amdgcn_ds_read_tr16_b64_v4i16((LAS s16x4*)p)); }
__device__ __forceinline__ float swap_max(float v) { auto rr = __builtin_amdgcn_permlane32_swap(__float_as_uint(v), __float_as_uint(v), false, false); return fmaxf(__uint_as_float(rr[0]), __uint_as_float(rr[1])); }
__device__ __forceinline__ float swap16_max(float v) { auto rr = __builtin_amdgcn_permlane16_swap(__float_as_uint(v), __float_as_uint(v), false, false); return fmaxf(__uint_as_float(rr[0]), __uint_as_float(rr[1])); }
__device__ __forceinline__ float swap16_add(float v) { auto rr = __builtin_amdgcn_permlane16_swap(__float_as_uint(v), __float_as_uint(v), false, false); return __uint_as_float(rr[0]) + __uint_as_float(rr[1]); }
__device__ __forceinline__ float swap_add(float v) { auto rr = __builtin_amdgcn_permlane32_swap(__float_as_uint(v), __float_as_uint(v), false, false); return __uint_as_float(rr[0]) + __uint_as_float(rr[1]); }
typedef float f32x2_t __attribute__((ext_vector_type(2))); typedef __bf16 bf16x2_t __attribute__((ext_vector_type(2)));
__device__ __forceinline__ unsigned cvtpk(float lo, float hi) { const f32x2_t v = {lo, hi}; const bf16x2_t b = __builtin_convertvector(v, bf16x2_t); return __builtin_bit_cast(unsigned, b); }
__device__ __forceinline__ void lds_add_u32_asm(LAS void* p, unsigned v) { asm volatile("ds_add_u32 %0, %1" :: "v"((unsigned)(uintptr_t)p), "v"(v) : "memory"); }
__device__ __forceinline__ void lds_st_b16_asm(LAS void* p, unsigned v) { asm volatile("ds_write_b16 %0, %1" :: "v"((unsigned)(uintptr_t)p), "v"(v) : "memory"); }
__device__ __forceinline__ void lds_st_b32_asm(LAS void* p, unsigned v) { asm volatile("ds_write_b32 %0, %1" :: "v"((unsigned)(uintptr_t)p), "v"(v) : "memory"); }
__device__ __forceinline__ s16x4 tr16_asm(const LAS unsigned char* p) { s16x4 v; asm volatile("ds_read_b64_tr_b16 %0, %1" : "=v"(v) : "v"((unsigned)(uintptr_t)p) : "memory"); return v; }
#define TRV(dst, base, off) asm volatile("ds_read_b64_tr_b16 %0, %1 offset:%c2" : "=&v"(dst) : "v"(base), "i"(off) : "memory")
#define LGKM_WAIT8(n, f) asm volatile("s_waitcnt lgkmcnt(" #n ")" : "+v"(f[0]), "+v"(f[1]), "+v"(f[2]), "+v"(f[3]), "+v"(f[4]), "+v"(f[5]), "+v"(f[6]), "+v"(f[7]) :: "memory")
#define VFRAG(f, i) ((bf16x8){f[2 * (i)][0], f[2 * (i)][1], f[2 * (i)][2], f[2 * (i)][3], f[2 * (i) + 1][0], f[2 * (i) + 1][1], f[2 * (i) + 1][2], f[2 * (i) + 1][3]})
#define RAW_BARRIER() do { asm volatile("s_waitcnt lgkmcnt(0)" ::: "memory"); __builtin_amdgcn_s_barrier(); asm volatile("" ::: "memory"); } while (0)

template <int MODE> __device__ __forceinline__ void mixB_fast(unsigned char* y, bf16* OUTB, const float* T, const float* gsub, float lam, float one_m_li, LAS unsigned char* lds, int tid, int lane, int wave, int G) {
    asm volatile("" : "+v"(lane), "+v"(tid));
    bf16* BQ = (bf16*)(y + Y_BQ); const bf16* BK = (const bf16*)(y + Y_BK); const bf16* BV = (const bf16*)(y + Y_BV);
    const int r32 = lane & 31, hi = lane >> 5, m = wave >> 2, qs = wave & 3;
    LAS float* gs_l = (LAS float*)(lds + 131072); LAS float* ctab = gs_l + 128; LAS float* btab = gs_l + 272;
    constexpr int BDM = 1599, BNX = 1728, BCS = 1744, SENTI = 0x7f000000;
    constexpr float THR = 8.0f;
    for (int item = blockIdx.x; item < CHB * 4 * 16; item += G) {
        const int bh = (G == 256) ? (2 * (item & 7) + (item >> 7)) : (item >> 4), pr = (G == 256) ? ((item >> 3) & 15) : (item & 15), bb = bh >> 2, h = bh & 3, rb = bb * SEQ;
        RAW_BARRIER();
        int tq = tid; asm volatile("" : "+v"(tq));
#pragma unroll
        for (int k = 0; k < 4; ++k) { const int x = tq + k * NTHREADS, d = BDM - x;
            const float v = (d >= 0 && x < BNX + 3) ? T[d * 24 + 8 + h] * LOG2E : -INFINITY;
#pragma unroll
            for (int sc = 0; sc < 4; ++sc) { const int i = x - sc; if (i >= 0 && i < BNX) btab[sc * BCS + i] = v; } }
        if (tid < 128) gs_l[tid] = gsub[tid];
        else if (tid < 128 + 136) { const int n = tid - 128 - 4, dmin = 32 * n + 1;
            ctab[tid - 128] = (n >= 0 && rel_bucket(dmin) == rel_bucket(dmin + 62)) ? T[dmin * 24 + 8 + h] * LOG2E : __int_as_float(SENTI); }
        for (int uu = 0; uu < 2; ++uu) {
            const int qb = (uu == 0) ? (31 - pr) : pr;
            const int q0w = qb * 128 + qs * 32, qpos = q0w + r32;
            bf16x8 qf[4];
#pragma unroll
            for (int ks = 0; ks < 4; ++ks) qf[ks] = *(const bf16x8*)(BQ + (size_t)(rb + qpos) * 512 + h * 128 + m * 64 + 16 * ks + 8 * hi);
            const int NT = 2 * (qb + 1);
            const int xl0 = BDM - qpos + 4 * hi;
            const LAS unsigned char* bta = (const LAS unsigned char*)(btab + (xl0 & 3) * (BCS - 1) + xl0);
            f32x16 O[4];
#pragma unroll
            for (int dq = 0; dq < 4; ++dq)
#pragma unroll
                for (int r = 0; r < 16; ++r) O[dq][r] = 0.f;
            float mref = -INFINITY, lsum = 0.f;
#define MB_STAGE(t_, buf_) do { const int kv0_ = (t_) * 64; LAS unsigned char* sb_ = lds + (buf_) * 32768; \
                _Pragma("unroll") for (int i_ = 0; i_ < 2; ++i_) { const int p_ = 2 * wave + i_, mk_ = p_ >> 3, rg_ = p_ & 7;     \
                    glds16(BK + (size_t)(rb + kv0_ + 8 * rg_ + (lane >> 3)) * 512 + h * 128 + mk_ * 64 + ((lane & 7) ^ ((4 * rg_ + (lane >> 4)) & 7)) * 8, sb_ + mk_ * 8192 + rg_ * 1024); } \
                _Pragma("unroll") for (int i_ = 0; i_ < 2; ++i_) { const int p_ = 2 * wave + i_, dq_ = p_ >> 2, rg_ = p_ & 3; \
                    glds16(BV + (size_t)(rb + kv0_ + 16 * rg_ + (lane >> 2)) * 512 + h * 128 + dq_ * 32 + (lane & 3) * 8, sb_ + 16384 + p_ * 1024); } } while (0)
            MB_STAGE(0, 0); MB_STAGE(1, 1);
#pragma unroll 1
            for (int u2 = 0; u2 < NT / 2; ++u2) {
                asm volatile("s_waitcnt vmcnt(0)" ::: "memory");
                RAW_BARRIER();
#if BSTAGE_POS == 0
                if (2 * u2 + 2 < NT && MODE != 3) { MB_STAGE(2 * u2 + 2, (2 * u2 + 2) & 3); MB_STAGE(2 * u2 + 3, (2 * u2 + 3) & 3); }
#endif
                const int kva = u2 * 128;
                if (MODE != 2 && kva <= q0w + 31) {
                    const LAS unsigned char* sba = lds + ((2 * u2) & 3) * 32768; const LAS unsigned char* sbb = lds + ((2 * u2 + 1) & 3) * 32768;
                    f32x16 sa0, sa1, sb0, sb1; float ct0, ct1, ct2, ct3;
#define KRD(dst_, a_, off_) asm volatile("ds_read_b128 %0, %1 offset:%c2" : "=&v"(dst_) : "v"(a_), "i"(off_) : "memory")
#define KRD4(f_, o_, a_) do { KRD(f_[o_], a_, 0); KRD(f_[(o_) + 1], a_, 4096); KRD(f_[(o_) + 2], a_, 32768); KRD(f_[(o_) + 3], a_, 36864); } while (0)
#define KWAIT4(n_, f_, o_) asm volatile("s_waitcnt lgkmcnt(" #n_ ")" : "+v"(f_[o_]), "+v"(f_[(o_) + 1]), "+v"(f_[(o_) + 2]), "+v"(f_[(o_) + 3]) :: "memory")
#define KMM4(f_, o_, ks_) do { sa0 = __builtin_amdgcn_mfma_f32_32x32x16_bf16(f_[o_], qf[ks_], sa0, 0, 0, 0); sa1 = __builtin_amdgcn_mfma_f32_32x32x16_bf16(f_[(o_) + 1], qf[ks_], sa1, 0, 0, 0); \
                        sb0 = __builtin_amdgcn_mfma_f32_32x32x16_bf16(f_[(o_) + 2], qf[ks_], sb0, 0, 0, 0); sb1 = __builtin_amdgcn_mfma_f32_32x32x16_bf16(f_[(o_) + 3], qf[ks_], sb1, 0, 0, 0); } while (0)
                    bf16x8 kf[8];
                    {   const int ci0 = (q0w - kva) >> 5;
                        const LAS unsigned char* bp = bta + kva * 4;
                        const unsigned cta = (unsigned)(uintptr_t)(ctab + ci0);
                        unsigned cw0, cw1, cw2, cw3;
                        asm volatile("ds_read_b32 %0, %4 offset:12\n\tds_read_b32 %1, %4 offset:8\n\tds_read_b32 %2, %4 offset:4\n\tds_read_b32 %3, %4" : "=&v"(cw0), "=&v"(cw1), "=&v"(cw2), "=&v"(cw3) : "v"(cta) : "memory");
                        const unsigned kbase = (unsigned)(uintptr_t)(sba + m * 8192 + r32 * 128); const int sw = (r32 >> 1) & 7;
                        const unsigned ka0 = kbase + ((hi ^ sw) << 4), ka1 = kbase + (((2 + hi) ^ sw) << 4), ka2 = kbase + (((4 + hi) ^ sw) << 4), ka3 = kbase + (((6 + hi) ^ sw) << 4);
                        KRD4(kf, 0, ka0); KRD4(kf, 4, ka1);
                        asm volatile("s_waitcnt lgkmcnt(8)" : "+v"(cw0), "+v"(cw1), "+v"(cw2), "+v"(cw3) :: "memory");
#define MB_INIT(s_, c_, t_, w_) do { const int cw_ = __builtin_amdgcn_readfirstlane((int)(w_)); \
                            if (cw_ != SENTI) { c_ = __int_as_float(cw_); _Pragma("unroll") for (int r = 0; r < 16; ++r) s_[r] = 0.f; } \
                            else { c_ = 0.f; _Pragma("unroll") for (int j_ = 0; j_ < 4; ++j_) { const f32x4 b_ = *(const LAS f32x4*)(bp + (t_) * 128 + j_ * 32); \
                                s_[4 * j_] = b_.x; s_[4 * j_ + 1] = b_.y; s_[4 * j_ + 2] = b_.z; s_[4 * j_ + 3] = b_.w; } } } while (0)
                        MB_INIT(sa0, ct0, 0, cw0); MB_INIT(sa1, ct1, 1, cw1); MB_INIT(sb0, ct2, 2, cw2); MB_INIT(sb1, ct3, 3, cw3);
#undef MB_INIT
                        KWAIT4(4, kf, 0); KMM4(kf, 0, 0);
                        KRD4(kf, 0, ka2); KWAIT4(4, kf, 4); KMM4(kf, 4, 1);
                        KRD4(kf, 4, ka3); KWAIT4(4, kf, 0); KMM4(kf, 0, 2);
                        KWAIT4(0, kf, 4); KMM4(kf, 4, 3);
                    }
#undef KRD
#undef KRD4
#undef KWAIT4
#undef KMM4
#if BSTAGE_POS == 1
                    if (2 * u2 + 2 < NT && MODE != 3) { MB_STAGE(2 * u2 + 2, (2 * u2 + 2) & 3); MB_STAGE(2 * u2 + 3, (2 * u2 + 3) & 3); }
#elif BSTAGE_POS == 2
                    if (2 * u2 + 2 < NT && MODE != 3) { MB_STAGE(2 * u2 + 2, (2 * u2 + 2) & 3); }
#endif
                    if (MODE == 4) { lsum += sa0[0] + sa1[0] + sb0[0] + sb1[0] + sa0[9] + sa1[9] + sb0[9] + sb1[9]; continue; }
                    float rm;
                    {   float m0 = fmaxf(sa0[0], sa0[1]), m1 = fmaxf(sa1[0], sa1[1]), m2 = fmaxf(sb0[0], sb0[1]), m3 = fmaxf(sb1[0], sb1[1]);
#pragma unroll
                        for (int r = 2; r < 16; ++r) { m0 = fmaxf(m0, sa0[r]); m1 = fmaxf(m1, sa1[r]); m2 = fmaxf(m2, sb0[r]); m3 = fmaxf(m3, sb1[r]); }
                        rm = fmaxf(fmaxf(m0 + ct0, m1 + ct1), fmaxf(m2 + ct2, m3 + ct3)); }
                    rm = swap_max(rm);
                    if (__any(rm > mref + THR)) {
                        const float mn = fmaxf(mref, rm), f = __builtin_amdgcn_exp2f(mref - mn);
                        lsum *= f; mref = mn;
#pragma unroll
                        for (int dq = 0; dq < 4; ++dq)
#pragma unroll
                            for (int r = 0; r < 16; ++r) O[dq][r] *= f;
                    }
                    float ps = 0.f; const float rf0 = mref - ct0, rf1 = mref - ct1, rf2 = mref - ct2, rf3 = mref - ct3;
#pragma unroll
                    for (int r = 0; r < 16; ++r) { sa0[r] = __builtin_amdgcn_exp2f(sa0[r] - rf0); sa1[r] = __builtin_amdgcn_exp2f(sa1[r] - rf1); ps += sa0[r] + sa1[r]; }
                    bf16x8 pf[8];
#define MB_PACK(dst_, s_, o_) do { v4u w_; w_.x = cvtpk(s_[o_], s_[o_ + 1]); w_.y = cvtpk(s_[o_ + 2], s_[o_ + 3]); w_.z = cvtpk(s_[o_ + 4], s_[o_ + 5]); w_.w = cvtpk(s_[o_ + 6], s_[o_ + 7]); dst_ = __builtin_bit_cast(bf16x8, w_); } while (0)
#define MB_EXPB(i0_) do { asm volatile("" : "+v"(sb0), "+v"(sb1)); \
                        _Pragma("unroll") for (int r = (i0_); r < (i0_) + 4; ++r) { sb0[r] = __builtin_amdgcn_exp2f(sb0[r] - rf2); sb1[r] = __builtin_amdgcn_exp2f(sb1[r] - rf3); ps += sb0[r] + sb1[r]; } } while (0)
                    MB_PACK(pf[0], sa0, 0); MB_PACK(pf[1], sa0, 8); MB_PACK(pf[2], sa1, 0); MB_PACK(pf[3], sa1, 8);
#if BSTAGE_POS == 2
                    if (2 * u2 + 2 < NT && MODE != 3) { MB_STAGE(2 * u2 + 3, (2 * u2 + 3) & 3); }
#endif
                    const unsigned vlo = (unsigned)(((lane >> 4) & 1) * 32 + (lane & 3) * 8 + (4 * hi + ((lane & 15) >> 2)) * 64);
                    const unsigned vba = (unsigned)(uintptr_t)(sba + 16384) + vlo, vbb = (unsigned)(uintptr_t)(sbb + 16384) + vlo;
                    s16x4 fa[8], fb[8];
#define MB_RD(f, vb_, dq_) do { if (MODE != 1) _Pragma("unroll") for (int sp_ = 0; sp_ < 4; ++sp_) { TRV(f[2 * sp_], vb_, ((dq_) * 4 + sp_) * 1024); TRV(f[2 * sp_ + 1], vb_, ((dq_) * 4 + sp_) * 1024 + 512); } } while (0)
#define MB_MM(f, dq_, po_) do { if (MODE == 1) { asm volatile("" :: "v"(pf[(po_)]), "v"(pf[(po_) + 1]), "v"(pf[(po_) + 2]), "v"(pf[(po_) + 3])); } else _Pragma("unroll") for (int sp_ = 0; sp_ < 4; ++sp_) O[dq_] = __builtin_amdgcn_mfma_f32_32x32x16_bf16(VFRAG(f, sp_), pf[(po_) + sp_], O[dq_], 0, 0, 0); } while (0)
                    MB_RD(fa, vba, 0); MB_RD(fb, vba, 1); LGKM_WAIT8(8, fa); MB_MM(fa, 0, 0); MB_EXPB(0);
                    MB_RD(fa, vba, 2); LGKM_WAIT8(8, fb); MB_MM(fb, 1, 0); MB_EXPB(4);
                    MB_RD(fb, vba, 3); LGKM_WAIT8(8, fa); MB_MM(fa, 2, 0); MB_EXPB(8);
                    MB_RD(fa, vbb, 0); LGKM_WAIT8(8, fb); MB_MM(fb, 3, 0); MB_EXPB(12);
                    lsum += ps;
                    MB_PACK(pf[4], sb0, 0); MB_PACK(pf[5], sb0, 8); MB_PACK(pf[6], sb1, 0); MB_PACK(pf[7], sb1, 8);
                    MB_RD(fb, vbb, 1); LGKM_WAIT8(8, fa); MB_MM(fa, 0, 4);
                    MB_RD(fa, vbb, 2); LGKM_WAIT8(8, fb); MB_MM(fb, 1, 4);
                    MB_RD(fb, vbb, 3); LGKM_WAIT8(8, fa); MB_MM(fa, 2, 4);
                    LGKM_WAIT8(0, fb); MB_MM(fb, 3, 4);
#undef MB_PACK
#undef MB_EXPB
#undef MB_RD
#undef MB_MM
                }
            }
            RAW_BARRIER();
#undef MB_STAGE
            const float inv = 1.0f / swap_add(lsum);
            LAS float* xb = (LAS float*)lds + qs * 4096;
            if (m == 1) {
#pragma unroll
                for (int dq = 0; dq < 4; ++dq)
#pragma unroll
                    for (int r = 0; r < 16; ++r) xb[(dq * 16 + r) * 64 + lane] = O[dq][r] * inv;
            }
            RAW_BARRIER();
            if (m == 0) {
                float ss = 0.f;
#pragma unroll
                for (int dq = 0; dq < 4; ++dq)
#pragma unroll
                    for (int r = 0; r < 16; ++r) { const float o = O[dq][r] * inv - lam * xb[(dq * 16 + r) * 64 + lane]; O[dq][r] = o; ss += o * o; }
                const float rstd = 1.0f / sqrtf(swap_add(ss) * (1.f / 128.f) + EPS) * one_m_li;
                bf16* orow = OUTB + (size_t)(rb + qpos) * 512 + h * 128;
#pragma unroll
                for (int dq = 0; dq < 4; ++dq)
#pragma unroll
                    for (int g4 = 0; g4 < 4; ++g4) { const int d0 = dq * 32 + 8 * g4 + 4 * hi; const f32x4 gs = *(const LAS f32x4*)(gs_l + d0);
                        v2u w; w.x = pk2(O[dq][4 * g4] * rstd * gs.x, O[dq][4 * g4 + 1] * rstd * gs.y); w.y = pk2(O[dq][4 * g4 + 2] * rstd * gs.z, O[dq][4 * g4 + 3] * rstd * gs.w);
                        *(v2u*)(orow + d0) = w; }
            }
            asm volatile("s_waitcnt vmcnt(0)" ::: "memory");
            RAW_BARRIER();
        }
    }
}

constexpr size_t WS_OG = 432 * MiB, WS_LSE = 480 * MiB;
__device__ __forceinline__ void mixC_fast(unsigned char* y, unsigned char* ws, const float* T, LAS unsigned char* lds, int tid, int lane, int wave, int G) {
    asm volatile("" : "+v"(lane), "+v"(tid));
    const bf16* CQ = (const bf16*)(y + Y_CQ); const bf16* CK = (const bf16*)(y + Y_CK); const bf16* CV = (const bf16*)(y + Y_CV);
    float* OG = (float*)(ws + WS_OG); float* LSE = (float*)(ws + WS_LSE);
    const int r32 = lane & 31, hi = lane >> 5;
    LAS unsigned char* Kl = lds;
    LAS unsigned char* Vl = lds + 49152;
    LAS float* bt = (LAS float*)(lds + 98304);
    constexpr int CBS = 208;
    for (int item = blockIdx.x; item < CHB * 192; item += G) {
        const int bb = item / 192, u = item % 192, g = u >> 6, v = u & 63;
        const int hp = v >> 4, w16 = v & 15;
        const int dil = (g == 0) ? 1 : (g == 1) ? 4 : 16;
        const int rc = (g == 0) ? 0 : (g == 1) ? (w16 >> 2) : w16;
        const int seg = (g == 0) ? w16 : (g == 1) ? (w16 & 3) : 0;
        const int hh = 4 * g + hp, M0 = seg * 256, rb = bb * SEQ;
        RAW_BARRIER();
        if (tid < 196) { const int rel = 159 - tid; const float v = (rel >= 0 && rel <= 128) ? T[(rel * dil) * 24 + 12 + hh] * LOG2E : -INFINITY;
#pragma unroll
            for (int sc = 0; sc < 4; ++sc) { const int i = tid - sc; if (i >= 0 && i < 192) bt[sc * CBS + i] = v; } }
#pragma unroll
        for (int i = 0; i < 6; ++i) { const int p = wave * 6 + i;
            int mk = M0 - 128 + 8 * p + (lane >> 3); mk = mk < 0 ? 0 : mk;
            glds16(CK + (size_t)(rb + mk * dil + rc) * 768 + hh * 64 + ((lane & 7) ^ ((4 * p + (lane >> 4)) & 7)) * 8, Kl + p * 1024); }
#pragma unroll
        for (int i = 0; i < 6; ++i) { const int p = wave * 6 + i, dq = p / 24, rg = p % 24;
            int mk = M0 - 128 + 16 * rg + (lane >> 2); mk = mk < 0 ? 0 : mk;
            glds16(CV + (size_t)(rb + mk * dil + rc) * 768 + hh * 64 + dq * 32 + (lane & 3) * 8, Vl + p * 1024); }
        const int mq = M0 + 32 * wave + r32, rowq = rb + mq * dil + rc;
        bf16x8 qf[4];
#pragma unroll
        for (int ks = 0; ks < 4; ++ks) qf[ks] = *(const bf16x8*)(CQ + (size_t)rowq * 768 + hh * 64 + 16 * ks + 8 * hi);
        asm volatile("s_waitcnt vmcnt(0)" ::: "memory");
        RAW_BARRIER();
        f32x16 O[2];
#pragma unroll
        for (int dq = 0; dq < 2; ++dq)
#pragma unroll
            for (int r = 0; r < 16; ++r) O[dq][r] = 0.f;
        float mref = -INFINITY, lsum = 0.f;
#pragma unroll 1
        for (int j = 0; j < 5; ++j) {
            const int lrow = 32 * wave + 32 * j;
            if (M0 - 128 + lrow + 31 < 0) continue;
            const LAS unsigned char* kb = Kl + (lrow + r32) * 128;
            f32x16 s0;
            {   const int xl = 31 + 32 * j - r32 + 4 * hi;
                const LAS float* bp = bt + (xl & 3) * (CBS - 1) + xl;
#pragma unroll
                for (int j4 = 0; j4 < 4; ++j4) { const f32x4 b = *(const LAS f32x4*)(bp + 8 * j4); s0[4 * j4] = b.x; s0[4 * j4 + 1] = b.y; s0[4 * j4 + 2] = b.z; s0[4 * j4 + 3] = b.w; } }
#pragma unroll
            for (int ks = 0; ks < 4; ++ks) { const bf16x8 k0 = *(const LAS bf16x8*)(kb + (((2 * ks + hi) ^ (((lrow + r32) >> 1) & 7)) << 4)); s0 = __builtin_amdgcn_mfma_f32_32x32x16_bf16(k0, qf[ks], s0, 0, 0, 0); }
            if (M0 - 128 + lrow < 0) {
                const int mkb = M0 - 128 + lrow + 4 * hi;
#pragma unroll
                for (int r = 0; r < 16; ++r) { const int cr = (r & 3) + 8 * (r >> 2); if (mkb + cr < 0) s0[r] = -INFINITY; } }
            float rm = s0[0];
#pragma unroll
            for (int r = 1; r < 16; ++r) rm = fmaxf(rm, s0[r]);
            rm = swap_max(rm);
            const float mn = fmaxf(mref, rm);
            const float f = (mn == -INFINITY) ? 1.f : __builtin_amdgcn_exp2f(mref - mn);
            const float msub = (mn == -INFINITY) ? 0.f : mn;
            lsum *= f; mref = mn;
#pragma unroll
            for (int dq = 0; dq < 2; ++dq)
#pragma unroll
                for (int r = 0; r < 16; ++r) O[dq][r] *= f;
            float ps = 0.f;
#pragma unroll
            for (int r = 0; r < 16; ++r) { s0[r] = __builtin_amdgcn_exp2f(s0[r] - msub); ps += s0[r]; }
            lsum += ps;
            bf16x8 pf[2];
            { v4u w;
              w.x = cvtpk(s0[0], s0[1]); w.y = cvtpk(s0[2], s0[3]); w.z = cvtpk(s0[4], s0[5]); w.w = cvtpk(s0[6], s0[7]); pf[0] = __builtin_bit_cast(bf16x8, w);
              w.x = cvtpk(s0[8], s0[9]); w.y = cvtpk(s0[10], s0[11]); w.z = cvtpk(s0[12], s0[13]); w.w = cvtpk(s0[14], s0[15]); pf[1] = __builtin_bit_cast(bf16x8, w); }
            const unsigned vb = (unsigned)(uintptr_t)(Vl + ((lane >> 4) & 1) * 32 + (lane & 3) * 8 + (4 * hi + ((lane & 15) >> 2)) * 64 + (lrow >> 4) * 1024);
            s16x4 fa[8];
#pragma unroll
            for (int dq = 0; dq < 2; ++dq)
#pragma unroll
                for (int sp = 0; sp < 2; ++sp) { TRV(fa[4 * dq + 2 * sp], vb, (dq * 24 + sp) * 1024); TRV(fa[4 * dq + 2 * sp + 1], vb, (dq * 24 + sp) * 1024 + 512); }
            LGKM_WAIT8(0, fa);
#pragma unroll
            for (int dq = 0; dq < 2; ++dq)
#pragma unroll
                for (int sp = 0; sp < 2; ++sp) O[dq] = __builtin_amdgcn_mfma_f32_32x32x16_bf16(VFRAG(fa, 2 * dq + sp), pf[sp], O[dq], 0, 0, 0);
        }
        const float ltot = swap_add(lsum), inv = 1.0f / ltot;
        float* og = OG + ((size_t)g * CHR + rowq) * 256 + hp * 64;
#pragma unroll
        for (int dq = 0; dq < 2; ++dq)
#pragma unroll
            for (int g4 = 0; g4 < 4; ++g4) { const int d0 = dq * 32 + 8 * g4 + 4 * hi;
                *(f32x4*)(og + d0) = (f32x4){O[dq][4 * g4] * inv, O[dq][4 * g4 + 1] * inv, O[dq][4 * g4 + 2] * inv, O[dq][4 * g4 + 3] * inv}; }
        if (hi == 0) LSE[((size_t)g * CHR + rowq) * 4 + hp] = (mref + __log2f(ltot)) * 0.6931471805599453f;
    }
}
__device__ __forceinline__ void mergeC(unsigned char* y, unsigned char* ws, int gw, int NGW, int lane) {
    asm volatile("" : "+v"(lane));
    const float* OG = (const float*)(ws + WS_OG); const float* LSE = (const float*)(ws + WS_LSE); bf16* OC = (bf16*)(y + Y_OC);
    const int hp = lane >> 4, d4 = (lane & 15) * 4;
    for (int r0 = gw; r0 < CHR; r0 += 2 * NGW) {
        const int r1 = (r0 + NGW < CHR) ? r0 + NGW : r0;
        float l[2][3]; f32x4 o[2][3];
#pragma unroll
        for (int i = 0; i < 2; ++i) { const int r = i ? r1 : r0;
#pragma unroll
            for (int g = 0; g < 3; ++g) { l[i][g] = LSE[((size_t)g * CHR + r) * 4 + hp]; o[i][g] = *(const f32x4*)(OG + ((size_t)g * CHR + r) * 256 + hp * 64 + d4); } }
#pragma unroll
        for (int i = 0; i < 2; ++i) { const int r = i ? r1 : r0; if (i == 1 && r1 == r0) break;
            const float M = fmaxf(fmaxf(l[i][0], l[i][1]), l[i][2]);
            const float a0 = __expf(l[i][0] - M), a1 = __expf(l[i][1] - M), a2 = __expf(l[i][2] - M), ia = 1.0f / (a0 + a1 + a2);
            const f32x4 ov = (o[i][0] * a0 + o[i][1] * a1 + o[i][2] * a2) * ia;
            v2u w; w.x = pk2(ov.x, ov.y); w.y = pk2(ov.z, ov.w);
            *(v2u*)(OC + (size_t)r * 256 + hp * 64 + d4) = w; }
    }
}

constexpr int CW_KMAX = 8192;
constexpr int A_KST = 0, A_HIST = 32768, A_CAND = 98304, A_SEL = 131072, A_BKT = 147456, A_BIAS = 151552;
__device__ __forceinline__ int a_bin(float s, int kb) {
    int k = (int)(__float_as_uint(fabsf(s)) >> 18) - kb; k = k < 0 ? 0 : (k > 511 ? 511 : k);
    return (s < 0.f) ? (511 - k) : (512 + k);
}
__device__ __forceinline__ unsigned a_edge(int b, int kb) {
    if (b <= 0) return 0u;
    if (b >= 1024) return 0xffffffffu;
    if (b == 512) return 0x80000000u;
    if (b > 512) { const int k = b - 512 + kb; return 0x80000000u | ((unsigned)(k > 0 ? k : 0) << 18); }
    const int k = 512 - b + kb; return 0x80000000u - ((unsigned)(k > 0 ? k : 0) << 18);
}
__device__ __forceinline__ void mixA_fast(unsigned char* y, bf16* OUTA, bf16* OUTA2, const bf16* KVN, const bf16* UKT, const float* T, const float* rel_bias, const unsigned* kmaxw, LAS unsigned char* lds, int tid, int lane, int wave, int G) {
    asm volatile("" : "+v"(lane), "+v"(tid));
    const bf16* AQ = (const bf16*)(y + Y_AQ); bf16* QLS = (bf16*)(y + Y_QLS) + (size_t)blockIdx.x * 32 * 1024; const bf16* MISC = (const bf16*)(y + Y_MISC); const bf16* IQ = (const bf16*)(y + Y_IQ);
    const int kl = lane & 31, hi = lane >> 5;
    constexpr float C2 = 0.125f * LOG2E, THR = 8.0f;
    unsigned short* KEYS = (unsigned short*)(y + ((blockIdx.x < 160) ? (Y_CK + 8 * MiB + (size_t)blockIdx.x * 262144) : (Y_BK + (size_t)(blockIdx.x - 160) * 262144)));
    LAS float* biasl = (LAS float*)(lds + A_BIAS);
    const unsigned lt32 = (1u << kl) - 1u;
    for (int item = blockIdx.x; item < CHB * 64; item += G) {
        const int bb = (G == 256) ? (item & 3) : (item >> 6), pr = (G == 256) ? (((item >> 2) & 1) * 32 + (item >> 3)) : (item & 63), rb = bb * SEQ;
        const float kmax = sqrtf(__uint_as_float(kmaxw[bb]));
        for (int uu = 0; uu < 2; ++uu) {
            const int qb = (uu == 0) ? (127 - pr) : pr, t0 = qb * 32, tw = t0 + 4 * wave;
            RAW_BARRIER();
            { int tq = tid; asm volatile("" : "+v"(tq)); if (tq < 256) biasl[tq] = rel_bias[(tq >> 3) * 24 + (tq & 7)] * LOG2E; }
            bf16x8 aq[4];
            int klq = kl, hiq = hi; asm volatile("" : "+v"(klq), "+v"(hiq));
            { const int rowq = klq >> 3, hr = klq & 7;
#pragma unroll
              for (int ks = 0; ks < 4; ++ks) aq[ks] = *(const bf16x8*)(IQ + (size_t)(rb + tw + rowq) * 512 + hr * 64 + 16 * ks + 8 * hiq); }
            float wr[16];
#pragma unroll
            for (int r = 0; r < 16; ++r) wr[r] = bf2f(MISC[(size_t)(rb + tw + (r >> 2)) * 256 + 192 + (r & 3) + 4 * hiq]) * 0.044194173824159216f;
            int kbX, kbY;
            { float ss = 0.f;
#pragma unroll
              for (int ks = 0; ks < 4; ++ks)
#pragma unroll
                  for (int j = 0; j < 8; ++j) { const float v = bf2f((bf16)aq[ks][j]); ss += v * v; }
              ss = swap_add(ss);
              const float wa = fabsf(bf2f(MISC[(size_t)(rb + tw + (klq >> 3)) * 256 + 192 + (klq & 7)])) * 0.044194173824159216f;
              float u = wa * sqrtf(ss) * kmax;
              u += __shfl_xor(u, 1); u += __shfl_xor(u, 2); u += __shfl_xor(u, 4);
              const float uX = __shfl(u, (2 * hi) * 8), uY = __shfl(u, (2 * hi + 1) * 8);
              kbX = (int)(__float_as_uint(uX) >> 18) - 511; kbY = (int)(__float_as_uint(uY) >> 18) - 511; }
            const int tX = tw + 2 * hi, tY = tw + 2 * hi + 1;
            const int qX = wave * 4 + 2 * hi, qY = qX + 1;
            LAS unsigned* histX = (LAS unsigned*)(lds + A_HIST + qX * 2048); LAS unsigned* histY = (LAS unsigned*)(lds + A_HIST + qY * 2048);
            int thrX = -1, thrY = -1; unsigned cntX = 0, cntY = 0, ccX = 0, ccY = 0;
            unsigned eSX = 0u, eCX = 0u, eSY = 0u, eCY = 0u;
#pragma unroll 1
            for (int rep8 = 0; rep8 < ((PROBE == 8 || PROBE == 15) ? 2 : 1); ++rep8) {
            thrX = -1; thrY = -1; cntX = 0; cntY = 0; ccX = 0; ccY = 0;
            { LAS v4u* hz = (LAS v4u*)(lds + A_HIST + wave * 8192);
              unsigned z0 = 0u; asm volatile("" : "+v"(z0));
#pragma unroll
              for (int i = 0; i < 8; ++i) hz[i * 64 + lane] = (v4u){z0, z0, z0, z0}; }
            const int NTK = qb + 1, NCK = (NTK + 3) >> 2;
#define MA_STAGE(ck_, buf_) do { _Pragma("unroll") for (int i_ = 0; i_ < 2; ++i_) { const int p_ = 2 * wave + i_, tl_ = p_ >> 2, ks_ = p_ & 3; \
                glds16(MISC + (size_t)(rb + 128 * (ck_) + 32 * tl_ + kl) * 256 + 128 + (2 * ks_ + hi) * 8, lds + A_KST + (buf_) * 16384 + tl_ * 4096 + ks_ * 1024); } } while (0)
#pragma unroll 1
            for (int pass = 0; pass < 1; ++pass) {
                const int NTR = (NTK + 1) >> 1;
                RAW_BARRIER();
                MA_STAGE(0, 0);
                asm volatile("s_waitcnt vmcnt(0)" ::: "memory");
                RAW_BARRIER();
                if (NCK > 1) MA_STAGE(1, 1);
#define RELU(x_) __int_as_float(max(__float_as_int(x_), 0))
#define MA_LOADK(kf_, bf_, tl_) do { const LAS unsigned char* kbp_ = lds + A_KST + (bf_) * 16384 + (tl_) * 4096 + hi * 512 + kl * 16; \
                        _Pragma("unroll") for (int ks = 0; ks < 4; ++ks) kf_[ks] = *(const LAS bf16x8*)(kbp_ + ks * 1024); } while (0)
#define MA_MMA(c_, kf_) do { _Pragma("unroll") for (int r = 0; r < 16; ++r) c_[r] = 0.f; \
                        _Pragma("unroll") for (int ks = 0; ks < 4; ++ks) c_ = __builtin_amdgcn_mfma_f32_32x32x16_bf16(aq[ks], kf_[ks], c_, 0, 0, 0); } while (0)
#define MA_RED(sX_, sY_, c_) do { float p0_ = 0.f, p1_ = 0.f, p2_ = 0.f, p3_ = 0.f; \
                        _Pragma("unroll") for (int i = 0; i < 4; ++i) { p0_ += wr[i] * RELU(c_[i]); p1_ += wr[4 + i] * RELU(c_[4 + i]); p2_ += wr[8 + i] * RELU(c_[8 + i]); p3_ += wr[12 + i] * RELU(c_[12 + i]); } \
                        { auto rr = __builtin_amdgcn_permlane32_swap(__float_as_uint(p0_), __float_as_uint(p2_), false, false); sX_ = __uint_as_float(rr[0]) + __uint_as_float(rr[1]) + 0.f; } \
                        { auto rr = __builtin_amdgcn_permlane32_swap(__float_as_uint(p1_), __float_as_uint(p3_), false, false); sY_ = __uint_as_float(rr[0]) + __uint_as_float(rr[1]) + 0.f; } } while (0)
#define MA_APPEND(sv_, val_, q_, cnt_, cc_, eS_, eC_, s_) do { const unsigned mk_ = __float_as_uint(sv_) ^ ((unsigned)((int)__float_as_uint(sv_) >> 31) | 0x80000000u); \
                        const bool sel_ = (val_) && mk_ >= (eS_), cd_ = (val_) && mk_ >= (eC_) && mk_ < (eS_); \
                        const unsigned long long bs_ = __ballot(sel_), bc_ = __ballot(cd_); \
                        const unsigned ms_ = hi ? (unsigned)(bs_ >> 32) : (unsigned)bs_, mc_ = hi ? (unsigned)(bc_ >> 32) : (unsigned)bc_; \
                        if (sel_) lds_st_b16_asm((LAS bf16*)(lds + A_SEL + (q_) * 512) + cnt_ + __popc(ms_ & lt32), (unsigned)(s_)); \
                        if (cd_) { const unsigned cp_ = cc_ + __popc(mc_ & lt32); if (cp_ < 128u) { lds_st_b32_asm((LAS float*)(lds + A_CAND + (q_) * 768) + cp_, __float_as_uint(sv_)); lds_st_b16_asm((LAS bf16*)(lds + A_CAND + (q_) * 768 + 512) + cp_, (unsigned)(s_)); } } \
                        cnt_ += __popc(ms_); cc_ += __popc(mc_); } while (0)
                f32x16 ca, cb;
                {   bf16x8 kfa[4], kfb[4];
                    MA_LOADK(kfa, 0, 0); MA_LOADK(kfb, 0, 1);
                    MA_MMA(ca, kfa); MA_MMA(cb, kfb); }
#pragma unroll 1
                for (int t = 0; t < NTR; ++t) {
                    bf16x8 kfa[4], kfb[4];
                    if (t + 1 < NTR && ((t + 1) & 1) == 0) {
                        const int c = (t + 1) >> 1;
                        asm volatile("s_waitcnt vmcnt(0)" ::: "memory");
                        RAW_BARRIER();
                        if (c + 1 < NCK) MA_STAGE(c + 1, (c + 1) & 1);
                    }
                    const int bf = ((t + 1) >> 1) & 1, tl = 2 * ((t + 1) & 1);
#define MA_KRD(kf_, a_) asm volatile("ds_read_b128 %0, %4\n\tds_read_b128 %1, %4 offset:1024\n\tds_read_b128 %2, %4 offset:2048\n\tds_read_b128 %3, %4 offset:3072" : "=&v"(kf_[0]), "=&v"(kf_[1]), "=&v"(kf_[2]), "=&v"(kf_[3]) : "v"(a_) : "memory")
#define MA_KWAIT(kf_) asm volatile("s_waitcnt lgkmcnt(0)" : "+v"(kf_[0]), "+v"(kf_[1]), "+v"(kf_[2]), "+v"(kf_[3]) :: "memory")
                    const unsigned kad = (unsigned)(uintptr_t)(lds + A_KST + bf * 16384 + tl * 4096 + hi * 512 + kl * 16);
                    MA_KRD(kfa, kad);
                    float sXa, sYa, sXb, sYb;
                    MA_RED(sXa, sYa, ca);
                    asm volatile("" : "+v"(sXa), "+v"(sYa));
                    MA_KWAIT(kfa); MA_MMA(ca, kfa);
                    MA_KRD(kfb, kad + 4096u);
                    MA_RED(sXb, sYb, cb);
                    asm volatile("" : "+v"(sXb), "+v"(sYb));
                    MA_KWAIT(kfb); MA_MMA(cb, kfb);
#undef MA_KRD
#undef MA_KWAIT
                    const int sa = t * 64 + kl, sb2 = sa + 32;
                    const bool vXa = sa <= tX, vYa = sa <= tY, vXb = sb2 <= tX, vYb = sb2 <= tY;
                    if (pass == 0) {
                        const int bXa = a_bin(sXa, kbX), bYa = a_bin(sYa, kbY), bXb = a_bin(sXb, kbX), bYb = a_bin(sYb, kbY);
                        lds_add_u32_asm(histX + (bXa >> 1), vXa ? (1u << ((bXa & 1) * 16)) : 0u);
                        lds_add_u32_asm(histY + (bYa >> 1), vYa ? (1u << ((bYa & 1) * 16)) : 0u);
                        lds_add_u32_asm(histX + (bXb >> 1), vXb ? (1u << ((bXb & 1) * 16)) : 0u);
                        lds_add_u32_asm(histY + (bYb >> 1), vYb ? (1u << ((bYb & 1) * 16)) : 0u);
#define A_KEY16(s_) ((unsigned short)((__float_as_uint(s_) ^ ((unsigned)((int)__float_as_uint(s_) >> 31) | 0x80000000u)) >> 16))
                        {   unsigned short* kw = KEYS + (size_t)qX * 4096 + sa;
                            kw[0] = A_KEY16(sXa); kw[4096] = A_KEY16(sYa); kw[32] = A_KEY16(sXb); kw[4096 + 32] = A_KEY16(sYb); }
#undef A_KEY16
                    } else {
                        MA_APPEND(sXa, vXa, qX, cntX, ccX, eSX, eCX, sa); MA_APPEND(sYa, vYa, qY, cntY, ccY, eSY, eCY, sa);
                        MA_APPEND(sXb, vXb, qX, cntX, ccX, eSX, eCX, sb2); MA_APPEND(sYb, vYb, qY, cntY, ccY, eSY, eCY, sb2);
                    }
                    asm volatile("" : "+v"(ca), "+v"(cb));
                }
#undef MA_LOADK
#undef MA_MMA
#undef MA_RED
#undef MA_APPEND
                RAW_BARRIER();
                if (pass == 0) {
#pragma unroll 1
                    for (int q4 = 0; q4 < 4; ++q4) {
                        const LAS unsigned* hq = (const LAS unsigned*)(lds + A_HIST + (wave * 4 + q4) * 2048) + 504 - 8 * lane;
                        unsigned w8[8];
                        { const v4u a0 = *(const LAS v4u*)hq, a1 = *(const LAS v4u*)(hq + 4); w8[0] = a0.x; w8[1] = a0.y; w8[2] = a0.z; w8[3] = a0.w; w8[4] = a1.x; w8[5] = a1.y; w8[6] = a1.z; w8[7] = a1.w; }
                        unsigned loc = 0;
#pragma unroll
                        for (int j = 0; j < 8; ++j) loc += (w8[j] & 0xffffu) + (w8[j] >> 16);
                        unsigned inc = loc;
#pragma unroll
                        for (int o = 1; o < 64; o <<= 1) { const unsigned v = __shfl_up(inc, o); if (lane >= o) inc += v; }
                        unsigned run = inc - loc; int thr = -1; unsigned cab = 0;
#pragma unroll
                        for (int j = 7; j >= 0; --j)
#pragma unroll
                            for (int hh = 1; hh >= 0; --hh) { const unsigned cn = (w8[j] >> (16 * hh)) & 0xffffu;
                                if (thr < 0 && run + cn >= (unsigned)TOPK) { thr = 2 * (504 - 8 * lane + j) + hh; cab = run; }
                                run += cn; }
                        const unsigned long long bl = __ballot(inc >= (unsigned)TOPK);
                        int thq = -1; unsigned cbq = 0;
                        if (bl) { const int L = __ffsll((long long)bl) - 1; thq = __shfl(thr, L); cbq = __shfl(cab, L); }
                        (void)cbq;
                        if (q4 == 2 * hi) thrX = thq; if (q4 == 2 * hi + 1) thrY = thq;
                    }
                    eCX = a_edge(thrX, kbX); eSX = a_edge(thrX + 1, kbX); eCY = a_edge(thrY, kbY); eSY = a_edge(thrY + 1, kbY);
                }
            }
            {
                asm volatile("s_waitcnt vmcnt(0)" ::: "memory");
                __builtin_amdgcn_fence(__ATOMIC_RELEASE, "workgroup"); __builtin_amdgcn_fence(__ATOMIC_ACQUIRE, "workgroup");
                unsigned cq0 = 0, cq1 = 0, cq2 = 0, cq3 = 0, kq0 = 0, kq1 = 0, kq2 = 0, kq3 = 0;
#define MA_SCANQ(q4_, cntv_, ccv_) do { \
                    const unsigned eS_ = (unsigned)__builtin_amdgcn_readlane((int)(((q4_) & 1) ? eSY : eSX), ((q4_) >> 1) * 32) >> 16, eC_ = (unsigned)__builtin_amdgcn_readlane((int)(((q4_) & 1) ? eCY : eCX), ((q4_) >> 1) * 32) >> 16; \
                    const int tq_ = tw + (q4_), nch_ = (tq_ + 512) >> 9; \
                    const unsigned short* row_ = KEYS + (size_t)(wave * 4 + (q4_)) * 4096 + lane;     \
                    LAS bf16* so_ = (LAS bf16*)(lds + A_SEL + (wave * 4 + (q4_)) * 512); LAS bf16* co_ = (LAS bf16*)(lds + A_CAND + (wave * 4 + (q4_)) * 768 + 512); \
                    unsigned cnt_ = 0, cc_ = 0; unsigned nx_[8]; \
                    _Pragma("unroll") for (int j_ = 0; j_ < 8; ++j_) nx_[j_] = row_[64 * j_]; \
                    _Pragma("unroll 1") for (int c_ = 0; c_ < nch_; ++c_) { \
                        unsigned w_[8]; _Pragma("unroll") for (int j_ = 0; j_ < 8; ++j_) w_[j_] = nx_[j_]; \
                        if (c_ + 1 < nch_) { _Pragma("unroll") for (int j_ = 0; j_ < 8; ++j_) nx_[j_] = row_[512 * (c_ + 1) + 64 * j_]; } \
                        _Pragma("unroll") for (int j_ = 0; j_ < 8; ++j_) { \
                            const unsigned k_ = w_[j_]; const int ki_ = 512 * c_ + 64 * j_ + lane; \
                            const bool val_ = ki_ <= tq_, sel_ = val_ && k_ >= eS_, cd_ = val_ && k_ >= eC_ && k_ < eS_; \
                            const unsigned long long bs_ = __ballot(sel_), bc_ = __ballot(cd_); \
                            if (sel_) lds_st_b16_asm(so_ + cnt_ + __builtin_amdgcn_mbcnt_hi((unsigned)(bs_ >> 32), __builtin_amdgcn_mbcnt_lo((unsigned)bs_, 0u)), (unsigned)ki_); \
                            if (cd_) { const unsigned cp_ = cc_ + __builtin_amdgcn_mbcnt_hi((unsigned)(bc_ >> 32), __builtin_amdgcn_mbcnt_lo((unsigned)bc_, 0u)); if (cp_ < 128u) lds_st_b16_asm(co_ + cp_, (unsigned)ki_); } \
                            cnt_ += (unsigned)__popcll(bs_); cc_ += (unsigned)__popcll(bc_); } } \
                    cntv_ = cnt_; ccv_ = cc_; } while (0)
                MA_SCANQ(0, cq0, kq0); MA_SCANQ(1, cq1, kq1); MA_SCANQ(2, cq2, kq2); MA_SCANQ(3, cq3, kq3);
#undef MA_SCANQ
                cntX = hi ? cq2 : cq0; cntY = hi ? cq3 : cq1; ccX = hi ? kq2 : kq0; ccY = hi ? kq3 : kq1;
                asm volatile("s_waitcnt lgkmcnt(0)" ::: "memory");
                const int n0 = min(__builtin_amdgcn_readlane((int)ccX, 0), 128), n2 = min(__builtin_amdgcn_readlane((int)ccX, 32), 128), n1 = min(__builtin_amdgcn_readlane((int)ccY, 0), 128), n3 = min(__builtin_amdgcn_readlane((int)ccY, 32), 128);
#pragma unroll 1
                for (int qp = 0; qp < 2; ++qp) {
                    const int na = qp ? n2 : n0, nb2 = qp ? n3 : n1, nmax = na > nb2 ? na : nb2;
                    LAS float* csa = (LAS float*)(lds + A_CAND + (wave * 4 + 2 * qp) * 768); LAS float* csb = (LAS float*)(lds + A_CAND + (wave * 4 + 2 * qp + 1) * 768);
                    const LAS bf16* cia = (const LAS bf16*)(lds + A_CAND + (wave * 4 + 2 * qp) * 768 + 512); const LAS bf16* cib = (const LAS bf16*)(lds + A_CAND + (wave * 4 + 2 * qp + 1) * 768 + 512);
#pragma unroll 1
                    for (int tb = 0; tb < nmax; tb += 32) {
                        const int ia = (tb + kl < na) ? (int)cia[tb + kl] : 0, ib = (tb + kl < nb2) ? (int)cib[tb + kl] : 0;
                        bf16x8 kfa[4], kfb[4];
#pragma unroll
                        for (int ks = 0; ks < 4; ++ks) { kfa[ks] = *(const bf16x8*)(MISC + (size_t)(rb + ia) * 256 + 128 + (2 * ks + hi) * 8); kfb[ks] = *(const bf16x8*)(MISC + (size_t)(rb + ib) * 256 + 128 + (2 * ks + hi) * 8); }
                        f32x16 ca, cb;
#pragma unroll
                        for (int r = 0; r < 16; ++r) { ca[r] = 0.f; cb[r] = 0.f; }
#pragma unroll
                        for (int ks = 0; ks < 4; ++ks) { ca = __builtin_amdgcn_mfma_f32_32x32x16_bf16(aq[ks], kfa[ks], ca, 0, 0, 0); cb = __builtin_amdgcn_mfma_f32_32x32x16_bf16(aq[ks], kfb[ks], cb, 0, 0, 0); }
#define RELU2(x_) __int_as_float(max(__float_as_int(x_), 0))
#define MA_RED2(sX_, sY_, c_) do { float p0_ = 0.f, p1_ = 0.f, p2_ = 0.f, p3_ = 0.f; \
                        _Pragma("unroll") for (int i = 0; i < 4; ++i) { p0_ += wr[i] * RELU2(c_[i]); p1_ += wr[4 + i] * RELU2(c_[4 + i]); p2_ += wr[8 + i] * RELU2(c_[8 + i]); p3_ += wr[12 + i] * RELU2(c_[12 + i]); } \
                        { auto rr = __builtin_amdgcn_permlane32_swap(__float_as_uint(p0_), __float_as_uint(p2_), false, false); sX_ = __uint_as_float(rr[0]) + __uint_as_float(rr[1]) + 0.f; } \
                        { auto rr = __builtin_amdgcn_permlane32_swap(__float_as_uint(p1_), __float_as_uint(p3_), false, false); sY_ = __uint_as_float(rr[0]) + __uint_as_float(rr[1]) + 0.f; } } while (0)
                        float aX, aY, bX, bY;
                        MA_RED2(aX, aY, ca); MA_RED2(bX, bY, cb);
#undef MA_RED2
#undef RELU2
                        if (hi == qp && tb + kl < na) csa[tb + kl] = aX;
                        if (hi == qp && tb + kl < nb2) csb[tb + kl] = bY;
                    }
                }
                asm volatile("s_waitcnt lgkmcnt(0)" ::: "memory");
            }
            }
#undef MA_STAGE
            {
                const unsigned c0 = (unsigned)__shfl((int)cntX, 0), c2 = (unsigned)__shfl((int)cntX, 32), c1 = (unsigned)__shfl((int)cntY, 0), c3 = (unsigned)__shfl((int)cntY, 32);
                const unsigned k0 = (unsigned)__shfl((int)ccX, 0), k2 = (unsigned)__shfl((int)ccX, 32), k1 = (unsigned)__shfl((int)ccY, 0), k3 = (unsigned)__shfl((int)ccY, 32);
#pragma unroll 1
                for (int q4 = 0; q4 < 4; ++q4) {
                    const unsigned cnt = (q4 == 0) ? c0 : (q4 == 1) ? c1 : (q4 == 2) ? c2 : c3; unsigned cc = (q4 == 0) ? k0 : (q4 == 1) ? k1 : (q4 == 2) ? k2 : k3;
                    if (cc > 128u) cc = 128u;
                    LAS unsigned* nfp = (LAS unsigned*)(lds + A_BIAS + 1024) + wave * 4 + q4;
                    if (lane == 0) *nfp = cnt;
                    if (cnt >= (unsigned)TOPK || cc == 0u) continue;
                    const unsigned need = (unsigned)TOPK - cnt;
                    const LAS float* cs = (const LAS float*)(lds + A_CAND + (wave * 4 + q4) * 768); const LAS bf16* ci = (const LAS bf16*)(lds + A_CAND + (wave * 4 + q4) * 768 + 512);
                    LAS bf16* so = (LAS bf16*)(lds + A_SEL + (wave * 4 + q4) * 512);
                    unsigned base = cnt;
#pragma unroll 1
                    for (unsigned r0 = 0; r0 < cc; r0 += 64) { const unsigned i = r0 + lane; const bool act = i < cc;
                        const float si = act ? cs[i] : 0.f; const unsigned ii = act ? ci[i] : 0u; unsigned rank = 0;
                        for (unsigned j = 0; j < cc; ++j) { const float sj = cs[j]; const unsigned ij = ci[j]; rank += (sj > si || (sj == si && ij < ii)) ? 1u : 0u; }
                        const bool take = act && rank < need;
                        const unsigned long long bt = __ballot(take);
                        if (take) so[base + __popcll(bt & ((1ull << lane) - 1ull))] = (bf16)ii;
                        base += __popcll(bt); }
                    if (lane == 0) *nfp = base;
                }
            }
            RAW_BARRIER();
            {
                bf16x8 bqa[4];
#pragma unroll
                for (int ks = 0; ks < 4; ++ks) bqa[ks] = *(const bf16x8*)(AQ + (size_t)(rb + t0 + kl) * 512 + wave * 64 + 16 * ks + 8 * hi);
#pragma unroll
                for (int nt = 0; nt < 4; ++nt) {
                    f32x16 cq;
#pragma unroll
                    for (int r = 0; r < 16; ++r) cq[r] = 0.f;
#pragma unroll
                    for (int ks = 0; ks < 4; ++ks) { const bf16x8 ua = *(const bf16x8*)(UKT + ((size_t)wave * 128 + 32 * nt + kl) * 64 + 16 * ks + 8 * hi); cq = __builtin_amdgcn_mfma_f32_32x32x16_bf16(ua, bqa[ks], cq, 0, 0, 0); }
                    bf16* qrow = QLS + (size_t)kl * 1024 + wave * 128 + 32 * nt + 4 * hi;
#pragma unroll
                    for (int g4 = 0; g4 < 4; ++g4) { v2u w; w.x = pk2(cq[4 * g4], cq[4 * g4 + 1]); w.y = pk2(cq[4 * g4 + 2], cq[4 * g4 + 3]); *(v2u*)(qrow + 8 * g4) = w; }
                }
                asm volatile("s_waitcnt vmcnt(0)" ::: "memory");
                __builtin_amdgcn_fence(__ATOMIC_RELEASE, "workgroup");
                RAW_BARRIER();
                __builtin_amdgcn_fence(__ATOMIC_ACQUIRE, "workgroup");
            }
#pragma unroll 1
            for (int rep9 = 0; rep9 < ((PROBE == 9 || PROBE == 10 || PROBE == 11) ? 2 : 1); ++rep9) {
                bf16* OUTP_ = ((PROBE == 9 || PROBE == 10 || PROBE == 11) && rep9 == 0) ? OUTA2 : OUTA;
                LAS unsigned char* gb = lds + wave * 16384;
                LAS bf16* bkt = (LAS bf16*)(lds + A_BKT + wave * 512);
#pragma unroll 1
                for (int q4 = 0; q4 < 4; ++q4) { int ns = (int)((const LAS unsigned*)(lds + A_BIAS + 1024))[wave * 4 + q4]; ns = ns < TOPK ? ns : TOPK; LAS bf16* so = (LAS bf16*)(lds + A_SEL + (wave * 4 + q4) * 512);
                    for (int i = lane; i < TOPK; i += 64) if (i >= ns) so[i] = 0; }
                asm volatile("s_waitcnt lgkmcnt(0)" ::: "memory");
                const int c15 = lane & 15, g = lane >> 4, q_ = c15 >> 2, p_ = c15 & 3, hc = c15 < 8 ? c15 : 7;
                const int Xr = ((c15 & 3) << 2) | ((c15 >> 2) & 3), Xt = (q_ << 2) | g;
                unsigned ra[4], ta[8];
#pragma unroll
                for (int ks = 0; ks < 4; ++ks) ra[ks] = (unsigned)(256 * c15 + 16 * ((4 * ks + g) ^ Xr));
#pragma unroll
                for (int dt = 0; dt < 8; ++dt) ta[dt] = (unsigned)(256 * (4 * g + q_) + 16 * ((2 * dt + (p_ >> 1)) ^ Xt) + 8 * (p_ & 1));
                bf16x8 bbf;
                { v4u w; const LAS float* bl = biasl + (8 * g) * 8 + hc;
                  constexpr float BS = 8.0f / LOG2E;
                  w.x = pk2(bl[0] * BS, bl[8] * BS); w.y = pk2(bl[16] * BS, bl[24] * BS); w.z = pk2(bl[32] * BS, bl[40] * BS); w.w = pk2(bl[48] * BS, bl[56] * BS); bbf = __builtin_bit_cast(bf16x8, w); }
#define MA_GATHER(q4_, c8_, buf_) do { const LAS bf16* so_ = (const LAS bf16*)(lds + A_SEL + (wave * 4 + (q4_)) * 512) + (c8_) * 32; \
                    int idx_[8]; _Pragma("unroll") for (int i_ = 0; i_ < 8; ++i_) idx_[i_] = (PROBE == 10 && rep9 == 0) ? (4 * i_ + (lane >> 4)) : (int)so_[4 * i_ + (lane >> 4)]; \
                    asm volatile("s_waitcnt lgkmcnt(0)" : "+v"(idx_[0]), "+v"(idx_[1]), "+v"(idx_[2]), "+v"(idx_[3]), "+v"(idx_[4]), "+v"(idx_[5]), "+v"(idx_[6]), "+v"(idx_[7]) :: "memory"); \
                    _Pragma("unroll") for (int i_ = 0; i_ < 8; ++i_) { const int row_ = 4 * i_ + (lane >> 4); \
                        const int ch_ = (lane & 15) ^ (((row_ & 3) << 2) | ((row_ >> 2) & 3)); \
                        glds16(KVN + (size_t)(rb + idx_[i_]) * 128 + ch_ * 8, gb + (buf_) * 8192 + i_ * 1024); } } while (0)
                MA_GATHER(0, 0, 0);
#pragma unroll 1
                for (int q4 = 0; q4 < 4; ++q4) {
                    const int t = tw + q4; int ns = (int)((const LAS unsigned*)(lds + A_BIAS + 1024))[wave * 4 + q4]; ns = ns < TOPK ? ns : TOPK;
                    const LAS bf16* so = (const LAS bf16*)(lds + A_SEL + (wave * 4 + q4) * 512);
                    for (int i = lane; i < TOPK; i += 64) { const int d = t - (int)so[i]; lds_st_b16_asm(bkt + i, (unsigned)rel_bucket(d < 0 ? 0 : d)); }
                    bf16x8 bq[4];
#pragma unroll
                    for (int ks = 0; ks < 4; ++ks) { bq[ks] = (bf16x8){0, 0, 0, 0, 0, 0, 0, 0}; if (c15 < 8) bq[ks] = *(const bf16x8*)(QLS + (size_t)(4 * wave + q4) * 1024 + c15 * 128 + 32 * ks + 8 * g); }
                    f32x4 O[8];
#pragma unroll
                    for (int dt = 0; dt < 8; ++dt) O[dt] = (f32x4){0.f, 0.f, 0.f, 0.f};
                    float mref = -INFINITY, lsum = 0.f;
#pragma unroll 1
                    for (int c8 = 0; c8 < 8; ++c8) {
                        const int step = q4 * 8 + c8, buf = step & 1;
#if AGATHER_POS == 0
                        asm volatile("s_waitcnt lgkmcnt(0)" ::: "memory");
                        if (step + 1 < 32) { MA_GATHER((step + 1) >> 3, (step + 1) & 7, buf ^ 1); asm volatile("s_waitcnt vmcnt(8)" ::: "memory"); }
                        else asm volatile("s_waitcnt vmcnt(0)" ::: "memory");
#else
                        asm volatile("s_waitcnt vmcnt(0) lgkmcnt(0)" ::: "memory");
#endif
                        const LAS unsigned char* cb = gb + buf * 8192;
                        if (PROBE == 11 && rep9 == 0) continue;
                        f32x4 sv[2];
#pragma unroll
                        for (int tau = 0; tau < 2; ++tau) {
                            f32x4 sa = (f32x4){0.f, 0.f, 0.f, 0.f};
#pragma unroll
                            for (int ks = 0; ks < 4; ++ks) { const bf16x8 kf = *(const LAS bf16x8*)(cb + ra[ks] + 4096 * tau); sa = __builtin_amdgcn_mfma_f32_16x16x32_bf16(kf, bq[ks], sa, 0, 0, 0); }
                            const int b = (int)bkt[c8 * 32 + 16 * tau + c15];
                            const unsigned val = ((b >> 3) == g) ? (0x3F80u << ((b & 1) * 16)) : 0u; const int di = (b >> 1) & 3;
                            v4u oh; oh.x = (di == 0) ? val : 0u; oh.y = (di == 1) ? val : 0u; oh.z = (di == 2) ? val : 0u; oh.w = (di == 3) ? val : 0u;
                            sa = __builtin_amdgcn_mfma_f32_16x16x32_bf16(__builtin_bit_cast(bf16x8, oh), bbf, sa, 0, 0, 0);
                            sv[tau] = sa * C2;
                        }
                        if (ns < TOPK) {
#pragma unroll
                            for (int tau = 0; tau < 2; ++tau)
#pragma unroll
                                for (int r = 0; r < 4; ++r) if (c8 * 32 + 16 * tau + 4 * g + r >= ns) sv[tau][r] = -INFINITY;
                        }
                        float rm = fmaxf(fmaxf(fmaxf(sv[0][0], sv[0][1]), fmaxf(sv[0][2], sv[0][3])), fmaxf(fmaxf(sv[1][0], sv[1][1]), fmaxf(sv[1][2], sv[1][3])));
                        rm = swap_max(swap16_max(rm));
                        if (__any(rm > mref + THR)) {
                            const float mn = fmaxf(mref, rm), f = (mn == -INFINITY) ? 1.f : __builtin_amdgcn_exp2f(mref - mn);
                            lsum *= f; mref = mn;
#pragma unroll
                            for (int dt = 0; dt < 8; ++dt) O[dt] = O[dt] * f;
                        }
                        const float msub = (mref == -INFINITY) ? 0.f : mref;
                        float ps = 0.f;
#pragma unroll
                        for (int tau = 0; tau < 2; ++tau)
#pragma unroll
                            for (int r = 0; r < 4; ++r) { sv[tau][r] = __builtin_amdgcn_exp2f(sv[tau][r] - msub); ps += sv[tau][r]; }
                        lsum += ps;
#if AGATHER_POS == 1
                        if (step + 1 < 32 && !(PROBE == 11 && rep9 == 0)) { MA_GATHER((step + 1) >> 3, (step + 1) & 7, buf ^ 1); }
#endif
                        bf16x8 pf;
                        { v4u w; w.x = cvtpk(sv[0][0], sv[0][1]); w.y = cvtpk(sv[0][2], sv[0][3]); w.z = cvtpk(sv[1][0], sv[1][1]); w.w = cvtpk(sv[1][2], sv[1][3]); pf = __builtin_bit_cast(bf16x8, w); }
                        {
                            const unsigned cbu = (unsigned)(uintptr_t)cb;
                            s16x4 fa[8], fb[8];
#pragma unroll
                            for (int dt = 0; dt < 4; ++dt) { TRV(fa[2 * dt], cbu + ta[dt], 0); TRV(fa[2 * dt + 1], cbu + ta[dt], 4096); }
#pragma unroll
                            for (int dt = 0; dt < 4; ++dt) { TRV(fb[2 * dt], cbu + ta[4 + dt], 0); TRV(fb[2 * dt + 1], cbu + ta[4 + dt], 4096); }
                            LGKM_WAIT8(8, fa);
#pragma unroll
                            for (int dt = 0; dt < 4; ++dt) O[dt] = __builtin_amdgcn_mfma_f32_16x16x32_bf16(VFRAG(fa, dt), pf, O[dt], 0, 0, 0);
                            LGKM_WAIT8(0, fb);
#pragma unroll
                            for (int dt = 0; dt < 4; ++dt) O[4 + dt] = __builtin_amdgcn_mfma_f32_16x16x32_bf16(VFRAG(fb, dt), pf, O[4 + dt], 0, 0, 0);
                        }
                    }
                    const float lt = swap_add(swap16_add(lsum));
                    const float inv = 1.0f / lt;
                    if (c15 < 8) { bf16* orow = OUTP_ + (size_t)(rb + t) * 1024 + c15 * 128 + 4 * g;
#pragma unroll
                        for (int dt = 0; dt < 8; ++dt) { v2u w; w.x = pk2(O[dt][0] * inv, O[dt][1] * inv); w.y = pk2(O[dt][2] * inv, O[dt][3] * inv); *(v2u*)(orow + 16 * dt) = w; } }
                }
#undef MA_GATHER
                asm volatile("s_waitcnt vmcnt(0)" ::: "memory");
            }
        }
    }
}
#define Y_() (WSP() + WS_Y)
#define WL_(l) (WSP() + WS_W + (size_t)(l) * W_LAYER)
#define MOD_(l) ((const float*)(WSP() + WS_MOD) + (size_t)(l) * 8 * 6144)
#define T_() ((const float*)(WSP() + WS_TAB))
#define H_() ((bf16*)(WSP() + WS_H))
#define KVN_() ((bf16*)(WSP() + WS_KVN))
#define KMAXW_(l, ch) ((unsigned*)(WSP() + WS_CTL) + 8192 + ((l) * NCH + (ch)) * 64)
#define LAMI_(l) (((l) == 0) ? 0.8f : 0.64449093f)
__device__ __forceinline__ int tidx(int w) { int t = (int)threadIdx.x; (void)w; asm volatile("" : "+v"(t)); return t; }
#define TID_ tidx(wave)
#define LANE_ (tidx(wave) & 63)
#ifndef STAGGER_TICKS
#define STAGGER_TICKS 0
#endif
#ifndef P1_ALIGN
#define P1_ALIGN true
#endif
#define GBAR() do { xcd_barrier(bar); if (PROBE == 16) xcd_barrier(bar); } while (0)
__global__ void __launch_bounds__(NTHREADS, 2) fwd(Args a) {
    extern __shared__ __attribute__((aligned(16))) unsigned char lds_raw[];
    LAS unsigned char* lds = (LAS unsigned char*)lds_raw;
    const int wave = __builtin_amdgcn_readfirstlane((int)threadIdx.x >> 6);
    const int G = gridDim.x, gw = blockIdx.x * NWAVES + wave, NGW = G * NWAVES;
    for (int u = (int)threadIdx.x; u < (LDS_BYTES - LDSCTL_OFF) / 4; u += NTHREADS) ((LAS unsigned*)(lds + LDSCTL_OFF))[u] = 0u;
    __syncthreads();
    XcdBarrier bar = xcd_barrier_post((unsigned*)(WSP() + WS_CTL) + CW_BAR, (volatile LAS unsigned*)(lds + LDSCTL_OFF), wave);

#pragma unroll 1
    for (int rep = 0; rep < (PROBE == 5 ? 2 : 1); ++rep) {
    p0a_prologue(WSP(), lds, TID_, LANE_, wave, G);
    GBAR(); }
    norm_rows(ARG(0), H_(), ARG(4), MOD_(0) + 0 * 1024, MOD_(0) + 1 * 1024, gw, NGW, LANE_);
    GBAR();

#pragma unroll 1
    for (int l = 0; l < NL; ++l) {
#pragma unroll 1
        for (int ch = 0; ch < NCH; ++ch) {
            { pg8::Gemm g{H_() + (size_t)ch * CHR * 1024, (const bf16*)(WL_(l) + W_IN), CHR, NIN, 1024}; pg8::StaticOrder S; S.init(CHR, NIN, G, (int)blockIdx.x);
              pg8::EpiIn E{Y_(), 0};
#if STAGGER_TICKS > 0
              { const unsigned long long t0 = __builtin_amdgcn_s_memrealtime(); const unsigned long long dl = (unsigned long long)((blockIdx.x >> 3) & 3u) * STAGGER_TICKS;
                while (__builtin_amdgcn_s_memrealtime() - t0 < dl) __builtin_amdgcn_s_sleep(8); }
#endif
#pragma unroll 1
              for (int rep = 0; rep < ((PROBE == 1 || PROBE == 17 || PROBE == 19) ? 2 : 1); ++rep) {
              E.skip = (PROBE == 19 && rep == 0) ? 1 : 0;
              pg8::gemm_phase<pg8::EpiIn, pg8::StaticOrder, P1_ALIGN, true>(lds, g, S, E, wave); }
            }
            GBAR();
            kvn_rows(Y_(), KVN_(), ARG(8) + l * 128, KMAXW_(l, ch), gw, NGW, LANE_);
#if PROBE == 4
            mixC_fast(Y_(), WSP(), T_(), lds, TID_, LANE_, wave, G);
#endif
            mixC_fast(Y_(), WSP(), T_(), lds, TID_, LANE_, wave, G);
#if PROBE == 2 || (PROBE >= 12 && PROBE <= 15)
            mixB_fast<(PROBE == 2 ? 0 : PROBE - 11)>(Y_(), (bf16*)(WSP() + 484 * MiB), T_(), ARG(13) + l * 128, ((const float*)(WSP() + WS_LAM))[l], LAMI_(l), lds, TID_, LANE_, wave, G);
#endif
            mixB_fast<0>(Y_(), (bf16*)(Y_() + Y_BQ), T_(), ARG(13) + l * 128, ((const float*)(WSP() + WS_LAM))[l], LAMI_(l), lds, TID_, LANE_, wave, G);
            GBAR();
            mergeC(Y_(), WSP(), gw, NGW, LANE_);
#if PROBE == 3 || PROBE == 9 || PROBE == 10 || PROBE == 11
            GBAR();
#endif
#if PROBE == 3
            mixA_fast(Y_(), (bf16*)(WSP() + WS_OG), (bf16*)(WSP() + WS_OG), KVN_(), (const bf16*)(WL_(l) + W_UKT), T_(), ARG(21), KMAXW_(l, ch), lds, TID_, LANE_, wave, G);
#endif
            mixA_fast(Y_(), (bf16*)(Y_() + Y_OLAT), (bf16*)(WSP() + WS_OG), KVN_(), (const bf16*)(WL_(l) + W_UKT), T_(), ARG(21), KMAXW_(l, ch), lds, TID_, LANE_, wave, G);
            GBAR();
#pragma unroll 1
            for (int rep = 0; rep < (PROBE == 7 ? 2 : 1); ++rep)
            { pg8::StaticOrder S; S.init(CHR, 1024, G, (int)blockIdx.x);
              { unsigned char* y = Y_(); pg8::Gemm g{(const bf16*)(y + Y_OLAT), (const bf16*)(WL_(l) + W_A), CHR, 1024, 1024}; pg8::EpiGate<0> E{(const unsigned char*)(y + Y_Z), 0, (float*)(y + Y_MF32), (bf16*)(y + Y_MBF)};
                pg8::gemm_phase<pg8::EpiGate<0>, pg8::StaticOrder, true, true>(lds, g, S, E, wave); }
              { unsigned char* y = Y_(); pg8::Gemm g{(const bf16*)(y + Y_BQ), (const bf16*)(WL_(l) + W_B), CHR, 1024, 512}; pg8::EpiGate<1> E{(const unsigned char*)(y + Y_Z), 1024, (float*)(y + Y_MF32), (bf16*)(y + Y_MBF)};
                pg8::gemm_phase<pg8::EpiGate<1>, pg8::StaticOrder, true, true>(lds, g, S, E, wave); }
              { unsigned char* y = Y_(); pg8::Gemm g{(const bf16*)(y + Y_OC), (const bf16*)(WL_(l) + W_C), CHR, 1024, 256}; pg8::EpiGate<2> E{(const unsigned char*)(y + Y_Z), 2048, (float*)(y + Y_MF32), (bf16*)(y + Y_MBF)};
                pg8::gemm_phase<pg8::EpiGate<2>, pg8::StaticOrder, true, true>(lds, g, S, E, wave); } }
            GBAR();
            { pg8::Gemm g{(const bf16*)(Y_() + Y_MBF), (const bf16*)(WL_(l) + W_OUT), CHR, 1024, 1024}; pg8::StaticOrder S; S.init(CHR, 1024, G, (int)blockIdx.x);
              pg8::EpiRes E{(l == 0) ? ARG(0) : (const float*)OUTP(), OUTP(), MOD_(l) + 2 * 1024, ch * CHR};
              pg8::gemm_phase<pg8::EpiRes, pg8::StaticOrder, true, true>(lds, g, S, E, wave); }
            GBAR();
        }
#pragma unroll 1
        for (int rep = 0; rep < (PROBE == 6 ? 2 : 1); ++rep) {
        norm_rows(OUTP(), H_(), ARG(18) + l * 1024, MOD_(l) + 3 * 1024, MOD_(l) + 4 * 1024, gw, NGW, LANE_);
        GBAR(); }
        { pg8::Gemm g{H_(), (const bf16*)(WL_(l) + W_GU), MT, NGU, 1024}; pg8::StaticOrder S; S.init(MT, NGU, G, (int)blockIdx.x);
          pg8::EpiSwiGLU E{(bf16*)(WSP() + WS_ACT)};
#pragma unroll 1
          for (int rep = 0; rep < ((PROBE == 1 || PROBE == 18) ? 2 : 1); ++rep)
          pg8::gemm_phase<pg8::EpiSwiGLU, pg8::StaticOrder, true, true>(lds, g, S, E, wave);
        }
        GBAR();
        { pg8::Gemm g{(const bf16*)(WSP() + WS_ACT), (const bf16*)(WL_(l) + W_D), MT, 1024, DFF}; pg8::StaticOrder S; S.init(MT, 1024, G, (int)blockIdx.x);
          pg8::EpiRes E{OUTP(), OUTP(), MOD_(l) + 5 * 1024, 0};
          pg8::gemm_phase<pg8::EpiRes, pg8::StaticOrder, true, true>(lds, g, S, E, wave); }
        GBAR();
        if (l + 1 < NL) { norm_rows(OUTP(), H_(), ARG(4) + (l + 1) * 1024, MOD_(l + 1) + 0 * 1024, MOD_(l + 1) + 1 * 1024, gw, NGW, LANE_); GBAR(); }
        else final_rows(OUTP(), ARG(22), gw, NGW, LANE_);
    }
}

extern "C" void kernel_launch(void* const* d_in, const int* in_sizes, int n_in, void* d_out, int out_size, void* d_ws, size_t ws_size, hipStream_t stream) {
    static int grid = 0;
    if (grid == 0) {
        if (n_in != 23 || out_size != MT * DM || ws_size < WS_END) { fprintf(stderr, "kernel_launch: unexpected shapes (n_in %d out %d ws %zu)\n", n_in, out_size, ws_size); grid = -1; return; }
        int dev = 0, cus = 0, per_cu = 0;
        if (hipGetDevice(&dev) != hipSuccess || hipDeviceGetAttribute(&cus, hipDeviceAttributeMultiprocessorCount, dev) != hipSuccess) { grid = -1; return; }
        if (hipFuncSetAttribute((const void*)fwd, hipFuncAttributeMaxDynamicSharedMemorySize, LDS_BYTES) != hipSuccess) { fprintf(stderr, "kernel_launch: hipFuncSetAttribute failed\n"); grid = -1; return; }
        if (hipOccupancyMaxActiveBlocksPerMultiprocessor(&per_cu, (const void*)fwd, NTHREADS, LDS_BYTES) != hipSuccess || per_cu < 1) { fprintf(stderr, "kernel_launch: occupancy query says %d\n", per_cu); }
        (void)hipGetLastError();
        grid = cus;
    }
    if (grid < 0) return;
    (void)hipMemsetAsync((char*)d_ws + WS_CTL, 0, CTL_ZERO_BYTES, stream);
    Args a{};
    for (int i = 0; i < 23; ++i) a.in[i] = (const float*)d_in[i];
    a.out = (float*)d_out; a.ws = (unsigned char*)d_ws; a.pad0 = 0; a.pad1 = 0;
    hipLaunchKernelGGL(fwd, dim3(grid), dim3(NTHREADS), LDS_BYTES, stream, a);
}
```

```cpp
#include <hip/hip_runtime.h>
#include <cstdio>
#include <cstdint>
#ifndef PROBE
#define PROBE 0
#endif
#ifndef DIAG_OFS
#define DIAG_OFS 0.5f
#endif
#ifndef BSTAGE_POS
#define BSTAGE_POS 2
#endif
#ifndef AGATHER_POS
#define AGATHER_POS 1
#endif
namespace pg8 {
#define PG8_LAS __attribute__((address_space(3)))
typedef unsigned short bf16_t;
typedef short bf16x8 __attribute__((ext_vector_type(8)));
typedef float f32x4 __attribute__((ext_vector_type(4)));
typedef unsigned u32x4 __attribute__((ext_vector_type(4)));
constexpr int BM = 256, BK = 64, HALF = 128, HTB = HALF * BK * 2  , STAGE_BYTES = 8 * HTB, NXCD = 8, WGM = 8;

__host__ __device__ __forceinline__ int lds_byte(int r, int c) { const int st = (r >> 4) * 2 + (c >> 5), rr = r & 15, cc = c & 31, ob = rr * 64 + cc * 2; return st * 1024 + (ob ^ (((ob >> 9) & 1) << 5)); }
__host__ __device__ __forceinline__ void stage_rc(int b, int& R, int& C) { const int st = b / 1024, sb = b % 1024, swz = sb ^ (((sb >> 9) & 1) << 5); R = (st >> 1) * 16 + swz / 64; C = (st & 1) * 32 + (swz % 64) / 2; }
__host__ __device__ __forceinline__ int perm32(int rho) { const int n = rho >> 4, i = rho & 15; return 8 * (i >> 2) + 4 * n + (i & 3); }

struct Unit { int pm, pn; };
struct Gemm { const bf16_t* A; const bf16_t* Bt; int M, N, K; };

struct StaticOrder {
    int nM, nN, nwg, G, c, rot = 0;
    __host__ __device__ void init(int M, int N, int G_, int c_) { nM = M / BM; nN = N / BM; nwg = nM * nN; G = G_; c = c_; }
    __host__ __device__ bool next(int i, Unit& u) const {
        const long L = (long)i * G + c; if (L >= nwg) return false;
        int wgid = (int)L; { const int q = nwg / NXCD, r = nwg % NXCD, xcd = wgid % NXCD, off = wgid / NXCD; wgid = (xcd < r ? xcd * (q + 1) : r * (q + 1) + (xcd - r) * q) + off; }
        const int nig = WGM * nN, gid = wgid / nig, fm = gid * WGM, gsz = (nM - fm) < WGM ? (nM - fm) : WGM;
        u.pm = fm + ((wgid % nig) % gsz); { int pn_ = (wgid % nig) / gsz + rot; u.pn = pn_ >= nN ? pn_ - nN : pn_; } return true;
    }
    __device__ __forceinline__ void a_ready(const Unit&) const {}
    __device__ __forceinline__ void done(const Unit&) const {}
};

template <class Epi, class Sched, bool ALIGN_EPI = false, bool SP2 = false>
__device__ __forceinline__ void gemm_phase(PG8_LAS unsigned char* lds, const Gemm g, const Sched& S, const Epi& E, int wv) {
    int tid_l = threadIdx.x; (void)wv; asm volatile("" : "+v"(tid_l));
    const int tid = tid_l, wid = __builtin_amdgcn_readfirstlane(tid >> 6), lane = tid & 63, wr = wid >> 2, wc = wid & 3, fr = lane & 15, fq = lane >> 4;
    int K_l = g.K; asm volatile("" : "+s"(K_l));
    const int K = K_l, nt = K / BK;
    unsigned voffA[2], voffB[2];
#pragma unroll
    for (int i = 0; i < 2; ++i) { int R, C; stage_rc(tid * 16 + i * 8192, R, C); const int Rb = Epi::PERM ? ((R & ~31) + perm32(R & 31)) : R;
        voffA[i] = (unsigned)(R * K + C) * 2u; voffB[i] = (unsigned)(Rb * K + C) * 2u; }
    const size_t kstep = (size_t)(BK * 2);
    const size_t hstep = (size_t)HALF * K * 2;
    const size_t tstep = 2 * hstep;
    const unsigned ldsw = (unsigned)wid * 1024u;
    const int aoff = lds_byte(wr * 64 + fr, fq * 8), boff = lds_byte(wc * 32 + fr, fq * 8);
#define PG8_SA(b, h) (((b) * 2 + (h)) * HTB)
#define PG8_SB(b, h) ((4 + (b) * 2 + (h)) * HTB)
#define PG8_STAGE(bufoff, gbase, voff) do { _Pragma("unroll") for (int _i = 0; _i < 2; ++_i) \
        __builtin_amdgcn_global_load_lds((const unsigned*)((const char*)(gbase) + (voff)[_i]), (PG8_LAS unsigned*)(lds + (bufoff) + ldsw + _i * 8192), 16, 0, 0); } while (0)
#define PG8_LDA(dst, b, h) do { _Pragma("unroll") for (int m = 0; m < 4; ++m) _Pragma("unroll") for (int k = 0; k < 2; ++k) dst[m][k] = *(const PG8_LAS bf16x8*)(lds + PG8_SA(b, h) + aoff + m * 2048 + k * 1024); } while (0)
#define PG8_LDB(dst, b, h) do { _Pragma("unroll") for (int n = 0; n < 2; ++n) _Pragma("unroll") for (int k = 0; k < 2; ++k) dst[n][k] = *(const PG8_LAS bf16x8*)(lds + PG8_SB(b, h) + boff + n * 2048 + k * 1024); } while (0)
#define PG8_MMA(ai, bj, At, Bt) do { __builtin_amdgcn_s_setprio(1); _Pragma("unroll") for (int m = 0; m < 4; ++m) _Pragma("unroll") for (int n = 0; n < 2; ++n) _Pragma("unroll") for (int k = 0; k < 2; ++k) \
        acc[ai][bj][m][n] = __builtin_amdgcn_mfma_f32_16x16x32_bf16(Bt[n][k], At[m][k], acc[ai][bj][m][n], 0, 0, 0); __builtin_amdgcn_s_setprio(0); } while (0)
#define PG8_WAIT_V(n) asm volatile("s_waitcnt vmcnt(" #n ")" ::: "memory")
#define PG8_WAIT_L(n) asm volatile("s_waitcnt lgkmcnt(" #n ")" ::: "memory")
#define PG8_BAR __builtin_amdgcn_s_barrier()
#define PG8_SCHED __builtin_amdgcn_sched_barrier(0)
    Unit cur, nxt; int ui = 0;
    if (!S.next(0, cur)) return;
    f32x4 acc[2][2][4][2];
#pragma unroll
    for (int a = 0; a < 2; ++a)
#pragma unroll
        for (int b = 0; b < 2; ++b)
#pragma unroll
            for (int m = 0; m < 4; ++m)
#pragma unroll
                for (int n = 0; n < 2; ++n) acc[a][b][m][n] = (f32x4){0.f, 0.f, 0.f, 0.f};
    bf16x8 At[4][2], B0[2][2], B1[2][2];
    const char* cA = (const char*)g.A + (size_t)cur.pm * tstep; const char* cB = (const char*)g.Bt + (size_t)cur.pn * tstep;
    S.a_ready(cur);
    if constexpr (SP2) {
        PG8_STAGE(PG8_SB(0, 0), cB, voffB); PG8_STAGE(PG8_SB(0, 1), cB + hstep, voffB); PG8_STAGE(PG8_SA(0, 0), cA, voffA); PG8_STAGE(PG8_SA(0, 1), cA + hstep, voffA);
        if (wr == 1) PG8_BAR;
        PG8_WAIT_V(2); PG8_BAR;
        PG8_STAGE(PG8_SB(1, 0), cB + kstep, voffB); PG8_STAGE(PG8_SA(1, 0), cA + kstep, voffA); PG8_STAGE(PG8_SB(1, 1), cB + hstep + kstep, voffB);
        PG8_WAIT_V(6); PG8_BAR;
    } else {
        PG8_STAGE(PG8_SB(0, 0), cB, voffB); PG8_STAGE(PG8_SA(0, 0), cA, voffA); PG8_STAGE(PG8_SB(0, 1), cB + hstep, voffB); PG8_STAGE(PG8_SA(0, 1), cA + hstep, voffA);
        if (wr == 1) PG8_BAR;
        PG8_WAIT_V(4); PG8_BAR;
        PG8_STAGE(PG8_SB(1, 0), cB + kstep, voffB); PG8_STAGE(PG8_SA(1, 0), cA + kstep, voffA); PG8_STAGE(PG8_SB(1, 1), cB + hstep + kstep, voffB);
        PG8_WAIT_V(6); PG8_BAR;
    }
    for (;;) {
        const bool has_next = S.next(ui + 1, nxt);
        const char* nA = has_next ? (const char*)g.A + (size_t)nxt.pm * tstep : cA; const char* nB = has_next ? (const char*)g.Bt + (size_t)nxt.pn * tstep : cB;
        for (int t = 0; t < nt; t += 2) {
            const bool last = (t == nt - 2);
            const char* a1 = cA + (size_t)(t + 1) * kstep;
            const char* a2 = last ? nA : cA + (size_t)(t + 2) * kstep; const char* b2 = last ? nB : cB + (size_t)(t + 2) * kstep;
            const char* a3 = a2 + kstep; const char* b3 = b2 + kstep;
            if (last && has_next) S.a_ready(nxt);
            if constexpr (SP2) {
            PG8_LDB(B0, 0, 0); PG8_LDB(B1, 0, 1); PG8_SCHED; PG8_LDA(At, 0, 0); PG8_STAGE(PG8_SA(1, 1), a1 + hstep, voffA);
            PG8_WAIT_V(8); PG8_WAIT_L(0); PG8_BAR; PG8_MMA(0, 0, At, B0); PG8_MMA(0, 1, At, B1); PG8_BAR; PG8_SCHED;
            PG8_LDA(At, 0, 1); PG8_STAGE(PG8_SB(0, 0), b2, voffB); PG8_STAGE(PG8_SB(0, 1), b2 + hstep, voffB); PG8_STAGE(PG8_SA(0, 0), a2, voffA);
            PG8_WAIT_V(8); PG8_WAIT_L(0); PG8_BAR; PG8_MMA(1, 0, At, B0); PG8_MMA(1, 1, At, B1); PG8_BAR; PG8_SCHED;
            PG8_LDB(B0, 1, 0); PG8_LDB(B1, 1, 1); PG8_SCHED; PG8_LDA(At, 1, 0); PG8_STAGE(PG8_SA(0, 1), a2 + hstep, voffA);
            PG8_WAIT_V(8); PG8_WAIT_L(0); PG8_BAR; PG8_MMA(0, 0, At, B0); PG8_MMA(0, 1, At, B1); PG8_BAR; PG8_SCHED;
            PG8_LDA(At, 1, 1); PG8_STAGE(PG8_SB(1, 0), b3, voffB); PG8_STAGE(PG8_SB(1, 1), b3 + hstep, voffB); PG8_STAGE(PG8_SA(1, 0), a3, voffA);
            PG8_WAIT_V(8); PG8_WAIT_L(0); PG8_BAR; PG8_MMA(1, 0, At, B0); PG8_MMA(1, 1, At, B1); PG8_BAR; PG8_SCHED;
            } else {
            PG8_LDB(B0, 0, 0); PG8_SCHED; PG8_LDA(At, 0, 0); PG8_STAGE(PG8_SA(1, 1), a1 + hstep, voffA);
            PG8_WAIT_L(8); PG8_BAR; PG8_WAIT_L(0); PG8_MMA(0, 0, At, B0); PG8_BAR; PG8_SCHED;
            PG8_LDB(B1, 0, 1); PG8_STAGE(PG8_SB(0, 0), b2, voffB);
            PG8_BAR; PG8_WAIT_L(0); PG8_MMA(0, 1, At, B1); PG8_BAR;
            PG8_LDA(At, 0, 1); PG8_STAGE(PG8_SA(0, 0), a2, voffA);
            PG8_BAR; PG8_WAIT_L(0); PG8_MMA(1, 0, At, B0); PG8_BAR; PG8_SCHED;
            PG8_STAGE(PG8_SB(0, 1), b2 + hstep, voffB);
            PG8_WAIT_V(6); PG8_BAR; PG8_MMA(1, 1, At, B1); PG8_BAR;
            PG8_LDB(B0, 1, 0); PG8_SCHED; PG8_LDA(At, 1, 0); PG8_STAGE(PG8_SA(0, 1), a2 + hstep, voffA);
            PG8_WAIT_L(8); PG8_BAR; PG8_WAIT_L(0); PG8_MMA(0, 0, At, B0); PG8_BAR; PG8_SCHED;
            PG8_LDB(B1, 1, 1); PG8_STAGE(PG8_SB(1, 0), b3, voffB);
            PG8_BAR; PG8_WAIT_L(0); PG8_MMA(0, 1, At, B1); PG8_BAR;
            PG8_LDA(At, 1, 1); PG8_STAGE(PG8_SA(1, 0), a3, voffA);
            PG8_BAR; PG8_WAIT_L(0); PG8_MMA(1, 0, At, B0); PG8_BAR; PG8_SCHED;
            PG8_STAGE(PG8_SB(1, 1), b3 + hstep, voffB);
            PG8_WAIT_V(6); PG8_BAR; PG8_MMA(1, 1, At, B1); PG8_BAR;
            }
        }
        if constexpr (ALIGN_EPI) { if (wr == 0) PG8_BAR; }
        if constexpr (!Epi::AFTER_DRAIN) { E(acc, cur, wr, wc, fr, fq); S.done(cur); }
        if (!has_next) break;
#pragma unroll
        for (int a = 0; a < 2; ++a)
#pragma unroll
            for (int b = 0; b < 2; ++b)
#pragma unroll
                for (int m = 0; m < 4; ++m)
#pragma unroll
                    for (int n = 0; n < 2; ++n) acc[a][b][m][n] = (f32x4){0.f, 0.f, 0.f, 0.f};
        cur = nxt; cA = nA; cB = nB; ++ui;
        if constexpr (ALIGN_EPI) { if (wr == 1) PG8_BAR; }
    }
    PG8_WAIT_V(0);
    if constexpr (!ALIGN_EPI) { if (wr == 0) PG8_BAR; }
    PG8_BAR;
    if constexpr (Epi::AFTER_DRAIN) { E.fused(acc, cur, wr, wc, fr, fq, lds, wid, lane); S.done(cur); }
#undef PG8_SA
#undef PG8_SB
#undef PG8_STAGE
#undef PG8_LDA
#undef PG8_LDB
#undef PG8_MMA
#undef PG8_WAIT_V
#undef PG8_WAIT_L
#undef PG8_BAR
#undef PG8_SCHED
}
}

constexpr int NB = 8, SEQ = 4096, DM = 1024, MT = NB * SEQ, NL = 2;
constexpr int CHB = 4, CHR = CHB * SEQ, NCH = NB / CHB;
constexpr int NIN = 8192, DFF = 2816, NGU = 2 * DFF, WIN_SRC = 8136;
constexpr int TOPK = 256;
constexpr float EPS = 1e-6f;
constexpr int NWAVES = 8, NTHREADS = 512;

constexpr size_t MiB = 1u << 20;
constexpr size_t WS_CTL = 0, CTL_ZERO_BYTES = 1 * MiB;
constexpr size_t WS_MOD = 1 * MiB;
constexpr size_t WS_TAB = WS_MOD + 393216;
constexpr size_t WS_LAM = WS_TAB + 393216;
constexpr size_t WS_W = 2 * MiB, W_LAYER = 39 * MiB;
constexpr size_t W_IN = 0, W_UKT = 16 * MiB  , W_A = 17 * MiB, W_B = 19 * MiB, W_C = 20 * MiB, W_OUT = 20 * MiB + 512 * 1024, W_GU = 22 * MiB + 512 * 1024, W_D = 33 * MiB + 512 * 1024;
constexpr size_t WS_H = 80 * MiB;
constexpr size_t WS_Y = 144 * MiB;
constexpr size_t Y_QLAT = 0, Y_MISC = 32 * MiB, Y_IQ = 40 * MiB, Y_BQ = 56 * MiB, Y_BK = 72 * MiB, Y_BV = 88 * MiB, Y_CQ = 104 * MiB, Y_CK = 128 * MiB, Y_CV = 152 * MiB, Y_Z = 176 * MiB, Y_OC = 272 * MiB;
constexpr size_t Y_AQ = Y_QLAT, Y_QLS = Y_QLAT + 16 * MiB, Y_OLAT = Y_CQ;
constexpr size_t Y_MF32 = Y_CQ, Y_MBF = Y_BK;
constexpr size_t WS_ACT = WS_Y;
constexpr size_t WS_KVN = 424 * MiB;
constexpr size_t WS_END = 500 * MiB;
constexpr int CW_BAR = 4096;

#define GAS __attribute__((address_space(1)))
#define LAS __attribute__((address_space(3)))
typedef unsigned short bf16;
typedef unsigned v4u __attribute__((ext_vector_type(4)));
typedef unsigned v2u __attribute__((ext_vector_type(2)));
typedef float f32x4 __attribute__((ext_vector_type(4)));

__device__ __forceinline__ unsigned f2bf(float f) { unsigned u = __builtin_bit_cast(unsigned, f); return (u + 0x7fffu + ((u >> 16) & 1u)) >> 16; }
typedef float f32x2_c __attribute__((ext_vector_type(2))); typedef __bf16 bf16x2_c __attribute__((ext_vector_type(2)));
__device__ __forceinline__ unsigned pk2(float lo, float hi) { const f32x2_c v = {lo, hi}; const bf16x2_c b = __builtin_convertvector(v, bf16x2_c); return __builtin_bit_cast(unsigned, b); }
__device__ __forceinline__ float bflo(unsigned w) { return __uint_as_float(w << 16); }
__device__ __forceinline__ float bfhi(unsigned w) { return __uint_as_float(w & 0xffff0000u); }
__device__ __forceinline__ float bf2f(bf16 h) { return __uint_as_float((unsigned)h << 16); }
__device__ __forceinline__ float wave_sum(float v) {
#pragma unroll
    for (int o = 1; o < 64; o <<= 1) v += __shfl_xor(v, o);
    return v;
}
__device__ __forceinline__ float wave_max(float v) {
#pragma unroll
    for (int o = 1; o < 64; o <<= 1) v = fmaxf(v, __shfl_xor(v, o));
    return v;
}
__device__ __forceinline__ float sigmoidf_(float v) { return __builtin_amdgcn_rcpf(1.f + __expf(-v)); }

namespace pg8 {
struct EpiIn {
    static constexpr bool PERM = true, AFTER_DRAIN = false;
    unsigned char* y; int skip;
    __device__ __forceinline__ void operator()(const f32x4 (&acc)[2][2][4][2], const Unit& u, int wr, int wc, int fr, int fq) const {
        if (skip) return;
        const int pn = u.pn; size_t off; int ld, c0; bool sig = false;
        if (pn < 2)        { off = Y_AQ;   ld = 512;  c0 = pn * 256; }
        else if (pn == 2)  { off = Y_MISC; ld = 256;  c0 = 0; }
        else if (pn < 5)   { off = Y_IQ;   ld = 512;  c0 = (pn - 3) * 256; }
        else if (pn < 7)   { off = Y_BQ;   ld = 512;  c0 = (pn - 5) * 256; }
        else if (pn < 9)   { off = Y_BK;   ld = 512;  c0 = (pn - 7) * 256; }
        else if (pn < 11)  { off = Y_BV;   ld = 512;  c0 = (pn - 9) * 256; }
        else if (pn < 14)  { off = Y_CQ;   ld = 768;  c0 = (pn - 11) * 256; }
        else if (pn < 17)  { off = Y_CK;   ld = 768;  c0 = (pn - 14) * 256; }
        else if (pn < 20)  { off = Y_CV;   ld = 768;  c0 = (pn - 17) * 256; }
        else               { off = Y_Z;    ld = 3072; c0 = (pn - 20) * 256; sig = true; }
        bf16_t* base = (bf16_t*)(y + off); const bool qsc = (pn == 5 || pn == 6 || (pn >= 11 && pn < 14));
        const int row0 = u.pm * BM + wr * 64 + fr, col0 = c0 + wc * 32 + 8 * fq;
#pragma unroll
        for (int ai = 0; ai < 2; ++ai)
#pragma unroll
            for (int m = 0; m < 4; ++m) { bf16_t* rowp = base + (size_t)(row0 + ai * HALF + m * 16) * ld + col0;
#pragma unroll
                for (int bj = 0; bj < 2; ++bj) { f32x4 v0 = acc[ai][bj][m][0], v1 = acc[ai][bj][m][1];
                    if (sig) {
#pragma unroll
                        for (int i = 0; i < 4; ++i) { v0[i] = sigmoidf_(v0[i]); v1[i] = sigmoidf_(v1[i]); } }
                    else if (qsc) {
#pragma unroll
                        for (int i = 0; i < 4; ++i) { v0[i] *= 0.125f * 1.4426950408889634f; v1[i] *= 0.125f * 1.4426950408889634f; } }
                    u32x4 w; w.x = pk2(v0[0], v0[1]); w.y = pk2(v0[2], v0[3]); w.z = pk2(v1[0], v1[1]); w.w = pk2(v1[2], v1[3]);
                    *(u32x4*)(rowp + bj * HALF) = w; } }
    }
};
template <int MODE> struct EpiGate {
    static constexpr bool PERM = true, AFTER_DRAIN = false;
    const bf16_t* z; int zc0; float* mf; bf16_t* mb;
    __device__ __forceinline__ void operator()(const f32x4 (&acc)[2][2][4][2], const Unit& u, int wr, int wc, int fr, int fq) const {
        const int row0 = u.pm * BM + wr * 64 + fr, col0 = u.pn * BM + wc * 32 + 8 * fq;
#pragma unroll
        for (int ai = 0; ai < 2; ++ai)
#pragma unroll
            for (int m = 0; m < 4; ++m) { const size_t row = (size_t)(row0 + ai * HALF + m * 16);
#pragma unroll
                for (int bj = 0; bj < 2; ++bj) { const int col = col0 + bj * HALF;
                    const u32x4 zw = *(const u32x4*)(z + row * 3072 + zc0 + col);
                    f32x4 v0 = acc[ai][bj][m][0], v1 = acc[ai][bj][m][1];
                    v0[0] *= __uint_as_float(zw.x << 16); v0[1] *= __uint_as_float(zw.x & 0xffff0000u); v0[2] *= __uint_as_float(zw.y << 16); v0[3] *= __uint_as_float(zw.y & 0xffff0000u);
                    v1[0] *= __uint_as_float(zw.z << 16); v1[1] *= __uint_as_float(zw.z & 0xffff0000u); v1[2] *= __uint_as_float(zw.w << 16); v1[3] *= __uint_as_float(zw.w & 0xffff0000u);
                    bf16_t* mp = mb + row * 1024 + col;
                    if (MODE >= 1) { const u32x4 pw = *(const u32x4*)mp;
                        v0[0] += __uint_as_float(pw.x << 16); v0[1] += __uint_as_float(pw.x & 0xffff0000u); v0[2] += __uint_as_float(pw.y << 16); v0[3] += __uint_as_float(pw.y & 0xffff0000u);
                        v1[0] += __uint_as_float(pw.z << 16); v1[1] += __uint_as_float(pw.z & 0xffff0000u); v1[2] += __uint_as_float(pw.w << 16); v1[3] += __uint_as_float(pw.w & 0xffff0000u); }
                    { u32x4 w; w.x = pk2(v0[0], v0[1]); w.y = pk2(v0[2], v0[3]); w.z = pk2(v1[0], v1[1]); w.w = pk2(v1[2], v1[3]); *(u32x4*)mp = w; } }
                asm volatile("" ::: "memory"); }
    }
};
struct EpiRes {
    static constexpr bool PERM = true, AFTER_DRAIN = false;
    const float* xin; float* xout; const float* gate; int row_off;
    __device__ __forceinline__ void operator()(const f32x4 (&acc)[2][2][4][2], const Unit& u, int wr, int wc, int fr, int fq) const {
        const int row0 = row_off + u.pm * BM + wr * 64 + fr, col0 = u.pn * BM + wc * 32 + 8 * fq;
        const float* gp = gate + (size_t)((row_off + u.pm * BM) / SEQ) * 6144 + col0;
        f32x4 g[2][2];
#pragma unroll
        for (int bj = 0; bj < 2; ++bj) { g[bj][0] = *(const f32x4*)(gp + bj * HALF); g[bj][1] = *(const f32x4*)(gp + bj * HALF + 4); }
#pragma unroll
        for (int ai = 0; ai < 2; ++ai)
#pragma unroll
            for (int m = 0; m < 4; ++m) { const size_t o = (size_t)(row0 + ai * HALF + m * 16) * 1024 + col0;
#pragma unroll
                for (int bj = 0; bj < 2; ++bj) {
                    const f32x4 a0 = *(const f32x4*)(xin + o + bj * HALF), a1 = *(const f32x4*)(xin + o + bj * HALF + 4);
                    *(f32x4*)(xout + o + bj * HALF) = a0 + g[bj][0] * acc[ai][bj][m][0];
                    *(f32x4*)(xout + o + bj * HALF + 4) = a1 + g[bj][1] * acc[ai][bj][m][1]; }
                asm volatile("" ::: "memory"); }
    }
};
struct EpiSwiGLU {
    static constexpr bool PERM = true, AFTER_DRAIN = false;
    bf16_t* act;
    __device__ __forceinline__ void operator()(const f32x4 (&acc)[2][2][4][2], const Unit& u, int wr, int wc, int fr, int fq) const {
        const int row0 = u.pm * BM + wr * 64 + fr, col0 = u.pn * HALF + wc * 32 + 8 * fq;
#pragma unroll
        for (int ai = 0; ai < 2; ++ai)
#pragma unroll
            for (int m = 0; m < 4; ++m) { bf16_t* rowp = act + (size_t)(row0 + ai * HALF + m * 16) * DFF + col0;
                f32x4 v0, v1;
#pragma unroll
                for (int i = 0; i < 4; ++i) { const float g0 = acc[ai][0][m][0][i], g1 = acc[ai][0][m][1][i];
                    v0[i] = g0 * sigmoidf_(g0) * acc[ai][1][m][0][i]; v1[i] = g1 * sigmoidf_(g1) * acc[ai][1][m][1][i]; }
                u32x4 w; w.x = pk2(v0[0], v0[1]); w.y = pk2(v0[2], v0[3]); w.z = pk2(v1[0], v1[1]); w.w = pk2(v1[2], v1[3]);
                *(u32x4*)rowp = w; }
    }
};
}

#define XB_TMO      128
#define XB_XCNT(j)  (256  + 64 * (j))
#define XB_XSUB(j)  (1280 + 64 * (j))
#define XB_XGEN(j)  (2304 + 64 * (j))
#define XB_TOP      3328
#define XB_TOPGEN   3392
#define XCD_BAR_WORDS 3456
#define XB_SPIN_CAP (1u << 24)

__device__ __forceinline__ unsigned xb_ld(unsigned* p)              { return __hip_atomic_load(p, __ATOMIC_RELAXED, __HIP_MEMORY_SCOPE_AGENT); }
__device__ __forceinline__ unsigned xb_add(unsigned* p, unsigned v) { return __hip_atomic_fetch_add(p, v, __ATOMIC_RELAXED, __HIP_MEMORY_SCOPE_AGENT); }
__device__ __forceinline__ unsigned xb_xcc_id() { return (unsigned)__builtin_amdgcn_s_getreg((3 << 11) | 20) & 0xFu; }
#define XB_SPIN(cond, bar) do { unsigned _sp = 0; while (cond) { __builtin_amdgcn_s_sleep(1); \
    if ((++_sp & 255u) == 0u) { if (xb_ld(&(bar)[XB_TMO])) break; if (_sp > XB_SPIN_CAP) { atomicAdd(&(bar)[XB_TMO], 1u); break; } } } } while (0)

__device__ __forceinline__ int lane_id_() { return (int)__builtin_amdgcn_mbcnt_hi(~0u, __builtin_amdgcn_mbcnt_lo(~0u, 0u)); }
struct XcdBarrier { unsigned* bar; unsigned x; volatile LAS unsigned* st; int w; };

__device__ __forceinline__ XcdBarrier xcd_barrier_post(unsigned* bar, volatile LAS unsigned* st, int w) {
    XcdBarrier b; b.bar = bar; b.x = (unsigned)__builtin_amdgcn_readfirstlane((int)xb_xcc_id()); b.st = st; b.w = w;
    if (threadIdx.x == 0) (void)xb_add(&bar[XB_XCNT(b.x)], 1u);
    return b;
}
__device__ __forceinline__ void xcd_barrier_complete(unsigned* bar, unsigned x, unsigned& nloc, unsigned& nx) {
    const unsigned G = gridDim.x * gridDim.y * gridDim.z;
    unsigned sum, cnt, mine, sp = 0u;
    for (;;) {
        sum = 0u; cnt = 0u; mine = 0u;
#pragma unroll
        for (unsigned j = 0; j < 16; ++j) { const unsigned c = xb_ld(&bar[XB_XCNT(j)]); sum += c; cnt += (c > 0u) ? 1u : 0u; mine = (j == x) ? c : mine; }
        if (sum == G) break;
        __builtin_amdgcn_s_sleep(1);
        if ((++sp & 255u) == 0u) { if (xb_ld(&bar[XB_TMO])) break; if (sp > XB_SPIN_CAP) { atomicAdd(&bar[XB_TMO], 1u); break; } }
    }
    nloc = mine > 0u ? mine : 1u; nx = cnt > 0u ? cnt : 1u;
}
__device__ __forceinline__ void xcd_barrier(const XcdBarrier& b) {
    asm volatile("s_waitcnt vmcnt(0)" ::: "memory");
    __syncthreads();
    if (threadIdx.x == 0) {
        unsigned* bar = b.bar; unsigned bx = b.x; asm volatile("" : "+s"(bar), "+s"(bx));
        __builtin_amdgcn_s_waitcnt(0);
        unsigned nloc = b.st[0], nx = b.st[1];
        if (nloc == 0u) { xcd_barrier_complete(bar, bx, nloc, nx); b.st[0] = nloc; b.st[1] = nx; }
        const unsigned old = xb_add(&bar[XB_XSUB(bx)], 1u);
        const unsigned gen = old / nloc;
        if (old + 1u == (gen + 1u) * nloc) {
            __builtin_amdgcn_fence(__ATOMIC_RELEASE, "agent");
            asm volatile("s_waitcnt vmcnt(0)" ::: "memory");
            const unsigned og = xb_add(&bar[XB_TOP], 1u);
            const unsigned tg = og / nx;
            if (og + 1u == (tg + 1u) * nx) xb_add(&bar[XB_TOPGEN], 1u);
            else XB_SPIN(xb_ld(&bar[XB_TOPGEN]) == tg, bar);
            __builtin_amdgcn_fence(__ATOMIC_ACQUIRE, "agent");
            xb_add(&bar[XB_XGEN(bx)], 1u);
            asm volatile("s_waitcnt vmcnt(0)" ::: "memory");
        } else {
            XB_SPIN(xb_ld(&bar[XB_XGEN(bx)]) == gen, bar);
            __builtin_amdgcn_fence(__ATOMIC_ACQUIRE, "agent");
            asm volatile("s_waitcnt vmcnt(0)" ::: "memory");
        }
    }
    __syncthreads();
}

constexpr int RING_BYTES = 131072;
constexpr int LDSCTL_OFF = 160256;
constexpr int LDS_BYTES = 161280;

struct Args {
    const float* in[23]; float* out; unsigned char* ws; int pad0, pad1;
};
__device__ __forceinline__ const void* ld_karg(unsigned off) {
    asm volatile("" : "+s"(off));
    return *(const void* const __attribute__((address_space(4)))*)((const __attribute__((address_space(4))) char*)__builtin_amdgcn_kernarg_segment_ptr() + off);
}
#define ARG(k) ((const float*)ld_karg(8u * (k)))
#define OUTP() ((float*)ld_karg(184u))
#define WSP() ((unsigned char*)ld_karg(192u))

__device__ __forceinline__ int rel_bucket(int d) {
    if (d < 16) return d;
    int b = 16;
    b += (d >= 22); b += (d >= 30); b += (d >= 40); b += (d >= 54); b += (d >= 73); b += (d >= 99); b += (d >= 134); b += (d >= 182);
    b += (d >= 246); b += (d >= 332); b += (d >= 450); b += (d >= 609); b += (d >= 825); b += (d >= 1117); b += (d >= 1513);
    return b;
}
__device__ __forceinline__ int win_src_col(int n) {
    if (n < 640) return n;
    if (n < 712) return n + 512;
    if (n < 768) return -1;
    if (n < 1280) return n - 128;
    return n - 56;
}
__device__ __forceinline__ void transpose_item(const float* W, int ldw, int K, bf16* WT, int kind, int kb, int nb, LAS float* scr, int lane) {
    const int k0 = 64 * kb, n0 = 32 * nb, nl = n0 + (lane & 31);
    int sc;
    if (kind == 0) sc = win_src_col(nl);
    else if (kind == 2) { const int j = nl >> 8, r = nl & 255; sc = (r < 128) ? (j * 128 + r) : (DFF + j * 128 + r - 128); }
    else sc = nl;
    float wv[32];
    const float* wsrc = W + (size_t)(k0 + (lane >> 5)) * ldw + (sc >= 0 ? sc : 0);
#pragma unroll
    for (int i = 0; i < 32; ++i) wv[i] = wsrc[(size_t)(2 * i) * ldw];
#pragma unroll
    for (int i = 0; i < 32; ++i) scr[(2 * i + (lane >> 5)) * 33 + (lane & 31)] = (sc >= 0) ? wv[i] : 0.f;
    asm volatile("s_waitcnt lgkmcnt(0)" ::: "memory");
    const int c = lane & 7;
    const int nrow0 = 0;
#pragma unroll
    for (int j = 0; j < 4; ++j) { const int n = (lane >> 3) + 8 * j; const LAS float* s = scr + (8 * c) * 33 + n;
        v4u o; o.x = pk2(s[0 * 33], s[1 * 33]); o.y = pk2(s[2 * 33], s[3 * 33]); o.z = pk2(s[4 * 33], s[5 * 33]); o.w = pk2(s[6 * 33], s[7 * 33]);
        *(v4u*)(WT + (size_t)(nrow0 + n0 + n) * K + k0 + 8 * c) = o; }
    asm volatile("s_waitcnt lgkmcnt(0)" ::: "memory");
}

__device__ __forceinline__ void p0a_prologue(unsigned char* ws, LAS unsigned char* lds, int tid, int lane, int wave, int G) {
    asm volatile("" : "+v"(lane), "+v"(tid));
    const float* c = ARG(1); const float* w_ada = ARG(2); const float* b_ada = ARG(3);
    float* mod = (float*)(ws + WS_MOD);
    if (blockIdx.x < 192) {
        LAS float* cs = (LAS float*)lds;
        LAS float* red = (LAS float*)(lds + 32768);
        {   float cv[16];
#pragma unroll
            for (int i = 0; i < 16; ++i) cv[i] = c[tid + i * NTHREADS];
#pragma unroll
            for (int i = 0; i < 16; ++i) cs[tid + i * NTHREADS] = cv[i] / (1.f + __expf(-cv[i])); }
        __syncthreads();
        for (int it = blockIdx.x; it < 192; it += G) {
            const int l = it / 96, cg = it % 96, n = cg * 64 + lane;
            float acc[8];
#pragma unroll
            for (int b = 0; b < 8; ++b) acc[b] = 0.f;
            const float* wp = w_ada + ((size_t)l * 1024 + wave * 128) * 6144 + n;
#pragma unroll 32
            for (int k = 0; k < 128; ++k) { const float wv = wp[(size_t)k * 6144];
#pragma unroll
                for (int b = 0; b < 8; ++b) acc[b] += cs[b * 1024 + wave * 128 + k] * wv; }
#pragma unroll
            for (int b = 0; b < 8; ++b) red[(wave * 8 + b) * 64 + lane] = acc[b];
            __syncthreads();
            { const int b = tid >> 6; float s = 0.f;
#pragma unroll
              for (int w = 0; w < 8; ++w) s += red[(w * 8 + b) * 64 + lane];
              mod[((size_t)l * 8 + b) * 6144 + n] = s + b_ada[l * 6144 + n]; }
            __syncthreads();
        }
    }
    { const float* rb = ARG(21); float* T = (float*)(ws + WS_TAB);
      for (int e = blockIdx.x * NTHREADS + tid; e < 4096 * 24; e += G * NTHREADS) { const int d = e / 24, j = e - d * 24; T[e] = rb[rel_bucket(d) * 24 + j]; } }
    if (blockIdx.x == G - 1 && wave == 0) {
        float* lam = (float*)(ws + WS_LAM);
        for (int l = 0; l < NL; ++l) {
            const float s1 = wave_sum(ARG(9)[l * 64 + lane] * ARG(10)[l * 64 + lane]);
            const float s2 = wave_sum(ARG(11)[l * 64 + lane] * ARG(12)[l * 64 + lane]);
            const float lam_init = (l == 0) ? 0.2f : 0.35550907f;
            if (lane == 0) lam[l] = expf(s1) - expf(s2) + lam_init;
        }
    }
    {
        LAS float* scr = (LAS float*)(lds + 65536 + wave * 8448);
        const int gw = blockIdx.x * NWAVES + wave, NGW = G * NWAVES;
        constexpr int I_WIN = 16 * 256, I_B = 8 * 32, I_C = 4 * 32, I_OUT = 16 * 32, I_GU = 16 * 176, I_D = 44 * 32, I_FQ = 128, I_FA = 2048;
        constexpr int I_LAYER = I_WIN + I_B + I_C + I_OUT + I_GU + I_D + I_FQ + I_FA;
        for (int it = gw; it < NL * I_LAYER; it += NGW) {
            const int l = it / I_LAYER; int r = it % I_LAYER;
            unsigned char* wl = ws + WS_W + (size_t)l * W_LAYER;
            const float* w_in = ARG(5) + (size_t)l * 1024 * WIN_SRC;
            if (r < I_WIN) { transpose_item(w_in, WIN_SRC, 1024, (bf16*)(wl + W_IN), 0, r / 256, r % 256, scr, lane); continue; } r -= I_WIN;
            if (r < I_B)   { transpose_item(ARG(15) + (size_t)l * 512 * 1024, 1024, 512, (bf16*)(wl + W_B), 1, r / 32, r % 32, scr, lane); continue; } r -= I_B;
            if (r < I_C)   { transpose_item(ARG(16) + (size_t)l * 256 * 1024, 1024, 256, (bf16*)(wl + W_C), 1, r / 32, r % 32, scr, lane); continue; } r -= I_C;
            if (r < I_OUT) { transpose_item(ARG(17) + (size_t)l * 1024 * 1024, 1024, 1024, (bf16*)(wl + W_OUT), 1, r / 32, r % 32, scr, lane); continue; } r -= I_OUT;
            if (r < I_GU)  { transpose_item(ARG(19) + (size_t)l * 1024 * NGU, NGU, 1024, (bf16*)(wl + W_GU), 2, r / 176, r % 176, scr, lane); continue; } r -= I_GU;
            if (r < I_D)   { transpose_item(ARG(20) + (size_t)l * DFF * 1024, 1024, DFF, (bf16*)(wl + W_D), 1, r / 32, r % 32, scr, lane); continue; } r -= I_D;
            if (r < I_FQ) {
                const int h = r >> 4, chalf = (r >> 3) & 1, d0 = (r & 7) * 8, cc = chalf * 64 + lane;
                const float* uk = ARG(6) + ((size_t)(l * 8 + h) * 64 + d0) * 128 + cc;
                v4u o; o.x = pk2(uk[0], uk[128]); o.y = pk2(uk[256], uk[384]); o.z = pk2(uk[512], uk[640]); o.w = pk2(uk[768], uk[896]);
                *(v4u*)((bf16*)(wl + W_UKT) + ((size_t)h * 128 + cc) * 64 + d0) = o;
                continue; }
            r -= I_FQ;
            {
                const int ng = r >> 7, kg = r & 127, h = kg >> 4, c0 = (kg & 15) * 8, n = ng * 64 + lane;
                const float* uv = ARG(7) + ((size_t)(l * 8 + h) * 128 + c0) * 64;
                const float* wa = ARG(14) + ((size_t)l * 512 + h * 64) * 1024 + n;
                float acc[8];
#pragma unroll
                for (int j = 0; j < 8; ++j) acc[j] = 0.f;
#pragma unroll 32
                for (int e = 0; e < 64; ++e) { const float wv = wa[(size_t)e * 1024];
#pragma unroll
                    for (int j = 0; j < 8; ++j) acc[j] += uv[j * 64 + e] * wv; }
                v4u o; o.x = pk2(acc[0], acc[1]); o.y = pk2(acc[2], acc[3]); o.z = pk2(acc[4], acc[5]); o.w = pk2(acc[6], acc[7]);
                *(v4u*)((bf16*)(wl + W_A) + (size_t)n * 1024 + kg * 8) = o;
            }
        }
    }
}

__device__ __forceinline__ void norm_rows(const float* x, bf16* out, const float* g, const float* sh, const float* sc, int gw, int NGW, int lane) {
    asm volatile("" : "+v"(lane));
    for (int row = gw; row < MT; row += 2 * NGW) {
        const int row2 = (row + NGW < MT) ? row + NGW : row;
        const f32x4* xr = (const f32x4*)(x + (size_t)row * 1024) + lane; const f32x4* xr2 = (const f32x4*)(x + (size_t)row2 * 1024) + lane;
        f32x4 v[4], u[4]; float s = 0.f, s2 = 0.f;
#pragma unroll
        for (int j = 0; j < 4; ++j) { v[j] = xr[64 * j]; u[j] = xr2[64 * j]; }
#pragma unroll
        for (int j = 0; j < 4; ++j) { s += (v[j].x * v[j].x + v[j].y * v[j].y) + (v[j].z * v[j].z + v[j].w * v[j].w); s2 += (u[j].x * u[j].x + u[j].y * u[j].y) + (u[j].z * u[j].z + u[j].w * u[j].w); }
        const float rstd = 1.0f / sqrtf(wave_sum(s) * (1.f / 1024.f) + EPS), rstd2 = 1.0f / sqrtf(wave_sum(s2) * (1.f / 1024.f) + EPS);
        const int b = row / SEQ, b2 = row2 / SEQ;
        v2u* o8 = (v2u*)(out + (size_t)row * 1024) + lane; v2u* o82 = (v2u*)(out + (size_t)row2 * 1024) + lane;
#pragma unroll
        for (int j = 0; j < 4; ++j) { const int col = 256 * j + 4 * lane;
            const f32x4 gg = *(const f32x4*)(g + col);
            { const f32x4 s1 = *(const f32x4*)(sc + (size_t)b * 6144 + col), s0 = *(const f32x4*)(sh + (size_t)b * 6144 + col);
              const f32x4 y = v[j] * rstd * gg * (s1 + 1.0f) + s0; v2u w; w.x = pk2(y.x, y.y); w.y = pk2(y.z, y.w); o8[64 * j] = w; }
            if (row2 != row) { const f32x4 s1 = *(const f32x4*)(sc + (size_t)b2 * 6144 + col), s0 = *(const f32x4*)(sh + (size_t)b2 * 6144 + col);
              const f32x4 y = u[j] * rstd2 * gg * (s1 + 1.0f) + s0; v2u w; w.x = pk2(y.x, y.y); w.y = pk2(y.z, y.w); o82[64 * j] = w; } }
    }
}
__device__ __forceinline__ void final_rows(float* x, const float* g, int gw, int NGW, int lane) {
    asm volatile("" : "+v"(lane));
    for (int row = gw; row < MT; row += 2 * NGW) {
        const int row2 = (row + NGW < MT) ? row + NGW : row;
        f32x4* xr = (f32x4*)(x + (size_t)row * 1024) + lane; f32x4* xr2 = (f32x4*)(x + (size_t)row2 * 1024) + lane;
        f32x4 v[4], u[4]; float s = 0.f, s2 = 0.f;
#pragma unroll
        for (int j = 0; j < 4; ++j) { v[j] = xr[64 * j]; u[j] = xr2[64 * j]; }
#pragma unroll
        for (int j = 0; j < 4; ++j) { s += (v[j].x * v[j].x + v[j].y * v[j].y) + (v[j].z * v[j].z + v[j].w * v[j].w); s2 += (u[j].x * u[j].x + u[j].y * u[j].y) + (u[j].z * u[j].z + u[j].w * u[j].w); }
        const float rstd = 1.0f / sqrtf(wave_sum(s) * (1.f / 1024.f) + EPS), rstd2 = 1.0f / sqrtf(wave_sum(s2) * (1.f / 1024.f) + EPS);
#pragma unroll
        for (int j = 0; j < 4; ++j) { const f32x4 gg = *(const f32x4*)(g + 256 * j + 4 * lane); xr[64 * j] = v[j] * rstd * gg; if (row2 != row) xr2[64 * j] = u[j] * rstd2 * gg; }
    }
}
__device__ __forceinline__ void kvn_rows(unsigned char* y, bf16* kvn, const float* gkv, unsigned* kmaxw, int gw, int NGW, int lane) {
    asm volatile("" : "+v"(lane));
    const bf16* misc = (const bf16*)(y + Y_MISC);
    float km0 = 0.f, km1 = 0.f, km2 = 0.f, km3 = 0.f;
    const float g0 = gkv[2 * lane], g1 = gkv[2 * lane + 1];
    for (int r0 = gw; r0 < CHR; r0 += 4 * NGW) {
        unsigned w[4]; bf16 kq[4];
#pragma unroll
        for (int i = 0; i < 4; ++i) { const int r = (r0 + i * NGW < CHR) ? r0 + i * NGW : r0; w[i] = *(const unsigned*)(misc + (size_t)r * 256 + 2 * lane); kq[i] = misc[(size_t)r * 256 + 128 + lane]; }
#pragma unroll
        for (int i = 0; i < 4; ++i) { const int r = r0 + i * NGW; if (r >= CHR) break;
            const float a0 = bflo(w[i]), a1 = bfhi(w[i]);
            const float rstd = 1.0f / sqrtf(wave_sum(a0 * a0 + a1 * a1) * (1.f / 128.f) + EPS);
            *(unsigned*)(kvn + (size_t)r * 128 + 2 * lane) = pk2(a0 * rstd * g0, a1 * rstd * g1);
            const float kk = bf2f(kq[i]); const float ks = wave_sum(kk * kk); const int b = r / SEQ;
            km0 = (b == 0) ? fmaxf(km0, ks) : km0; km1 = (b == 1) ? fmaxf(km1, ks) : km1; km2 = (b == 2) ? fmaxf(km2, ks) : km2; km3 = (b == 3) ? fmaxf(km3, ks) : km3; }
    }
    if (lane == 0) {
        __hip_atomic_fetch_max(kmaxw + 0, __float_as_uint(km0), __ATOMIC_RELAXED, __HIP_MEMORY_SCOPE_AGENT); __hip_atomic_fetch_max(kmaxw + 1, __float_as_uint(km1), __ATOMIC_RELAXED, __HIP_MEMORY_SCOPE_AGENT);
        __hip_atomic_fetch_max(kmaxw + 2, __float_as_uint(km2), __ATOMIC_RELAXED, __HIP_MEMORY_SCOPE_AGENT); __hip_atomic_fetch_max(kmaxw + 3, __float_as_uint(km3), __ATOMIC_RELAXED, __HIP_MEMORY_SCOPE_AGENT);
    }
}
typedef short bf16x8 __attribute__((ext_vector_type(8)));
typedef short s16x4 __attribute__((ext_vector_type(4)));
typedef float f32x16 __attribute__((ext_vector_type(16)));
#define LOG2E 1.4426950408889634f
__device__ __forceinline__ int crow(int r, int hi) { return (r & 3) + 8 * (r >> 2) + 4 * hi; }
__device__ __forceinline__ void glds16(const void* g, LAS void* l) { __builtin_amdgcn_global_load_lds((const unsigned*)g, (LAS unsigned*)l, 16, 0, 0); }
__device__ __forceinline__ s16x4 tr16(const LAS unsigned char* p) { return __builtin_bit_cast(s16x4, __builtin_amdgcn_ds_read_tr16_b64_v4i16((LAS s16x4*)p)); }
__device__ __forceinline__ float swap_max(float v) { auto rr = __builtin_amdgcn_permlane32_swap(__float_as_uint(v), __float_as_uint(v), false, false); return fmaxf(__uint_as_float(rr[0]), __uint_as_float(rr[1])); }
__device__ __forceinline__ float swap16_max(float v) { auto rr = __builtin_amdgcn_permlane16_swap(__float_as_uint(v), __float_as_uint(v), false, false); return fmaxf(__uint_as_float(rr[0]), __uint_as_float(rr[1])); }
__device__ __forceinline__ float swap16_add(float v) { auto rr = __builtin_amdgcn_permlane16_swap(__float_as_uint(v), __float_as_uint(v), false, false); return __uint_as_float(rr[0]) + __uint_as_float(rr[1]); }
__device__ __forceinline__ float swap_add(float v) { auto rr = __builtin_amdgcn_permlane32_swap(__float_as_uint(v), __float_as_uint(v), false, false); return __uint_as_float(rr[0]) + __uint_as_float(rr[1]); }
typedef float f32x2_t __attribute__((ext_vector_type(2))); typedef __bf16 bf16x2_t __attribute__((ext_vector_type(2)));
__device__ __forceinline__ unsigned cvtpk(float lo, float hi) { const f32x2_t v = {lo, hi}; const bf16x2_t b = __builtin_convertvector(v, bf16x2_t); return __builtin_bit_cast(unsigned, b); }
__device__ __forceinline__ void lds_add_u32_asm(LAS void* p, unsigned v) { asm volatile("ds_add_u32 %0, %1" :: "v"((unsigned)(uintptr_t)p), "v"(v) : "memory"); }
__device__ __forceinline__ void lds_st_b16_asm(LAS void* p, unsigned v) { asm volatile("ds_write_b16 %0, %1" :: "v"((unsigned)(uintptr_t)p), "v"(v) : "memory"); }
__device__ __forceinline__ void lds_st_b32_asm(LAS void* p, unsigned v) { asm volatile("ds_write_b32 %0, %1" :: "v"((unsigned)(uintptr_t)p), "v"(v) : "memory"); }
__device__ __forceinline__ s16x4 tr16_asm(const LAS unsigned char* p) { s16x4 v; asm volatile("ds_read_b64_tr_b16 %0, %1" : "=v"(v) : "v"((unsigned)(uintptr_t)p) : "memory"); return v; }
#define TRV(dst, base, off) asm volatile("ds_read_b64_tr_b16 %0, %1 offset:%c2" : "=&v"(dst) : "v"(base), "i"(off) : "memory")
#define LGKM_WAIT8(n, f) asm volatile("s_waitcnt lgkmcnt(" #n ")" : "+v"(f[0]), "+v"(f[1]), "+v"(f[2]), "+v"(f[3]), "+v"(f[4]), "+v"(f[5]), "+v"(f[6]), "+v"(f[7]) :: "memory")
#define VFRAG(f, i) ((bf16x8){f[2 * (i)][0], f[2 * (i)][1], f[2 * (i)][2], f[2 * (i)][3], f[2 * (i) + 1][0], f[2 * (i) + 1][1], f[2 * (i) + 1][2], f[2 * (i) + 1][3]})
#define RAW_BARRIER() do { asm volatile("s_waitcnt lgkmcnt(0)" ::: "memory"); __builtin_amdgcn_s_barrier(); asm volatile("" ::: "memory"); } while (0)

template <int MODE> __device__ __forceinline__ void mixB_fast(unsigned char* y, bf16* OUTB, const float* T, const float* gsub, float lam, float one_m_li, LAS unsigned char* lds, int tid, int lane, int wave, int G) {
    asm volatile("" : "+v"(lane), "+v"(tid));
    bf16* BQ = (bf16*)(y + Y_BQ); const bf16* BK = (const bf16*)(y + Y_BK); const bf16* BV = (const bf16*)(y + Y_BV);
    const int r32 = lane & 31, hi = lane >> 5, m = wave >> 2, qs = wave & 3;
    LAS float* gs_l = (LAS float*)(lds + 131072); LAS float* ctab = gs_l + 128; LAS float* btab = gs_l + 272;
    constexpr int BDM = 1599, BNX = 1728, BCS = 1744, SENTI = 0x7f000000;
    constexpr float THR = 8.0f;
    for (int item = blockIdx.x; item < CHB * 4 * 16; item += G) {
        const int bh = (G == 256) ? (2 * (item & 7) + (item >> 7)) : (item >> 4), pr = (G == 256) ? ((item >> 3) & 15) : (item & 15), bb = bh >> 2, h = bh & 3, rb = bb * SEQ;
        RAW_BARRIER();
        int tq = tid; asm volatile("" : "+v"(tq));
#pragma unroll
        for (int k = 0; k < 4; ++k) { const int x = tq + k * NTHREADS, d = BDM - x;
            const float v = (d >= 0 && x < BNX + 3) ? T[d * 24 + 8 + h] * LOG2E : -INFINITY;
#pragma unroll
            for (int sc = 0; sc < 4; ++sc) { const int i = x - sc; if (i >= 0 && i < BNX) btab[sc * BCS + i] = v; } }
        if (tq < 128) gs_l[tq] = gsub[tq];
        else if (tq < 128 + 136) { const int n = tq - 128 - 4, dmin = 32 * n + 1;
            ctab[tq - 128] = (n >= 0 && rel_bucket(dmin) == rel_bucket(dmin + 62)) ? T[dmin * 24 + 8 + h] * LOG2E : __int_as_float(SENTI); }
        for (int uu = 0; uu < 2; ++uu) {
            const int qb = (uu == 0) ? (31 - pr) : pr;
            const int q0w = qb * 128 + qs * 32, qpos = q0w + r32;
            bf16x8 qf[4];
#pragma unroll
            for (int ks = 0; ks < 4; ++ks) qf[ks] = *(const bf16x8*)(BQ + (size_t)(rb + qpos) * 512 + h * 128 + m * 64 + 16 * ks + 8 * hi);
            const int NT = 2 * (qb + 1);
            const int xl0 = BDM - qpos + 4 * hi;
            const LAS unsigned char* bta = (const LAS unsigned char*)(btab + (xl0 & 3) * (BCS - 1) + xl0);
            f32x16 O[4];
#pragma unroll
            for (int dq = 0; dq < 4; ++dq)
#pragma unroll
                for (int r = 0; r < 16; ++r) O[dq][r] = 0.f;
            float mref = -INFINITY, lsum = 0.f;
#define MB_STAGE(t_, buf_) do { const int kv0_ = (t_) * 64; LAS unsigned char* sb_ = lds + (buf_) * 32768; \
                _Pragma("unroll") for (int i_ = 0; i_ < 2; ++i_) { const int p_ = 2 * wave + i_, mk_ = p_ >> 3, rg_ = p_ & 7;     \
                    glds16(BK + (size_t)(rb + kv0_ + 8 * rg_ + (lane >> 3)) * 512 + h * 128 + mk_ * 64 + ((lane & 7) ^ ((4 * rg_ + (lane >> 4)) & 7)) * 8, sb_ + mk_ * 8192 + rg_ * 1024); } \
                _Pragma("unroll") for (int i_ = 0; i_ < 2; ++i_) { const int p_ = 2 * wave + i_, dq_ = p_ >> 2, rg_ = p_ & 3; \
                    glds16(BV + (size_t)(rb + kv0_ + 16 * rg_ + (lane >> 2)) * 512 + h * 128 + dq_ * 32 + (lane & 3) * 8, sb_ + 16384 + p_ * 1024); } } while (0)
            MB_STAGE(0, 0); MB_STAGE(1, 1);
#pragma unroll 1
            for (int u2 = 0; u2 < NT / 2; ++u2) {
                asm volatile("s_waitcnt vmcnt(0)" ::: "memory");
                RAW_BARRIER();
#if BSTAGE_POS == 0
                if (2 * u2 + 2 < NT && MODE != 3) { MB_STAGE(2 * u2 + 2, (2 * u2 + 2) & 3); MB_STAGE(2 * u2 + 3, (2 * u2 + 3) & 3); }
#endif
                const int kva = u2 * 128;
                if (MODE != 2 && kva <= q0w + 31) {
                    const LAS unsigned char* sba = lds + ((2 * u2) & 3) * 32768; const LAS unsigned char* sbb = lds + ((2 * u2 + 1) & 3) * 32768;
                    f32x16 sa0, sa1, sb0, sb1; float ct0, ct1, ct2, ct3;
#define KRD(dst_, a_, off_) asm volatile("ds_read_b128 %0, %1 offset:%c2" : "=&v"(dst_) : "v"(a_), "i"(off_) : "memory")
#define KRD4(f_, o_, a_) do { KRD(f_[o_], a_, 0); KRD(f_[(o_) + 1], a_, 4096); KRD(f_[(o_) + 2], a_, 32768); KRD(f_[(o_) + 3], a_, 36864); } while (0)
#define KWAIT4(n_, f_, o_) asm volatile("s_waitcnt lgkmcnt(" #n_ ")" : "+v"(f_[o_]), "+v"(f_[(o_) + 1]), "+v"(f_[(o_) + 2]), "+v"(f_[(o_) + 3]) :: "memory")
#define KMM4(f_, o_, ks_) do { sa0 = __builtin_amdgcn_mfma_f32_32x32x16_bf16(f_[o_], qf[ks_], sa0, 0, 0, 0); sa1 = __builtin_amdgcn_mfma_f32_32x32x16_bf16(f_[(o_) + 1], qf[ks_], sa1, 0, 0, 0); \
                        sb0 = __builtin_amdgcn_mfma_f32_32x32x16_bf16(f_[(o_) + 2], qf[ks_], sb0, 0, 0, 0); sb1 = __builtin_amdgcn_mfma_f32_32x32x16_bf16(f_[(o_) + 3], qf[ks_], sb1, 0, 0, 0); } while (0)
                    bf16x8 kf[8];
                    {   const int ci0 = (q0w - kva) >> 5;
                        const LAS unsigned char* bp = bta + kva * 4;
                        const unsigned cta = (unsigned)(uintptr_t)(ctab + ci0);
                        unsigned cw0, cw1, cw2, cw3;
                        asm volatile("ds_read_b32 %0, %4 offset:12\n\tds_read_b32 %1, %4 offset:8\n\tds_read_b32 %2, %4 offset:4\n\tds_read_b32 %3, %4" : "=&v"(cw0), "=&v"(cw1), "=&v"(cw2), "=&v"(cw3) : "v"(cta) : "memory");
                        const unsigned kbase = (unsigned)(uintptr_t)(sba + m * 8192 + r32 * 128); const int sw = (r32 >> 1) & 7;
                        const unsigned ka0 = kbase + ((hi ^ sw) << 4), ka1 = kbase + (((2 + hi) ^ sw) << 4), ka2 = kbase + (((4 + hi) ^ sw) << 4), ka3 = kbase + (((6 + hi) ^ sw) << 4);
                        KRD4(kf, 0, ka0); KRD4(kf, 4, ka1);
                        asm volatile("s_waitcnt lgkmcnt(8)" : "+v"(cw0), "+v"(cw1), "+v"(cw2), "+v"(cw3) :: "memory");
#define MB_INIT(s_, c_, t_, w_) do { const int cw_ = __builtin_amdgcn_readfirstlane((int)(w_)); \
                            if (cw_ != SENTI) { c_ = __int_as_float(cw_); _Pragma("unroll") for (int r = 0; r < 16; ++r) s_[r] = 0.f; } \
                            else { c_ = 0.f; _Pragma("unroll") for (int j_ = 0; j_ < 4; ++j_) { const f32x4 b_ = *(const LAS f32x4*)(bp + (t_) * 128 + j_ * 32); \
                                s_[4 * j_] = b_.x; s_[4 * j_ + 1] = b_.y; s_[4 * j_ + 2] = b_.z; s_[4 * j_ + 3] = b_.w; } } } while (0)
                        MB_INIT(sa0, ct0, 0, cw0); MB_INIT(sa1, ct1, 1, cw1); MB_INIT(sb0, ct2, 2, cw2); MB_INIT(sb1, ct3, 3, cw3);
#undef MB_INIT
                        KWAIT4(4, kf, 0); KMM4(kf, 0, 0);
                        KRD4(kf, 0, ka2); KWAIT4(4, kf, 4); KMM4(kf, 4, 1);
                        KRD4(kf, 4, ka3); KWAIT4(4, kf, 0); KMM4(kf, 0, 2);
                        KWAIT4(0, kf, 4); KMM4(kf, 4, 3);
                    }
#undef KRD
#undef KRD4
#undef KWAIT4
#undef KMM4
#if BSTAGE_POS == 1
                    if (2 * u2 + 2 < NT && MODE != 3) { MB_STAGE(2 * u2 + 2, (2 * u2 + 2) & 3); MB_STAGE(2 * u2 + 3, (2 * u2 + 3) & 3); }
#elif BSTAGE_POS == 2
                    if (2 * u2 + 2 < NT && MODE != 3) { MB_STAGE(2 * u2 + 2, (2 * u2 + 2) & 3); }
#endif
                    if (MODE == 4) { lsum += sa0[0] + sa1[0] + sb0[0] + sb1[0] + sa0[9] + sa1[9] + sb0[9] + sb1[9]; continue; }
                    float rm;
                    {   float m0 = fmaxf(sa0[0], sa0[1]), m1 = fmaxf(sa1[0], sa1[1]), m2 = fmaxf(sb0[0], sb0[1]), m3 = fmaxf(sb1[0], sb1[1]);
#pragma unroll
                        for (int r = 2; r < 16; ++r) { m0 = fmaxf(m0, sa0[r]); m1 = fmaxf(m1, sa1[r]); m2 = fmaxf(m2, sb0[r]); m3 = fmaxf(m3, sb1[r]); }
                        rm = fmaxf(fmaxf(m0 + ct0, m1 + ct1), fmaxf(m2 + ct2, m3 + ct3)); }
                    rm = swap_max(rm);
                    if (__any(rm > mref + THR)) {
                        const float mn = fmaxf(mref, rm), f = __builtin_amdgcn_exp2f(mref - mn);
                        lsum *= f; mref = mn;
#pragma unroll
                        for (int dq = 0; dq < 4; ++dq)
#pragma unroll
                            for (int r = 0; r < 16; ++r) O[dq][r] *= f;
                    }
                    float ps = 0.f; const float rf0 = mref - ct0, rf1 = mref - ct1, rf2 = mref - ct2, rf3 = mref - ct3;
#pragma unroll
                    for (int r = 0; r < 16; ++r) { sa0[r] = __builtin_amdgcn_exp2f(sa0[r] - rf0); sa1[r] = __builtin_amdgcn_exp2f(sa1[r] - rf1); ps += sa0[r] + sa1[r]; }
                    bf16x8 pf[8];
#define MB_PACK(dst_, s_, o_) do { v4u w_; w_.x = cvtpk(s_[o_], s_[o_ + 1]); w_.y = cvtpk(s_[o_ + 2], s_[o_ + 3]); w_.z = cvtpk(s_[o_ + 4], s_[o_ + 5]); w_.w = cvtpk(s_[o_ + 6], s_[o_ + 7]); dst_ = __builtin_bit_cast(bf16x8, w_); } while (0)
#define MB_EXPB(i0_) do { asm volatile("" : "+v"(sb0), "+v"(sb1)); \
                        _Pragma("unroll") for (int r = (i0_); r < (i0_) + 4; ++r) { sb0[r] = __builtin_amdgcn_exp2f(sb0[r] - rf2); sb1[r] = __builtin_amdgcn_exp2f(sb1[r] - rf3); ps += sb0[r] + sb1[r]; } } while (0)
                    MB_PACK(pf[0], sa0, 0); MB_PACK(pf[1], sa0, 8); MB_PACK(pf[2], sa1, 0); MB_PACK(pf[3], sa1, 8);
#if BSTAGE_POS == 2
                    if (2 * u2 + 2 < NT && MODE != 3) { MB_STAGE(2 * u2 + 3, (2 * u2 + 3) & 3); }
#endif
                    const unsigned vlo = (unsigned)(((lane >> 4) & 1) * 32 + (lane & 3) * 8 + (4 * hi + ((lane & 15) >> 2)) * 64);
                    const unsigned vba = (unsigned)(uintptr_t)(sba + 16384) + vlo, vbb = (unsigned)(uintptr_t)(sbb + 16384) + vlo;
                    s16x4 fa[8], fb[8];
#define MB_RD(f, vb_, dq_) do { if (MODE != 1) _Pragma("unroll") for (int sp_ = 0; sp_ < 4; ++sp_) { TRV(f[2 * sp_], vb_, ((dq_) * 4 + sp_) * 1024); TRV(f[2 * sp_ + 1], vb_, ((dq_) * 4 + sp_) * 1024 + 512); } } while (0)
#define MB_MM(f, dq_, po_) do { if (MODE == 1) { asm volatile("" :: "v"(pf[(po_)]), "v"(pf[(po_) + 1]), "v"(pf[(po_) + 2]), "v"(pf[(po_) + 3])); } else _Pragma("unroll") for (int sp_ = 0; sp_ < 4; ++sp_) O[dq_] = __builtin_amdgcn_mfma_f32_32x32x16_bf16(VFRAG(f, sp_), pf[(po_) + sp_], O[dq_], 0, 0, 0); } while (0)
                    MB_RD(fa, vba, 0); MB_RD(fb, vba, 1); LGKM_WAIT8(8, fa); MB_MM(fa, 0, 0); MB_EXPB(0);
                    MB_RD(fa, vba, 2); LGKM_WAIT8(8, fb); MB_MM(fb, 1, 0); MB_EXPB(4);
                    MB_RD(fb, vba, 3); LGKM_WAIT8(8, fa); MB_MM(fa, 2, 0); MB_EXPB(8);
                    MB_RD(fa, vbb, 0); LGKM_WAIT8(8, fb); MB_MM(fb, 3, 0); MB_EXPB(12);
                    lsum += ps;
                    MB_PACK(pf[4], sb0, 0); MB_PACK(pf[5], sb0, 8); MB_PACK(pf[6], sb1, 0); MB_PACK(pf[7], sb1, 8);
                    MB_RD(fb, vbb, 1); LGKM_WAIT8(8, fa); MB_MM(fa, 0, 4);
                    MB_RD(fa, vbb, 2); LGKM_WAIT8(8, fb); MB_MM(fb, 1, 4);
                    MB_RD(fb, vbb, 3); LGKM_WAIT8(8, fa); MB_MM(fa, 2, 4);
                    LGKM_WAIT8(0, fb); MB_MM(fb, 3, 4);
#undef MB_PACK
#undef MB_EXPB
#undef MB_RD
#undef MB_MM
                }
            }
            RAW_BARRIER();
#undef MB_STAGE
            const float inv = 1.0f / swap_add(lsum);
            LAS float* xb = (LAS float*)lds + qs * 4096;
            if (m == 1) {
#pragma unroll
                for (int dq = 0; dq < 4; ++dq)
#pragma unroll
                    for (int r = 0; r < 16; ++r) xb[(dq * 16 + r) * 64 + lane] = O[dq][r] * inv;
            }
            RAW_BARRIER();
            if (m == 0) {
                float ss = 0.f;
#pragma unroll
                for (int dq = 0; dq < 4; ++dq)
#pragma unroll
                    for (int r = 0; r < 16; ++r) { const float o = O[dq][r] * inv - lam * xb[(dq * 16 + r) * 64 + lane]; O[dq][r] = o; ss += o * o; }
                const float rstd = 1.0f / sqrtf(swap_add(ss) * (1.f / 128.f) + EPS) * one_m_li;
                bf16* orow = OUTB + (size_t)(rb + qpos) * 512 + h * 128;
#pragma unroll
                for (int dq = 0; dq < 4; ++dq)
#pragma unroll
                    for (int g4 = 0; g4 < 4; ++g4) { const int d0 = dq * 32 + 8 * g4 + 4 * hi; const f32x4 gs = *(const LAS f32x4*)(gs_l + d0);
                        v2u w; w.x = pk2(O[dq][4 * g4] * rstd * gs.x, O[dq][4 * g4 + 1] * rstd * gs.y); w.y = pk2(O[dq][4 * g4 + 2] * rstd * gs.z, O[dq][4 * g4 + 3] * rstd * gs.w);
                        *(v2u*)(orow + d0) = w; }
            }
            asm volatile("s_waitcnt vmcnt(0)" ::: "memory");
            RAW_BARRIER();
        }
    }
}

constexpr size_t WS_OG = 432 * MiB, WS_LSE = 480 * MiB;
__device__ __forceinline__ void mixC_fast(unsigned char* y, unsigned char* ws, const float* T, LAS unsigned char* lds, int tid, int lane, int wave, int G) {
    asm volatile("" : "+v"(lane), "+v"(tid));
    const bf16* CQ = (const bf16*)(y + Y_CQ); const bf16* CK = (const bf16*)(y + Y_CK); const bf16* CV = (const bf16*)(y + Y_CV);
    float* OG = (float*)(ws + WS_OG); float* LSE = (float*)(ws + WS_LSE);
    const int r32 = lane & 31, hi = lane >> 5;
    LAS unsigned char* Kl = lds;
    LAS unsigned char* Vl = lds + 49152;
    LAS float* bt = (LAS float*)(lds + 98304);
    constexpr int CBS = 208;
    for (int item = blockIdx.x; item < CHB * 192; item += G) {
        const int bb = item / 192, u = item % 192, g = u >> 6, v = u & 63;
        const int hp = v >> 4, w16 = v & 15;
        const int dil = (g == 0) ? 1 : (g == 1) ? 4 : 16;
        const int rc = (g == 0) ? 0 : (g == 1) ? (w16 >> 2) : w16;
        const int seg = (g == 0) ? w16 : (g == 1) ? (w16 & 3) : 0;
        const int hh = 4 * g + hp, M0 = seg * 256, rb = bb * SEQ;
        RAW_BARRIER();
        if (tid < 196) { const int rel = 159 - tid; const float v = (rel >= 0 && rel <= 128) ? T[(rel * dil) * 24 + 12 + hh] * LOG2E : -INFINITY;
#pragma unroll
            for (int sc = 0; sc < 4; ++sc) { const int i = tid - sc; if (i >= 0 && i < 192) bt[sc * CBS + i] = v; } }
        const int mq = M0 + 32 * wave + r32, rowq = rb + mq * dil + rc;
        bf16x8 qf[4];
#pragma unroll
        for (int ks = 0; ks < 4; ++ks) qf[ks] = *(const bf16x8*)(CQ + (size_t)rowq * 768 + hh * 64 + 16 * ks + 8 * hi);
#pragma unroll
        for (int i = 0; i < 6; ++i) { const int p = wave * 6 + i;
            int mk = M0 - 128 + 8 * p + (lane >> 3); mk = mk < 0 ? 0 : mk;
            glds16(CK + (size_t)(rb + mk * dil + rc) * 768 + hh * 64 + ((lane & 7) ^ ((4 * p + (lane >> 4)) & 7)) * 8, Kl + p * 1024); }
#pragma unroll
        for (int i = 0; i < 6; ++i) { const int p = wave * 6 + i, dq = p / 24, rg = p % 24;
            int mk = M0 - 128 + 16 * rg + (lane >> 2); mk = mk < 0 ? 0 : mk;
            glds16(CV + (size_t)(rb + mk * dil + rc) * 768 + hh * 64 + dq * 32 + (lane & 3) * 8, Vl + p * 1024); }
        asm volatile("s_waitcnt vmcnt(6)" ::: "memory");
        RAW_BARRIER();
        int vok = 0;
        f32x16 O[2];
#pragma unroll
        for (int dq = 0; dq < 2; ++dq)
#pragma unroll
            for (int r = 0; r < 16; ++r) O[dq][r] = 0.f;
        float mref = -INFINITY, lsum = 0.f;
#pragma unroll 1
        for (int j = 0; j < 5; ++j) {
            const int lrow = 32 * wave + 32 * j;
            if (M0 - 128 + lrow + 31 < 0) continue;
            const LAS unsigned char* kb = Kl + (lrow + r32) * 128;
            f32x16 s0;
            {   const int xl = 31 + 32 * j - r32 + 4 * hi;
                const LAS float* bp = bt + (xl & 3) * (CBS - 1) + xl;
#pragma unroll
                for (int j4 = 0; j4 < 4; ++j4) { const f32x4 b = *(const LAS f32x4*)(bp + 8 * j4); s0[4 * j4] = b.x; s0[4 * j4 + 1] = b.y; s0[4 * j4 + 2] = b.z; s0[4 * j4 + 3] = b.w; } }
#pragma unroll
            for (int ks = 0; ks < 4; ++ks) { const bf16x8 k0 = *(const LAS bf16x8*)(kb + (((2 * ks + hi) ^ (((lrow + r32) >> 1) & 7)) << 4)); s0 = __builtin_amdgcn_mfma_f32_32x32x16_bf16(k0, qf[ks], s0, 0, 0, 0); }
            if (M0 - 128 + lrow < 0) {
                const int mkb = M0 - 128 + lrow + 4 * hi;
#pragma unroll
                for (int r = 0; r < 16; ++r) { const int cr = (r & 3) + 8 * (r >> 2); if (mkb + cr < 0) s0[r] = -INFINITY; } }
            float rm = s0[0];
#pragma unroll
            for (int r = 1; r < 16; ++r) rm = fmaxf(rm, s0[r]);
            rm = swap_max(rm);
            const float mn = fmaxf(mref, rm);
            const float f = (mn == -INFINITY) ? 1.f : __builtin_amdgcn_exp2f(mref - mn);
            const float msub = (mn == -INFINITY) ? 0.f : mn;
            lsum *= f; mref = mn;
#pragma unroll
            for (int dq = 0; dq < 2; ++dq)
#pragma unroll
                for (int r = 0; r < 16; ++r) O[dq][r] *= f;
            float ps = 0.f;
#pragma unroll
            for (int r = 0; r < 16; ++r) { s0[r] = __builtin_amdgcn_exp2f(s0[r] - msub); ps += s0[r]; }
            lsum += ps;
            bf16x8 pf[2];
            { v4u w;
              w.x = cvtpk(s0[0], s0[1]); w.y = cvtpk(s0[2], s0[3]); w.z = cvtpk(s0[4], s0[5]); w.w = cvtpk(s0[6], s0[7]); pf[0] = __builtin_bit_cast(bf16x8, w);
              w.x = cvtpk(s0[8], s0[9]); w.y = cvtpk(s0[10], s0[11]); w.z = cvtpk(s0[12], s0[13]); w.w = cvtpk(s0[14], s0[15]); pf[1] = __builtin_bit_cast(bf16x8, w); }
            if (!vok) { asm volatile("s_waitcnt vmcnt(0)" ::: "memory"); RAW_BARRIER(); vok = 1; }
            const unsigned vb = (unsigned)(uintptr_t)(Vl + ((lane >> 4) & 1) * 32 + (lane & 3) * 8 + (4 * hi + ((lane & 15) >> 2)) * 64 + (lrow >> 4) * 1024);
            s16x4 fa[8];
#pragma unroll
            for (int dq = 0; dq < 2; ++dq)
#pragma unroll
                for (int sp = 0; sp < 2; ++sp) { TRV(fa[4 * dq + 2 * sp], vb, (dq * 24 + sp) * 1024); TRV(fa[4 * dq + 2 * sp + 1], vb, (dq * 24 + sp) * 1024 + 512); }
            LGKM_WAIT8(0, fa);
#pragma unroll
            for (int dq = 0; dq < 2; ++dq)
#pragma unroll
                for (int sp = 0; sp < 2; ++sp) O[dq] = __builtin_amdgcn_mfma_f32_32x32x16_bf16(VFRAG(fa, 2 * dq + sp), pf[sp], O[dq], 0, 0, 0);
        }
        const float ltot = swap_add(lsum), inv = 1.0f / ltot;
        float* og = OG + ((size_t)g * CHR + rowq) * 256 + hp * 64;
#pragma unroll
        for (int dq = 0; dq < 2; ++dq)
#pragma unroll
            for (int g4 = 0; g4 < 4; ++g4) { const int d0 = dq * 32 + 8 * g4 + 4 * hi;
                *(f32x4*)(og + d0) = (f32x4){O[dq][4 * g4] * inv, O[dq][4 * g4 + 1] * inv, O[dq][4 * g4 + 2] * inv, O[dq][4 * g4 + 3] * inv}; }
        if (hi == 0) LSE[((size_t)g * CHR + rowq) * 4 + hp] = (mref + __log2f(ltot)) * 0.6931471805599453f;
    }
}
__device__ __forceinline__ void mergeC(unsigned char* y, unsigned char* ws, int gw, int NGW, int lane) {
    asm volatile("" : "+v"(lane));
    const float* OG = (const float*)(ws + WS_OG); const float* LSE = (const float*)(ws + WS_LSE); bf16* OC = (bf16*)(y + Y_OC);
    const int hp = lane >> 4, d4 = (lane & 15) * 4;
    for (int r0 = gw; r0 < CHR; r0 += 2 * NGW) {
        const int r1 = (r0 + NGW < CHR) ? r0 + NGW : r0;
        float l[2][3]; f32x4 o[2][3];
#pragma unroll
        for (int i = 0; i < 2; ++i) { const int r = i ? r1 : r0;
#pragma unroll
            for (int g = 0; g < 3; ++g) { l[i][g] = LSE[((size_t)g * CHR + r) * 4 + hp]; o[i][g] = *(const f32x4*)(OG + ((size_t)g * CHR + r) * 256 + hp * 64 + d4); } }
#pragma unroll
        for (int i = 0; i < 2; ++i) { const int r = i ? r1 : r0; if (i == 1 && r1 == r0) break;
            const float M = fmaxf(fmaxf(l[i][0], l[i][1]), l[i][2]);
            const float a0 = __expf(l[i][0] - M), a1 = __expf(l[i][1] - M), a2 = __expf(l[i][2] - M), ia = 1.0f / (a0 + a1 + a2);
            const f32x4 ov = (o[i][0] * a0 + o[i][1] * a1 + o[i][2] * a2) * ia;
            v2u w; w.x = pk2(ov.x, ov.y); w.y = pk2(ov.z, ov.w);
            *(v2u*)(OC + (size_t)r * 256 + hp * 64 + d4) = w; }
    }
}

constexpr int CW_KMAX = 8192;
constexpr int A_KST = 0, A_HIST = 32768, A_CAND = 98304, A_SEL = 131072, A_BKT = 147456, A_BIAS = 151552;
__device__ __forceinline__ int a_bin(float s, int kb) {
    int k = (int)(__float_as_uint(fabsf(s)) >> 18) - kb; k = k < 0 ? 0 : (k > 511 ? 511 : k);
    return (s < 0.f) ? (511 - k) : (512 + k);
}
__device__ __forceinline__ unsigned a_edge(int b, int kb) {
    if (b <= 0) return 0u;
    if (b >= 1024) return 0xffffffffu;
    if (b == 512) return 0x80000000u;
    if (b > 512) { const int k = b - 512 + kb; return 0x80000000u | ((unsigned)(k > 0 ? k : 0) << 18); }
    const int k = 512 - b + kb; return 0x80000000u - ((unsigned)(k > 0 ? k : 0) << 18);
}
__device__ __forceinline__ void mixA_fast(unsigned char* y, bf16* OUTA, bf16* OUTA2, const bf16* KVN, const bf16* UKT, const float* T, const float* rel_bias, const unsigned* kmaxw, LAS unsigned char* lds, int tid, int lane, int wave, int G) {
    asm volatile("" : "+v"(lane), "+v"(tid));
    const bf16* AQ = (const bf16*)(y + Y_AQ); bf16* QLS = (bf16*)(y + Y_QLS) + (size_t)blockIdx.x * 32 * 1024; const bf16* MISC = (const bf16*)(y + Y_MISC); const bf16* IQ = (const bf16*)(y + Y_IQ);
    const int kl = lane & 31, hi = lane >> 5;
    constexpr float C2 = 0.125f * LOG2E, THR = 8.0f;
    unsigned short* KEYS = (unsigned short*)(y + ((blockIdx.x < 160) ? (Y_CK + 8 * MiB + (size_t)blockIdx.x * 262144) : (Y_BK + (size_t)(blockIdx.x - 160) * 262144)));
    LAS float* biasl = (LAS float*)(lds + A_BIAS);
    const unsigned lt32 = (1u << kl) - 1u;
    for (int item = blockIdx.x; item < CHB * 64; item += G) {
        const int bb = (G == 256) ? (item & 3) : (item >> 6), pr = (G == 256) ? (((item >> 2) & 1) * 32 + (item >> 3)) : (item & 63), rb = bb * SEQ;
        const float kmax = sqrtf(__uint_as_float(kmaxw[bb]));
        for (int uu = 0; uu < 2; ++uu) {
            const int qb = (uu == 0) ? (127 - pr) : pr, t0 = qb * 32, tw = t0 + 4 * wave;
            RAW_BARRIER();
            {   _Pragma("unroll") for (int i_ = 0; i_ < 2; ++i_) { const int p_ = 2 * wave + i_, tl_ = p_ >> 2, ks_ = p_ & 3;
                    glds16(MISC + (size_t)(rb + 32 * tl_ + kl) * 256 + 128 + (2 * ks_ + hi) * 8, lds + A_KST + tl_ * 4096 + ks_ * 1024); } }
            { int tq = tid; asm volatile("" : "+v"(tq)); if (tq < 256) biasl[tq] = rel_bias[(tq >> 3) * 24 + (tq & 7)] * LOG2E; }
            {
                bf16x8 bqa[4];
                int klb = kl, hib = hi; asm volatile("" : "+v"(klb), "+v"(hib));
                const bf16* aqp = AQ + (size_t)(rb + t0 + klb) * 512 + wave * 64 + 8 * hib; const bf16* ukp = UKT + ((size_t)wave * 128 + klb) * 64 + 8 * hib;
#pragma unroll
                for (int ks = 0; ks < 4; ++ks) asm volatile("global_load_dwordx4 %0, %1, off" : "=&v"(bqa[ks]) : "v"(aqp + 16 * ks) : "memory");
#pragma unroll
                for (int np = 0; np < 2; ++np) {
                    bf16x8 ua[2][4];
#pragma unroll
                    for (int n2 = 0; n2 < 2; ++n2)
#pragma unroll
                        for (int ks = 0; ks < 4; ++ks) asm volatile("global_load_dwordx4 %0, %1, off" : "=&v"(ua[n2][ks]) : "v"(ukp + (size_t)(32 * (2 * np + n2)) * 64 + 16 * ks) : "memory");
                    asm volatile("s_waitcnt vmcnt(0)" : "+v"(bqa[0]), "+v"(bqa[1]), "+v"(bqa[2]), "+v"(bqa[3]), "+v"(ua[0][0]), "+v"(ua[0][1]), "+v"(ua[0][2]), "+v"(ua[0][3]), "+v"(ua[1][0]), "+v"(ua[1][1]), "+v"(ua[1][2]), "+v"(ua[1][3]) :: "memory");
#pragma unroll
                    for (int n2 = 0; n2 < 2; ++n2) { const int nt = 2 * np + n2;
                        f32x16 cq;
#pragma unroll
                        for (int r = 0; r < 16; ++r) cq[r] = 0.f;
#pragma unroll
                        for (int ks = 0; ks < 4; ++ks) cq = __builtin_amdgcn_mfma_f32_32x32x16_bf16(ua[n2][ks], bqa[ks], cq, 0, 0, 0);
                        bf16* qrow = QLS + (size_t)klb * 1024 + wave * 128 + 32 * nt + 4 * hib;
#pragma unroll
                        for (int g4 = 0; g4 < 4; ++g4) { v2u w; w.x = pk2(cq[4 * g4], cq[4 * g4 + 1]); w.y = pk2(cq[4 * g4 + 2], cq[4 * g4 + 3]); *(v2u*)(qrow + 8 * g4) = w; } }
                }
            }
            bf16x8 aq[4];
            int klq = kl, hiq = hi; asm volatile("" : "+v"(klq), "+v"(hiq));
            { const int rowq = klq >> 3, hr = klq & 7;
#pragma unroll
              for (int ks = 0; ks < 4; ++ks) aq[ks] = *(const bf16x8*)(IQ + (size_t)(rb + tw + rowq) * 512 + hr * 64 + 16 * ks + 8 * hiq); }
            float wr[16];
#pragma unroll
            for (int r = 0; r < 16; ++r) wr[r] = bf2f(MISC[(size_t)(rb + tw + (r >> 2)) * 256 + 192 + (r & 3) + 4 * hiq]) * 0.044194173824159216f;
            int kbX, kbY;
            { float ss = 0.f;
#pragma unroll
              for (int ks = 0; ks < 4; ++ks)
#pragma unroll
                  for (int j = 0; j < 8; ++j) { const float v = bf2f((bf16)aq[ks][j]); ss += v * v; }
              ss = swap_add(ss);
              const float wa = fabsf(bf2f(MISC[(size_t)(rb + tw + (klq >> 3)) * 256 + 192 + (klq & 7)])) * 0.044194173824159216f;
              float u = wa * sqrtf(ss) * kmax;
              u += __shfl_xor(u, 1); u += __shfl_xor(u, 2); u += __shfl_xor(u, 4);
              const float uX = __shfl(u, (2 * hi) * 8), uY = __shfl(u, (2 * hi + 1) * 8);
              kbX = (int)(__float_as_uint(uX) >> 18) - 511; kbY = (int)(__float_as_uint(uY) >> 18) - 511; }
            const int tX = tw + 2 * hi, tY = tw + 2 * hi + 1;
            const int qX = wave * 4 + 2 * hi, qY = qX + 1;
            LAS unsigned* histX = (LAS unsigned*)(lds + A_HIST + qX * 2048); LAS unsigned* histY = (LAS unsigned*)(lds + A_HIST + qY * 2048);
            int thrX = -1, thrY = -1; unsigned cntX = 0, cntY = 0, ccX = 0, ccY = 0;
            unsigned eSX = 0u, eCX = 0u, eSY = 0u, eCY = 0u;
#pragma unroll 1
            for (int rep8 = 0; rep8 < ((PROBE == 8 || PROBE == 15) ? 2 : 1); ++rep8) {
            thrX = -1; thrY = -1; cntX = 0; cntY = 0; ccX = 0; ccY = 0;
            { LAS v4u* hz = (LAS v4u*)(lds + A_HIST + wave * 8192);
              unsigned z0 = 0u; asm volatile("" : "+v"(z0));
#pragma unroll
              for (int i = 0; i < 8; ++i) hz[i * 64 + lane] = (v4u){z0, z0, z0, z0}; }
            const int NTK = qb + 1, NCK = (NTK + 3) >> 2;
#define MA_STAGE(ck_, buf_) do { _Pragma("unroll") for (int i_ = 0; i_ < 2; ++i_) { const int p_ = 2 * wave + i_, tl_ = p_ >> 2, ks_ = p_ & 3; \
                glds16(MISC + (size_t)(rb + 128 * (ck_) + 32 * tl_ + kl) * 256 + 128 + (2 * ks_ + hi) * 8, lds + A_KST + (buf_) * 16384 + tl_ * 4096 + ks_ * 1024); } } while (0)
#pragma unroll 1
            for (int pass = 0; pass < 1; ++pass) {
                const int NTR = (NTK + 1) >> 1;
                if (rep8 > 0) { RAW_BARRIER(); MA_STAGE(0, 0); }
                asm volatile("s_waitcnt vmcnt(0)" ::: "memory");
                RAW_BARRIER();
                if (NCK > 1) MA_STAGE(1, 1);
#define RELU(x_) __int_as_float(max(__float_as_int(x_), 0))
#define MA_LOADK(kf_, bf_, tl_) do { const LAS unsigned char* kbp_ = lds + A_KST + (bf_) * 16384 + (tl_) * 4096 + hi * 512 + kl * 16; \
                        _Pragma("unroll") for (int ks = 0; ks < 4; ++ks) kf_[ks] = *(const LAS bf16x8*)(kbp_ + ks * 1024); } while (0)
#define MA_MMA(c_, kf_) do { _Pragma("unroll") for (int r = 0; r < 16; ++r) c_[r] = 0.f; \
                        _Pragma("unroll") for (int ks = 0; ks < 4; ++ks) c_ = __builtin_amdgcn_mfma_f32_32x32x16_bf16(aq[ks], kf_[ks], c_, 0, 0, 0); } while (0)
#define MA_RED(sX_, sY_, c_) do { float p0_ = 0.f, p1_ = 0.f, p2_ = 0.f, p3_ = 0.f; \
                        _Pragma("unroll") for (int i = 0; i < 4; ++i) { p0_ += wr[i] * RELU(c_[i]); p1_ += wr[4 + i] * RELU(c_[4 + i]); p2_ += wr[8 + i] * RELU(c_[8 + i]); p3_ += wr[12 + i] * RELU(c_[12 + i]); } \
                        { auto rr = __builtin_amdgcn_permlane32_swap(__float_as_uint(p0_), __float_as_uint(p2_), false, false); sX_ = __uint_as_float(rr[0]) + __uint_as_float(rr[1]) + 0.f; } \
                        { auto rr = __builtin_amdgcn_permlane32_swap(__float_as_uint(p1_), __float_as_uint(p3_), false, false); sY_ = __uint_as_float(rr[0]) + __uint_as_float(rr[1]) + 0.f; } } while (0)
#define MA_APPEND(sv_, val_, q_, cnt_, cc_, eS_, eC_, s_) do { const unsigned mk_ = __float_as_uint(sv_) ^ ((unsigned)((int)__float_as_uint(sv_) >> 31) | 0x80000000u); \
                        const bool sel_ = (val_) && mk_ >= (eS_), cd_ = (val_) && mk_ >= (eC_) && mk_ < (eS_); \
                        const unsigned long long bs_ = __ballot(sel_), bc_ = __ballot(cd_); \
                        const unsigned ms_ = hi ? (unsigned)(bs_ >> 32) : (unsigned)bs_, mc_ = hi ? (unsigned)(bc_ >> 32) : (unsigned)bc_; \
                        if (sel_) lds_st_b16_asm((LAS bf16*)(lds + A_SEL + (q_) * 512) + cnt_ + __popc(ms_ & lt32), (unsigned)(s_)); \
                        if (cd_) { const unsigned cp_ = cc_ + __popc(mc_ & lt32); if (cp_ < 128u) { lds_st_b32_asm((LAS float*)(lds + A_CAND + (q_) * 768) + cp_, __float_as_uint(sv_)); lds_st_b16_asm((LAS bf16*)(lds + A_CAND + (q_) * 768 + 512) + cp_, (unsigned)(s_)); } } \
                        cnt_ += __popc(ms_); cc_ += __popc(mc_); } while (0)
                f32x16 ca, cb;
                {   bf16x8 kfa[4], kfb[4];
                    MA_LOADK(kfa, 0, 0); MA_LOADK(kfb, 0, 1);
                    MA_MMA(ca, kfa); MA_MMA(cb, kfb); }
#pragma unroll 1
                for (int t = 0; t < NTR; ++t) {
                    bf16x8 kfa[4], kfb[4];
                    if (t + 1 < NTR && ((t + 1) & 1) == 0) {
                        const int c = (t + 1) >> 1;
                        asm volatile("s_waitcnt vmcnt(0)" ::: "memory");
                        RAW_BARRIER();
                        if (c + 1 < NCK) MA_STAGE(c + 1, (c + 1) & 1);
                    }
                    const int bf = ((t + 1) >> 1) & 1, tl = 2 * ((t + 1) & 1);
#define MA_KRD(kf_, a_) asm volatile("ds_read_b128 %0, %4\n\tds_read_b128 %1, %4 offset:1024\n\tds_read_b128 %2, %4 offset:2048\n\tds_read_b128 %3, %4 offset:3072" : "=&v"(kf_[0]), "=&v"(kf_[1]), "=&v"(kf_[2]), "=&v"(kf_[3]) : "v"(a_) : "memory")
#define MA_KWAIT(kf_) asm volatile("s_waitcnt lgkmcnt(0)" : "+v"(kf_[0]), "+v"(kf_[1]), "+v"(kf_[2]), "+v"(kf_[3]) :: "memory")
                    const unsigned kad = (unsigned)(uintptr_t)(lds + A_KST + bf * 16384 + tl * 4096 + hi * 512 + kl * 16);
                    MA_KRD(kfa, kad);
                    float sXa, sYa, sXb, sYb;
                    MA_RED(sXa, sYa, ca);
                    asm volatile("" : "+v"(sXa), "+v"(sYa));
                    MA_KWAIT(kfa); MA_MMA(ca, kfa);
                    MA_KRD(kfb, kad + 4096u);
                    MA_RED(sXb, sYb, cb);
                    asm volatile("" : "+v"(sXb), "+v"(sYb));
                    MA_KWAIT(kfb); MA_MMA(cb, kfb);
#undef MA_KRD
#undef MA_KWAIT
                    const int sa = t * 64 + kl, sb2 = sa + 32;
                    const bool vXa = sa <= tX, vYa = sa <= tY, vXb = sb2 <= tX, vYb = sb2 <= tY;
                    if (pass == 0) {
                        const int bXa = a_bin(sXa, kbX), bYa = a_bin(sYa, kbY), bXb = a_bin(sXb, kbX), bYb = a_bin(sYb, kbY);
                        lds_add_u32_asm(histX + (bXa >> 1), vXa ? (1u << ((bXa & 1) * 16)) : 0u);
                        lds_add_u32_asm(histY + (bYa >> 1), vYa ? (1u << ((bYa & 1) * 16)) : 0u);
                        lds_add_u32_asm(histX + (bXb >> 1), vXb ? (1u << ((bXb & 1) * 16)) : 0u);
                        lds_add_u32_asm(histY + (bYb >> 1), vYb ? (1u << ((bYb & 1) * 16)) : 0u);
#define A_KEY16(s_) ((unsigned short)((__float_as_uint(s_) ^ ((unsigned)((int)__float_as_uint(s_) >> 31) | 0x80000000u)) >> 16))
                        {   unsigned short* kw = KEYS + (size_t)qX * 4096 + sa;
                            kw[0] = A_KEY16(sXa); kw[4096] = A_KEY16(sYa); kw[32] = A_KEY16(sXb); kw[4096 + 32] = A_KEY16(sYb); }
#undef A_KEY16
                    } else {
                        MA_APPEND(sXa, vXa, qX, cntX, ccX, eSX, eCX, sa); MA_APPEND(sYa, vYa, qY, cntY, ccY, eSY, eCY, sa);
                        MA_APPEND(sXb, vXb, qX, cntX, ccX, eSX, eCX, sb2); MA_APPEND(sYb, vYb, qY, cntY, ccY, eSY, eCY, sb2);
                    }
                    asm volatile("" : "+v"(ca), "+v"(cb));
                }
#undef MA_LOADK
#undef MA_MMA
#undef MA_RED
#undef MA_APPEND
                RAW_BARRIER();
                if (pass == 0) {
#pragma unroll 1
                    for (int q4 = 0; q4 < 4; ++q4) {
                        const LAS unsigned* hq = (const LAS unsigned*)(lds + A_HIST + (wave * 4 + q4) * 2048) + 504 - 8 * lane;
                        unsigned w8[8];
                        { const v4u a0 = *(const LAS v4u*)hq, a1 = *(const LAS v4u*)(hq + 4); w8[0] = a0.x; w8[1] = a0.y; w8[2] = a0.z; w8[3] = a0.w; w8[4] = a1.x; w8[5] = a1.y; w8[6] = a1.z; w8[7] = a1.w; }
                        unsigned loc = 0;
#pragma unroll
                        for (int j = 0; j < 8; ++j) loc += (w8[j] & 0xffffu) + (w8[j] >> 16);
                        unsigned inc = loc;
                        inc += (unsigned)__builtin_amdgcn_update_dpp(0, (int)inc, 0x111, 0xf, 0xf, false);
                        inc += (unsigned)__builtin_amdgcn_update_dpp(0, (int)inc, 0x112, 0xf, 0xf, false);
                        inc += (unsigned)__builtin_amdgcn_update_dpp(0, (int)inc, 0x114, 0xf, 0xf, false);
                        inc += (unsigned)__builtin_amdgcn_update_dpp(0, (int)inc, 0x118, 0xf, 0xf, false);
                        inc += (unsigned)__builtin_amdgcn_update_dpp(0, (int)inc, 0x142, 0xa, 0xf, false);
                        inc += (unsigned)__builtin_amdgcn_update_dpp(0, (int)inc, 0x143, 0xc, 0xf, false);
                        unsigned run = inc - loc; int thr = -1; unsigned cab = 0;
#pragma unroll
                        for (int j = 7; j >= 0; --j)
#pragma unroll
                            for (int hh = 1; hh >= 0; --hh) { const unsigned cn = (w8[j] >> (16 * hh)) & 0xffffu;
                                if (thr < 0 && run + cn >= (unsigned)TOPK) { thr = 2 * (504 - 8 * lane + j) + hh; cab = run; }
                                run += cn; }
                        const unsigned long long bl = __ballot(inc >= (unsigned)TOPK);
                        int thq = -1; unsigned cbq = 0;
                        if (bl) { const int L = __ffsll((long long)bl) - 1; thq = __shfl(thr, L); cbq = __shfl(cab, L); }
                        (void)cbq;
                        if (q4 == 2 * hi) thrX = thq; if (q4 == 2 * hi + 1) thrY = thq;
                    }
                    eCX = a_edge(thrX, kbX); eSX = a_edge(thrX + 1, kbX); eCY = a_edge(thrY, kbY); eSY = a_edge(thrY + 1, kbY);
                }
            }
            {
                asm volatile("s_waitcnt vmcnt(0)" ::: "memory");
                __builtin_amdgcn_fence(__ATOMIC_RELEASE, "workgroup"); __builtin_amdgcn_fence(__ATOMIC_ACQUIRE, "workgroup");
                unsigned cq0 = 0, cq1 = 0, cq2 = 0, cq3 = 0, kq0 = 0, kq1 = 0, kq2 = 0, kq3 = 0;
#define MA_SCANQ(q4_, cntv_, ccv_) do { \
                    const unsigned eS_ = (unsigned)__builtin_amdgcn_readlane((int)(((q4_) & 1) ? eSY : eSX), ((q4_) >> 1) * 32) >> 16, eC_ = (unsigned)__builtin_amdgcn_readlane((int)(((q4_) & 1) ? eCY : eCX), ((q4_) >> 1) * 32) >> 16; \
                    const int tq_ = tw + (q4_), nch_ = (tq_ + 512) >> 9; \
                    const unsigned short* row_ = KEYS + (size_t)(wave * 4 + (q4_)) * 4096 + lane;     \
                    LAS bf16* so_ = (LAS bf16*)(lds + A_SEL + (wave * 4 + (q4_)) * 512); LAS bf16* co_ = (LAS bf16*)(lds + A_CAND + (wave * 4 + (q4_)) * 768 + 512); \
                    unsigned cnt_ = 0, cc_ = 0; unsigned nx_[8]; \
                    _Pragma("unroll") for (int j_ = 0; j_ < 8; ++j_) nx_[j_] = row_[64 * j_]; \
                    _Pragma("unroll 1") for (int c_ = 0; c_ < nch_; ++c_) { \
                        unsigned w_[8]; _Pragma("unroll") for (int j_ = 0; j_ < 8; ++j_) w_[j_] = nx_[j_]; \
                        if (c_ + 1 < nch_) { _Pragma("unroll") for (int j_ = 0; j_ < 8; ++j_) nx_[j_] = row_[512 * (c_ + 1) + 64 * j_]; } \
                        _Pragma("unroll") for (int j_ = 0; j_ < 8; ++j_) { \
                            const unsigned k_ = w_[j_]; const int ki_ = 512 * c_ + 64 * j_ + lane; \
                            const bool val_ = ki_ <= tq_, sel_ = val_ && k_ >= eS_, cd_ = val_ && k_ >= eC_ && k_ < eS_; \
                            const unsigned long long bs_ = __ballot(sel_), bc_ = __ballot(cd_); \
                            if (sel_) lds_st_b16_asm(so_ + cnt_ + __builtin_amdgcn_mbcnt_hi((unsigned)(bs_ >> 32), __builtin_amdgcn_mbcnt_lo((unsigned)bs_, 0u)), (unsigned)ki_); \
                            if (cd_) { const unsigned cp_ = cc_ + __builtin_amdgcn_mbcnt_hi((unsigned)(bc_ >> 32), __builtin_amdgcn_mbcnt_lo((unsigned)bc_, 0u)); if (cp_ < 128u) lds_st_b16_asm(co_ + cp_, (unsigned)ki_); } \
                            cnt_ += (unsigned)__popcll(bs_); cc_ += (unsigned)__popcll(bc_); } } \
                    cntv_ = cnt_; ccv_ = cc_; } while (0)
                MA_SCANQ(0, cq0, kq0); MA_SCANQ(1, cq1, kq1); MA_SCANQ(2, cq2, kq2); MA_SCANQ(3, cq3, kq3);
#undef MA_SCANQ
                cntX = hi ? cq2 : cq0; cntY = hi ? cq3 : cq1; ccX = hi ? kq2 : kq0; ccY = hi ? kq3 : kq1;
                asm volatile("s_waitcnt lgkmcnt(0)" ::: "memory");
                const int n0 = min(__builtin_amdgcn_readlane((int)ccX, 0), 128), n2 = min(__builtin_amdgcn_readlane((int)ccX, 32), 128), n1 = min(__builtin_amdgcn_readlane((int)ccY, 0), 128), n3 = min(__builtin_amdgcn_readlane((int)ccY, 32), 128);
#pragma unroll 1
                for (int qp = 0; qp < 2; ++qp) {
                    const int na = qp ? n2 : n0, nb2 = qp ? n3 : n1, nmax = na > nb2 ? na : nb2;
                    LAS float* csa = (LAS float*)(lds + A_CAND + (wave * 4 + 2 * qp) * 768); LAS float* csb = (LAS float*)(lds + A_CAND + (wave * 4 + 2 * qp + 1) * 768);
                    const LAS bf16* cia = (const LAS bf16*)(lds + A_CAND + (wave * 4 + 2 * qp) * 768 + 512); const LAS bf16* cib = (const LAS bf16*)(lds + A_CAND + (wave * 4 + 2 * qp + 1) * 768 + 512);
#pragma unroll 1
                    for (int tb = 0; tb < nmax; tb += 32) {
                        const int ia = (tb + kl < na) ? (int)cia[tb + kl] : 0, ib = (tb + kl < nb2) ? (int)cib[tb + kl] : 0;
                        bf16x8 kfa[4], kfb[4];
#pragma unroll
                        for (int ks = 0; ks < 4; ++ks) {
                            asm volatile("global_load_dwordx4 %0, %1, off" : "=&v"(kfa[ks]) : "v"(MISC + (size_t)(rb + ia) * 256 + 128 + (2 * ks + hi) * 8) : "memory");
                            asm volatile("global_load_dwordx4 %0, %1, off" : "=&v"(kfb[ks]) : "v"(MISC + (size_t)(rb + ib) * 256 + 128 + (2 * ks + hi) * 8) : "memory"); }
                        asm volatile("s_waitcnt vmcnt(0)" : "+v"(kfa[0]), "+v"(kfa[1]), "+v"(kfa[2]), "+v"(kfa[3]), "+v"(kfb[0]), "+v"(kfb[1]), "+v"(kfb[2]), "+v"(kfb[3]) :: "memory");
                        f32x16 ca, cb;
#pragma unroll
                        for (int r = 0; r < 16; ++r) { ca[r] = 0.f; cb[r] = 0.f; }
#pragma unroll
                        for (int ks = 0; ks < 4; ++ks) { ca = __builtin_amdgcn_mfma_f32_32x32x16_bf16(aq[ks], kfa[ks], ca, 0, 0, 0); cb = __builtin_amdgcn_mfma_f32_32x32x16_bf16(aq[ks], kfb[ks], cb, 0, 0, 0); }
#define RELU2(x_) __int_as_float(max(__float_as_int(x_), 0))
#define MA_RED2(sX_, sY_, c_) do { float p0_ = 0.f, p1_ = 0.f, p2_ = 0.f, p3_ = 0.f; \
                        _Pragma("unroll") for (int i = 0; i < 4; ++i) { p0_ += wr[i] * RELU2(c_[i]); p1_ += wr[4 + i] * RELU2(c_[4 + i]); p2_ += wr[8 + i] * RELU2(c_[8 + i]); p3_ += wr[12 + i] * RELU2(c_[12 + i]); } \
                        { auto rr = __builtin_amdgcn_permlane32_swap(__float_as_uint(p0_), __float_as_uint(p2_), false, false); sX_ = __uint_as_float(rr[0]) + __uint_as_float(rr[1]) + 0.f; } \
                        { auto rr = __builtin_amdgcn_permlane32_swap(__float_as_uint(p1_), __float_as_uint(p3_), false, false); sY_ = __uint_as_float(rr[0]) + __uint_as_float(rr[1]) + 0.f; } } while (0)
                        float aX, aY, bX, bY;
                        MA_RED2(aX, aY, ca); MA_RED2(bX, bY, cb);
#undef MA_RED2
#undef RELU2
                        if (hi == qp && tb + kl < na) csa[tb + kl] = aX;
                        if (hi == qp && tb + kl < nb2) csb[tb + kl] = bY;
                    }
                }
                asm volatile("s_waitcnt lgkmcnt(0)" ::: "memory");
            }
            }
#undef MA_STAGE
            {
                const unsigned c0 = (unsigned)__shfl((int)cntX, 0), c2 = (unsigned)__shfl((int)cntX, 32), c1 = (unsigned)__shfl((int)cntY, 0), c3 = (unsigned)__shfl((int)cntY, 32);
                const unsigned k0 = (unsigned)__shfl((int)ccX, 0), k2 = (unsigned)__shfl((int)ccX, 32), k1 = (unsigned)__shfl((int)ccY, 0), k3 = (unsigned)__shfl((int)ccY, 32);
#pragma unroll 1
                for (int q4 = 0; q4 < 4; ++q4) {
                    const unsigned cnt = (q4 == 0) ? c0 : (q4 == 1) ? c1 : (q4 == 2) ? c2 : c3; unsigned cc = (q4 == 0) ? k0 : (q4 == 1) ? k1 : (q4 == 2) ? k2 : k3;
                    if (cc > 128u) cc = 128u;
                    LAS unsigned* nfp = (LAS unsigned*)(lds + A_BIAS + 1024) + wave * 4 + q4;
                    if (lane == 0) *nfp = cnt;
                    if (cnt >= (unsigned)TOPK || cc == 0u) continue;
                    const unsigned need = (unsigned)TOPK - cnt;
                    const LAS float* cs = (const LAS float*)(lds + A_CAND + (wave * 4 + q4) * 768); const LAS bf16* ci = (const LAS bf16*)(lds + A_CAND + (wave * 4 + q4) * 768 + 512);
                    LAS bf16* so = (LAS bf16*)(lds + A_SEL + (wave * 4 + q4) * 512);
                    unsigned base = cnt;
#pragma unroll 1
                    for (unsigned r0 = 0; r0 < cc; r0 += 64) { const unsigned i = r0 + lane; const bool act = i < cc;
                        const float si = act ? cs[i] : 0.f; const unsigned ii = act ? ci[i] : 0u; unsigned rank = 0;
                        unsigned j = 0;
                        for (; j + 8 <= cc; j += 8) { float sj[8]; unsigned ij[8];
#pragma unroll
                            for (int u = 0; u < 8; ++u) { sj[u] = cs[j + u]; ij[u] = ci[j + u]; }
#pragma unroll
                            for (int u = 0; u < 8; ++u) rank += (sj[u] > si || (sj[u] == si && ij[u] < ii)) ? 1u : 0u; }
                        if (j < cc) { float sj[8]; unsigned ij[8];
#pragma unroll
                            for (int u = 0; u < 8; ++u) { const unsigned jj = (j + u < cc) ? j + u : j; sj[u] = cs[jj]; ij[u] = ci[jj]; }
#pragma unroll
                            for (int u = 0; u < 8; ++u) rank += (j + u < cc && (sj[u] > si || (sj[u] == si && ij[u] < ii))) ? 1u : 0u; }
                        const bool take = act && rank < need;
                        const unsigned long long bt = __ballot(take);
                        if (take) so[base + __popcll(bt & ((1ull << lane) - 1ull))] = (bf16)ii;
                        base += __popcll(bt); }
                    if (lane == 0) *nfp = base;
                }
            }
            asm volatile("s_waitcnt vmcnt(0)" ::: "memory");
            __builtin_amdgcn_fence(__ATOMIC_RELEASE, "workgroup");
            RAW_BARRIER();
            __builtin_amdgcn_fence(__ATOMIC_ACQUIRE, "workgroup");
#pragma unroll 1
            for (int rep9 = 0; rep9 < ((PROBE == 9 || PROBE == 10 || PROBE == 11) ? 2 : 1); ++rep9) {
                bf16* OUTP_ = ((PROBE == 9 || PROBE == 10 || PROBE == 11) && rep9 == 0) ? OUTA2 : OUTA;
                LAS unsigned char* gb = lds + wave * 16384;
                LAS bf16* bkt = (LAS bf16*)(lds + A_BKT + wave * 512);
#pragma unroll 1
                for (int q4 = 0; q4 < 4; ++q4) { int ns = (int)((const LAS unsigned*)(lds + A_BIAS + 1024))[wave * 4 + q4]; ns = ns < TOPK ? ns : TOPK; LAS bf16* so = (LAS bf16*)(lds + A_SEL + (wave * 4 + q4) * 512);
                    for (int i = lane; i < TOPK; i += 64) if (i >= ns) so[i] = 0; }
                asm volatile("s_waitcnt lgkmcnt(0)" ::: "memory");
                const int c15 = lane & 15, g = lane >> 4, q_ = c15 >> 2, p_ = c15 & 3, hc = c15 < 8 ? c15 : 7;
                const int Xr = ((c15 & 3) << 2) | ((c15 >> 2) & 3), Xt = (q_ << 2) | g;
                unsigned ra[4], ta[8];
#pragma unroll
                for (int ks = 0; ks < 4; ++ks) ra[ks] = (unsigned)(256 * c15 + 16 * ((4 * ks + g) ^ Xr));
#pragma unroll
                for (int dt = 0; dt < 8; ++dt) ta[dt] = (unsigned)(256 * (4 * g + q_) + 16 * ((2 * dt + (p_ >> 1)) ^ Xt) + 8 * (p_ & 1));
                bf16x8 bbf;
                { v4u w; const LAS float* bl = biasl + (8 * g) * 8 + hc;
                  constexpr float BS = 8.0f / LOG2E;
                  w.x = pk2(bl[0] * BS, bl[8] * BS); w.y = pk2(bl[16] * BS, bl[24] * BS); w.z = pk2(bl[32] * BS, bl[40] * BS); w.w = pk2(bl[48] * BS, bl[56] * BS); bbf = __builtin_bit_cast(bf16x8, w); }
#define MA_GATHER(q4_, c8_, buf_) do { const LAS bf16* so_ = (const LAS bf16*)(lds + A_SEL + (wave * 4 + (q4_)) * 512) + (c8_) * 32; \
                    int idx_[8]; _Pragma("unroll") for (int i_ = 0; i_ < 8; ++i_) idx_[i_] = (PROBE == 10 && rep9 == 0) ? (4 * i_ + (lane >> 4)) : (int)so_[4 * i_ + (lane >> 4)]; \
                    asm volatile("s_waitcnt lgkmcnt(0)" : "+v"(idx_[0]), "+v"(idx_[1]), "+v"(idx_[2]), "+v"(idx_[3]), "+v"(idx_[4]), "+v"(idx_[5]), "+v"(idx_[6]), "+v"(idx_[7]) :: "memory"); \
                    _Pragma("unroll") for (int i_ = 0; i_ < 8; ++i_) { const int row_ = 4 * i_ + (lane >> 4); \
                        const int ch_ = (lane & 15) ^ (((row_ & 3) << 2) | ((row_ >> 2) & 3)); \
                        glds16(KVN + (size_t)(rb + idx_[i_]) * 128 + ch_ * 8, gb + (buf_) * 8192 + i_ * 1024); } } while (0)
                MA_GATHER(0, 0, 0);
#pragma unroll 1
                for (int q4 = 0; q4 < 4; ++q4) {
                    const int t = tw + q4; int ns = (int)((const LAS unsigned*)(lds + A_BIAS + 1024))[wave * 4 + q4]; ns = ns < TOPK ? ns : TOPK;
                    const LAS bf16* so = (const LAS bf16*)(lds + A_SEL + (wave * 4 + q4) * 512);
                    {   int dd[4];
#pragma unroll
                        for (int i4 = 0; i4 < 4; ++i4) dd[i4] = t - (int)so[lane + 64 * i4];
#pragma unroll
                        for (int i4 = 0; i4 < 4; ++i4) lds_st_b16_asm(bkt + lane + 64 * i4, (unsigned)rel_bucket(dd[i4] < 0 ? 0 : dd[i4])); }
                    bf16x8 bq[4];
#pragma unroll
                    for (int ks = 0; ks < 4; ++ks) { bq[ks] = (bf16x8){0, 0, 0, 0, 0, 0, 0, 0}; if (c15 < 8) bq[ks] = *(const bf16x8*)(QLS + (size_t)(4 * wave + q4) * 1024 + c15 * 128 + 32 * ks + 8 * g); }
                    f32x4 O[8];
#pragma unroll
                    for (int dt = 0; dt < 8; ++dt) O[dt] = (f32x4){0.f, 0.f, 0.f, 0.f};
                    float mref = -INFINITY, lsum = 0.f;
#pragma unroll 1
                    for (int c8 = 0; c8 < 8; ++c8) {
                        const int step = q4 * 8 + c8, buf = step & 1;
#if AGATHER_POS == 0
                        asm volatile("s_waitcnt lgkmcnt(0)" ::: "memory");
                        if (step + 1 < 32) { MA_GATHER((step + 1) >> 3, (step + 1) & 7, buf ^ 1); asm volatile("s_waitcnt vmcnt(8)" ::: "memory"); }
                        else asm volatile("s_waitcnt vmcnt(0)" ::: "memory");
#else
                        asm volatile("s_waitcnt vmcnt(0) lgkmcnt(0)" ::: "memory");
#endif
                        const LAS unsigned char* cb = gb + buf * 8192;
                        if (PROBE == 11 && rep9 == 0) continue;
                        f32x4 sv[2];
#pragma unroll
                        for (int tau = 0; tau < 2; ++tau) {
                            f32x4 sa = (f32x4){0.f, 0.f, 0.f, 0.f};
#pragma unroll
                            for (int ks = 0; ks < 4; ++ks) { const bf16x8 kf = *(const LAS bf16x8*)(cb + ra[ks] + 4096 * tau); sa = __builtin_amdgcn_mfma_f32_16x16x32_bf16(kf, bq[ks], sa, 0, 0, 0); }
                            const int b = (int)bkt[c8 * 32 + 16 * tau + c15];
                            const unsigned val = ((b >> 3) == g) ? (0x3F80u << ((b & 1) * 16)) : 0u; const int di = (b >> 1) & 3;
                            v4u oh; oh.x = (di == 0) ? val : 0u; oh.y = (di == 1) ? val : 0u; oh.z = (di == 2) ? val : 0u; oh.w = (di == 3) ? val : 0u;
                            sa = __builtin_amdgcn_mfma_f32_16x16x32_bf16(__builtin_bit_cast(bf16x8, oh), bbf, sa, 0, 0, 0);
                            sv[tau] = sa * C2;
                        }
                        if (ns < TOPK) {
#pragma unroll
                            for (int tau = 0; tau < 2; ++tau)
#pragma unroll
                                for (int r = 0; r < 4; ++r) if (c8 * 32 + 16 * tau + 4 * g + r >= ns) sv[tau][r] = -INFINITY;
                        }
                        float rm = fmaxf(fmaxf(fmaxf(sv[0][0], sv[0][1]), fmaxf(sv[0][2], sv[0][3])), fmaxf(fmaxf(sv[1][0], sv[1][1]), fmaxf(sv[1][2], sv[1][3])));
                        rm = swap_max(swap16_max(rm));
                        if (__any(rm > mref + THR)) {
                            const float mn = fmaxf(mref, rm), f = (mn == -INFINITY) ? 1.f : __builtin_amdgcn_exp2f(mref - mn);
                            lsum *= f; mref = mn;
#pragma unroll
                            for (int dt = 0; dt < 8; ++dt) O[dt] = O[dt] * f;
                        }
                        const float msub = (mref == -INFINITY) ? 0.f : mref;
                        float ps = 0.f;
#pragma unroll
                        for (int tau = 0; tau < 2; ++tau)
#pragma unroll
                            for (int r = 0; r < 4; ++r) { sv[tau][r] = __builtin_amdgcn_exp2f(sv[tau][r] - msub); ps += sv[tau][r]; }
                        lsum += ps;
#if AGATHER_POS == 1
                        if (step + 1 < 32 && !(PROBE == 11 && rep9 == 0)) { MA_GATHER((step + 1) >> 3, (step + 1) & 7, buf ^ 1); }
#endif
                        bf16x8 pf;
                        { v4u w; w.x = cvtpk(sv[0][0], sv[0][1]); w.y = cvtpk(sv[0][2], sv[0][3]); w.z = cvtpk(sv[1][0], sv[1][1]); w.w = cvtpk(sv[1][2], sv[1][3]); pf = __builtin_bit_cast(bf16x8, w); }
                        {
                            const unsigned cbu = (unsigned)(uintptr_t)cb;
                            s16x4 fa[8], fb[8];
#pragma unroll
                            for (int dt = 0; dt < 4; ++dt) { TRV(fa[2 * dt], cbu + ta[dt], 0); TRV(fa[2 * dt + 1], cbu + ta[dt], 4096); }
#pragma unroll
                            for (int dt = 0; dt < 4; ++dt) { TRV(fb[2 * dt], cbu + ta[4 + dt], 0); TRV(fb[2 * dt + 1], cbu + ta[4 + dt], 4096); }
                            LGKM_WAIT8(8, fa);
#pragma unroll
                            for (int dt = 0; dt < 4; ++dt) O[dt] = __builtin_amdgcn_mfma_f32_16x16x32_bf16(VFRAG(fa, dt), pf, O[dt], 0, 0, 0);
                            LGKM_WAIT8(0, fb);
#pragma unroll
                            for (int dt = 0; dt < 4; ++dt) O[4 + dt] = __builtin_amdgcn_mfma_f32_16x16x32_bf16(VFRAG(fb, dt), pf, O[4 + dt], 0, 0, 0);
                        }
                    }
                    const float lt = swap_add(swap16_add(lsum));
                    const float inv = 1.0f / lt;
                    if (c15 < 8) { bf16* orow = OUTP_ + (size_t)(rb + t) * 1024 + c15 * 128 + 4 * g;
#pragma unroll
                        for (int dt = 0; dt < 8; ++dt) { v2u w; w.x = pk2(O[dt][0] * inv, O[dt][1] * inv); w.y = pk2(O[dt][2] * inv, O[dt][3] * inv); *(v2u*)(orow + 16 * dt) = w; } }
                }
#undef MA_GATHER
                asm volatile("s_waitcnt vmcnt(0)" ::: "memory");
            }
        }
    }
}
#define Y_() (WSP() + WS_Y)
#define WL_(l) (WSP() + WS_W + (size_t)(l) * W_LAYER)
#define MOD_(l) ((const float*)(WSP() + WS_MOD) + (size_t)(l) * 8 * 6144)
#define T_() ((const float*)(WSP() + WS_TAB))
#define H_() ((bf16*)(WSP() + WS_H))
#define KVN_() ((bf16*)(WSP() + WS_KVN))
#define KMAXW_(l, ch) ((unsigned*)(WSP() + WS_CTL) + 8192 + ((l) * NCH + (ch)) * 64)
#define LAMI_(l) (((l) == 0) ? 0.8f : 0.64449093f)
__device__ __forceinline__ int tidx(int w) { int t = (int)threadIdx.x; (void)w; asm volatile("" : "+v"(t)); return t; }
#define TID_ tidx(wave)
#define LANE_ (tidx(wave) & 63)
#ifndef STAGGER_TICKS
#define STAGGER_TICKS 0
#endif
#ifndef P1_ALIGN
#define P1_ALIGN true
#endif
#define GBAR() do { xcd_barrier(bar); if (PROBE == 16) xcd_barrier(bar); } while (0)
__global__ void __launch_bounds__(NTHREADS, 2) fwd(Args a) {
    extern __shared__ __attribute__((aligned(16))) unsigned char lds_raw[];
    LAS unsigned char* lds = (LAS unsigned char*)lds_raw;
    const int wave = __builtin_amdgcn_readfirstlane((int)threadIdx.x >> 6);
    const int G = gridDim.x, gw = blockIdx.x * NWAVES + wave, NGW = G * NWAVES;
    for (int u = (int)threadIdx.x; u < (LDS_BYTES - LDSCTL_OFF) / 4; u += NTHREADS) ((LAS unsigned*)(lds + LDSCTL_OFF))[u] = 0u;
    __syncthreads();
    XcdBarrier bar = xcd_barrier_post((unsigned*)(WSP() + WS_CTL) + CW_BAR, (volatile LAS unsigned*)(lds + LDSCTL_OFF), wave);

#pragma unroll 1
    for (int rep = 0; rep < (PROBE == 5 ? 2 : 1); ++rep) {
    p0a_prologue(WSP(), lds, TID_, LANE_, wave, G);
    GBAR(); }
    norm_rows(ARG(0), H_(), ARG(4), MOD_(0) + 0 * 1024, MOD_(0) + 1 * 1024, gw, NGW, LANE_);
    GBAR();

#pragma unroll 1
    for (int l = 0; l < NL; ++l) {
#pragma unroll 1
        for (int ch = 0; ch < NCH; ++ch) {
            { pg8::Gemm g{H_() + (size_t)ch * CHR * 1024, (const bf16*)(WL_(l) + W_IN), CHR, NIN, 1024}; pg8::StaticOrder S; S.init(CHR, NIN, G, (int)blockIdx.x); S.rot = 20;
              pg8::EpiIn E{Y_(), 0};
#if STAGGER_TICKS > 0
              { const unsigned long long t0 = __builtin_amdgcn_s_memrealtime(); const unsigned long long dl = (unsigned long long)((blockIdx.x >> 3) & 3u) * STAGGER_TICKS;
                while (__builtin_amdgcn_s_memrealtime() - t0 < dl) __builtin_amdgcn_s_sleep(8); }
#endif
#pragma unroll 1
              for (int rep = 0; rep < ((PROBE == 1 || PROBE == 17 || PROBE == 19) ? 2 : 1); ++rep) {
              E.skip = (PROBE == 19 && rep == 0) ? 1 : 0;
              pg8::gemm_phase<pg8::EpiIn, pg8::StaticOrder, P1_ALIGN, true>(lds, g, S, E, wave); }
            }
            GBAR();
            kvn_rows(Y_(), KVN_(), ARG(8) + l * 128, KMAXW_(l, ch), gw, NGW, LANE_);
#if PROBE == 4
            mixC_fast(Y_(), WSP(), T_(), lds, TID_, LANE_, wave, G);
#endif
            mixC_fast(Y_(), WSP(), T_(), lds, TID_, LANE_, wave, G);
#if PROBE == 2 || (PROBE >= 12 && PROBE <= 15)
            mixB_fast<(PROBE == 2 ? 0 : PROBE - 11)>(Y_(), (bf16*)(WSP() + 484 * MiB), T_(), ARG(13) + l * 128, ((const float*)(WSP() + WS_LAM))[l], LAMI_(l), lds, TID_, LANE_, wave, G);
#endif
            mixB_fast<0>(Y_(), (bf16*)(Y_() + Y_BQ), T_(), ARG(13) + l * 128, ((const float*)(WSP() + WS_LAM))[l], LAMI_(l), lds, TID_, LANE_, wave, G);
            GBAR();
            mergeC(Y_(), WSP(), gw, NGW, LANE_);
#if PROBE == 3 || PROBE == 9 || PROBE == 10 || PROBE == 11
            GBAR();
#endif
#if PROBE == 3
            mixA_fast(Y_(), (bf16*)(WSP() + WS_OG), (bf16*)(WSP() + WS_OG), KVN_(), (const bf16*)(WL_(l) + W_UKT), T_(), ARG(21), KMAXW_(l, ch), lds, TID_, LANE_, wave, G);
#endif
            mixA_fast(Y_(), (bf16*)(Y_() + Y_OLAT), (bf16*)(WSP() + WS_OG), KVN_(), (const bf16*)(WL_(l) + W_UKT), T_(), ARG(21), KMAXW_(l, ch), lds, TID_, LANE_, wave, G);
            GBAR();
#pragma unroll 1
            for (int rep = 0; rep < (PROBE == 7 ? 2 : 1); ++rep)
            { pg8::StaticOrder S; S.init(CHR, 1024, G, (int)blockIdx.x);
              { unsigned char* y = Y_(); pg8::Gemm g{(const bf16*)(y + Y_OLAT), (const bf16*)(WL_(l) + W_A), CHR, 1024, 1024}; pg8::EpiGate<0> E{(const bf16*)(y + Y_Z), 0, (float*)(y + Y_MF32), (bf16*)(y + Y_MBF)};
                pg8::gemm_phase<pg8::EpiGate<0>, pg8::StaticOrder, true, true>(lds, g, S, E, wave); }
              { unsigned char* y = Y_(); pg8::Gemm g{(const bf16*)(y + Y_BQ), (const bf16*)(WL_(l) + W_B), CHR, 1024, 512}; pg8::EpiGate<1> E{(const bf16*)(y + Y_Z), 1024, (float*)(y + Y_MF32), (bf16*)(y + Y_MBF)};
                pg8::gemm_phase<pg8::EpiGate<1>, pg8::StaticOrder, true, true>(lds, g, S, E, wave); }
              { unsigned char* y = Y_(); pg8::Gemm g{(const bf16*)(y + Y_OC), (const bf16*)(WL_(l) + W_C), CHR, 1024, 256}; pg8::EpiGate<2> E{(const bf16*)(y + Y_Z), 2048, (float*)(y + Y_MF32), (bf16*)(y + Y_MBF)};
                pg8::gemm_phase<pg8::EpiGate<2>, pg8::StaticOrder, true, true>(lds, g, S, E, wave); } }
            GBAR();
            { pg8::Gemm g{(const bf16*)(Y_() + Y_MBF), (const bf16*)(WL_(l) + W_OUT), CHR, 1024, 1024}; pg8::StaticOrder S; S.init(CHR, 1024, G, (int)blockIdx.x);
              pg8::EpiRes E{(l == 0) ? ARG(0) : (const float*)OUTP(), OUTP(), MOD_(l) + 2 * 1024, ch * CHR};
              pg8::gemm_phase<pg8::EpiRes, pg8::StaticOrder, true, true>(lds, g, S, E, wave); }
            GBAR();
        }
#pragma unroll 1
        for (int rep = 0; rep < (PROBE == 6 ? 2 : 1); ++rep) {
        norm_rows(OUTP(), H_(), ARG(18) + l * 1024, MOD_(l) + 3 * 1024, MOD_(l) + 4 * 1024, gw, NGW, LANE_);
        GBAR(); }
        { pg8::Gemm g{H_(), (const bf16*)(WL_(l) + W_GU), MT, NGU, 1024}; pg8::StaticOrder S; S.init(MT, NGU, G, (int)blockIdx.x);
          pg8::EpiSwiGLU E{(bf16*)(WSP() + WS_ACT)};
#pragma unroll 1
          for (int rep = 0; rep < ((PROBE == 1 || PROBE == 18) ? 2 : 1); ++rep)
          pg8::gemm_phase<pg8::EpiSwiGLU, pg8::StaticOrder, true, true>(lds, g, S, E, wave);
        }
        GBAR();
        { pg8::Gemm g{(const bf16*)(WSP() + WS_ACT), (const bf16*)(WL_(l) + W_D), MT, 1024, DFF}; pg8::StaticOrder S; S.init(MT, 1024, G, (int)blockIdx.x);
          pg8::EpiRes E{OUTP(), OUTP(), MOD_(l) + 5 * 1024, 0};
          pg8::gemm_phase<pg8::EpiRes, pg8::StaticOrder, true, true>(lds, g, S, E, wave); }
        GBAR();
        if (l + 1 < NL) { norm_rows(OUTP(), H_(), ARG(4) + (l + 1) * 1024, MOD_(l + 1) + 0 * 1024, MOD_(l + 1) + 1 * 1024, gw, NGW, LANE_); GBAR(); }
        else final_rows(OUTP(), ARG(22), gw, NGW, LANE_);
    }
}

extern "C" void kernel_launch(void* const* d_in, const int* in_sizes, int n_in, void* d_out, int out_size, void* d_ws, size_t ws_size, hipStream_t stream) {
    static int grid = 0;
    if (grid == 0) {
        if (n_in != 23 || out_size != MT * DM || ws_size < WS_END) { fprintf(stderr, "kernel_launch: unexpected shapes (n_in %d out %d ws %zu)\n", n_in, out_size, ws_size); grid = -1; return; }
        int dev = 0, cus = 0, per_cu = 0;
        if (hipGetDevice(&dev) != hipSuccess || hipDeviceGetAttribute(&cus, hipDeviceAttributeMultiprocessorCount, dev) != hipSuccess) { grid = -1; return; }
        if (hipFuncSetAttribute((const void*)fwd, hipFuncAttributeMaxDynamicSharedMemorySize, LDS_BYTES) != hipSuccess) { fprintf(stderr, "kernel_launch: hipFuncSetAttribute failed\n"); grid = -1; return; }
        if (hipOccupancyMaxActiveBlocksPerMultiprocessor(&per_cu, (const void*)fwd, NTHREADS, LDS_BYTES) != hipSuccess || per_cu < 1) { fprintf(stderr, "kernel_launch: occupancy query says %d\n", per_cu); }
        (void)hipGetLastError();
        grid = cus;
    }
    if (grid < 0) return;
    (void)hipMemsetAsync((char*)d_ws + WS_CTL, 0, CTL_ZERO_BYTES, stream);
    Args a{};
    for (int i = 0; i < 23; ++i) a.in[i] = (const float*)d_in[i];
    a.out = (float*)d_out; a.ws = (unsigned char*)d_ws; a.pad0 = 0; a.pad1 = 0;
    hipLaunchKernelGGL(fwd, dim3(grid), dim3(NTHREADS), LDS_BYTES, stream, a);
}
```
